# Optimizing an MI355X kernel written in HIP

```python
import math
import jax, jax.numpy as jnp
from jax import lax
import numpy as np

D_MODEL = 2048
BATCH = 4
SEQ = 2048
DEPTH = 2

N_MIXERS = 2
ATT_HEADS = 16
ATT_KV_HEADS = 4
ATT_HEAD_DIM = D_MODEL // ATT_HEADS
IDX_HEADS = 16
IDX_HEAD_DIM = 64
TOPK_MAX = 256
Q_BLOCK = 128
ML_HEADS = 8
ML_V_DIM = D_MODEL // ML_HEADS
ML_QK_DIM = ML_V_DIM // 2
ML_CHUNK = 64
GATE_SOFTCAP = 15.0
D_FF = 4 * D_MODEL
ROPE_THETA = 500000.0
ROT_FRAC = 4
EPS = 1e-6

N_ATT_LAYERS = (DEPTH + 1) // 2
N_ML_LAYERS = DEPTH // 2

ATT_SIZES = [ATT_HEADS * ATT_HEAD_DIM, ATT_KV_HEADS * ATT_HEAD_DIM, ATT_KV_HEADS * ATT_HEAD_DIM,
             IDX_HEADS * IDX_HEAD_DIM, IDX_HEAD_DIM, IDX_HEADS]
ATT_IN = sum(ATT_SIZES)
ML_SIZES = [ML_HEADS * ML_QK_DIM, ML_HEADS * ML_QK_DIM, ML_HEADS * ML_V_DIM, D_MODEL, ML_HEADS, ML_HEADS]
ML_IN = sum(ML_SIZES)

kernel_name = "hybrid_dsa_mlstm_trunk"


def _split_points(sizes):
    return np.cumsum(sizes)[:-1].tolist()


def rms_norm(x, g):
    xf = x.astype(jnp.float32)
    y = xf * lax.rsqrt(jnp.mean(xf * xf, axis=-1, keepdims=True) + EPS)
    return (y * g.astype(jnp.float32)).astype(x.dtype)


def rope_partial(x, pos):
    rot = x.shape[-1] // ROT_FRAC
    half = rot // 2
    inv_freq = ROPE_THETA ** (-2.0 * jnp.arange(half, dtype=jnp.float32) / rot)
    ang = pos.astype(jnp.float32)[:, None] * inv_freq[None, :]
    cos = jnp.cos(ang)[:, None, :]
    sin = jnp.sin(ang)[:, None, :]
    xf = x.astype(jnp.float32)
    x1 = xf[..., :half]
    x2 = xf[..., half:rot]
    out = jnp.concatenate([x1 * cos - x2 * sin, x1 * sin + x2 * cos, xf[..., rot:]], axis=-1)
    return out.astype(x.dtype)


def dsa_attention(h, w_in, q_gain, k_gain, w_out):
    B, T, _ = h.shape
    H, G, Dh = ATT_HEADS, ATT_KV_HEADS, ATT_HEAD_DIM
    R = H // G
    Hi, Di = IDX_HEADS, IDX_HEAD_DIM
    proj = h @ w_in
    q, k, v, qi, ki, wi = jnp.split(proj, _split_points(ATT_SIZES), axis=-1)
    pos = jnp.arange(T)
    q = rope_partial(rms_norm(q.reshape(B, T, H, Dh), q_gain), pos)
    k = rope_partial(rms_norm(k.reshape(B, T, G, Dh), k_gain), pos)
    v = v.reshape(B, T, G, Dh)
    qi = rope_partial(qi.reshape(B, T, Hi, Di), pos)
    ki = rope_partial(ki.reshape(B, T, 1, Di), pos)[:, :, 0].astype(jnp.float32)
    wi = wi.astype(jnp.float32) * (Hi ** -0.5 * Di ** -0.5)
    topk = min(TOPK_MAX, T // 4)
    nb = T // Q_BLOCK

    def to_blocks(a):
        return jnp.moveaxis(a.reshape((B, nb, Q_BLOCK) + a.shape[2:]), 1, 0)

    key_pos = jnp.arange(T)

    def block_fn(args):
        q_b, qi_b, wi_b, t0 = args
        tpos = t0 + jnp.arange(Q_BLOCK)
        dots = jnp.einsum('bthd,bsd->bths', qi_b.astype(jnp.float32), ki)
        score = jnp.einsum('bths,bth->bts', jax.nn.relu(dots), wi_b)
        causal = key_pos[None, :] <= tpos[:, None]
        score = jnp.where(causal[None], score, -jnp.inf)
        _, idx = lax.top_k(score, topk)
        valid = idx <= tpos[None, :, None]
        k_sel = jax.vmap(lambda kb, ib: kb[ib])(k, idx).astype(jnp.float32)
        v_sel = jax.vmap(lambda vb, ib: vb[ib])(v, idx).astype(jnp.float32)
        qg = q_b.reshape(B, Q_BLOCK, G, R, Dh).astype(jnp.float32)
        logits = jnp.einsum('btgrd,btkgd->btgrk', qg, k_sel) * (Dh ** -0.5)
        logits = jnp.where(valid[:, :, None, None, :], logits, -jnp.inf)
        p = jax.nn.softmax(logits, axis=-1)
        o = jnp.einsum('btgrk,btkgd->btgrd', p, v_sel)
        return o.reshape(B, Q_BLOCK, H * Dh).astype(h.dtype)

    starts = jnp.arange(nb, dtype=jnp.int32) * Q_BLOCK
    out = lax.map(block_fn, (to_blocks(q), to_blocks(qi), to_blocks(wi), starts))
    out = jnp.moveaxis(out, 0, 1).reshape(B, T, H * Dh)
    return out @ w_out


def mlstm_chunkwise(q, k, v, ig, logf):
    B, H, T, dk = q.shape
    dv = v.shape[-1]
    L = ML_CHUNK
    NC = T // L
    q = q.reshape(B, H, NC, L, dk)
    k = k.reshape(B, H, NC, L, dk)
    v = v.reshape(B, H, NC, L, dv)
    ig = ig.reshape(B, H, NC, L)
    b = jnp.cumsum(logf.reshape(B, H, NC, L), axis=-1)
    a = b[..., -1]
    g = a[..., None] - b + ig
    m_loc = jnp.max(g, axis=-1)
    wgt = jnp.exp(g - m_loc[..., None])
    C_loc = jnp.einsum('bhcl,bhcld,bhcle->bhcde', wgt, k, v)
    n_loc = jnp.einsum('bhcl,bhcld->bhcd', wgt, k)

    def step(carry, xs):
        C, n, m = carry
        a_c, m_c, C_c, n_c = xs
        m_new = jnp.maximum(a_c + m, m_c)
        s_old = jnp.exp(a_c + m - m_new)
        s_new = jnp.exp(m_c - m_new)
        C2 = s_old[..., None, None] * C + s_new[..., None, None] * C_c
        n2 = s_old[..., None] * n + s_new[..., None] * n_c
        return (C2, n2, m_new), (C, n, m)

    init = (jnp.zeros((B, H, dk, dv), jnp.float32), jnp.zeros((B, H, dk), jnp.float32),
            jnp.zeros((B, H), jnp.float32))
    xs = (jnp.moveaxis(a, 2, 0), jnp.moveaxis(m_loc, 2, 0), jnp.moveaxis(C_loc, 2, 0), jnp.moveaxis(n_loc, 2, 0))
    _, (C_st, n_st, m_st) = lax.scan(step, init, xs)
    C_st = jnp.moveaxis(C_st, 0, 2)
    n_st = jnp.moveaxis(n_st, 0, 2)
    m_st = jnp.moveaxis(m_st, 0, 2)

    causal = jnp.tril(jnp.ones((L, L), dtype=bool))
    Dm = b[..., :, None] - b[..., None, :] + ig[..., None, :]
    Dm = jnp.where(causal, Dm, -jnp.inf)
    inter = b + m_st[..., None]
    m_t = jnp.maximum(inter, jnp.max(Dm, axis=-1))
    S = jnp.einsum('bhcld,bhcsd->bhcls', q, k) * jnp.exp(Dm - m_t[..., None])
    s_inter = jnp.exp(inter - m_t)
    num = jnp.einsum('bhcls,bhcse->bhcle', S, v) + s_inter[..., None] * jnp.einsum('bhcld,bhcde->bhcle', q, C_st)
    den = jnp.sum(S, axis=-1) + s_inter * jnp.einsum('bhcld,bhcd->bhcl', q, n_st)
    h_t = num / jnp.maximum(jnp.abs(den), jnp.exp(-m_t))[..., None]
    return h_t.reshape(B, H, T, dv)


def mlstm_mixer(h, w_in, b_gate, h_gain, w_out):
    B, T, _ = h.shape
    Hm, dk, dv = ML_HEADS, ML_QK_DIM, ML_V_DIM
    proj = h @ w_in
    q, k, v, o, ig, fg = jnp.split(proj, _split_points(ML_SIZES), axis=-1)
    q = q.reshape(B, T, Hm, dk).transpose(0, 2, 1, 3).astype(jnp.float32)
    k = k.reshape(B, T, Hm, dk).transpose(0, 2, 1, 3).astype(jnp.float32) * (dk ** -0.5)
    v = v.reshape(B, T, Hm, dv).transpose(0, 2, 1, 3).astype(jnp.float32)
    gates = jnp.concatenate([ig, fg], axis=-1).astype(jnp.float32) + b_gate.astype(jnp.float32)
    gates = GATE_SOFTCAP * jnp.tanh(gates / GATE_SOFTCAP)
    ig_pre = gates[..., :Hm].transpose(0, 2, 1)
    logf = jax.nn.log_sigmoid(gates[..., Hm:]).transpose(0, 2, 1)
    h_t = mlstm_chunkwise(q, k, v, ig_pre, logf)
    h_t = rms_norm(h_t, h_gain)
    h_t = h_t.transpose(0, 2, 1, 3).reshape(B, T, Hm * dv).astype(h.dtype)
    return (jax.nn.sigmoid(o) * h_t) @ w_out


def setup_inputs(seed: int = 0) -> dict:
    key = jax.random.key(seed)
    ks = jax.random.split(key, 16)

    def nrm(k, shape, scale):
        return jax.random.normal(k, shape, jnp.float32) * scale

    Hm = ML_HEADS
    b_in = nrm(ks[9], (N_ML_LAYERS, Hm), 0.1)
    b_f = 3.0 + nrm(ks[10], (N_ML_LAYERS, Hm), 0.1)
    return {
        "x": nrm(ks[0], (BATCH, SEQ, D_MODEL), 1.0),
        "norm_mix": 1.0 + nrm(ks[1], (DEPTH, D_MODEL), 0.1),
        "norm_ffn": 1.0 + nrm(ks[2], (DEPTH, D_MODEL), 0.1),
        "att_w_in": nrm(ks[3], (N_ATT_LAYERS, D_MODEL, ATT_IN), D_MODEL ** -0.5),
        "att_q_gain": 1.0 + nrm(ks[4], (N_ATT_LAYERS, ATT_HEAD_DIM), 0.1),
        "att_k_gain": 1.0 + nrm(ks[5], (N_ATT_LAYERS, ATT_HEAD_DIM), 0.1),
        "att_w_out": nrm(ks[6], (N_ATT_LAYERS, ATT_HEADS * ATT_HEAD_DIM, D_MODEL), (ATT_HEADS * ATT_HEAD_DIM) ** -0.5),
        "ml_w_in": nrm(ks[7], (N_ML_LAYERS, D_MODEL, ML_IN), D_MODEL ** -0.5),
        "ml_b_gate": jnp.concatenate([b_in, b_f], axis=-1),
        "ml_h_gain": 1.0 + nrm(ks[11], (N_ML_LAYERS, ML_V_DIM), 0.1),
        "ml_w_out": nrm(ks[12], (N_ML_LAYERS, ML_HEADS * ML_V_DIM, D_MODEL), (ML_HEADS * ML_V_DIM) ** -0.5),
        "ffn_w_up": nrm(ks[13], (DEPTH, D_MODEL, D_FF), D_MODEL ** -0.5),
        "ffn_w_down": nrm(ks[14], (DEPTH, D_FF, D_MODEL), D_FF ** -0.5),
    }


def reference(x, norm_mix, norm_ffn, att_w_in, att_q_gain, att_k_gain, att_w_out,
              ml_w_in, ml_b_gate, ml_h_gain, ml_w_out, ffn_w_up, ffn_w_down):
    h = x
    for i in range(DEPTH):
        j = i // N_MIXERS
        hn = rms_norm(h, norm_mix[i])
        if i % N_MIXERS == 0:
            y = dsa_attention(hn, att_w_in[j], att_q_gain[j], att_k_gain[j], att_w_out[j])
        else:
            y = mlstm_mixer(hn, ml_w_in[j], ml_b_gate[j], ml_h_gain[j], ml_w_out[j])
        h = h + y
        hn = rms_norm(h, norm_ffn[i])
        h = h + jnp.square(jax.nn.relu(hn @ ffn_w_up[i])) @ ffn_w_down[i]
    return h
```

```cpp
#ifndef MK_MULTI
#define MK_MULTI 0
#endif
#ifndef ORA_IDX
#define ORA_IDX 0
#endif
#ifndef ORA_ATT
#define ORA_ATT 0
#endif
#ifndef ORA_ML
#define ORA_ML 0
#endif
#ifndef PROBE_DBL
#define PROBE_DBL (-1)
#endif
#include <hip/hip_runtime.h>
#include <cstdio>
#include <cstdint>
#include <cmath>
__device__ __forceinline__ int opaque_tid() { int t = threadIdx.x; asm volatile("" : "+v"(t)); return t; }
namespace pg8 {
#define PG8_LAS __attribute__((address_space(3)))
typedef unsigned short bf16_t;
typedef short bf16x8 __attribute__((ext_vector_type(8)));
typedef float f32x4 __attribute__((ext_vector_type(4)));
typedef unsigned u32x4 __attribute__((ext_vector_type(4)));
constexpr int BM = 256, BK = 64, HALF = 128, HTB = HALF * BK * 2  , STAGE_BYTES = 8 * HTB, NXCD = 8, WGM = 2;

__host__ __device__ __forceinline__ int lds_byte(int r, int c) { const int st = (r >> 4) * 2 + (c >> 5), rr = r & 15, cc = c & 31, ob = rr * 64 + cc * 2; return st * 1024 + (ob ^ (((ob >> 9) & 1) << 5)); }
__host__ __device__ __forceinline__ void stage_rc(int b, int& R, int& C) { const int st = b / 1024, sb = b % 1024, swz = sb ^ (((sb >> 9) & 1) << 5); R = (st >> 1) * 16 + swz / 64; C = (st & 1) * 32 + (swz % 64) / 2; }
__host__ __device__ __forceinline__ int perm32(int rho) { const int n = rho >> 4, i = rho & 15; return 8 * (i >> 2) + 4 * n + (i & 3); }

struct Unit { int pm, pn; };
struct Gemm { const bf16_t* A; const bf16_t* Bt; int M, N, K; };

struct StaticOrder {
    int nM, nN, nwg, G, c;
    __host__ __device__ void init(int M, int N, int G_, int c_) { nM = M / BM; nN = N / BM; nwg = nM * nN; G = G_; c = c_; }
    __host__ __device__ bool next(int i, Unit& u) const {
        const long L = (long)i * G + c; if (L >= nwg) return false;
        int wgid = (int)L; { const int q = nwg / NXCD, r = nwg % NXCD, xcd = wgid % NXCD, off = wgid / NXCD; wgid = (xcd < r ? xcd * (q + 1) : r * (q + 1) + (xcd - r) * q) + off; }
        const int nig = WGM * nN, gid = wgid / nig, fm = gid * WGM, gsz = (nM - fm) < WGM ? (nM - fm) : WGM;
        u.pm = fm + ((wgid % nig) % gsz); u.pn = (wgid % nig) / gsz; return true;
    }
    __device__ __forceinline__ void a_ready(const Unit&) const {}
    __device__ __forceinline__ void done(const Unit&) const {}
};

__device__ __forceinline__ unsigned cvt_pk_bf16(float lo, float hi) { unsigned r; asm volatile("v_cvt_pk_bf16_f32 %0, %1, %2" : "=v"(r) : "v"(lo), "v"(hi)); return r; }
typedef float f32x2 __attribute__((ext_vector_type(2)));
typedef unsigned u32x2 __attribute__((ext_vector_type(2)));
template <int MODE> struct EpiScale {
    static constexpr bool PERM = true, AFTER_DRAIN = false;
    bf16_t* O; int ldc; const float* ss; float inv_n, eps;
    __device__ __forceinline__ void operator()(const f32x4 (&acc)[2][2][4][2], const Unit& u, int wr, int wc, int fr, int fq) const {
        const int row0 = u.pm * BM + wr * 64 + fr, col0 = u.pn * BM + wc * 64 + 8 * fq;
#pragma unroll
        for (int ai = 0; ai < 2; ++ai)
#pragma unroll
            for (int m = 0; m < 4; ++m) { const int row = row0 + ai * HALF + m * 16; const float rs = __builtin_amdgcn_rsqf(ss[row] * inv_n + eps); const float rs2 = rs * rs;
                bf16_t* rowp = O + (size_t)row * ldc + col0;
#pragma unroll
                for (int bj = 0; bj < 2; ++bj) { f32x4 v0 = acc[ai][bj][m][0], v1 = acc[ai][bj][m][1];
                    if (MODE == 0) { v0 = v0 * rs; v1 = v1 * rs; }
                    else { v0 = __builtin_elementwise_max(v0, (f32x4){0.f, 0.f, 0.f, 0.f}); v1 = __builtin_elementwise_max(v1, (f32x4){0.f, 0.f, 0.f, 0.f}); v0 = v0 * v0 * rs2; v1 = v1 * v1 * rs2; }
                    u32x4 w; w.x = cvt_pk_bf16(v0[0], v0[1]); w.y = cvt_pk_bf16(v0[2], v0[3]); w.z = cvt_pk_bf16(v1[0], v1[1]); w.w = cvt_pk_bf16(v1[2], v1[3]);
                    *(u32x4*)(rowp + bj * 32) = w; } }
    }
};
struct EpiRes {
    static constexpr bool PERM = true, AFTER_DRAIN = false;
    const bf16_t* base; bf16_t* hb; float* outf; float* ss; int ldc;
    __device__ __forceinline__ void operator()(const f32x4 (&acc)[2][2][4][2], const Unit& u, int wr, int wc, int fr, int fq) const {
        const int col0 = u.pn * BM + wc * 64 + 8 * fq;
#pragma unroll
        for (int ai = 0; ai < 2; ++ai)
#pragma unroll
            for (int m = 0; m < 4; ++m) { const int row = u.pm * BM + ai * HALF + wr * 64 + m * 16 + fr; const size_t off = (size_t)row * ldc + col0; float s = 0.f;
#pragma unroll
                for (int bj = 0; bj < 2; ++bj) { const u32x4 bw = *(const u32x4*)(base + off + bj * 32);
                    const f32x4 b0 = {__builtin_bit_cast(float, bw.x << 16), __builtin_bit_cast(float, bw.x & 0xffff0000u), __builtin_bit_cast(float, bw.y << 16), __builtin_bit_cast(float, bw.y & 0xffff0000u)};
                    const f32x4 b1 = {__builtin_bit_cast(float, bw.z << 16), __builtin_bit_cast(float, bw.z & 0xffff0000u), __builtin_bit_cast(float, bw.w << 16), __builtin_bit_cast(float, bw.w & 0xffff0000u)};
                    const f32x4 o0 = b0 + acc[ai][bj][m][0], o1 = b1 + acc[ai][bj][m][1];
                    if (outf) { *(f32x4*)(outf + off + bj * 32) = o0; *(f32x4*)(outf + off + bj * 32 + 4) = o1; }
                    else { u32x4 w; w.x = cvt_pk_bf16(o0[0], o0[1]); w.y = cvt_pk_bf16(o0[2], o0[3]); w.z = cvt_pk_bf16(o1[0], o1[1]); w.w = cvt_pk_bf16(o1[2], o1[3]); *(u32x4*)(hb + off + bj * 32) = w;
                        s += ((o0[0] * o0[0] + o0[1] * o0[1]) + (o0[2] * o0[2] + o0[3] * o0[3])) + ((o1[0] * o1[0] + o1[1] * o1[1]) + (o1[2] * o1[2] + o1[3] * o1[3])); } }
                if (!outf) { s += __shfl_xor(s, 16); s += __shfl_xor(s, 32); if (fq == 0) atomicAdd(ss + row, s); }
                asm volatile("" ::: "memory"); }
    }
};
struct EpiNull {
    static constexpr bool PERM = false, AFTER_DRAIN = false;
    __device__ __forceinline__ void operator()(const f32x4 (&acc)[2][2][4][2], const Unit&, int, int, int, int) const {
#pragma unroll
        for (int ai = 0; ai < 2; ++ai)
#pragma unroll
            for (int bj = 0; bj < 2; ++bj)
#pragma unroll
                for (int m = 0; m < 4; ++m)
#pragma unroll
                    for (int n = 0; n < 2; ++n) asm volatile("" :: "v"(acc[ai][bj][m][n]));
    }
};
template <class Epi, class Sched, bool ALIGN_EPI = false, bool SP2 = false>
__device__ __forceinline__ void gemm_phase(PG8_LAS unsigned char* lds, const Gemm g, const Sched& S, const Epi& E) {
    const int tid = opaque_tid(), wid = __builtin_amdgcn_readfirstlane(tid >> 6), lane = tid & 63, wr = wid >> 2, wc = wid & 3, fr = lane & 15, fq = lane >> 4;
    const int K = g.K, nt = K / BK;
    unsigned voffA[2], voffB[2];
#pragma unroll
    for (int i = 0; i < 2; ++i) { int R, C; stage_rc(tid * 16 + i * 8192, R, C); const int Rb = Epi::PERM ? (64 * (R >> 5) + perm32(R & 31)) : R;
        voffA[i] = (unsigned)(R * K + C) * 2u; voffB[i] = (unsigned)(Rb * K + C) * 2u; }
    const size_t kstep = (size_t)(BK * 2);
    const size_t hstep = (size_t)HALF * K * 2;
    const size_t hstepB = Epi::PERM ? (size_t)32 * K * 2 : hstep;
    const size_t tstep = 2 * hstep;
    const unsigned ldsw = (unsigned)wid * 1024u;
    const int aoff = lds_byte(wr * 64 + fr, fq * 8), boff = lds_byte(wc * 32 + fr, fq * 8);
#define PG8_SA(b, h) (((b) * 2 + (h)) * HTB)
#define PG8_SB(b, h) ((4 + (b) * 2 + (h)) * HTB)
#define PG8_STAGE(bufoff, gbase, voff) do { _Pragma("unroll") for (int _i = 0; _i < 2; ++_i) \
        __builtin_amdgcn_global_load_lds((const unsigned*)((const char*)(gbase) + (voff)[_i]), (PG8_LAS unsigned*)(lds + (bufoff) + ldsw + _i * 8192), 16, 0, 0); } while (0)
#define PG8_LDA(dst, b, h) do { _Pragma("unroll") for (int m = 0; m < 4; ++m) _Pragma("unroll") for (int k = 0; k < 2; ++k) dst[m][k] = *(const PG8_LAS bf16x8*)(lds + PG8_SA(b, h) + aoff + m * 2048 + k * 1024); } while (0)
#define PG8_LDB(dst, b, h) do { _Pragma("unroll") for (int n = 0; n < 2; ++n) _Pragma("unroll") for (int k = 0; k < 2; ++k) dst[n][k] = *(const PG8_LAS bf16x8*)(lds + PG8_SB(b, h) + boff + n * 2048 + k * 1024); } while (0)
#define PG8_MMA(ai, bj, At, Bt) do { __builtin_amdgcn_s_setprio(1); _Pragma("unroll") for (int m = 0; m < 4; ++m) _Pragma("unroll") for (int n = 0; n < 2; ++n) _Pragma("unroll") for (int k = 0; k < 2; ++k) \
        acc[ai][bj][m][n] = __builtin_amdgcn_mfma_f32_16x16x32_bf16(Bt[n][k], At[m][k], acc[ai][bj][m][n], 0, 0, 0); __builtin_amdgcn_s_setprio(0); } while (0)
#define PG8_WAIT_V(n) asm volatile("s_waitcnt vmcnt(" #n ")" ::: "memory")
#define PG8_WAIT_L(n) asm volatile("s_waitcnt lgkmcnt(" #n ")" ::: "memory")
#define PG8_BAR __builtin_amdgcn_s_barrier()
#define PG8_SCHED __builtin_amdgcn_sched_barrier(0)
    Unit cur, nxt; int ui = 0;
    if (!S.next(0, cur)) return;
    f32x4 acc[2][2][4][2];
#pragma unroll
    for (int a = 0; a < 2; ++a)
#pragma unroll
        for (int b = 0; b < 2; ++b)
#pragma unroll
            for (int m = 0; m < 4; ++m)
#pragma unroll
                for (int n = 0; n < 2; ++n) acc[a][b][m][n] = (f32x4){0.f, 0.f, 0.f, 0.f};
    bf16x8 At[4][2], B0[2][2], B1[2][2];
    const char* cA = (const char*)g.A + (size_t)cur.pm * tstep; const char* cB = (const char*)g.Bt + (size_t)cur.pn * tstep;
    S.a_ready(cur);
    if constexpr (SP2) {
        PG8_STAGE(PG8_SB(0, 0), cB, voffB); PG8_STAGE(PG8_SB(0, 1), cB + hstepB, voffB); PG8_STAGE(PG8_SA(0, 0), cA, voffA); PG8_STAGE(PG8_SA(0, 1), cA + hstep, voffA);
        if (wr == 1) PG8_BAR;
        PG8_WAIT_V(2); PG8_BAR;
        PG8_STAGE(PG8_SB(1, 0), cB + kstep, voffB); PG8_STAGE(PG8_SA(1, 0), cA + kstep, voffA); PG8_STAGE(PG8_SB(1, 1), cB + hstepB + kstep, voffB);
        PG8_WAIT_V(6); PG8_BAR;
    } else {
        PG8_STAGE(PG8_SB(0, 0), cB, voffB); PG8_STAGE(PG8_SA(0, 0), cA, voffA); PG8_STAGE(PG8_SB(0, 1), cB + hstepB, voffB); PG8_STAGE(PG8_SA(0, 1), cA + hstep, voffA);
        if (wr == 1) PG8_BAR;
        PG8_WAIT_V(4); PG8_BAR;
        PG8_STAGE(PG8_SB(1, 0), cB + kstep, voffB); PG8_STAGE(PG8_SA(1, 0), cA + kstep, voffA); PG8_STAGE(PG8_SB(1, 1), cB + hstepB + kstep, voffB);
        PG8_WAIT_V(6); PG8_BAR;
    }
    for (;;) {
        const bool has_next = S.next(ui + 1, nxt);
        const char* nA = has_next ? (const char*)g.A + (size_t)nxt.pm * tstep : cA; const char* nB = has_next ? (const char*)g.Bt + (size_t)nxt.pn * tstep : cB;
        for (int t = 0; t < nt; t += 2) {
            const bool last = (t == nt - 2);
            const char* a1 = cA + (size_t)(t + 1) * kstep;
            const char* a2 = last ? nA : cA + (size_t)(t + 2) * kstep; const char* b2 = last ? nB : cB + (size_t)(t + 2) * kstep;
            const char* a3 = a2 + kstep; const char* b3 = b2 + kstep;
            if (last && has_next) S.a_ready(nxt);
            if constexpr (SP2) {
            PG8_LDB(B0, 0, 0); PG8_LDB(B1, 0, 1); PG8_SCHED; PG8_LDA(At, 0, 0); PG8_STAGE(PG8_SA(1, 1), a1 + hstep, voffA);
            PG8_WAIT_V(8); PG8_WAIT_L(0); PG8_BAR; PG8_MMA(0, 0, At, B0); PG8_MMA(0, 1, At, B1); PG8_BAR; PG8_SCHED;
            PG8_LDA(At, 0, 1); PG8_STAGE(PG8_SB(0, 0), b2, voffB); PG8_STAGE(PG8_SB(0, 1), b2 + hstepB, voffB); PG8_STAGE(PG8_SA(0, 0), a2, voffA);
            PG8_WAIT_V(8); PG8_WAIT_L(0); PG8_BAR; PG8_MMA(1, 0, At, B0); PG8_MMA(1, 1, At, B1); PG8_BAR; PG8_SCHED;
            PG8_LDB(B0, 1, 0); PG8_LDB(B1, 1, 1); PG8_SCHED; PG8_LDA(At, 1, 0); PG8_STAGE(PG8_SA(0, 1), a2 + hstep, voffA);
            PG8_WAIT_V(8); PG8_WAIT_L(0); PG8_BAR; PG8_MMA(0, 0, At, B0); PG8_MMA(0, 1, At, B1); PG8_BAR; PG8_SCHED;
            PG8_LDA(At, 1, 1); PG8_STAGE(PG8_SB(1, 0), b3, voffB); PG8_STAGE(PG8_SB(1, 1), b3 + hstepB, voffB); PG8_STAGE(PG8_SA(1, 0), a3, voffA);
            PG8_WAIT_V(8); PG8_WAIT_L(0); PG8_BAR; PG8_MMA(1, 0, At, B0); PG8_MMA(1, 1, At, B1); PG8_BAR; PG8_SCHED;
            } else {
            PG8_LDB(B0, 0, 0); PG8_SCHED; PG8_LDA(At, 0, 0); PG8_STAGE(PG8_SA(1, 1), a1 + hstep, voffA);
            PG8_WAIT_L(8); PG8_BAR; PG8_WAIT_L(0); PG8_MMA(0, 0, At, B0); PG8_BAR; PG8_SCHED;
            PG8_LDB(B1, 0, 1); PG8_STAGE(PG8_SB(0, 0), b2, voffB);
            PG8_BAR; PG8_WAIT_L(0); PG8_MMA(0, 1, At, B1); PG8_BAR;
            PG8_LDA(At, 0, 1); PG8_STAGE(PG8_SA(0, 0), a2, voffA);
            PG8_BAR; PG8_WAIT_L(0); PG8_MMA(1, 0, At, B0); PG8_BAR; PG8_SCHED;
            PG8_STAGE(PG8_SB(0, 1), b2 + hstepB, voffB);
            PG8_WAIT_V(6); PG8_BAR; PG8_MMA(1, 1, At, B1); PG8_BAR;
            PG8_LDB(B0, 1, 0); PG8_SCHED; PG8_LDA(At, 1, 0); PG8_STAGE(PG8_SA(0, 1), a2 + hstep, voffA);
            PG8_WAIT_L(8); PG8_BAR; PG8_WAIT_L(0); PG8_MMA(0, 0, At, B0); PG8_BAR; PG8_SCHED;
            PG8_LDB(B1, 1, 1); PG8_STAGE(PG8_SB(1, 0), b3, voffB);
            PG8_BAR; PG8_WAIT_L(0); PG8_MMA(0, 1, At, B1); PG8_BAR;
            PG8_LDA(At, 1, 1); PG8_STAGE(PG8_SA(1, 0), a3, voffA);
            PG8_BAR; PG8_WAIT_L(0); PG8_MMA(1, 0, At, B0); PG8_BAR; PG8_SCHED;
            PG8_STAGE(PG8_SB(1, 1), b3 + hstepB, voffB);
            PG8_WAIT_V(6); PG8_BAR; PG8_MMA(1, 1, At, B1); PG8_BAR;
            }
        }
        if constexpr (ALIGN_EPI) { if (wr == 0) PG8_BAR; }
        if constexpr (!Epi::AFTER_DRAIN) { E(acc, cur, wr, wc, fr, fq); S.done(cur); }
        if (!has_next) break;
#pragma unroll
        for (int a = 0; a < 2; ++a)
#pragma unroll
            for (int b = 0; b < 2; ++b)
#pragma unroll
                for (int m = 0; m < 4; ++m)
#pragma unroll
                    for (int n = 0; n < 2; ++n) acc[a][b][m][n] = (f32x4){0.f, 0.f, 0.f, 0.f};
        cur = nxt; cA = nA; cB = nB; ++ui;
        if constexpr (ALIGN_EPI) { if (wr == 1) PG8_BAR; }
    }
    PG8_WAIT_V(0);
    if constexpr (!ALIGN_EPI) { if (wr == 0) PG8_BAR; }
    PG8_BAR;
    if constexpr (Epi::AFTER_DRAIN) { E.fused(acc, cur, wr, wc, fr, fq, lds, wid, lane); S.done(cur); }
#undef PG8_SA
#undef PG8_SB
#undef PG8_STAGE
#undef PG8_LDA
#undef PG8_LDB
#undef PG8_MMA
#undef PG8_WAIT_V
#undef PG8_WAIT_L
#undef PG8_BAR
#undef PG8_SCHED
}
}
#ifndef PG8_SP2
#define PG8_SP2 true
#endif
#ifndef PG8_ALIGN
#define PG8_ALIGN true
#endif
constexpr int NWAVES = 8, NTHR = NWAVES * 64;
#ifndef MK_MULTI
#define MK_MULTI 0
#endif
#ifndef ORA_IDX
#define ORA_IDX 0
#endif
#ifndef ORA_ATT
#define ORA_ATT 0
#endif
#ifndef ORA_ML
#define ORA_ML 0
#endif
constexpr int N_PHASES = 15;
#ifndef ML_CHAIN
#define ML_CHAIN 1
#endif
constexpr int BATCH = 4, T = 2048, DM = 2048, M = BATCH * T, FF = 8192;
constexpr int AH = 16, AG = 4, HD = 128, IH = 16, IDIM = 64, TOPK = 256;
constexpr int ATT_IN = 4176, ATT_N = 4096, SM_N = 80;
constexpr int C_Q = 0, C_K = 2048, C_V = 2560, C_QI = 3072;
constexpr int MH = 8, MDK = 128, MDV = 256, ML_IN = 6160, ML_N = 6144;
constexpr int C_MQ = 0, C_MK = 1024, C_MV = 2048, C_MO = 4096;
constexpr float EPS = 1e-6f, GATE_CAP = 15.0f;
constexpr size_t MiB = 1u << 20;
constexpr size_t WS_CTL = 0, CTL_ZERO_BYTES = 320 * 1024;
constexpr size_t WS_WIN = 1 * MiB, WS_WSM = 17 * MiB, WS_WO = 18 * MiB, WS_WML = 26 * MiB, WS_WG = 50 * MiB, WS_WMO = 51 * MiB;
constexpr size_t WS_WUP0 = 59 * MiB, WS_WUP1 = 91 * MiB, WS_WDN0 = 123 * MiB, WS_WDN1 = 155 * MiB;
constexpr size_t WS_XB = 188 * MiB, WS_PROJ = 220 * MiB, WS_Q = 316 * MiB, WS_K = 348 * MiB, WS_QI = 356 * MiB, WS_KI = 372 * MiB, WS_WI = 373 * MiB, WS_MASK = 374 * MiB;
constexpr size_t WS_GATE = 376 * MiB, WS_ROPE = 377 * MiB, WS_SC = 380 * MiB, WS_O = 444 * MiB, WS_V = 476 * MiB, WS_ML = 484 * MiB, WS_END = 486 * MiB;
constexpr size_t WS_H = 220 * MiB;
static_assert(WS_H + (size_t)M * FF * 2 <= WS_K && WS_PROJ + (size_t)M * ML_N * 2 <= WS_Q && WS_SC + (size_t)BATCH * T * T * 4 <= WS_O, "d_ws map");
constexpr int CW_TMO = 0, CW_CODE = 1, CW_BAR = 4096, CW_SS = 32768;
constexpr int RING_OFF = 0, RING_BYTES = 143360;
constexpr int LDSCTL_OFF = RING_BYTES, MISC_OFF = LDSCTL_OFF + 320;
constexpr int LDS_BYTES = 147456;
#define GAS __attribute__((address_space(1)))
#define LAS __attribute__((address_space(3)))
typedef unsigned short bf16;
typedef unsigned v4u __attribute__((ext_vector_type(4)));
typedef unsigned v2u __attribute__((ext_vector_type(2)));
typedef float f32x4 __attribute__((ext_vector_type(4)));
typedef float f32x16 __attribute__((ext_vector_type(16)));
typedef float f32x2 __attribute__((ext_vector_type(2)));
typedef short bf16x8 __attribute__((ext_vector_type(8)));
typedef short s16x4 __attribute__((ext_vector_type(4)));
typedef GAS unsigned gu32;
typedef GAS unsigned long long gu64;
typedef unsigned long long u64;
#define RLX_AGENT __ATOMIC_RELAXED, __HIP_MEMORY_SCOPE_AGENT
#define LDS_WAIT() asm volatile("s_waitcnt lgkmcnt(0)" ::: "memory")
#define VM_WAIT() asm volatile("s_waitcnt vmcnt(0)" ::: "memory")
__device__ __forceinline__ unsigned f2bf(float f) { unsigned u = __builtin_bit_cast(unsigned, f); return (u + 0x7fffu + ((u >> 16) & 1u)) >> 16; }
__device__ __forceinline__ unsigned pk2(float lo, float hi) { return f2bf(lo) | (f2bf(hi) << 16); }
__device__ __forceinline__ float bf2f(bf16 h) { return __builtin_bit_cast(float, (unsigned)h << 16); }
__device__ __forceinline__ float bflo(unsigned w) { return __builtin_bit_cast(float, w << 16); }
__device__ __forceinline__ float bfhi(unsigned w) { return __builtin_bit_cast(float, w & 0xffff0000u); }
__device__ __forceinline__ unsigned fkey(float f) { const unsigned u = __builtin_bit_cast(unsigned, f); return (u & 0x80000000u) ? ~u : (u | 0x80000000u); }
#define XB_TMO      128
#define XB_XCNT(j)  (256  + 64 * (j))
#define XB_XSUB(j)  (1280 + 64 * (j))
#define XB_XGEN(j)  (2304 + 64 * (j))
#define XB_TOP      3328
#define XB_TOPGEN   3392
#define XCD_BAR_WORDS 3456
#define XB_SPIN_CAP (1u << 18)

__device__ __forceinline__ unsigned xb_ld(unsigned* p)              { return __hip_atomic_load(p, __ATOMIC_RELAXED, __HIP_MEMORY_SCOPE_AGENT); }
__device__ __forceinline__ unsigned xb_add(unsigned* p, unsigned v) { return __hip_atomic_fetch_add(p, v, __ATOMIC_RELAXED, __HIP_MEMORY_SCOPE_AGENT); }
__device__ __forceinline__ unsigned xb_xcc_id() { return (unsigned)__builtin_amdgcn_s_getreg((3 << 11) | 20) & 0xFu; }
#define XB_SPIN(cond, bar) do { unsigned _sp = 0; while (cond) { __builtin_amdgcn_s_sleep(0); \
    if ((++_sp & 255u) == 0u) { if (xb_ld(&(bar)[XB_TMO])) break; if (_sp > XB_SPIN_CAP) { atomicAdd(&(bar)[XB_TMO], 1u); break; } } } } while (0)

struct XcdBarrier {
    unsigned* bar; unsigned x;
    volatile LAS unsigned* st;
};

__device__ __forceinline__ XcdBarrier xcd_barrier_post(unsigned* bar, volatile LAS unsigned* st) {
    XcdBarrier b; b.bar = bar; b.x = xb_xcc_id(); b.st = st;
    if (threadIdx.x == 0) (void)xb_add(&bar[XB_XCNT(b.x)], 1u);
    return b;
}
__device__ __forceinline__ void xcd_barrier_complete(unsigned* bar, unsigned x, unsigned& nloc, unsigned& nx) {
    const unsigned G = gridDim.x * gridDim.y * gridDim.z;
    unsigned sum, cnt, mine, sp = 0u;
    for (;;) {
        sum = 0u; cnt = 0u; mine = 0u;
#pragma unroll
        for (unsigned j = 0; j < 16; ++j) { const unsigned c = xb_ld(&bar[XB_XCNT(j)]); sum += c; cnt += (c > 0u) ? 1u : 0u; mine = (j == x) ? c : mine; }
        if (sum == G) break;
        __builtin_amdgcn_s_sleep(1);
        if ((++sp & 255u) == 0u) { if (xb_ld(&bar[XB_TMO])) break; if (sp > XB_SPIN_CAP) { atomicAdd(&bar[XB_TMO], 1u); break; } }
    }
    nloc = mine > 0u ? mine : 1u; nx = cnt > 0u ? cnt : 1u;
}

__device__ __forceinline__ void xcd_barrier(const XcdBarrier& b) {
    asm volatile("s_waitcnt vmcnt(0)" ::: "memory");
    __syncthreads();
    if (threadIdx.x == 0) {
        unsigned* bar = b.bar;
        __builtin_amdgcn_s_waitcnt(0);
        unsigned nloc = b.st[0], nx = b.st[1];
        if (nloc == 0u) { xcd_barrier_complete(bar, b.x, nloc, nx); b.st[0] = nloc; b.st[1] = nx; }
        const unsigned old = xb_add(&bar[XB_XSUB(b.x)], 1u);
        const unsigned gen = old / nloc;
        if (old + 1u == (gen + 1u) * nloc) {
            __builtin_amdgcn_fence(__ATOMIC_RELEASE, "agent");
            asm volatile("s_waitcnt vmcnt(0)" ::: "memory");
            const unsigned og = xb_add(&bar[XB_TOP], 1u);
            const unsigned tg = og / nx;
            if (og + 1u == (tg + 1u) * nx) xb_add(&bar[XB_TOPGEN], 1u);
            else XB_SPIN(xb_ld(&bar[XB_TOPGEN]) == tg, bar);
            __builtin_amdgcn_fence(__ATOMIC_ACQUIRE, "agent");
            xb_add(&bar[XB_XGEN(b.x)], 1u);
            asm volatile("s_waitcnt vmcnt(0)" ::: "memory");
        } else {
            XB_SPIN(xb_ld(&bar[XB_XGEN(b.x)]) == gen, bar);
            __builtin_amdgcn_fence(__ATOMIC_ACQUIRE, "agent");
            asm volatile("s_waitcnt vmcnt(0)" ::: "memory");
        }
    }
    __syncthreads();
}
struct Args { const float* in[13]; float* out; unsigned char* ws; int ph_lo, ph_hi, li, pad; };
struct Frame {
    LAS unsigned char* lds;
    volatile LAS unsigned* MISC;
    gu32* ctl;
    int tid, lane, wave, vcu, G;
    const float* x; float* out;
    const float *norm_mix, *norm_ffn, *att_w_in, *q_gain, *k_gain, *att_w_out, *ml_w_in, *b_gate, *h_gain, *ml_w_out, *w_up, *w_dn;
    bf16 *WinT, *WsmT, *WoT, *WmlT, *WgT, *WmoT, *WupT0, *WupT1, *WdnT0, *WdnT1;
    bf16 *XB, *PROJ, *Q, *K, *V, *QI, *KI, *O, *H;
    float *WI, *IG, *LF, *SC, *NST, *SCAL; bf16* ST; f32x2 *ROPE_A, *ROPE_I; u64* MASK;
    float *ss0, *ss1, *ss2, *ss3;
};
__device__ __forceinline__ float wave_sum(float v) {
#pragma unroll
    for (int o = 1; o < 64; o <<= 1) v += __shfl_xor(v, o);
    return v;
}
__device__ __forceinline__ unsigned cvtpk2(float lo, float hi) { unsigned r; asm volatile("v_cvt_pk_bf16_f32 %0, %1, %2" : "=v"(r) : "v"(lo), "v"(hi)); return r; }
template <bool NTS = false> __device__ __forceinline__ void tr_item(const float* W, int ldw, int col0, int nvalid, int nblk, int K, const float* gain, float scale, bf16* WT, LAS float* scr, int item, int lane) {
    const int kb = item / nblk, nb = item - kb * nblk, k0 = 64 * kb, n0 = 32 * nb, nn = n0 + (lane & 31), nc = nn < nvalid ? nn : nvalid - 1, c = lane & 7;
    const GAS float* wp = (const GAS float*)W + (size_t)(k0 + (lane >> 5)) * ldw + col0 + nc;
    float v[32];
#pragma unroll
    for (int i = 0; i < 32; ++i) v[i] = __builtin_nontemporal_load(wp + (size_t)(2 * i) * ldw);
    f32x4 g0 = (f32x4){scale, scale, scale, scale}, g1 = g0;
    if (gain) { g0 = *(const GAS f32x4*)(gain + k0 + 8 * c) * scale; g1 = *(const GAS f32x4*)(gain + k0 + 8 * c + 4) * scale; }
    const bool ok = nn < nvalid;
#pragma unroll
    for (int i = 0; i < 32; ++i) scr[(2 * i + (lane >> 5)) * 33 + (lane & 31)] = ok ? v[i] : 0.f;
    LDS_WAIT(); asm volatile("" ::: "memory");
#pragma unroll
    for (int j = 0; j < 4; ++j) { const int n = (lane >> 3) + 8 * j; const LAS float* s = scr + (8 * c) * 33 + n;
        v4u o; o.x = cvtpk2(s[0 * 33] * g0.x, s[1 * 33] * g0.y); o.y = cvtpk2(s[2 * 33] * g0.z, s[3 * 33] * g0.w); o.z = cvtpk2(s[4 * 33] * g1.x, s[5 * 33] * g1.y); o.w = cvtpk2(s[6 * 33] * g1.z, s[7 * 33] * g1.w);
        if (NTS) __builtin_nontemporal_store(o, (GAS v4u*)(WT + (size_t)(n0 + n) * K + k0 + 8 * c)); else *(GAS v4u*)(WT + (size_t)(n0 + n) * K + k0 + 8 * c) = o; }
    LDS_WAIT(); asm volatile("" ::: "memory");
}
__device__ __forceinline__ void p0_prologue(Frame& F) {
    LAS float* scr = (LAS float*)(F.lds + RING_OFF + F.wave * 16384);
    const int gw = F.vcu * NWAVES + F.wave, NGW = F.G * NWAVES;
    constexpr int I0 = 32 * 128, I1 = 32 * 3, I2 = 32 * 64, I3 = 32 * 256, I4 = 128 * 64, I5 = 32 * 32, I6 = 32 * 32, I7 = 32 * 128, I8 = 32 * 1;
#if ML_CHAIN
    constexpr int I9 = 32 * 64, I10 = I3, I11 = I4, NITEMS = I0 + I1 + I2 + I3 + I4 + I5 + I6 + I7 + I8 + I9 + I10 + I11;
#else
    constexpr int NITEMS = I0 + I1 + I2 + I3 + I4 + I5 + I6 + I7 + I8;
#endif
    constexpr float KSC = 0.08838834764831845f;
    for (int it = gw; it < NITEMS; it += NGW) {
        int r = it;
        if (r < I0) { tr_item(F.att_w_in, ATT_IN, 0, ATT_N, 128, DM, F.norm_mix, 1.f, F.WinT, scr, r, F.lane); continue; } r -= I0;
        if (r < I1) { tr_item(F.att_w_in, ATT_IN, ATT_N, SM_N, 3, DM, F.norm_mix, 1.f, F.WsmT, scr, r, F.lane); continue; } r -= I1;
        if (r < I2) { tr_item(F.att_w_out, DM, 0, DM, 64, DM, nullptr, 1.f, F.WoT, scr, r, F.lane); continue; } r -= I2;
        if (r < I3) { tr_item<true>(F.w_up, FF, 0, FF, 256, DM, F.norm_ffn, 1.f, F.WupT0, scr, r, F.lane); continue; } r -= I3;
        if (r < I4) { tr_item<true>(F.w_dn, DM, 0, DM, 64, FF, nullptr, 1.f, F.WdnT0, scr, r, F.lane); continue; } r -= I4;
        if (r < I5) { tr_item<true>(F.ml_w_in, ML_IN, C_MQ, 1024, 32, DM, F.norm_mix + DM, 1.f, F.WmlT, scr, r, F.lane); continue; } r -= I5;
        if (r < I6) { tr_item<true>(F.ml_w_in, ML_IN, C_MK, 1024, 32, DM, F.norm_mix + DM, KSC, F.WmlT + (size_t)C_MK * DM, scr, r, F.lane); continue; } r -= I6;
        if (r < I7) { tr_item<true>(F.ml_w_in, ML_IN, C_MV, 4096, 128, DM, F.norm_mix + DM, 1.f, F.WmlT + (size_t)C_MV * DM, scr, r, F.lane); continue; } r -= I7;
#if ML_CHAIN
        if (r < I8) { tr_item<true>(F.ml_w_in, ML_IN, ML_N, 16, 1, DM, F.norm_mix + DM, 1.f, F.WgT, scr, r, F.lane); continue; } r -= I8;
        if (r < I9) { tr_item<true>(F.ml_w_out, DM, 0, DM, 64, DM, nullptr, 1.f, F.WmoT, scr, r, F.lane); continue; } r -= I9;
        if (r < I10) { tr_item<true>(F.w_up + (size_t)DM * FF, FF, 0, FF, 256, DM, F.norm_ffn + DM, 1.f, F.WupT1, scr, r, F.lane); continue; } r -= I10;
        tr_item<true>(F.w_dn + (size_t)FF * DM, DM, 0, DM, 64, FF, nullptr, 1.f, F.WdnT1, scr, r, F.lane);
#else
        tr_item(F.ml_w_in, ML_IN, ML_N, 16, 1, DM, F.norm_mix + DM, 1.f, F.WgT, scr, r, F.lane);
#endif
    }
    for (int m = gw; m < M; m += NGW) {
        const GAS f32x4* xr = (const GAS f32x4*)(F.x + (size_t)m * DM) + F.lane; GAS u64* o8 = (GAS u64*)(F.XB + (size_t)m * DM) + F.lane;
        f32x4 v[8]; float s = 0.f;
#pragma unroll
        for (int j = 0; j < 8; ++j) { v[j] = __builtin_nontemporal_load(xr + 64 * j); s += (v[j].x * v[j].x + v[j].y * v[j].y) + (v[j].z * v[j].z + v[j].w * v[j].w); }
        s = wave_sum(s); if (F.lane == 0) F.ss0[m] = s;
#pragma unroll
        for (int j = 0; j < 8; ++j) o8[64 * j] = (u64)cvtpk2(v[j].x, v[j].y) | ((u64)cvtpk2(v[j].z, v[j].w) << 32);
    }
    for (int idx = gw * 64 + F.lane; idx < T * 24; idx += NGW * 64) { const int t = idx / 24, i = idx - t * 24;
        if (i < 16) { const float inv = powf(500000.0f, -2.0f * (float)i / 32.0f), a = (float)t * inv; F.ROPE_A[t * 16 + i] = (f32x2){cosf(a), sinf(a)}; }
        else { const int ii = i - 16; const float inv = powf(500000.0f, -2.0f * (float)ii / 16.0f), a = (float)t * inv; F.ROPE_I[t * 8 + ii] = (f32x2){cosf(a), sinf(a)}; } }
}
template <int NT> __device__ __forceinline__ void skinny_mma(Frame& F, const bf16* A, const bf16* Wt, int r0, LAS float* red) {
    const int rt = F.wave & 1, kq = F.wave >> 1, fr = F.lane & 15, fq = F.lane >> 4;
    f32x4 acc[NT];
#pragma unroll
    for (int n = 0; n < NT; ++n) acc[n] = (f32x4){0.f, 0.f, 0.f, 0.f};
    const bf16* ap = A + (size_t)(r0 + rt * 16 + fr) * DM + kq * 512 + fq * 8; const bf16* bp = Wt + (size_t)fr * DM + kq * 512 + fq * 8;
#pragma unroll 4
    for (int ks = 0; ks < 16; ++ks) { const bf16x8 a = *(const bf16x8*)(ap + ks * 32);
#pragma unroll
        for (int n = 0; n < NT; ++n) { const bf16x8 b = *(const bf16x8*)(bp + (size_t)n * 16 * DM + ks * 32); acc[n] = __builtin_amdgcn_mfma_f32_16x16x32_bf16(a, b, acc[n], 0, 0, 0); } }
#pragma unroll
    for (int n = 0; n < NT; ++n)
#pragma unroll
        for (int g = 0; g < 4; ++g) red[((kq * 32 + rt * 16 + 4 * fq + g) * (NT * 16)) + n * 16 + fr] = acc[n][g];
}
__device__ __forceinline__ void skinny_att(Frame& F) {
    LAS float* red = (LAS float*)(F.lds + RING_OFF);
    for (int u = F.vcu; u < M / 32; u += F.G) { const int r0 = u * 32;
        skinny_mma<5>(F, F.XB, F.WsmT, r0, red);
        LDS_WAIT(); __syncthreads();
        const int r = F.tid >> 4, q = F.tid & 15, m = r0 + r, t = m % T; const float rs = __builtin_amdgcn_rsqf(F.ss0[m] * (1.f / DM) + EPS);
#define SMV(c) ((red[(0 * 32 + r) * 80 + (c)] + red[(1 * 32 + r) * 80 + (c)] + red[(2 * 32 + r) * 80 + (c)] + red[(3 * 32 + r) * 80 + (c)]) * rs)
        if (q < 8) { const float a = SMV(q), b = SMV(q + 8); const f32x2 cs = F.ROPE_I[t * 8 + q];
            F.KI[(size_t)m * 64 + q] = (bf16)f2bf(a * cs.x - b * cs.y); F.KI[(size_t)m * 64 + q + 8] = (bf16)f2bf(a * cs.y + b * cs.x); }
#pragma unroll
        for (int e = 0; e < 3; ++e) { const int c = 16 + q * 3 + e; F.KI[(size_t)m * 64 + c] = (bf16)f2bf(SMV(c)); }
        F.WI[(size_t)m * 16 + q] = SMV(64 + q) * 0.03125f;
#undef SMV
        LDS_WAIT(); __syncthreads();
    }
}
__device__ __forceinline__ void skinny_gates(Frame& F) {
    LAS float* red = (LAS float*)(F.lds + RING_OFF);
    for (int u = F.vcu; u < M / 32; u += F.G) { const int r0 = u * 32;
        skinny_mma<1>(F, F.XB, F.WgT, r0, red);
        LDS_WAIT(); __syncthreads();
        const int r = F.tid >> 4, c = F.tid & 15, m = r0 + r, b = m / T, t = m - b * T; const float rs = __builtin_amdgcn_rsqf(F.ss2[m] * (1.f / DM) + EPS);
        float g = (red[(0 * 32 + r) * 16 + c] + red[(1 * 32 + r) * 16 + c] + red[(2 * 32 + r) * 16 + c] + red[(3 * 32 + r) * 16 + c]) * rs + F.b_gate[c];
        g = GATE_CAP * tanhf(g * (1.f / GATE_CAP));
        if (c < 8) F.IG[(size_t)(b * MH + c) * T + t] = g;
        else { const float ls = g >= 0.f ? -log1pf(expf(-g)) : g - log1pf(expf(g)); F.LF[(size_t)(b * MH + c - 8) * T + t] = ls; }
        LDS_WAIT(); __syncthreads();
    }
}
__device__ __forceinline__ void unpack8(const v4u w, float* f) { f[0] = bflo(w.x); f[1] = bfhi(w.x); f[2] = bflo(w.y); f[3] = bfhi(w.y); f[4] = bflo(w.z); f[5] = bfhi(w.z); f[6] = bflo(w.w); f[7] = bfhi(w.w); }
__device__ __forceinline__ v4u pack8f(const float* f) { v4u w; w.x = pk2(f[0], f[1]); w.y = pk2(f[2], f[3]); w.z = pk2(f[4], f[5]); w.w = pk2(f[6], f[7]); return w; }
__device__ __forceinline__ void norm_rope32(Frame& F, const bf16* src, bf16* dst, const float* gain, int t, bool active) {
    float y[32]; float s = 0.f;
    if (active) {
#pragma unroll
        for (int j = 0; j < 4; ++j) unpack8(*(const GAS v4u*)(src + 8 * j), y + 8 * j);
    } else {
#pragma unroll
        for (int e = 0; e < 32; ++e) y[e] = 0.f;
    }
#pragma unroll
    for (int e = 0; e < 32; ++e) s += y[e] * y[e];
    s += __shfl_xor(s, 1); s += __shfl_xor(s, 2);
    const float rs = __builtin_amdgcn_rsqf(s * (1.f / 128.f) + EPS); const int d0 = (F.lane & 3) * 32;
    if (active) {
#pragma unroll
        for (int e = 0; e < 32; ++e) y[e] = y[e] * rs * gain[d0 + e];
        if ((F.lane & 3) == 0) {
#pragma unroll
            for (int i = 0; i < 16; ++i) { const f32x2 cs = F.ROPE_A[t * 16 + i]; const float a = y[i], b = y[i + 16]; y[i] = a * cs.x - b * cs.y; y[i + 16] = a * cs.y + b * cs.x; }
        }
#pragma unroll
        for (int j = 0; j < 4; ++j) *(GAS v4u*)(dst + 8 * j) = pack8f(y + 8 * j);
    }
}
__device__ __forceinline__ void p2_prep(Frame& F) {
    const int gw = F.vcu * NWAVES + F.wave, NGW = F.G * NWAVES;
    for (int m = gw; m < M; m += NGW) { const int t = m % T; const bf16* pr = F.PROJ + (size_t)m * ATT_N;
        norm_rope32(F, pr + C_Q + 32 * F.lane, F.Q + (size_t)m * DM + 32 * F.lane, F.q_gain, t, true);
        norm_rope32(F, pr + C_K + 32 * (F.lane & 15), F.K + (size_t)m * 512 + 32 * (F.lane & 15), F.k_gain, t, F.lane < 16);
        *(GAS v4u*)(F.V + (size_t)m * 512 + 8 * F.lane) = *(const GAS v4u*)(pr + C_V + 8 * F.lane);
        float y[16]; unpack8(*(const GAS v4u*)(pr + C_QI + 16 * F.lane), y); unpack8(*(const GAS v4u*)(pr + C_QI + 16 * F.lane + 8), y + 8);
        if ((F.lane & 3) == 0) {
#pragma unroll
            for (int i = 0; i < 8; ++i) { const f32x2 cs = F.ROPE_I[t * 8 + i]; const float a = y[i], b = y[i + 8]; y[i] = a * cs.x - b * cs.y; y[i + 8] = a * cs.y + b * cs.x; }
        }
        *(GAS v4u*)(F.QI + (size_t)m * 1024 + 16 * F.lane) = pack8f(y); *(GAS v4u*)(F.QI + (size_t)m * 1024 + 16 * F.lane + 8) = pack8f(y + 8);
    }
}
template <bool TWO, int ABL = 0> __device__ __forceinline__ void p3a_tiles(Frame& F, int b, size_t m0, int kt, const LAS unsigned char* qrow, int swz, const LAS float* wl, int r32, int hi) {
    bf16x8 ka[4], kb[4];
    { const bf16* kp = F.KI + ((size_t)b * T + 32 * kt + r32) * 64 + hi * 8;
#pragma unroll
      for (int ks = 0; ks < 4; ++ks) { ka[ks] = *(const GAS bf16x8*)(kp + 16 * ks); if (TWO) kb[ks] = *(const GAS bf16x8*)(kp + (size_t)32 * NWAVES * 64 + 16 * ks); } }
    f32x16 sa, sb;
#pragma unroll
    for (int r = 0; r < 16; ++r) { sa[r] = 0.f; sb[r] = 0.f; }
#pragma unroll 2
    for (int h = 0; h < 16; ++h) { f32x16 da, db; const float wh = wl[r32 * 16 + h];
#pragma unroll
        for (int r = 0; r < 16; ++r) { da[r] = 0.f; db[r] = 0.f; }
#pragma unroll
        for (int ks = 0; ks < 4; ++ks) { const bf16x8 q = *(const LAS bf16x8*)(qrow + (((h * 64 + 16 * ks + 8 * hi) * 2) ^ swz));
            da = __builtin_amdgcn_mfma_f32_32x32x16_bf16(ka[ks], q, da, 0, 0, 0); if (TWO) db = __builtin_amdgcn_mfma_f32_32x32x16_bf16(kb[ks], q, db, 0, 0, 0); }
#pragma unroll
        for (int r = 0; r < 16; ++r) { const float xa = da[r]; const int ia = __float_as_int(xa); sa[r] = fmaf(wh, __int_as_float(ia > 0 ? ia : 0), sa[r]);
            if (TWO) { const float xb = db[r]; const int ib = __float_as_int(xb); sb[r] = fmaf(wh, __int_as_float(ib > 0 ? ib : 0), sb[r]); } } }
    LAS float* tsc = (LAS float*)(F.lds + RING_OFF + 69632 + F.wave * 4608);
    const int trow = F.lane >> 1, th = F.lane & 1;
#pragma unroll
    for (int q4 = 0; q4 < 4; ++q4) *(LAS f32x4*)(tsc + r32 * 36 + 8 * q4 + 4 * hi) = (f32x4){sa[4 * q4], sa[4 * q4 + 1], sa[4 * q4 + 2], sa[4 * q4 + 3]};
    if (ABL != 2) { float* dst = F.SC + (m0 + trow) * T + 32 * kt + 16 * th;
#pragma unroll
      for (int q4 = 0; q4 < 4; ++q4) *(GAS f32x4*)(dst + 4 * q4) = *(const LAS f32x4*)(tsc + trow * 36 + 16 * th + 4 * q4); }
    if (TWO) {
#pragma unroll
        for (int q4 = 0; q4 < 4; ++q4) *(LAS f32x4*)(tsc + r32 * 36 + 8 * q4 + 4 * hi) = (f32x4){sb[4 * q4], sb[4 * q4 + 1], sb[4 * q4 + 2], sb[4 * q4 + 3]};
        float* dst = F.SC + (m0 + trow) * T + 32 * (kt + NWAVES) + 16 * th;
        if (ABL != 2) {
#pragma unroll
        for (int q4 = 0; q4 < 4; ++q4) *(GAS f32x4*)(dst + 4 * q4) = *(const LAS f32x4*)(tsc + trow * 36 + 16 * th + 4 * q4); } }
}
template <int ABL = 0> __device__ __forceinline__ void p3a_segment(Frame& F, int b, int i, int kt0, int kt1) {
    LAS unsigned char* qs = F.lds + RING_OFF;
    LAS float* wl = (LAS float*)(F.lds + RING_OFF + 65536);
    const int r32 = F.lane & 31, hi = F.lane >> 5, t0 = 32 * i; const size_t m0 = (size_t)b * T + t0;
#pragma unroll
    for (int k = 0; k < 8; ++k) { const int p = F.tid + 512 * k, row = p >> 7, ch = p & 127;
        v4u v = *(const GAS v4u*)(F.PROJ + (m0 + row) * ATT_N + C_QI + ch * 8);
        v4u o; o.x = (unsigned)__builtin_amdgcn_update_dpp(0, (int)v.x, 0xB1, 0xf, 0xf, false); o.y = (unsigned)__builtin_amdgcn_update_dpp(0, (int)v.y, 0xB1, 0xf, 0xf, false);
        o.z = (unsigned)__builtin_amdgcn_update_dpp(0, (int)v.z, 0xB1, 0xf, 0xf, false); o.w = (unsigned)__builtin_amdgcn_update_dpp(0, (int)v.w, 0xB1, 0xf, 0xf, false);
        if ((ch & 7) < 2) { float a[8], bq[8]; unpack8((ch & 1) ? o : v, a); unpack8((ch & 1) ? v : o, bq); const f32x2* rp = F.ROPE_I + (size_t)(t0 + row) * 8; float y[8];
#pragma unroll
            for (int e = 0; e < 8; ++e) { const f32x2 cs = rp[e]; y[e] = (ch & 1) ? a[e] * cs.y + bq[e] * cs.x : a[e] * cs.x - bq[e] * cs.y; }
            v = pack8f(y); }
        *(LAS v4u*)(qs + row * 2048 + ((ch * 16) ^ ((row & 15) << 4))) = v; }
    wl[F.tid] = F.WI[(m0 + (F.tid >> 4)) * 16 + (F.tid & 15)];
    LDS_WAIT(); __syncthreads();
    const LAS unsigned char* qrow = qs + r32 * 2048; const int swz = (r32 & 15) << 4;
    if (ABL != 1) for (int kt = kt0 + F.wave; kt < kt1; kt += 2 * NWAVES) { const bool two = kt + NWAVES < kt1;
        if (two) p3a_tiles<true, ABL>(F, b, m0, kt, qrow, swz, wl, r32, hi); else p3a_tiles<false, ABL>(F, b, m0, kt, qrow, swz, wl, r32, hi); }
    LDS_WAIT(); __syncthreads();
}
template <int ABL = 0> __device__ __forceinline__ void p3a_scores(Frame& F) {
    { const int gw = F.vcu * NWAVES + F.wave, NGW = F.G * NWAVES;
      for (int m = gw; m < M; m += NGW) { const int t = m % T; const bf16* pr = F.PROJ + (size_t)m * ATT_N;
          norm_rope32(F, pr + C_K + 32 * (F.lane & 15), F.K + (size_t)m * 512 + 32 * (F.lane & 15), F.k_gain, t, F.lane < 16);
          *(GAS v4u*)(F.V + (size_t)m * 512 + 8 * F.lane) = *(const GAS v4u*)(pr + C_V + 8 * F.lane); } }
    for (int c = F.vcu; c < 256; c += F.G) { const int p = c >> 1, b = p >> 5, i = p & 31;
        if ((c & 1) == 0) p3a_segment<ABL>(F, b, 63 - i, 0, 32);
        else { p3a_segment<ABL>(F, b, 63 - i, 32, 64 - i); p3a_segment<ABL>(F, b, i, 0, i + 1); } }
}
__device__ __forceinline__ void p3b_select(Frame& F) {
    LAS unsigned* hist = (LAS unsigned*)(F.lds + RING_OFF + F.wave * 8192);
    const int gw = F.vcu * NWAVES + F.wave, NGW = F.G * NWAVES, rep = F.lane & 7;
    for (int e = gw; e < M; e += NGW) { const int bb = e / T, tt = e - bb * T, t = (bb & 1) ? T - 1 - tt : tt, m = bb * T + t; const float* srow = F.SC + (size_t)m * T; const int nj = (t >> 6) + 1;
            unsigned k[32]; float sv[32];
#pragma unroll
            for (int j = 0; j < 32; ++j) { const int s = F.lane + 64 * j; sv[j] = __builtin_nontemporal_load(srow + (s < t ? s : t)); }
#pragma unroll
            for (int j = 0; j < 32; ++j) { const int s = F.lane + 64 * j; k[j] = fkey(s <= t ? sv[j] : -__builtin_inff()); }
            unsigned P = 0;
            if (t + 1 > TOPK) { unsigned need = TOPK;
#pragma unroll 1
                for (int p = 0; p < 4; ++p) { const int sh = 24 - 8 * p; const unsigned hmask = p ? (0xffffffffu << (sh + 8)) : 0u;
#pragma unroll
                    for (int z = 0; z < 8; ++z) *(LAS v4u*)(hist + 4 * (F.lane + 64 * z)) = (v4u){0u, 0u, 0u, 0u};
#pragma unroll
                    for (int j = 0; j < 32; ++j) if (j < nj) { if (((k[j] ^ P) & hmask) == 0u) __hip_atomic_fetch_add(hist + (((k[j] >> sh) & 255u) * 8u + rep), 1u, __ATOMIC_RELAXED, __HIP_MEMORY_SCOPE_WORKGROUP); }
                    v4u hb;
                    { const LAS v4u* hp = (const LAS v4u*)(hist + 32 * F.lane);
                      const v4u r0 = hp[0], r1 = hp[1], r2 = hp[2], r3 = hp[3], r4 = hp[4], r5 = hp[5], r6 = hp[6], r7 = hp[7];
                      hb.x = (r0.x + r0.y + r0.z + r0.w) + (r1.x + r1.y + r1.z + r1.w); hb.y = (r2.x + r2.y + r2.z + r2.w) + (r3.x + r3.y + r3.z + r3.w);
                      hb.z = (r4.x + r4.y + r4.z + r4.w) + (r5.x + r5.y + r5.z + r5.w); hb.w = (r6.x + r6.y + r6.z + r6.w) + (r7.x + r7.y + r7.z + r7.w); }
                    const unsigned s4 = hb.x + hb.y + hb.z + hb.w;
                    unsigned ps = s4;
                    ps += (unsigned)__builtin_amdgcn_update_dpp(0, (int)ps, 0x111, 0xf, 0xf, false); ps += (unsigned)__builtin_amdgcn_update_dpp(0, (int)ps, 0x112, 0xf, 0xf, false);
                    ps += (unsigned)__builtin_amdgcn_update_dpp(0, (int)ps, 0x114, 0xf, 0xf, false); ps += (unsigned)__builtin_amdgcn_update_dpp(0, (int)ps, 0x118, 0xf, 0xf, false);
                    ps += (unsigned)__builtin_amdgcn_update_dpp(0, (int)ps, 0x142, 0xa, 0xf, false); ps += (unsigned)__builtin_amdgcn_update_dpp(0, (int)ps, 0x143, 0xc, 0xf, false);
                    const unsigned total = (unsigned)__builtin_amdgcn_readlane((int)ps, 63), above = total - ps;
                    const u64 bm = __ballot(above < need && need <= above + s4); const int src = __builtin_ctzll(bm);
                    const unsigned a3 = above + hb.w, a2 = a3 + hb.z, a1 = a2 + hb.y;
                    unsigned dig, gt;
                    if (need <= a3) { dig = 3; gt = above; } else if (need <= a2) { dig = 2; gt = a3; } else if (need <= a1) { dig = 1; gt = a2; } else { dig = 0; gt = a1; }
                    dig += 4u * F.lane;
                    dig = (unsigned)__builtin_amdgcn_readlane((int)dig, src); gt = (unsigned)__builtin_amdgcn_readlane((int)gt, src);
                    P |= dig << sh; need -= gt; } }
            u64 myw = 0;
#pragma unroll
            for (int j = 0; j < 32; ++j) { const int s = F.lane + 64 * j; const u64 w = __ballot(k[j] >= P && s <= t); if (F.lane == j) myw = w; }
            if (F.lane < 32) F.MASK[(size_t)m * 32 + F.lane] = myw;
    }
}
#ifndef IDX_FUSED
#define IDX_FUSED 0
#endif
__device__ __forceinline__ unsigned radix_select(const unsigned (&k)[32], int nj, int lane, LAS unsigned* hist) {
    unsigned P = 0, need = TOPK;
#pragma unroll 1
    for (int p = 0; p < 4; ++p) { const int sh = 24 - 8 * p; const unsigned hmask = p ? (0xffffffffu << (sh + 8)) : 0u;
        *(LAS v4u*)(hist + 4 * lane) = (v4u){0u, 0u, 0u, 0u};
#pragma unroll
        for (int j = 0; j < 32; ++j) if (j < nj) { if (((k[j] ^ P) & hmask) == 0u) __hip_atomic_fetch_add(hist + ((k[j] >> sh) & 255u), 1u, __ATOMIC_RELAXED, __HIP_MEMORY_SCOPE_WORKGROUP); }
        const v4u hb = *(const LAS v4u*)(hist + 4 * lane);
        const unsigned s4 = hb.x + hb.y + hb.z + hb.w;
        unsigned ps = s4;
        ps += (unsigned)__builtin_amdgcn_update_dpp(0, (int)ps, 0x111, 0xf, 0xf, false); ps += (unsigned)__builtin_amdgcn_update_dpp(0, (int)ps, 0x112, 0xf, 0xf, false);
        ps += (unsigned)__builtin_amdgcn_update_dpp(0, (int)ps, 0x114, 0xf, 0xf, false); ps += (unsigned)__builtin_amdgcn_update_dpp(0, (int)ps, 0x118, 0xf, 0xf, false);
        ps += (unsigned)__builtin_amdgcn_update_dpp(0, (int)ps, 0x142, 0xa, 0xf, false); ps += (unsigned)__builtin_amdgcn_update_dpp(0, (int)ps, 0x143, 0xc, 0xf, false);
        const unsigned total = (unsigned)__builtin_amdgcn_readlane((int)ps, 63), above = total - ps;
        const u64 bm = __ballot(above < need && need <= above + s4); const int src = __builtin_ctzll(bm);
        const unsigned a3 = above + hb.w, a2 = a3 + hb.z, a1 = a2 + hb.y;
        unsigned dig, gt;
        if (need <= a3) { dig = 3; gt = above; } else if (need <= a2) { dig = 2; gt = a3; } else if (need <= a1) { dig = 1; gt = a2; } else { dig = 0; gt = a1; }
        dig += 4u * lane;
        dig = (unsigned)__builtin_amdgcn_readlane((int)dig, src); gt = (unsigned)__builtin_amdgcn_readlane((int)gt, src);
        P |= dig << sh; need -= gt; }
    return P;
}
__device__ __forceinline__ void p3f_tile(Frame& F, int b, int ti) {
    constexpr int SROW = 2052;
    LAS float* SCL = (LAS float*)(F.lds + RING_OFF);
    LAS unsigned* hist = (LAS unsigned*)(F.lds + RING_OFF + 16 * SROW * 4 + F.wave * 1024);
    static_assert(16 * SROW * 4 + 8 * 1024 <= RING_BYTES, "fused indexer LDS");
    const int lane = F.lane, c16 = lane & 15, kq = lane >> 4, t0 = 16 * ti; const size_t m0 = (size_t)b * T + t0;
#pragma unroll 1
    for (int hh = 0; hh < 2; ++hh) {
        bf16x8 qf[8][2]; float wv[8];
        { const bf16* qp = F.PROJ + (m0 + c16) * ATT_N + C_QI + hh * 512 + 8 * kq; const f32x2* rp = F.ROPE_I + (size_t)(t0 + c16) * 8;
          f32x2 cs[8];
#pragma unroll
          for (int e = 0; e < 8; ++e) cs[e] = rp[e];
#pragma unroll
          for (int h = 0; h < 8; ++h) { v4u v0 = *(const GAS v4u*)(qp + h * 64), v1 = *(const GAS v4u*)(qp + h * 64 + 32);
              v4u o; o.x = (unsigned)__shfl_xor((int)v0.x, 16); o.y = (unsigned)__shfl_xor((int)v0.y, 16); o.z = (unsigned)__shfl_xor((int)v0.z, 16); o.w = (unsigned)__shfl_xor((int)v0.w, 16);
              if (kq < 2) { float a[8], bq[8], y[8]; unpack8(kq ? o : v0, a); unpack8(kq ? v0 : o, bq);
#pragma unroll
                  for (int e = 0; e < 8; ++e) y[e] = kq ? a[e] * cs[e].y + bq[e] * cs[e].x : a[e] * cs[e].x - bq[e] * cs[e].y;
                  v0 = pack8f(y); }
              qf[h][0] = *reinterpret_cast<bf16x8*>(&v0); qf[h][1] = *reinterpret_cast<bf16x8*>(&v1); }
          const float* wp = F.WI + (m0 + c16) * 16 + hh * 8;
#pragma unroll
          for (int h4 = 0; h4 < 2; ++h4) { const f32x4 w4 = *(const GAS f32x4*)(wp + 4 * h4); wv[4 * h4] = w4.x; wv[4 * h4 + 1] = w4.y; wv[4 * h4 + 2] = w4.z; wv[4 * h4 + 3] = w4.w; } }
        bf16x8 a0, a1, n0, n1;
        { const int kt = F.wave; if (kt <= ti) { const bf16* kp = F.KI + ((size_t)b * T + 16 * kt + c16) * 64 + 8 * kq; n0 = *(const GAS bf16x8*)kp; n1 = *(const GAS bf16x8*)(kp + 32); } }
        for (int kt = F.wave; kt <= ti; kt += NWAVES) { const int s0 = 16 * kt;
            a0 = n0; a1 = n1;
            if (kt + NWAVES <= ti) { const bf16* kp = F.KI + ((size_t)b * T + 16 * (kt + NWAVES) + c16) * 64 + 8 * kq; n0 = *(const GAS bf16x8*)kp; n1 = *(const GAS bf16x8*)(kp + 32); }
            LAS f32x4* dst = (LAS f32x4*)(SCL + c16 * SROW + s0 + 4 * kq);
            f32x4 sc = (f32x4){0.f, 0.f, 0.f, 0.f}; if (hh) sc = *dst;
#pragma unroll
            for (int h = 0; h < 8; ++h) { f32x4 d = __builtin_amdgcn_mfma_f32_16x16x32_bf16(a0, qf[h][0], (f32x4){0.f, 0.f, 0.f, 0.f}, 0, 0, 0); d = __builtin_amdgcn_mfma_f32_16x16x32_bf16(a1, qf[h][1], d, 0, 0, 0);
                sc += __builtin_elementwise_max(d, (f32x4){0.f, 0.f, 0.f, 0.f}) * wv[h]; }
            *dst = sc;
        }
    }
    LDS_WAIT(); __syncthreads();
#pragma unroll 1
    for (int rr = 0; rr < 2; ++rr) { const int row = 2 * F.wave + rr, t = t0 + row, nj = (t >> 6) + 1; const LAS float* srow = SCL + row * SROW;
        unsigned k[32];
#pragma unroll
        for (int j = 0; j < 32; ++j) { const int s = lane + 64 * j; k[j] = fkey(s <= t ? srow[s] : -__builtin_inff()); }
        unsigned P = 0;
        if (t + 1 > TOPK) P = radix_select(k, nj, lane, hist);
        u64 myw = 0;
#pragma unroll
        for (int j = 0; j < 32; ++j) { const int s = lane + 64 * j; const u64 w = __ballot(k[j] >= P && s <= t); if (lane == j) myw = w; }
        if (lane < 32) F.MASK[(m0 + row) * 32 + lane] = myw;
    }
    LDS_WAIT(); __syncthreads();
}
__device__ __forceinline__ void p3_fused(Frame& F) {
    { const int gw = F.vcu * NWAVES + F.wave, NGW = F.G * NWAVES;
      for (int m = gw; m < M; m += NGW) { const int t = m % T; const bf16* pr = F.PROJ + (size_t)m * ATT_N;
          norm_rope32(F, pr + C_K + 32 * (F.lane & 15), F.K + (size_t)m * 512 + 32 * (F.lane & 15), F.k_gain, t, F.lane < 16);
          *(GAS v4u*)(F.V + (size_t)m * 512 + 8 * F.lane) = *(const GAS v4u*)(pr + C_V + 8 * F.lane); } }
    for (int u = F.vcu; u < 256; u += F.G) { const int b = u >> 6, i = u & 63; p3f_tile(F, b, 127 - i); p3f_tile(F, b, i); }
}
namespace att {
constexpr int D = 128, NW = 8, QBLK = 32, KVBLK = 64;
constexpr float SCALE = 0.088388347648318440f, THR = 8.f;
constexpr int LDQ = ATT_N, LDK = 512, LDO = DM;
constexpr int SHM_V = KVBLK * D * 2, SHM_K = KVBLK * D * 2, SHM_MASK = 2 * SHM_V + 2 * SHM_K + NW * 64 * 4, MROW = 33 * 8, SHM_ATTN = SHM_MASK + 256 * MROW;
#define KSWZ(row, colB) ((row) * 256 + ((colB) ^ (((row) & 7) << 4)))
#define SBAR() __builtin_amdgcn_sched_barrier(0)
__device__ __forceinline__ int crow(int r, int hi) { return (r & 3) + 8 * (r >> 2) + 4 * hi; }
__device__ __forceinline__ unsigned cvtpk(float lo, float hi) { unsigned r; asm volatile("v_cvt_pk_bf16_f32 %0, %1, %2" : "=v"(r) : "v"(lo), "v"(hi)); return r; }
__device__ __forceinline__ void partialSM(f32x16& p0, f32x16& p1, float& m_reg, float& mn, float& alpha) {
  constexpr float C = SCALE * 1.4426950408889634f;
  float pmax;
  { float m0, m1, m2, m3;
#define MAX3(d, a, b, c) asm volatile("v_max3_f32 %0, %1, %2, %3" : "=v"(d) : "v"(a), "v"(b), "v"(c))
    asm volatile("s_nop 7\n\ts_nop 5\n\tv_max3_f32 %0, %1, %2, %3" : "=v"(m0) : "v"(p0[0]), "v"(p0[1]), "v"(p0[2])); MAX3(m1, p0[3], p0[4], p0[5]); MAX3(m2, p0[6], p0[7], p0[8]); MAX3(m3, p0[9], p0[10], p0[11]);
    MAX3(m0, m0, p0[12], p0[13]); MAX3(m1, m1, p0[14], p0[15]); MAX3(m2, m2, p1[0], p1[1]); MAX3(m3, m3, p1[2], p1[3]);
    MAX3(m0, m0, p1[4], p1[5]); MAX3(m1, m1, p1[6], p1[7]); MAX3(m2, m2, p1[8], p1[9]); MAX3(m3, m3, p1[10], p1[11]);
    MAX3(m0, m0, p1[12], p1[13]); MAX3(m1, m1, p1[14], p1[15]); MAX3(m0, m0, m1, m2); MAX3(pmax, m0, m3, m3);
#undef MAX3
  }
  { auto rr = __builtin_amdgcn_permlane32_swap(__float_as_uint(pmax), __float_as_uint(pmax), false, false);
    pmax = fmaxf(__uint_as_float(rr[0]), __uint_as_float(rr[1])); }
  if (__builtin_expect(__all(pmax - m_reg <= THR / SCALE), 1)) { mn = m_reg; alpha = 1.f; }
  else { mn = fmaxf(m_reg, pmax); alpha = __builtin_amdgcn_exp2f((m_reg - mn) * C); m_reg = mn; }
  float mnC = -mn * C;
  for (int r = 0; r < 16; ++r) p0[r] = fmaf(p0[r], C, mnC); for (int r = 0; r < 16; ++r) p1[r] = fmaf(p1[r], C, mnC);
  for (int r = 0; r < 16; ++r) p0[r] = __builtin_amdgcn_exp2f(p0[r]);
}
__device__ __forceinline__ void finishSM(f32x16& p0, f32x16& p1, float alpha, float& l_reg, bf16x8& pa0, bf16x8& pa1, bf16x8& pa2, bf16x8& pa3) {
  for (int r = 0; r < 16; ++r) p1[r] = __builtin_amdgcn_exp2f(p1[r]);
  float ps = 0; for (int r = 0; r < 16; ++r) ps += p0[r]; for (int r = 0; r < 16; ++r) ps += p1[r];
  { auto rr = __builtin_amdgcn_permlane32_swap(__float_as_uint(ps), __float_as_uint(ps), false, false);
    ps = __uint_as_float(rr[0]) + __uint_as_float(rr[1]); }
  l_reg = l_reg * alpha + ps;
#define PK4(P, BASE, OUT) do { unsigned a0 = cvtpk(P[BASE + 0], P[BASE + 1]), a1 = cvtpk(P[BASE + 2], P[BASE + 3]);   \
    unsigned b0 = cvtpk(P[BASE + 4], P[BASE + 5]), b1 = cvtpk(P[BASE + 6], P[BASE + 7]);                              \
    auto r0 = __builtin_amdgcn_permlane32_swap(a0, b0, false, false); auto r1 = __builtin_amdgcn_permlane32_swap(a1, b1, false, false); \
    v4u w = {r0[0], r1[0], r0[1], r1[1]}; OUT = *reinterpret_cast<bf16x8*>(&w); } while (0)
  PK4(p0, 0, pa0); PK4(p0, 8, pa1); PK4(p1, 0, pa2); PK4(p1, 8, pa3);
#undef PK4
}
__device__ __forceinline__ void qkt(f32x16& p0, f32x16& p1, const bf16* Ks, const bf16x8* qr, int r32, int hi, unsigned mlo, unsigned mhi) {
#ifndef MASKV
#define MASKV 1
#endif
#if MASKV == 0
  const float NEG = -__builtin_inff(); mlo >>= 4 * hi; mhi >>= 4 * hi;
#pragma unroll
  for (int r = 0; r < 16; ++r) { const int c = (r & 3) + 8 * (r >> 2); p0[r] = ((mlo >> c) & 1u) ? 0.f : NEG; p1[r] = ((mhi >> c) & 1u) ? 0.f : NEG; }
#else
  const int nlo = (int)(~mlo >> (4 * hi)), nhi = (int)(~mhi >> (4 * hi));
#pragma unroll
  for (int r = 0; r < 16; ++r) { const int c = (r & 3) + 8 * (r >> 2);
    p0[r] = __uint_as_float((unsigned)__builtin_amdgcn_sbfe(nlo, c, 1) & 0xff800000u); p1[r] = __uint_as_float((unsigned)__builtin_amdgcn_sbfe(nhi, c, 1) & 0xff800000u); }
#endif
#pragma unroll
  for (int d0 = 0; d0 < 8; ++d0) { int cb = (d0 * 16 + hi * 8) * 2;
    bf16x8 b0 = *reinterpret_cast<const bf16x8*>((const char*)Ks + KSWZ(r32, cb));
    bf16x8 b1 = *reinterpret_cast<const bf16x8*>((const char*)Ks + KSWZ(32 + r32, cb));
    p0 = __builtin_amdgcn_mfma_f32_32x32x16_bf16(b0, qr[d0], p0, 0, 0, 0);
    p1 = __builtin_amdgcn_mfma_f32_32x32x16_bf16(b1, qr[d0], p1, 0, 0, 0); }
}
__device__ __forceinline__ int v_st(int k, int c) { const int kk = (k & ~0xC) | ((k & 4) << 1) | ((k & 8) >> 1); return ((kk >> 3) * 4 + (c >> 5)) * 512 + ((kk & 7) * 32 + (c & 31)) * 2; }
__device__ __forceinline__ int v_rd_base(int lane) { return ((lane & 3) << 3) | (((lane >> 2) & 3) << 6) | (((lane >> 4) & 1) << 5) | (((lane >> 5) & 1) << 8); }
constexpr int v_rd_off(int d0, int ks, int half) { return d0 * 512 + ks * 4096 + half * 2048; }
template <int OFF> __device__ __forceinline__ s16x4 tr_read(int vb) {
  s16x4 r; asm volatile("ds_read_b64_tr_b16 %0, %1 offset:%2" : "=&v"(r) : "v"(vb), "i"(OFF) : "memory"); return r;
}
template <int D0> __device__ __forceinline__ void pv_one(f32x16& od, int vb, bf16x8 pa0, bf16x8 pa1, bf16x8 pa2, bf16x8 pa3) {
  const s16x4 l0 = tr_read<v_rd_off(D0, 0, 0)>(vb), h0 = tr_read<v_rd_off(D0, 0, 1)>(vb), l1 = tr_read<v_rd_off(D0, 1, 0)>(vb), h1 = tr_read<v_rd_off(D0, 1, 1)>(vb);
  const s16x4 l2 = tr_read<v_rd_off(D0, 2, 0)>(vb), h2 = tr_read<v_rd_off(D0, 2, 1)>(vb), l3 = tr_read<v_rd_off(D0, 3, 0)>(vb), h3 = tr_read<v_rd_off(D0, 3, 1)>(vb);
  asm volatile("s_waitcnt lgkmcnt(0)" ::: "memory"); SBAR();
#define PK(L, H) (bf16x8){L[0], L[1], L[2], L[3], H[0], H[1], H[2], H[3]}
  od = __builtin_amdgcn_mfma_f32_32x32x16_bf16(pa0, PK(l0, h0), od, 0, 0, 0);
  od = __builtin_amdgcn_mfma_f32_32x32x16_bf16(pa1, PK(l1, h1), od, 0, 0, 0);
  od = __builtin_amdgcn_mfma_f32_32x32x16_bf16(pa2, PK(l2, h2), od, 0, 0, 0);
  od = __builtin_amdgcn_mfma_f32_32x32x16_bf16(pa3, PK(l3, h3), od, 0, 0, 0);
#undef PK
}
__device__ __forceinline__ void pv_d0(f32x16* o, int vb, bf16x8 pa0, bf16x8 pa1, bf16x8 pa2, bf16x8 pa3) {
  pv_one<0>(o[0], vb, pa0, pa1, pa2, pa3); pv_one<1>(o[1], vb, pa0, pa1, pa2, pa3); pv_one<2>(o[2], vb, pa0, pa1, pa2, pa3); pv_one<3>(o[3], vb, pa0, pa1, pa2, pa3);
}
__device__ __forceinline__ void attn_body(const bf16* __restrict__ Qb, const bf16* __restrict__ Kh, const bf16* __restrict__ Vh, bf16* __restrict__ Ob, const u64* __restrict__ mrow, int seq, char* lds,
                                          const float* __restrict__ qgain, const f32x2* __restrict__ ropeA, int tpos0) {
  const int tid = opaque_tid(), wid = tid >> 6, lane = tid & 63, r32 = lane & 31, hi = lane >> 5;
  bf16* V_lds = (bf16*)lds; bf16* K_lds = (bf16*)(lds + 2 * SHM_V);
  float* ws = (float*)(lds + 2 * SHM_V + 2 * SHM_K) + wid * 64; float* li_l = ws; float* al_l = ws + 32;
  float m_reg = -1e30f, l_reg = 0; f32x16 o[4] = {}; bf16x8 qr[8];
  const bf16* Qw = Qb + (long)(wid * QBLK + r32) * LDQ + hi * 8;
  { float x[64]; float s = 0.f;
#pragma unroll
    for (int d0 = 0; d0 < 8; ++d0) unpack8(*reinterpret_cast<const v4u*>(Qw + d0 * 16), x + 8 * d0);
#pragma unroll
    for (int e = 0; e < 64; ++e) s += x[e] * x[e];
    { auto rr = __builtin_amdgcn_permlane32_swap(__float_as_uint(s), __float_as_uint(s), false, false); s = __uint_as_float(rr[0]) + __uint_as_float(rr[1]); }
    const float rs = __builtin_amdgcn_rsqf(s * (1.f / 128.f) + EPS);
#pragma unroll
    for (int d0 = 0; d0 < 8; ++d0) { const f32x4 g0 = *(const f32x4*)(qgain + 16 * d0 + 8 * hi), g1 = *(const f32x4*)(qgain + 16 * d0 + 8 * hi + 4);
        x[8 * d0 + 0] *= rs * g0.x; x[8 * d0 + 1] *= rs * g0.y; x[8 * d0 + 2] *= rs * g0.z; x[8 * d0 + 3] *= rs * g0.w; x[8 * d0 + 4] *= rs * g1.x; x[8 * d0 + 5] *= rs * g1.y; x[8 * d0 + 6] *= rs * g1.z; x[8 * d0 + 7] *= rs * g1.w; }
    const f32x2* rp = ropeA + (size_t)(tpos0 + wid * QBLK + r32) * 16 + 8 * hi;
#pragma unroll
    for (int e = 0; e < 8; ++e) { const f32x2 cs = rp[e]; const float a = x[e], bq = x[8 + e]; x[e] = a * cs.x - bq * cs.y; x[8 + e] = a * cs.y + bq * cs.x; }
#pragma unroll
    for (int d0 = 0; d0 < 8; ++d0) { v4u w = pack8f(x + 8 * d0); qr[d0] = *reinterpret_cast<bf16x8*>(&w); } }
  const char* mw = lds + SHM_MASK + (wid * QBLK + r32) * MROW;
  const int sr = tid >> 4, sc = (tid & 15) * 8, vst0 = v_st(sr, sc), vst1 = v_st(32 + sr, sc);
  const int vb0 = (int)(uintptr_t)V_lds + v_rd_base(lane);
  constexpr int SDEPTH = 2;
  struct { bf16x8 vs0, vs1, ks0, ks1; } sr_[SDEPTH];
#define SLOAD(i, k0) do { sr_[i].vs0 = *reinterpret_cast<const bf16x8*>(&Vh[(long)((k0) + sr) * LDK + sc]); sr_[i].vs1 = *reinterpret_cast<const bf16x8*>(&Vh[(long)((k0) + 32 + sr) * LDK + sc]); \
    sr_[i].ks0 = *reinterpret_cast<const bf16x8*>(&Kh[(long)((k0) + sr) * LDK + sc]); sr_[i].ks1 = *reinterpret_cast<const bf16x8*>(&Kh[(long)((k0) + 32 + sr) * LDK + sc]); } while (0)
#define SWRITE(b, i) do { *(bf16x8*)((char*)V_lds + (b) * SHM_V + vst0) = sr_[i].vs0;          \
    *(bf16x8*)((char*)V_lds + (b) * SHM_V + vst1) = sr_[i].vs1; int kc = sc * 2;               \
    *(bf16x8*)((char*)K_lds + (b) * SHM_K + KSWZ(sr, kc)) = sr_[i].ks0;                       \
    *(bf16x8*)((char*)K_lds + (b) * SHM_K + KSWZ(32 + sr, kc)) = sr_[i].ks1; } while (0)
#define SWAIT() do { if constexpr (SDEPTH == 2) asm volatile("s_waitcnt vmcnt(4)" ::: "memory"); else asm volatile("s_waitcnt vmcnt(0)" ::: "memory"); } while (0)
#define RESC(a) do { if (__any((a) < 1.f)) { if (hi == 0) al_l[r32] = (a); asm volatile("s_waitcnt lgkmcnt(0)" ::: "memory"); \
    for (int d = 0; d < 4; ++d) for (int r = 0; r < 16; ++r) o[d][r] *= al_l[crow(r, hi)]; } } while (0)
  f32x16 pA0, pA1, pB0, pB1; float mnA, mnB, alA, alB; bf16x8 pa0, pa1, pa2, pa3; const int NT = seq / KVBLK;
  constexpr int SE = 0, SO = SDEPTH - 1;
  { const int NTw = seq / KVBLK; for (int e = tid; e < 256 * NTw; e += 512) { const int row = e / NTw, j = e - row * NTw; *(u64*)(lds + SHM_MASK + row * MROW + j * 8) = mrow[(size_t)row * 32 + j]; } }
#define MK(j) (*(const v2u*)(mw + (j) * 8))
  v2u mk;
  SLOAD(SE, 0); asm volatile("s_waitcnt vmcnt(0)" ::: "memory"); SWRITE(0, SE); __syncthreads();
  mk = MK(0); qkt(pA0, pA1, K_lds, qr, r32, hi, mk.x, mk.y); partialSM(pA0, pA1, m_reg, mnA, alA);
  SLOAD(SO, KVBLK); if constexpr (SDEPTH == 2) { if (2 < NT) SLOAD(SE, 2 * KVBLK); }
  SWAIT(); SWRITE(1, SO); __syncthreads();
  for (int j = 1; j + 1 < NT; j += 2) {
    SBAR(); mk = MK(j); qkt(pB0, pB1, (bf16*)((char*)K_lds + SHM_K), qr, r32, hi, mk.x, mk.y);
    finishSM(pA0, pA1, alA, l_reg, pa0, pa1, pa2, pa3); SBAR();
    SLOAD(SO, (j + SDEPTH) * KVBLK); SBAR();
    pv_d0(o, vb0, pa0, pa1, pa2, pa3); partialSM(pB0, pB1, m_reg, mnB, alB);
    __syncthreads(); SWAIT(); SWRITE(0, SE);
    RESC(alB); __syncthreads();
    SBAR(); mk = MK(j + 1); qkt(pA0, pA1, K_lds, qr, r32, hi, mk.x, mk.y);
    finishSM(pB0, pB1, alB, l_reg, pa0, pa1, pa2, pa3); SBAR();
    if (SDEPTH == 1 || j + 3 < NT) SLOAD(SE, (j + 1 + SDEPTH) * KVBLK); SBAR();
    pv_d0(o, vb0 + (int)SHM_V, pa0, pa1, pa2, pa3); partialSM(pA0, pA1, m_reg, mnA, alA);
    __syncthreads(); SWAIT(); SWRITE(1, SO);
    RESC(alA); __syncthreads();
  }
  SBAR(); mk = MK(NT - 1); qkt(pB0, pB1, (bf16*)((char*)K_lds + SHM_K), qr, r32, hi, mk.x, mk.y);
  finishSM(pA0, pA1, alA, l_reg, pa0, pa1, pa2, pa3); SBAR();
  pv_d0(o, vb0, pa0, pa1, pa2, pa3); partialSM(pB0, pB1, m_reg, mnB, alB);
  __syncthreads(); RESC(alB);
  finishSM(pB0, pB1, alB, l_reg, pa0, pa1, pa2, pa3); SBAR();
  pv_d0(o, vb0 + (int)SHM_V, pa0, pa1, pa2, pa3);
  if (hi == 0) li_l[r32] = l_reg; asm volatile("s_waitcnt lgkmcnt(0)" ::: "memory");
  float rli[16];
#pragma unroll
  for (int r = 0; r < 16; ++r) rli[r] = __builtin_amdgcn_rcpf(li_l[crow(r, hi)]);
  bf16* Ow = Ob + (long)(wid * QBLK) * LDO;
#pragma unroll
  for (int r = 0; r < 16; ++r) { const int orow = crow(r, hi);
#pragma unroll
    for (int d0 = 0; d0 < 4; ++d0) { const float v = o[d0][r] * rli[r]; const float vn = __shfl_xor(v, 1);
      if ((r32 & 1) == 0) *(unsigned*)(Ow + (long)orow * LDO + d0 * 32 + r32) = cvtpk(v, vn); } }
#undef MK
#undef SLOAD
#undef SWRITE
#undef SWAIT
#undef RESC
}
#undef KSWZ
#undef SBAR
}
__device__ __forceinline__ void p4_attention(Frame& F, char* lds) {
    static_assert(att::SHM_ATTN <= RING_BYTES, "attention LDS");
    for (int it = F.vcu; it < 256; it += F.G) { const int grp = it >> 4, b = grp >> 2, g = grp & 3, h = g * 4 + ((it >> 2) & 3), x = it & 3;
        for (int pass = 0; pass < 2; ++pass) { const int qb = pass ? x : 7 - x; const size_t row0 = (size_t)b * T + (size_t)qb * 256;
            att::attn_body(F.PROJ + row0 * ATT_N + C_Q + h * HD, F.K + (size_t)b * T * 512 + g * HD, F.V + (size_t)b * T * 512 + g * HD, F.O + row0 * DM + h * HD, F.MASK + row0 * 32, 256 * (qb + 1), lds, F.q_gain, F.ROPE_A, qb * 256);
            __syncthreads(); } }
}
namespace ml {
constexpr int QS = 0, KS = 16384, VS = 32768, PF = 65536, HS = 73728, HROW = 528, MISC = HS + 64 * HROW, PW = MISC + 2048, PWB = 1536, LDS_END_B = PW + 8 * PWB;
constexpr int A_KP = 0, A_VS = 16384, A_BUF = 49152, A_WK = 2 * A_BUF, A_B = A_WK + 8192, A_U = A_B + 8192, A_M = A_U + 8192, A_CH = A_M + 8192, LDS_END_A = A_CH + 1024;
#define SW16(row, colB) ((row) * 256 + ((colB) ^ (((row) & 15) << 4)))
#define SBAR() __builtin_amdgcn_sched_barrier(0)
#define MBAR() do { asm volatile("s_waitcnt lgkmcnt(0)" ::: "memory"); __builtin_amdgcn_s_barrier(); asm volatile("" ::: "memory"); } while (0)
using att::crow; using att::cvtpk; using att::v_st; using att::v_rd_base; using att::tr_read;
__device__ __forceinline__ bf16x8 pk88(const s16x4 l, const s16x4 h) { return (bf16x8){l[0], l[1], l[2], l[3], h[0], h[1], h[2], h[3]}; }
__device__ __forceinline__ bf16x8 pack_acc8(const f32x16& x, int s8) { v4u w = {cvtpk(x[s8 + 0], x[s8 + 1]), cvtpk(x[s8 + 2], x[s8 + 3]), cvtpk(x[s8 + 4], x[s8 + 5]), cvtpk(x[s8 + 6], x[s8 + 7])}; return *reinterpret_cast<bf16x8*>(&w); }
__device__ __forceinline__ v4u wmul8(const v4u k, float w) { v4u o; o.x = cvtpk(bflo(k.x) * w, bfhi(k.x) * w); o.y = cvtpk(bflo(k.y) * w, bfhi(k.y) * w); o.z = cvtpk(bflo(k.z) * w, bfhi(k.z) * w); o.w = cvtpk(bflo(k.w) * w, bfhi(k.w) * w); return o; }
template <int CTRL, int ROWMASK> __device__ __forceinline__ float dppf(float old, float src) {
    return __builtin_bit_cast(float, __builtin_amdgcn_update_dpp(__builtin_bit_cast(int, old), __builtin_bit_cast(int, src), CTRL, ROWMASK, 0xf, false)); }
__device__ __forceinline__ float wave_sum_dpp(float v) {
    v += dppf<0xB1, 0xf>(0.f, v); v += dppf<0x4E, 0xf>(0.f, v); v += dppf<0x141, 0xf>(0.f, v); v += dppf<0x140, 0xf>(0.f, v);
    const int iv = __builtin_bit_cast(int, v);
    return (__builtin_bit_cast(float, __builtin_amdgcn_readlane(iv, 0)) + __builtin_bit_cast(float, __builtin_amdgcn_readlane(iv, 16))) +
           (__builtin_bit_cast(float, __builtin_amdgcn_readlane(iv, 32)) + __builtin_bit_cast(float, __builtin_amdgcn_readlane(iv, 48)));
}
__device__ __forceinline__ float scan_sum64(float x) {
    x += dppf<0x111, 0xf>(0.f, x); x += dppf<0x112, 0xf>(0.f, x); x += dppf<0x114, 0xf>(0.f, x); x += dppf<0x118, 0xf>(0.f, x);
    x += dppf<0x142, 0xa>(0.f, x); x += dppf<0x143, 0xc>(0.f, x); return x;
}
__device__ __forceinline__ float scan_max64(float x) {
    const float NI = -__builtin_inff();
    x = fmaxf(x, dppf<0x111, 0xf>(NI, x)); x = fmaxf(x, dppf<0x112, 0xf>(NI, x)); x = fmaxf(x, dppf<0x114, 0xf>(NI, x)); x = fmaxf(x, dppf<0x118, 0xf>(NI, x));
    x = fmaxf(x, dppf<0x142, 0xa>(NI, x)); x = fmaxf(x, dppf<0x143, 0xc>(NI, x)); return x;
}
template <int I> __device__ __forceinline__ void cupd(f32x16& Xi, int vbK, const bf16x8 (&vB)[4]) {
    const s16x4 l0 = tr_read<I * 512 + 0 * 4096>(vbK), h0 = tr_read<I * 512 + 0 * 4096 + 2048>(vbK), l1 = tr_read<I * 512 + 1 * 4096>(vbK), h1 = tr_read<I * 512 + 1 * 4096 + 2048>(vbK);
    const s16x4 l2 = tr_read<I * 512 + 2 * 4096>(vbK), h2 = tr_read<I * 512 + 2 * 4096 + 2048>(vbK), l3 = tr_read<I * 512 + 3 * 4096>(vbK), h3 = tr_read<I * 512 + 3 * 4096 + 2048>(vbK);
    asm volatile("s_waitcnt lgkmcnt(0)" ::: "memory"); SBAR();
    Xi = __builtin_amdgcn_mfma_f32_32x32x16_bf16(pk88(l0, h0), vB[0], Xi, 0, 0, 0);
    Xi = __builtin_amdgcn_mfma_f32_32x32x16_bf16(pk88(l1, h1), vB[1], Xi, 0, 0, 0);
    Xi = __builtin_amdgcn_mfma_f32_32x32x16_bf16(pk88(l2, h2), vB[2], Xi, 0, 0, 0);
    Xi = __builtin_amdgcn_mfma_f32_32x32x16_bf16(pk88(l3, h3), vB[3], Xi, 0, 0, 0);
}
template <int I> __device__ __forceinline__ void yinter(f32x16& acc, const LAS unsigned char* qrow, int swz, int hi, bf16x8 xb0, bf16x8 xb1) {
    const v2u a00 = *(const LAS v2u*)(qrow + (((I * 32 + 0) * 2) ^ swz) + 8 * hi), a01 = *(const LAS v2u*)(qrow + (((I * 32 + 8) * 2) ^ swz) + 8 * hi);
    const v2u a10 = *(const LAS v2u*)(qrow + (((I * 32 + 16) * 2) ^ swz) + 8 * hi), a11 = *(const LAS v2u*)(qrow + (((I * 32 + 24) * 2) ^ swz) + 8 * hi);
    v4u A0 = {a00.x, a00.y, a01.x, a01.y}, A1 = {a10.x, a10.y, a11.x, a11.y};
    acc = __builtin_amdgcn_mfma_f32_32x32x16_bf16(*reinterpret_cast<bf16x8*>(&A0), xb0, acc, 0, 0, 0);
    acc = __builtin_amdgcn_mfma_f32_32x32x16_bf16(*reinterpret_cast<bf16x8*>(&A1), xb1, acc, 0, 0, 0);
}
}
__device__ __forceinline__ void late_weights(Frame& F, int gw, int NGW) {
    LAS float* scr = (LAS float*)(F.lds + RING_OFF + F.wave * 16384);
    constexpr int I9 = 32 * 64, I10 = 32 * 256, I11 = 128 * 64;
    for (int it = gw; it < I9 + I10 + I11; it += NGW) { int r = it;
        if (r < I9) { tr_item(F.ml_w_out, DM, 0, DM, 64, DM, nullptr, 1.f, F.WmoT, scr, r, F.lane); continue; } r -= I9;
        if (r < I10) { tr_item(F.w_up + (size_t)DM * FF, FF, 0, FF, 256, DM, F.norm_ffn + DM, 1.f, F.WupT1, scr, r, F.lane); continue; } r -= I10;
        tr_item(F.w_dn + (size_t)FF * DM, DM, 0, DM, 64, FF, nullptr, 1.f, F.WdnT1, scr, r, F.lane); }
}
template <int mode> __device__ __forceinline__ void p9a_state(Frame& F) {
    using namespace ml;
    constexpr int NBH = BATCH * MH, NC = T / 64;
    if (F.vcu >= NBH) { if (F.G > NBH && mode != 1) late_weights(F, (F.vcu - NBH) * NWAVES + F.wave, (F.G - NBH) * NWAVES); return; }
    if (mode == 2) return;
    LAS unsigned char* L = F.lds + RING_OFF;
    static_assert(ml::LDS_END_A <= RING_BYTES, "mLSTM pass A LDS");
    const int bh = F.vcu, b = bh / MH, h = bh % MH, w = F.wave, tid = F.tid;
    const size_t mb = (size_t)b * T;
    LAS float* WKL = (LAS float*)(L + A_WK); LAS float* BL = (LAS float*)(L + A_B); LAS float* UL = (LAS float*)(L + A_U); LAS float* MLs = (LAS float*)(L + A_M);
    LAS float* CH = (LAS float*)(L + A_CH);
    const float* igp = F.IG + (size_t)bh * T; const float* lfp = F.LF + (size_t)bh * T;
#pragma unroll
    for (int cc = 0; cc < 4; ++cc) { const int c = 4 * w + cc, t = c * 64 + F.lane; const float ig = igp[t], lf = lfp[t];
        const float bb = scan_sum64(lf), u = ig - bb, Mx = scan_max64(u);
        BL[t] = bb; UL[t] = u; MLs[t] = Mx; if (F.lane == 63) { CH[c] = bb; CH[32 + c] = Mx; } }
    LDS_WAIT(); __syncthreads();
    if (tid == 0) { float m = 0.f; for (int c = 0; c < NC; ++c) { const float mm63 = fmaxf(m, CH[32 + c]); CH[64 + c] = m; CH[96 + c] = __expf(m - mm63); CH[128 + c] = mm63; m = CH[c] + mm63; } }
    LDS_WAIT(); __syncthreads();
    { float* scal = F.SCAL + (size_t)bh * 4 * T;
      for (int t = tid; t < T; t += NTHR) { const int c = t >> 6; const float mst = CH[64 + c], mm = fmaxf(mst, MLs[t]), u = UL[t];
          scal[t] = u; scal[T + t] = mm; scal[2 * T + t] = __expf(mst - mm); scal[3 * T + t] = __expf(-(BL[t] + mm)); WKL[t] = __expf(u - CH[128 + c]); } }
    LDS_WAIT(); __syncthreads();
    f32x16 X[4];
#pragma unroll
    for (int i = 0; i < 4; ++i)
#pragma unroll
        for (int r = 0; r < 16; ++r) X[i][r] = 0.f;
    float nreg = 0.f;
    struct KV { v4u k0, k1, v00, v01, v10, v11; }; KV S0, S1, S2;
    const int lbase = (int)(uintptr_t)L;
#define A_LOAD(cc, S) do { const bf16* rp0 = F.PROJ + (mb + (size_t)(cc) * 64 + sr) * ML_N + sc; const bf16* rp1 = rp0 + 32 * ML_N;                              \
        S.k0 = *(const GAS v4u*)(rp0 + C_MK + h * MDK); S.k1 = *(const GAS v4u*)(rp1 + C_MK + h * MDK);                                                       \
        S.v00 = *(const GAS v4u*)(rp0 + C_MV + h * MDV); S.v01 = *(const GAS v4u*)(rp0 + C_MV + h * MDV + 128); S.v10 = *(const GAS v4u*)(rp1 + C_MV + h * MDV); S.v11 = *(const GAS v4u*)(rp1 + C_MV + h * MDV + 128); } while (0)
#define A_WRITE(cc, S) do { LAS unsigned char* B_ = L + ((cc) & 1) * A_BUF; const float w0 = WKL[(cc) * 64 + sr], w1 = WKL[(cc) * 64 + 32 + sr];            \
        *(LAS v4u*)(B_ + A_KP + v_st(sr, sc)) = wmul8(S.k0, w0); *(LAS v4u*)(B_ + A_KP + v_st(32 + sr, sc)) = wmul8(S.k1, w1);                                \
        *(LAS v4u*)(B_ + A_VS + v_st(sr, sc)) = S.v00; *(LAS v4u*)(B_ + A_VS + 16384 + v_st(sr, sc)) = S.v01;                                                 \
        *(LAS v4u*)(B_ + A_VS + v_st(32 + sr, sc)) = S.v10; *(LAS v4u*)(B_ + A_VS + 16384 + v_st(32 + sr, sc)) = S.v11; } while (0)
    { const int sr = tid >> 4, sc = (tid & 15) * 8; A_LOAD(0, S0); A_WRITE(0, S0); A_LOAD(1, S1); A_LOAD(2, S2); A_LOAD(3, S0); }
    LDS_WAIT(); __syncthreads();
#define A_ITER(cc, SN) do { if ((cc) < NC) {                                                                                                                  \
        int lane_o = F.lane, tid_o = F.tid; asm volatile("" : "+v"(lane_o), "+v"(tid_o));           \
        const int lane = lane_o, sr = tid_o >> 4, sc = (tid_o & 15) * 8;                                                                                         \
        { bf16* st = F.ST + ((((size_t)bh * NC + (cc)) * 8 + w) * 8) * 512 + lane * 8;                                                                           \
          _Pragma("unroll") for (int i = 0; i < 4; ++i) { *(GAS bf16x8*)(st + (i * 2 + 0) * 512) = pack_acc8(X[i], 0); *(GAS bf16x8*)(st + (i * 2 + 1) * 512) = pack_acc8(X[i], 8); } \
          if (w == 4 || w == 5) F.NST[((size_t)bh * NC + (cc)) * 128 + (w - 4) * 64 + lane] = nreg; }                                                            \
        if ((cc) < NC - 1) {                                                                                                                                     \
        const int boff = ((cc) & 1) * A_BUF; const float s_old = CH[96 + (cc)];                                                                                  \
        const int vbK = lbase + boff + A_KP + v_rd_base(lane), vbV = lbase + boff + A_VS + (w >> 2) * 16384 + (w & 3) * 512 + v_rd_base(lane);                   \
        bf16x8 vB[4];                                                                                                                                            \
        { const s16x4 l0 = tr_read<0 * 4096>(vbV), h0 = tr_read<0 * 4096 + 2048>(vbV), l1 = tr_read<1 * 4096>(vbV), h1 = tr_read<1 * 4096 + 2048>(vbV);          \
          const s16x4 l2 = tr_read<2 * 4096>(vbV), h2 = tr_read<2 * 4096 + 2048>(vbV), l3 = tr_read<3 * 4096>(vbV), h3 = tr_read<3 * 4096 + 2048>(vbV);          \
          asm volatile("s_waitcnt lgkmcnt(0)" ::: "memory"); SBAR();                                                                                             \
          vB[0] = pk88(l0, h0); vB[1] = pk88(l1, h1); vB[2] = pk88(l2, h2); vB[3] = pk88(l3, h3); }                                                              \
        _Pragma("unroll") for (int i = 0; i < 4; ++i) _Pragma("unroll") for (int r = 0; r < 16; ++r) X[i][r] *= s_old;                                           \
        cupd<0>(X[0], vbK, vB); cupd<1>(X[1], vbK, vB); cupd<2>(X[2], vbK, vB); cupd<3>(X[3], vbK, vB);                                                          \
        if (w == 4 || w == 5) { const int d = (w - 4) * 64 + lane; float acc = 0.f; const LAS unsigned char* kcol = L + boff + A_KP + ((d >> 5) * 512 + (d & 31) * 2); \
            _Pragma("unroll 1") for (int s8 = 0; s8 < 8; ++s8) {                                                                                                  \
                _Pragma("unroll") for (int e = 0; e < 8; ++e) acc += bf2f(*(const LAS bf16*)(kcol + s8 * 2048 + e * 64)); }                                       \
            nreg = s_old * nreg + acc; }                                                                                                                         \
        if ((cc) + 1 < NC - 1) { A_WRITE((cc) + 1, SN); if ((cc) + 4 < NC - 1) A_LOAD((cc) + 4, SN); }                                                           \
        MBAR(); } } } while (0)
    for (int c = 0; c < NC; c += 3) { A_ITER(c, S1); A_ITER(c + 1, S2); A_ITER(c + 2, S0); }
#undef A_ITER
#undef A_LOAD
#undef A_WRITE
}
__device__ __forceinline__ void p9b_output(Frame& F) {
    using namespace ml;
    constexpr int NC = T / 64, NITEMS = BATCH * MH * NC;
    LAS unsigned char* L = F.lds + RING_OFF;
    static_assert(ml::LDS_END_B <= RING_BYTES, "mLSTM pass B LDS");
    const int w = F.wave, tid = F.tid;
    LAS float* misc = (LAS float*)(L + MISC); LAS float* RSA = misc, * RSB = misc + 64, * QN = misc + 128;
    LAS float* pw = (LAS float*)(L + PW + w * PWB);
    const int lbase = (int)(uintptr_t)L;
    if (tid < 64) RSB[tid] = 0.f;
    f32x4 hg; { const float* gp = F.h_gain + 4 * F.lane; hg = (f32x4){gp[0], gp[1], gp[2], gp[3]}; }
    v4u sq0, sq1, sk0, sk1, sv00, sv01, sv10, sv11; float s_u, s_mm, s_sint, s_nrm; f32x2 s_n;
    LAS float* NBl = misc + 192;
#define B_LOAD(it_) do { const int bh_ = (it_) & 31, c_ = (it_) >> 5, b_ = bh_ / MH, h_ = bh_ % MH;                                                         \
        const bf16* rp0 = F.PROJ + ((size_t)b_ * T + (size_t)c_ * 64 + sr) * ML_N + sc; const bf16* rp1 = rp0 + 32 * ML_N;                                      \
        sq0 = *(const GAS v4u*)(rp0 + C_MQ + h_ * MDK); sq1 = *(const GAS v4u*)(rp1 + C_MQ + h_ * MDK); sk0 = *(const GAS v4u*)(rp0 + C_MK + h_ * MDK); sk1 = *(const GAS v4u*)(rp1 + C_MK + h_ * MDK);   \
        sv00 = *(const GAS v4u*)(rp0 + C_MV + h_ * MDV); sv01 = *(const GAS v4u*)(rp0 + C_MV + h_ * MDV + 128); sv10 = *(const GAS v4u*)(rp1 + C_MV + h_ * MDV); sv11 = *(const GAS v4u*)(rp1 + C_MV + h_ * MDV + 128); \
        const float* sp_ = F.SCAL + (size_t)bh_ * 4 * T + c_ * 64 + lane; s_u = sp_[0]; s_mm = sp_[T]; s_sint = sp_[2 * T]; s_nrm = sp_[3 * T];                                                \
        s_n = *(const GAS f32x2*)(F.NST + ((size_t)bh_ * NC + c_) * 128 + 2 * lane); } while (0)
#define B_WRITE() do { pw[lane] = s_u; pw[64 + lane] = s_mm; if (w == 3) *(LAS f32x2*)(NBl + 2 * lane) = s_n;                                                                                            \
        *(LAS v4u*)(L + QS + SW16(sr, sc * 2)) = sq0; *(LAS v4u*)(L + QS + SW16(32 + sr, sc * 2)) = sq1;                                                \
        *(LAS v4u*)(L + KS + SW16(sr, sc * 2)) = sk0; *(LAS v4u*)(L + KS + SW16(32 + sr, sc * 2)) = sk1;                                                \
        *(LAS v4u*)(L + VS + v_st(sr, sc)) = sv00; *(LAS v4u*)(L + VS + 16384 + v_st(sr, sc)) = sv01;                                                   \
        *(LAS v4u*)(L + VS + v_st(32 + sr, sc)) = sv10; *(LAS v4u*)(L + VS + 16384 + v_st(32 + sr, sc)) = sv11; } while (0)
    int it = F.vcu; if (it >= NITEMS) return;
    float c_sint, c_nrm;
    { const int lane = F.lane, sr = tid >> 4, sc = (tid & 15) * 8; B_LOAD(it); B_WRITE(); c_sint = s_sint; c_nrm = s_nrm; if (it + F.G < NITEMS) B_LOAD(it + F.G); }
    LDS_WAIT(); __syncthreads();
    for (; it < NITEMS; it += F.G) {
        const int bh = it & 31, c = it >> 5, b = bh / MH, h = bh % MH, t0 = c * 64; const size_t mb = (size_t)b * T;
        int lane_o = F.lane, tid_o = F.tid; asm volatile("" : "+v"(lane_o), "+v"(tid_o));
        const int lane = lane_o, r32 = lane & 31, hi = lane >> 5, sr = tid_o >> 4, sc = (tid_o & 15) * 8;
        const int vbV = lbase + VS + (w >> 2) * 16384 + (w & 3) * 512 + v_rd_base(lane);
        bf16x8 xb[4][2];
        { const bf16* st = F.ST + ((((size_t)bh * NC + c) * 8 + w) * 8) * 512 + lane * 8;
#pragma unroll
          for (int i = 0; i < 4; ++i) { xb[i][0] = __builtin_nontemporal_load((const GAS bf16x8*)(st + (i * 2 + 0) * 512)); xb[i][1] = __builtin_nontemporal_load((const GAS bf16x8*)(st + (i * 2 + 1) * 512)); } }
        if (w < 3) { const int lt = w ? 1 : 0, st = w == 2 ? 1 : 0; const int srow = r32 + 32 * st, lrow = r32 + 32 * lt;
            f32x16 p;
#pragma unroll
            for (int r = 0; r < 16; ++r) p[r] = 0.f;
#pragma unroll
            for (int kk = 0; kk < 8; ++kk) { const bf16x8 ka = *(const LAS bf16x8*)(L + KS + SW16(srow, (16 * kk + 8 * hi) * 2)), qb = *(const LAS bf16x8*)(L + QS + SW16(lrow, (16 * kk + 8 * hi) * 2));
                p = __builtin_amdgcn_mfma_f32_32x32x16_bf16(ka, qb, p, 0, 0, 0); }
            const float mml = pw[64 + lrow]; float ps = 0.f;
#pragma unroll
            for (int r = 0; r < 16; ++r) { const int s = crow(r, hi) + 32 * st; const float us = pw[s]; const float wgt = (s <= lrow) ? __expf(us - mml) : 0.f; p[r] *= wgt; ps += p[r]; }
            { auto rr = __builtin_amdgcn_permlane32_swap(__float_as_uint(ps), __float_as_uint(ps), false, false); ps = __uint_as_float(rr[0]) + __uint_as_float(rr[1]); }
            if (hi == 0) { if (st == 0) RSA[lrow] = ps; else RSB[lrow] = ps; }
            bf16x8 pa0, pa1;
#define PK4(P, BASE, OUT) do { unsigned a0 = cvtpk(P[BASE + 0], P[BASE + 1]), a1 = cvtpk(P[BASE + 2], P[BASE + 3]);   \
    unsigned b0 = cvtpk(P[BASE + 4], P[BASE + 5]), b1 = cvtpk(P[BASE + 6], P[BASE + 7]);                              \
    auto r0 = __builtin_amdgcn_permlane32_swap(a0, b0, false, false); auto r1 = __builtin_amdgcn_permlane32_swap(a1, b1, false, false); \
    v4u w_ = {r0[0], r1[0], r0[1], r1[1]}; OUT = *reinterpret_cast<bf16x8*>(&w_); } while (0)
            PK4(p, 0, pa0); PK4(p, 8, pa1);
#undef PK4
            *(LAS bf16x8*)(L + PF + (lt * 4 + 2 * st + 0) * 1024 + lane * 16) = pa0; *(LAS bf16x8*)(L + PF + (lt * 4 + 2 * st + 1) * 1024 + lane * 16) = pa1;
        } else if (w == 3) { const LAS float* nb = NBl; float acc = 0.f;
#pragma unroll 2
            for (int ch = 0; ch < 16; ++ch) { const v4u qv = *(const LAS v4u*)(L + QS + SW16(lane, ch * 16)); const f32x4 n0 = *(const LAS f32x4*)(nb + 8 * ch), n1 = *(const LAS f32x4*)(nb + 8 * ch + 4);
                acc += bflo(qv.x) * n0.x + bfhi(qv.x) * n0.y + bflo(qv.y) * n0.z + bfhi(qv.y) * n0.w + bflo(qv.z) * n1.x + bfhi(qv.z) * n1.y + bflo(qv.w) * n1.z + bfhi(qv.w) * n1.w; }
            QN[lane] = acc;
        }
        MBAR();
        { const float den = RSA[lane] + RSB[lane] + c_sint * QN[lane]; const float rinv = 1.f / fmaxf(fabsf(den), c_nrm); pw[192 + lane] = rinv; pw[256 + lane] = c_sint * rinv; }
        bf16x8 vB[4];
        { const s16x4 l0 = tr_read<0 * 4096>(vbV), h0 = tr_read<0 * 4096 + 2048>(vbV), l1 = tr_read<1 * 4096>(vbV), h1 = tr_read<1 * 4096 + 2048>(vbV);
          const s16x4 l2 = tr_read<2 * 4096>(vbV), h2 = tr_read<2 * 4096 + 2048>(vbV), l3 = tr_read<3 * 4096>(vbV), h3 = tr_read<3 * 4096 + 2048>(vbV);
          asm volatile("s_waitcnt lgkmcnt(0)" ::: "memory"); SBAR();
          vB[0] = pk88(l0, h0); vB[1] = pk88(l1, h1); vB[2] = pk88(l2, h2); vB[3] = pk88(l3, h3); }
        f32x16 aI0, aI1;
#pragma unroll
        for (int r = 0; r < 16; ++r) { aI0[r] = 0.f; aI1[r] = 0.f; }
        { const LAS unsigned char* qrow0 = L + QS + r32 * 256; const LAS unsigned char* qrow1 = qrow0 + 32 * 256; const int swz = (r32 & 15) << 4;
#define YI(I) do { yinter<I>(aI0, qrow0, swz, hi, xb[I][0], xb[I][1]); yinter<I>(aI1, qrow1, swz, hi, xb[I][0], xb[I][1]); } while (0)
          YI(0); YI(1); YI(2); YI(3);
#undef YI
        }
        v2u og[8];
#pragma unroll
        for (int e = 0; e < 8; ++e) og[e] = *(const GAS v2u*)(F.PROJ + (mb + t0 + 8 * w + e) * ML_N + C_MO + h * MDV + 4 * lane);
#pragma unroll
        for (int lt = 0; lt < 2; ++lt) { f32x16 aY;
#pragma unroll
            for (int r = 0; r < 16; ++r) aY[r] = 0.f;
            { const bf16x8 p0 = *(const LAS bf16x8*)(L + PF + (lt * 4 + 0) * 1024 + lane * 16), p1 = *(const LAS bf16x8*)(L + PF + (lt * 4 + 1) * 1024 + lane * 16);
              aY = __builtin_amdgcn_mfma_f32_32x32x16_bf16(p0, vB[0], aY, 0, 0, 0); aY = __builtin_amdgcn_mfma_f32_32x32x16_bf16(p1, vB[1], aY, 0, 0, 0); }
            if (lt == 1) { const bf16x8 p2 = *(const LAS bf16x8*)(L + PF + (4 + 2) * 1024 + lane * 16), p3 = *(const LAS bf16x8*)(L + PF + (4 + 3) * 1024 + lane * 16);
              aY = __builtin_amdgcn_mfma_f32_32x32x16_bf16(p2, vB[2], aY, 0, 0, 0); aY = __builtin_amdgcn_mfma_f32_32x32x16_bf16(p3, vB[3], aY, 0, 0, 0); }
#pragma unroll
            for (int r = 0; r < 16; ++r) { const int l = crow(r, hi) + 32 * lt; const float y = aY[r] * pw[192 + l] + (lt ? aI1[r] : aI0[r]) * pw[256 + l];
                *(LAS bf16*)(L + HS + l * HROW + (32 * w + r32) * 2) = (bf16)f2bf(y); }
        }
        MBAR();
#pragma unroll
        for (int e = 0; e < 8; ++e) { const int l = 8 * w + e; const v2u hv = *(const LAS v2u*)(L + HS + l * HROW + lane * 8);
            const float h0 = bflo(hv.x), h1 = bfhi(hv.x), h2 = bflo(hv.y), h3 = bfhi(hv.y);
            const float ss = wave_sum_dpp((h0 * h0 + h1 * h1) + (h2 * h2 + h3 * h3)); const float rn = __builtin_amdgcn_rsqf(ss * (1.f / MDV) + EPS);
            const float o0 = bflo(og[e].x), o1 = bfhi(og[e].x), o2 = bflo(og[e].y), o3 = bfhi(og[e].y);
            const float y0 = h0 * rn * hg.x / (1.f + __expf(-o0)), y1 = h1 * rn * hg.y / (1.f + __expf(-o1)), y2 = h2 * rn * hg.z / (1.f + __expf(-o2)), y3 = h3 * rn * hg.w / (1.f + __expf(-o3));
            v2u ov; ov.x = cvtpk(y0, y1); ov.y = cvtpk(y2, y3);
            *(GAS v2u*)(F.O + (mb + t0 + l) * DM + h * MDV + 4 * lane) = ov; }
        if (it + F.G < NITEMS) { B_WRITE(); c_sint = s_sint; c_nrm = s_nrm; if (it + 2 * F.G < NITEMS) B_LOAD(it + 2 * F.G); }
        MBAR();
    }
#undef B_LOAD
#undef B_WRITE
}
#undef SW16
#undef SBAR
#undef MBAR
namespace mlh {
constexpr int WREG = 12288, KIMG = 0, VIMG = 8192, XB0 = 8 * WREG, XBSZ = 16384 + 1024, WKO = XB0 + 2 * XBSZ, CHO = WKO + 8192, FLAGO = CHO + 1024, LDS_END = FLAGO + 64;
constexpr int TB = 0, TU = 8192, TM = 16384;
__device__ __forceinline__ int kh_st(int k, int c) { const int kk = (k & ~0xC) | ((k & 4) << 1) | ((k & 8) >> 1); return ((kk >> 3) * 2 + (c >> 5)) * 512 + ((kk & 7) * 32 + (c & 31)) * 2; }
__device__ __forceinline__ int vs_st(int k, int c) { const int kk = (k & ~0xC) | ((k & 4) << 1) | ((k & 8) >> 1); return (kk >> 3) * 512 + ((kk & 7) * 32 + c) * 2; }
using att::tr_read; using att::v_rd_base; using att::cvtpk; using ml::pk88; using ml::pack_acc8; using ml::wmul8; using ml::scan_sum64; using ml::scan_max64;
template <bool WITHN> __device__ __forceinline__ void dhalf(f32x16& D0, f32x16& D1, float& n0, float& n1, int vbK, const bf16x8 (&vB)[4]) {
    const bf16x8 ones = (bf16x8){0x3f80, 0x3f80, 0x3f80, 0x3f80, 0x3f80, 0x3f80, 0x3f80, 0x3f80};
    f32x16 N0, N1;
    if (WITHN) {
#pragma unroll
        for (int r = 0; r < 16; ++r) { N0[r] = 0.f; N1[r] = 0.f; } }
#define DH_STEP(KS) do { const s16x4 l0 = tr_read<0 * 512 + KS * 2048>(vbK), h0 = tr_read<0 * 512 + KS * 2048 + 1024>(vbK), l1 = tr_read<1 * 512 + KS * 2048>(vbK), h1 = tr_read<1 * 512 + KS * 2048 + 1024>(vbK); \
        asm volatile("s_waitcnt lgkmcnt(0)" ::: "memory"); __builtin_amdgcn_sched_barrier(0);                                                                           \
        const bf16x8 a0 = pk88(l0, h0), a1 = pk88(l1, h1);                                                                                                               \
        D0 = __builtin_amdgcn_mfma_f32_32x32x16_bf16(a0, vB[KS], D0, 0, 0, 0); D1 = __builtin_amdgcn_mfma_f32_32x32x16_bf16(a1, vB[KS], D1, 0, 0, 0);                      \
        if (WITHN) { N0 = __builtin_amdgcn_mfma_f32_32x32x16_bf16(ones, a0, N0, 0, 0, 0); N1 = __builtin_amdgcn_mfma_f32_32x32x16_bf16(ones, a1, N1, 0, 0, 0); } } while (0)
    DH_STEP(0); DH_STEP(1); DH_STEP(2); DH_STEP(3);
#undef DH_STEP
    if (WITHN) { n0 = N0[0]; n1 = N1[0]; }
}
}
template <bool WITHN> __device__ __forceinline__ void p10_chain(Frame& F, int bh, int js) {
    using namespace mlh;
    constexpr int NC = T / 64;
    LAS unsigned char* L = F.lds + RING_OFF;
    const int b = bh / MH, h = bh % MH, w = F.wave, lane = F.lane;
    const size_t mb = (size_t)b * T;
    LAS unsigned char* R = L + w * WREG;
    const LAS float* WKL = (const LAS float*)(L + WKO); const LAS float* CH = (const LAS float*)(L + CHO);
    volatile LAS unsigned* flag = (volatile LAS unsigned*)(L + FLAGO);
    const int lbase = (int)(uintptr_t)R;
    const int vbK = lbase + KIMG + v_rd_base(lane), vbV = lbase + VIMG + v_rd_base(lane);
    v4u ka[8], va[4];
    const int krow = lane >> 3, kc16 = lane & 7, vrow = lane >> 2, vc16 = lane & 3;
#define H_LOADK(cc, hh) do { const bf16* kp = F.PROJ + (mb + (size_t)(cc) * 64 + krow) * ML_N + C_MK + h * MDK + (hh) * 64 + 8 * kc16;                      \
        _Pragma("unroll") for (int e = 0; e < 8; ++e) ka[e] = *(const GAS v4u*)(kp + (size_t)(8 * e) * ML_N); } while (0)
#define H_LOADV(cc) do { const bf16* vp = F.PROJ + (mb + (size_t)(cc) * 64 + vrow) * ML_N + C_MV + h * MDV + js * 32 + 8 * vc16;                           \
        _Pragma("unroll") for (int e = 0; e < 4; ++e) va[e] = *(const GAS v4u*)(vp + (size_t)(16 * e) * ML_N); } while (0)
#define H_WRITEK(cc) do { _Pragma("unroll") for (int e = 0; e < 8; ++e) { const int s = 8 * e + krow; *(LAS v4u*)(R + KIMG + kh_st(s, 8 * kc16)) = wmul8(ka[e], WKL[(cc) * 64 + s]); } } while (0)
#define H_WRITEV() do { _Pragma("unroll") for (int e = 0; e < 4; ++e) { const int s = 16 * e + vrow; *(LAS v4u*)(R + VIMG + vs_st(s, 8 * vc16)) = va[e]; } } while (0)
    f32x16 D[4]; float dn[4] = {0.f, 0.f, 0.f, 0.f};
    if (w < NC - 1) { H_LOADK(w, 0); H_LOADV(w); }
#pragma unroll 1
    for (int r = 0; r < NC / 8; ++r) { const int c = w + 8 * r;
        if (c < NC - 1) {
#pragma unroll
            for (int i = 0; i < 4; ++i)
#pragma unroll
                for (int q = 0; q < 16; ++q) D[i][q] = 0.f;
            H_WRITEK(c); H_WRITEV(); H_LOADK(c, 1);
            bf16x8 vB[4];
            { const s16x4 l0 = tr_read<0 * 1024>(vbV), h0 = tr_read<0 * 1024 + 512>(vbV), l1 = tr_read<1 * 1024>(vbV), h1 = tr_read<1 * 1024 + 512>(vbV);
              const s16x4 l2 = tr_read<2 * 1024>(vbV), h2 = tr_read<2 * 1024 + 512>(vbV), l3 = tr_read<3 * 1024>(vbV), h3 = tr_read<3 * 1024 + 512>(vbV);
              asm volatile("s_waitcnt lgkmcnt(0)" ::: "memory"); __builtin_amdgcn_sched_barrier(0);
              vB[0] = pk88(l0, h0); vB[1] = pk88(l1, h1); vB[2] = pk88(l2, h2); vB[3] = pk88(l3, h3); }
            dhalf<WITHN>(D[0], D[1], dn[0], dn[1], vbK, vB);
            H_WRITEK(c);
            if (c + 8 < NC - 1) { H_LOADK(c + 8, 0); }
            dhalf<WITHN>(D[2], D[3], dn[2], dn[3], vbK, vB);
            if (c + 8 < NC - 1) { H_LOADV(c + 8); }
        }
        f32x16 X[4]; float nn[4] = {0.f, 0.f, 0.f, 0.f};
        if (c > 0) { while (*flag < (unsigned)c) __builtin_amdgcn_s_sleep(1);
            asm volatile("" ::: "memory");
            const LAS unsigned char* xb = L + XB0 + (c & 1) * XBSZ;
#pragma unroll
            for (int i = 0; i < 4; ++i)
#pragma unroll
                for (int q = 0; q < 4; ++q) { const f32x4 v = *(const LAS f32x4*)(xb + ((i * 4 + q) * 64 + lane) * 16); X[i][4 * q] = v.x; X[i][4 * q + 1] = v.y; X[i][4 * q + 2] = v.z; X[i][4 * q + 3] = v.w; }
            if (WITHN) {
#pragma unroll
                for (int i = 0; i < 4; ++i) nn[i] = *(const LAS float*)(xb + 16384 + (i * 32 + (lane & 31)) * 4); }
        } else {
#pragma unroll
            for (int i = 0; i < 4; ++i)
#pragma unroll
                for (int q = 0; q < 16; ++q) X[i][q] = 0.f;
        }
        { bf16* st = F.ST + ((((size_t)bh * NC + c) * 8 + js) * 8) * 512 + lane * 8;
#pragma unroll
          for (int i = 0; i < 4; ++i) { *(GAS bf16x8*)(st + (i * 2 + 0) * 512) = pack_acc8(X[i], 0); *(GAS bf16x8*)(st + (i * 2 + 1) * 512) = pack_acc8(X[i], 8); }
          if (WITHN && lane < 32) {
#pragma unroll
              for (int i = 0; i < 4; ++i) F.NST[((size_t)bh * NC + c) * 128 + i * 32 + lane] = nn[i]; } }
        if (c < NC - 1) { const float s_old = CH[96 + c]; LAS unsigned char* xo = L + XB0 + ((c + 1) & 1) * XBSZ;
#pragma unroll
            for (int i = 0; i < 4; ++i)
#pragma unroll
                for (int q = 0; q < 4; ++q) { f32x4 v; v.x = s_old * X[i][4 * q] + D[i][4 * q]; v.y = s_old * X[i][4 * q + 1] + D[i][4 * q + 1]; v.z = s_old * X[i][4 * q + 2] + D[i][4 * q + 2]; v.w = s_old * X[i][4 * q + 3] + D[i][4 * q + 3];
                    *(LAS f32x4*)(xo + ((i * 4 + q) * 64 + lane) * 16) = v; }
            if (WITHN && lane < 32) {
#pragma unroll
                for (int i = 0; i < 4; ++i) *(LAS float*)(xo + 16384 + (i * 32 + lane) * 4) = s_old * nn[i] + dn[i]; }
            asm volatile("s_waitcnt lgkmcnt(0)" ::: "memory");
            if (lane == 0) *flag = (unsigned)(c + 1);
        }
    }
#undef H_LOADK
#undef H_LOADV
#undef H_WRITEK
#undef H_WRITEV
}
__device__ __forceinline__ void p10_state_chain(Frame& F) {
    using namespace mlh;
    constexpr int NC = T / 64;
    static_assert(mlh::LDS_END <= RING_BYTES, "mLSTM chain LDS");
    LAS unsigned char* L = F.lds + RING_OFF;
    for (int it = F.vcu; it < BATCH * MH * 8; it += F.G) { const int bh = it >> 3, js = it & 7, w = F.wave, tid = F.tid;
        LAS float* WKL = (LAS float*)(L + WKO); LAS float* BL = (LAS float*)(L + TB); LAS float* UL = (LAS float*)(L + TU); LAS float* MLs = (LAS float*)(L + TM); LAS float* CH = (LAS float*)(L + CHO);
        const float* igp = F.IG + (size_t)bh * T; const float* lfp = F.LF + (size_t)bh * T;
        if (tid == 0) *(LAS unsigned*)(L + FLAGO) = 0u;
#pragma unroll
        for (int cc = 0; cc < 4; ++cc) { const int c = 4 * w + cc, t = c * 64 + F.lane; const float ig = igp[t], lf = lfp[t];
            const float bb = scan_sum64(lf), u = ig - bb, Mx = scan_max64(u);
            BL[t] = bb; UL[t] = u; MLs[t] = Mx; if (F.lane == 63) { CH[c] = bb; CH[32 + c] = Mx; } }
        LDS_WAIT(); __syncthreads();
        if (tid == 0) { float m = 0.f; for (int c = 0; c < NC; ++c) { const float mm63 = fmaxf(m, CH[32 + c]); CH[64 + c] = m; CH[96 + c] = __expf(m - mm63); CH[128 + c] = mm63; m = CH[c] + mm63; } }
        LDS_WAIT(); __syncthreads();
        { float* scal = F.SCAL + (size_t)bh * 4 * T;
          for (int t = tid; t < T; t += NTHR) { const int c = t >> 6; const float mst = CH[64 + c], mm = fmaxf(mst, MLs[t]), u = UL[t];
              if (js == 0) { scal[t] = u; scal[T + t] = mm; scal[2 * T + t] = __expf(mst - mm); scal[3 * T + t] = __expf(-(BL[t] + mm)); }
              WKL[t] = __expf(u - CH[128 + c]); } }
        LDS_WAIT(); __syncthreads();
        if (js == 0) p10_chain<true>(F, bh, js); else p10_chain<false>(F, bh, js);
        LDS_WAIT(); __syncthreads();
    }
}
#if ORA_IDX
__global__ __launch_bounds__(256) void ora_indexer(const bf16* QI, const bf16* KI, const float* WI, u64* MASK) {
    __shared__ float qi[1024]; __shared__ float sc[2048]; __shared__ float wi[16]; __shared__ unsigned cnt;
    const int m = blockIdx.x, b = m / T, t = m % T, tid = threadIdx.x;
    for (int i = tid; i < 1024; i += 256) qi[i] = bf2f(QI[(size_t)m * 1024 + i]);
    if (tid < 16) wi[tid] = WI[(size_t)m * 16 + tid];
    __syncthreads();
    for (int s = tid; s < T; s += 256) { float v = -__builtin_inff();
        if (s <= t) { float kk[64]; const v4u* kp = (const v4u*)(KI + (size_t)(b * T + s) * 64);
#pragma unroll
            for (int j = 0; j < 8; ++j) unpack8(kp[j], kk + 8 * j);
            v = 0.f;
            for (int h = 0; h < 16; ++h) { float d = 0.f;
#pragma unroll
                for (int e = 0; e < 64; ++e) d += qi[h * 64 + e] * kk[e];
                v += wi[h] * fmaxf(d, 0.f); } }
        sc[s] = v; }
    __syncthreads();
    unsigned k[8];
#pragma unroll
    for (int j = 0; j < 8; ++j) k[j] = fkey(sc[tid + 256 * j]);
    unsigned P = 0;
    for (int bit = 31; bit >= 0; --bit) { const unsigned cand = P | (1u << bit); unsigned c = 0;
#pragma unroll
        for (int j = 0; j < 8; ++j) c += (k[j] >= cand) ? 1u : 0u;
        if (tid == 0) cnt = 0; __syncthreads(); atomicAdd(&cnt, c); __syncthreads(); if (cnt >= (unsigned)TOPK) P = cand; __syncthreads(); }
    if (tid < 32) { u64 w = 0; for (int e = 0; e < 64; ++e) { const int s = 64 * tid + e; if (s <= t && fkey(sc[s]) >= P) w |= (1ull << e); } MASK[(size_t)m * 32 + tid] = w; }
}
#endif
#if ORA_ATT
__global__ __launch_bounds__(128) void ora_attn(const bf16* Q, const bf16* K, const bf16* V, const u64* MASK, bf16* O) {
    __shared__ float q[4][128]; __shared__ int idx[320]; __shared__ float p[4][320]; __shared__ int cnts[128]; __shared__ int total; __shared__ float linv[4];
    const int m = blockIdx.x >> 2, g = blockIdx.x & 3, b = m / T, tid = threadIdx.x;
    for (int r = 0; r < 4; ++r) q[r][tid] = bf2f(Q[(size_t)m * DM + (g * 4 + r) * HD + tid]);
    const unsigned bits = (unsigned)(MASK[(size_t)m * 32 + (tid >> 2)] >> (16 * (tid & 3))) & 0xffffu;
    cnts[tid] = __builtin_popcount(bits); __syncthreads();
    if (tid == 0) { int a = 0; for (int i = 0; i < 128; ++i) { const int c = cnts[i]; cnts[i] = a; a += c; } total = a; }
    __syncthreads();
    { int o = cnts[tid]; for (int e = 0; e < 16; ++e) if ((bits >> e) & 1u) { if (o < 320) idx[o] = 16 * tid + e; ++o; } }
    __syncthreads();
    const int n = total < 320 ? total : 320;
    for (int j = tid; j < n; j += 128) { const bf16* kr = K + (size_t)(b * T + idx[j]) * 512 + g * HD; float d0 = 0, d1 = 0, d2 = 0, d3 = 0;
        for (int e = 0; e < 128; ++e) { const float kv = bf2f(kr[e]); d0 += q[0][e] * kv; d1 += q[1][e] * kv; d2 += q[2][e] * kv; d3 += q[3][e] * kv; }
        const float sc = 0.08838834764831845f; p[0][j] = d0 * sc; p[1][j] = d1 * sc; p[2][j] = d2 * sc; p[3][j] = d3 * sc; }
    __syncthreads();
    if (tid < 4) { float mx = -__builtin_inff(); for (int j = 0; j < n; ++j) mx = fmaxf(mx, p[tid][j]); float s = 0.f; for (int j = 0; j < n; ++j) { const float e = expf(p[tid][j] - mx); p[tid][j] = e; s += e; } linv[tid] = 1.f / s; }
    __syncthreads();
    float o0 = 0, o1 = 0, o2 = 0, o3 = 0;
    for (int j = 0; j < n; ++j) { const float v = bf2f(V[(size_t)(b * T + idx[j]) * 512 + g * HD + tid]); o0 += p[0][j] * v; o1 += p[1][j] * v; o2 += p[2][j] * v; o3 += p[3][j] * v; }
    bf16* op = O + (size_t)m * DM + g * 4 * HD + tid;
    op[0] = (bf16)f2bf(o0 * linv[0]); op[HD] = (bf16)f2bf(o1 * linv[1]); op[2 * HD] = (bf16)f2bf(o2 * linv[2]); op[3 * HD] = (bf16)f2bf(o3 * linv[3]);
}
#endif
#if ORA_ML
__global__ __launch_bounds__(256) void ora_mlstm(const bf16* PROJ, const float* IG, const float* LF, const float* hgain, bf16* A2) {
    __shared__ float qs[128], ks[128], pr[128], red[4];
    const int b = blockIdx.x / MH, h = blockIdx.x % MH, e = threadIdx.x;
    float C[128]; float nd = 0.f, mst = 0.f;
#pragma unroll
    for (int d = 0; d < 128; ++d) C[d] = 0.f;
    const float hg = hgain[e];
    for (int t = 0; t < T; ++t) { const size_t m = (size_t)b * T + t; const bf16* row = PROJ + m * ML_N;
        const float ig = IG[(size_t)(b * MH + h) * T + t], lf = LF[(size_t)(b * MH + h) * T + t];
        const float mn = fmaxf(lf + mst, ig), fo = expf(lf + mst - mn), io = expf(ig - mn);
        if (e < 128) { const float qv = bf2f(row[C_MQ + h * MDK + e]), kv = bf2f(row[C_MK + h * MDK + e]); nd = fo * nd + io * kv; qs[e] = qv; ks[e] = kv; pr[e] = qv * nd; }
        __syncthreads();
        const float v = bf2f(row[C_MV + h * MDV + e]); float num = 0.f, den = 0.f;
#pragma unroll
        for (int d = 0; d < 128; ++d) { C[d] = fo * C[d] + io * ks[d] * v; num += qs[d] * C[d]; den += pr[d]; }
        const float hv = num / fmaxf(fabsf(den), expf(-mn));
        float s2 = wave_sum(hv * hv); if ((e & 63) == 0) red[e >> 6] = s2;
        __syncthreads();
        const float ssq = (red[0] + red[1]) + (red[2] + red[3]); const float rn = __builtin_amdgcn_rsqf(ssq * (1.f / MDV) + EPS);
        const float og = bf2f(row[C_MO + h * MDV + e]); const float sg = 1.f / (1.f + expf(-og));
        A2[m * DM + h * MDV + e] = (bf16)f2bf(sg * hv * rn * hg);
        mst = mn;
        __syncthreads();
    }
}
#endif
__global__ void __launch_bounds__(NTHR, 2) mk_fwd(Args args) {
    extern __shared__ __attribute__((aligned(16))) unsigned char lds[];
    Frame F;
    F.lds = (LAS unsigned char*)lds;
    F.MISC = (volatile LAS unsigned*)(F.lds + MISC_OFF);
    F.tid = threadIdx.x; F.lane = F.tid & 63; F.wave = __builtin_amdgcn_readfirstlane(F.tid >> 6);
    F.G = gridDim.x; { const int bx = blockIdx.x; F.vcu = (F.G % 8 == 0) ? (bx % 8) * (F.G / 8) + bx / 8 : bx; }
    unsigned char* ws = args.ws;
    F.ctl = (gu32*)(ws + WS_CTL);
    F.x = args.in[0]; F.norm_mix = args.in[1]; F.norm_ffn = args.in[2]; F.att_w_in = args.in[3]; F.q_gain = args.in[4]; F.k_gain = args.in[5]; F.att_w_out = args.in[6];
    F.ml_w_in = args.in[7]; F.b_gate = args.in[8]; F.h_gain = args.in[9]; F.ml_w_out = args.in[10]; F.w_up = args.in[11]; F.w_dn = args.in[12]; F.out = args.out;
    F.WinT = (bf16*)(ws + WS_WIN); F.WsmT = (bf16*)(ws + WS_WSM); F.WoT = (bf16*)(ws + WS_WO); F.WmlT = (bf16*)(ws + WS_WML); F.WgT = (bf16*)(ws + WS_WG); F.WmoT = (bf16*)(ws + WS_WMO);
    F.WupT0 = (bf16*)(ws + WS_WUP0); F.WupT1 = (bf16*)(ws + WS_WUP1); F.WdnT0 = (bf16*)(ws + WS_WDN0); F.WdnT1 = (bf16*)(ws + WS_WDN1);
    F.XB = (bf16*)(ws + WS_XB); F.PROJ = (bf16*)(ws + WS_PROJ); F.Q = (bf16*)(ws + WS_Q); F.K = (bf16*)(ws + WS_K); F.V = (bf16*)(ws + WS_V); F.QI = (bf16*)(ws + WS_QI); F.KI = (bf16*)(ws + WS_KI);
    F.O = (bf16*)(ws + WS_O); F.H = (bf16*)(ws + WS_H); F.WI = (float*)(ws + WS_WI); F.IG = (float*)(ws + WS_GATE); F.LF = (float*)(ws + WS_GATE + 512 * 1024); F.SC = (float*)(ws + WS_SC); F.ST = (bf16*)(ws + WS_SC); F.NST = (float*)(ws + WS_ML); F.SCAL = (float*)(ws + WS_ML + MiB);
    F.ROPE_A = (f32x2*)(ws + WS_ROPE); F.ROPE_I = (f32x2*)(ws + WS_ROPE + 512 * 1024); F.MASK = (u64*)(ws + WS_MASK);
    F.ss0 = (float*)(ws + WS_CTL) + CW_SS; F.ss1 = F.ss0 + M; F.ss2 = F.ss1 + M; F.ss3 = F.ss2 + M;
    for (int u = F.tid; u < (LDS_BYTES - LDSCTL_OFF) / 4; u += NTHR) ((LAS unsigned*)(F.lds + LDSCTL_OFF))[u] = 0u;
    __syncthreads();
    XcdBarrier bar; bar.bar = (unsigned*)(F.ctl + CW_BAR); bar.x = 0; bar.st = nullptr;
    if (!MK_MULTI) bar = xcd_barrier_post((unsigned*)(F.ctl + CW_BAR), F.MISC + 8);
    const int lo = args.ph_lo, hi = args.ph_hi;
#ifdef ONLY_PHASE
#define IN(k) ((k) == ONLY_PHASE && lo <= (k) && (k) < hi)
#else
#define IN(k) (lo <= (k) && (k) < hi)
#endif
#define SEAM(k) do { if (IN(k) && IN((k) + 1)) xcd_barrier(bar); } while (0)
#ifndef PROBE_DBL
#define PROBE_DBL (-1)
#endif
#define REPS(k) for (int rep_ = (F.tid = opaque_tid(), F.lane = F.tid & 63, 0); rep_ < ((k) == PROBE_DBL ? 2 : 1); ++rep_, ((k) == PROBE_DBL && rep_ == 1 ? xcd_barrier(bar) : (void)0))
#define DUMMY(k) ((k) == PROBE_DBL && rep_ == 0)
    float* const dummy_out = (float*)(ws + WS_SC);
    if (IN(0)) REPS(0) { p0_prologue(F); } SEAM(0);
    if (IN(1)) REPS(1) { pg8::Gemm g{F.XB, F.WinT, M, ATT_N, DM}; pg8::StaticOrder S; S.init(M, ATT_N, F.G, (int)blockIdx.x);
        pg8::EpiScale<0> E{F.PROJ, ATT_N, F.ss0, 1.f / DM, EPS};
        pg8::gemm_phase<pg8::EpiScale<0>, pg8::StaticOrder, PG8_ALIGN, PG8_SP2>(F.lds + RING_OFF, g, S, E);
        skinny_att(F);
#ifdef PROBE_SK
        xcd_barrier(bar); skinny_att(F);
#endif
        } SEAM(1);
#if IDX_FUSED
    if (IN(3)) REPS(3) {
#if !ORA_IDX
        p3_fused(F);
#endif
    } SEAM(3);
#else
    if (IN(3)) REPS(3) {
#if !ORA_IDX
        p3a_scores(F);
#ifdef PROBE_P3ABL
        xcd_barrier(bar); p3a_scores<PROBE_P3ABL>(F);
#endif
#endif
    } SEAM(3);
    if (IN(4)) REPS(4) {
#if !ORA_IDX
        p3b_select(F);
#endif
    } SEAM(4);
#endif
#ifdef PROBE_BAR
    if (IN(5)) { for (int q = 0; q < 10; ++q) xcd_barrier(bar); }
#endif
    if (IN(5)) REPS(5) {
#if !ORA_ATT
        p4_attention(F, (char*)lds + RING_OFF);
#endif
    } SEAM(5);
    if (IN(6)) REPS(6) { pg8::Gemm g{F.O, F.WoT, M, DM, DM}; pg8::StaticOrder S; S.init(M, DM, F.G, (int)blockIdx.x);
        pg8::EpiRes E{F.XB, DUMMY(6) ? (bf16*)dummy_out : F.XB, nullptr, DUMMY(6) ? F.ss0 + 4 * M : F.ss1, DM};
        pg8::gemm_phase<pg8::EpiRes, pg8::StaticOrder, PG8_ALIGN, PG8_SP2>(F.lds + RING_OFF, g, S, E); } SEAM(6);
#ifdef PROBE_NULLEPI
    if (IN(PROBE_NULLEPI)) { xcd_barrier(bar);
        if (PROBE_NULLEPI == 7) { pg8::Gemm g{F.XB, F.WupT0, M, FF, DM}; pg8::StaticOrder S; S.init(M, FF, F.G, (int)blockIdx.x); pg8::EpiNull E{}; pg8::gemm_phase<pg8::EpiNull, pg8::StaticOrder, PG8_ALIGN, PG8_SP2>(F.lds + RING_OFF, g, S, E); }
        if (PROBE_NULLEPI == 8) { pg8::Gemm g{F.H, F.WdnT0, M, DM, FF}; pg8::StaticOrder S; S.init(M, DM, F.G, (int)blockIdx.x); pg8::EpiNull E{}; pg8::gemm_phase<pg8::EpiNull, pg8::StaticOrder, PG8_ALIGN, PG8_SP2>(F.lds + RING_OFF, g, S, E); }
        xcd_barrier(bar); }
#endif
    if (IN(7)) REPS(7) { pg8::Gemm g{F.XB, F.WupT0, M, FF, DM}; pg8::StaticOrder S; S.init(M, FF, F.G, (int)blockIdx.x);
        pg8::EpiScale<1> E{F.H, FF, F.ss1, 1.f / DM, EPS};
        pg8::gemm_phase<pg8::EpiScale<1>, pg8::StaticOrder, PG8_ALIGN, PG8_SP2>(F.lds + RING_OFF, g, S, E); } SEAM(7);
    if (IN(8)) REPS(8) { pg8::Gemm g{F.H, F.WdnT0, M, DM, FF}; pg8::StaticOrder S; S.init(M, DM, F.G, (int)blockIdx.x);
        pg8::EpiRes E{F.XB, DUMMY(8) ? (bf16*)dummy_out : F.XB, nullptr, DUMMY(8) ? F.ss0 + 4 * M : F.ss2, DM};
        pg8::gemm_phase<pg8::EpiRes, pg8::StaticOrder, PG8_ALIGN, PG8_SP2>(F.lds + RING_OFF, g, S, E); } SEAM(8);
    if (IN(9)) REPS(9) { pg8::Gemm g{F.XB, F.WmlT, M, ML_N, DM}; pg8::StaticOrder S; S.init(M, ML_N, F.G, (int)blockIdx.x);
        pg8::EpiScale<0> E{F.PROJ, ML_N, F.ss2, 1.f / DM, EPS};
        pg8::gemm_phase<pg8::EpiScale<0>, pg8::StaticOrder, PG8_ALIGN, PG8_SP2>(F.lds + RING_OFF, g, S, E);
        skinny_gates(F); } SEAM(9);
    if (IN(10)) REPS(10) {
#if !ORA_ML
#if ML_CHAIN
        p10_state_chain(F);
#else
        p9a_state<0>(F);
#endif
#ifdef PROBE_SUB
        xcd_barrier(bar); p9a_state<PROBE_SUB>(F);
#endif
#endif
    } SEAM(10);
    if (IN(11)) REPS(11) {
#if !ORA_ML
        p9b_output(F);
#endif
    } SEAM(11);
    if (IN(12)) REPS(12) { pg8::Gemm g{F.O, F.WmoT, M, DM, DM}; pg8::StaticOrder S; S.init(M, DM, F.G, (int)blockIdx.x);
        pg8::EpiRes E{F.XB, DUMMY(12) ? (bf16*)dummy_out : F.XB, nullptr, DUMMY(12) ? F.ss0 + 4 * M : F.ss3, DM};
        pg8::gemm_phase<pg8::EpiRes, pg8::StaticOrder, PG8_ALIGN, PG8_SP2>(F.lds + RING_OFF, g, S, E); } SEAM(12);
    if (IN(13)) REPS(13) { pg8::Gemm g{F.XB, F.WupT1, M, FF, DM}; pg8::StaticOrder S; S.init(M, FF, F.G, (int)blockIdx.x);
        pg8::EpiScale<1> E{F.H, FF, F.ss3, 1.f / DM, EPS};
        pg8::gemm_phase<pg8::EpiScale<1>, pg8::StaticOrder, PG8_ALIGN, PG8_SP2>(F.lds + RING_OFF, g, S, E); } SEAM(13);
    if (IN(14)) REPS(14) { pg8::Gemm g{F.H, F.WdnT1, M, DM, FF}; pg8::StaticOrder S; S.init(M, DM, F.G, (int)blockIdx.x);
        pg8::EpiRes E{F.XB, nullptr, DUMMY(14) ? dummy_out : F.out, nullptr, DM};
        pg8::gemm_phase<pg8::EpiRes, pg8::StaticOrder, PG8_ALIGN, PG8_SP2>(F.lds + RING_OFF, g, S, E); }
#undef IN
#undef SEAM
}

extern "C" void kernel_launch(void* const* d_in, const int* in_sizes, int n_in, void* d_out, int out_size, void* d_ws, size_t ws_size, hipStream_t stream) {
    static int grid = 0;
    if (grid == 0) {
        if (n_in != 13 || in_sizes[0] != M * DM || out_size != M * DM || ws_size < WS_END) { fprintf(stderr, "kernel_launch: shape/workspace mismatch (n_in %d, in0 %d, out %d, ws %zu, need %zu)\n", n_in, n_in > 0 ? in_sizes[0] : -1, out_size, ws_size, (size_t)WS_END); grid = -1; return; }
        int dev = 0, cus = 0, per_cu = 0;
        if (hipGetDevice(&dev) != hipSuccess || hipDeviceGetAttribute(&cus, hipDeviceAttributeMultiprocessorCount, dev) != hipSuccess) { grid = -1; return; }
        if (hipFuncSetAttribute((const void*)mk_fwd, hipFuncAttributeMaxDynamicSharedMemorySize, LDS_BYTES) != hipSuccess) { fprintf(stderr, "kernel_launch: hipFuncSetAttribute failed\n"); grid = -1; return; }
        if (hipOccupancyMaxActiveBlocksPerMultiprocessor(&per_cu, (const void*)mk_fwd, NTHR, LDS_BYTES) != hipSuccess || per_cu < 1) fprintf(stderr, "kernel_launch: occupancy query reports %d blocks per CU\n", per_cu);
        (void)hipGetLastError();
        grid = cus;
    }
    if (grid < 0) return;
    if (hipMemsetAsync((char*)d_ws + WS_CTL, 0, CTL_ZERO_BYTES, stream) != hipSuccess) { fprintf(stderr, "kernel_launch: memset failed\n"); return; }
    Args a{};
    for (int i = 0; i < 13; ++i) a.in[i] = (const float*)d_in[i];
    a.out = (float*)d_out; a.ws = (unsigned char*)d_ws;
#if MK_MULTI
    unsigned char* ws = (unsigned char*)d_ws;
    for (int p = 0; p < N_PHASES; ++p) {
        if (p == 4 && ORA_IDX) continue;
        if (p == 3 && ORA_IDX) {
#if ORA_IDX
            hipLaunchKernelGGL(ora_indexer, dim3(M), dim3(256), 0, stream, (const bf16*)(ws + WS_QI), (const bf16*)(ws + WS_KI), (const float*)(ws + WS_WI), (u64*)(ws + WS_MASK));
#endif
            continue; }
        if (p == 5 && ORA_ATT) {
#if ORA_ATT
            hipLaunchKernelGGL(ora_attn, dim3(M * 4), dim3(128), 0, stream, (const bf16*)(ws + WS_Q), (const bf16*)(ws + WS_K), (const bf16*)(ws + WS_V), (const u64*)(ws + WS_MASK), (bf16*)(ws + WS_O));
#endif
            continue; }
        if (p == 11 && ORA_ML) continue;
        if (p == 10 && ORA_ML) {
#if ORA_ML
            hipLaunchKernelGGL(ora_mlstm, dim3(BATCH * MH), dim3(256), 0, stream, (const bf16*)(ws + WS_PROJ), (const float*)(ws + WS_GATE), (const float*)(ws + WS_GATE + 512 * 1024), (const float*)d_in[9], (bf16*)(ws + WS_O));
#endif
            continue; }
        a.ph_lo = p; a.ph_hi = p + 1; a.li = p;
        hipLaunchKernelGGL(mk_fwd, dim3(grid), dim3(NTHR), LDS_BYTES, stream, a);
    }
#else
    a.ph_lo = 0; a.ph_hi = N_PHASES; a.li = 0;
    hipLaunchKernelGGL(mk_fwd, dim3(grid), dim3(NTHR), LDS_BYTES, stream, a);
#endif
    const hipError_t le = hipPeekAtLastError();
    if (le != hipSuccess) fprintf(stderr, "kernel_launch: launch failed: %s\n", hipGetErrorName(le));
}
```

```cpp
#ifndef MK_MULTI
#define MK_MULTI 0
#endif
#ifndef ORA_IDX
#define ORA_IDX 0
#endif
#ifndef ORA_ATT
#define ORA_ATT 0
#endif
#ifndef ORA_ML
#define ORA_ML 0
#endif
#ifndef PROBE_DBL
#define PROBE_DBL (-1)
#endif
#include <hip/hip_runtime.h>
#include <cstdio>
#include <cstdint>
#include <cmath>
__device__ __forceinline__ int opaque_tid() { int t = threadIdx.x; asm volatile("" : "+v"(t)); return t; }
namespace pg8 {
#define PG8_LAS __attribute__((address_space(3)))
typedef unsigned short bf16_t;
typedef short bf16x8 __attribute__((ext_vector_type(8)));
typedef float f32x4 __attribute__((ext_vector_type(4)));
typedef unsigned u32x4 __attribute__((ext_vector_type(4)));
constexpr int BM = 256, BK = 64, HALF = 128, HTB = HALF * BK * 2  , STAGE_BYTES = 8 * HTB, NXCD = 8, WGM = 2;

__host__ __device__ __forceinline__ int lds_byte(int r, int c) { const int st = (r >> 4) * 2 + (c >> 5), rr = r & 15, cc = c & 31, ob = rr * 64 + cc * 2; return st * 1024 + (ob ^ (((ob >> 9) & 1) << 5)); }
__host__ __device__ __forceinline__ void stage_rc(int b, int& R, int& C) { const int st = b / 1024, sb = b % 1024, swz = sb ^ (((sb >> 9) & 1) << 5); R = (st >> 1) * 16 + swz / 64; C = (st & 1) * 32 + (swz % 64) / 2; }
__host__ __device__ __forceinline__ int perm32(int rho) { const int n = rho >> 4, i = rho & 15; return 8 * (i >> 2) + 4 * n + (i & 3); }

struct Unit { int pm, pn; };
struct Gemm { const bf16_t* A; const bf16_t* Bt; int M, N, K; };

struct StaticOrder {
    int nM, nN, nwg, G, c;
    __host__ __device__ void init(int M, int N, int G_, int c_) { nM = M / BM; nN = N / BM; nwg = nM * nN; G = G_; c = c_; }
    __host__ __device__ bool next(int i, Unit& u) const {
        const long L = (long)i * G + c; if (L >= nwg) return false;
        int wgid = (int)L; { const int q = nwg / NXCD, r = nwg % NXCD, xcd = wgid % NXCD, off = wgid / NXCD; wgid = (xcd < r ? xcd * (q + 1) : r * (q + 1) + (xcd - r) * q) + off; }
        const int nig = WGM * nN, gid = wgid / nig, fm = gid * WGM, gsz = (nM - fm) < WGM ? (nM - fm) : WGM;
        u.pm = fm + ((wgid % nig) % gsz); u.pn = (wgid % nig) / gsz; return true;
    }
    __device__ __forceinline__ void a_ready(const Unit&) const {}
    __device__ __forceinline__ void done(const Unit&) const {}
};

__device__ __forceinline__ unsigned cvt_pk_bf16(float lo, float hi) { unsigned r; asm volatile("v_cvt_pk_bf16_f32 %0, %1, %2" : "=v"(r) : "v"(lo), "v"(hi)); return r; }
typedef float f32x2 __attribute__((ext_vector_type(2)));
typedef unsigned u32x2 __attribute__((ext_vector_type(2)));
template <int MODE> struct EpiScale {
    static constexpr bool PERM = true, AFTER_DRAIN = false;
    bf16_t* O; int ldc; const float* ss; float inv_n, eps;
    __device__ __forceinline__ void operator()(const f32x4 (&acc)[2][2][4][2], const Unit& u, int wr, int wc, int fr, int fq) const {
        const int row0 = u.pm * BM + wr * 64 + fr, col0 = u.pn * BM + wc * 64 + 8 * fq;
#pragma unroll
        for (int ai = 0; ai < 2; ++ai)
#pragma unroll
            for (int m = 0; m < 4; ++m) { const int row = row0 + ai * HALF + m * 16; const float rs = __builtin_amdgcn_rsqf(ss[row] * inv_n + eps); const float rs2 = rs * rs;
                bf16_t* rowp = O + (size_t)row * ldc + col0;
#pragma unroll
                for (int bj = 0; bj < 2; ++bj) { f32x4 v0 = acc[ai][bj][m][0], v1 = acc[ai][bj][m][1];
                    if (MODE == 0) { v0 = v0 * rs; v1 = v1 * rs; }
                    else { v0 = __builtin_elementwise_max(v0, (f32x4){0.f, 0.f, 0.f, 0.f}); v1 = __builtin_elementwise_max(v1, (f32x4){0.f, 0.f, 0.f, 0.f}); v0 = v0 * v0 * rs2; v1 = v1 * v1 * rs2; }
                    u32x4 w; w.x = cvt_pk_bf16(v0[0], v0[1]); w.y = cvt_pk_bf16(v0[2], v0[3]); w.z = cvt_pk_bf16(v1[0], v1[1]); w.w = cvt_pk_bf16(v1[2], v1[3]);
                    *(u32x4*)(rowp + bj * 32) = w; } }
    }
};
struct EpiRes {
    static constexpr bool PERM = true, AFTER_DRAIN = false;
    const bf16_t* base; bf16_t* hb; float* outf; float* ss; int ldc;
    __device__ __forceinline__ void operator()(const f32x4 (&acc)[2][2][4][2], const Unit& u, int wr, int wc, int fr, int fq) const {
        const int col0 = u.pn * BM + wc * 64 + 8 * fq;
#pragma unroll
        for (int ai = 0; ai < 2; ++ai)
#pragma unroll
            for (int m = 0; m < 4; ++m) { const int row = u.pm * BM + ai * HALF + wr * 64 + m * 16 + fr; const size_t off = (size_t)row * ldc + col0; float s = 0.f;
#pragma unroll
                for (int bj = 0; bj < 2; ++bj) { const u32x4 bw = *(const u32x4*)(base + off + bj * 32);
                    const f32x4 b0 = {__builtin_bit_cast(float, bw.x << 16), __builtin_bit_cast(float, bw.x & 0xffff0000u), __builtin_bit_cast(float, bw.y << 16), __builtin_bit_cast(float, bw.y & 0xffff0000u)};
                    const f32x4 b1 = {__builtin_bit_cast(float, bw.z << 16), __builtin_bit_cast(float, bw.z & 0xffff0000u), __builtin_bit_cast(float, bw.w << 16), __builtin_bit_cast(float, bw.w & 0xffff0000u)};
                    const f32x4 o0 = b0 + acc[ai][bj][m][0], o1 = b1 + acc[ai][bj][m][1];
                    if (outf) { *(f32x4*)(outf + off + bj * 32) = o0; *(f32x4*)(outf + off + bj * 32 + 4) = o1; }
                    else { u32x4 w; w.x = cvt_pk_bf16(o0[0], o0[1]); w.y = cvt_pk_bf16(o0[2], o0[3]); w.z = cvt_pk_bf16(o1[0], o1[1]); w.w = cvt_pk_bf16(o1[2], o1[3]); *(u32x4*)(hb + off + bj * 32) = w;
                        s += ((o0[0] * o0[0] + o0[1] * o0[1]) + (o0[2] * o0[2] + o0[3] * o0[3])) + ((o1[0] * o1[0] + o1[1] * o1[1]) + (o1[2] * o1[2] + o1[3] * o1[3])); } }
                if (!outf) { s += __shfl_xor(s, 16); s += __shfl_xor(s, 32); if (fq == 0) atomicAdd(ss + row, s); }
                asm volatile("" ::: "memory"); }
    }
};
struct EpiNull {
    static constexpr bool PERM = false, AFTER_DRAIN = false;
    __device__ __forceinline__ void operator()(const f32x4 (&acc)[2][2][4][2], const Unit&, int, int, int, int) const {
#pragma unroll
        for (int ai = 0; ai < 2; ++ai)
#pragma unroll
            for (int bj = 0; bj < 2; ++bj)
#pragma unroll
                for (int m = 0; m < 4; ++m)
#pragma unroll
                    for (int n = 0; n < 2; ++n) asm volatile("" :: "v"(acc[ai][bj][m][n]));
    }
};
template <class Epi, class Sched, bool ALIGN_EPI = false, bool SP2 = false>
__device__ __forceinline__ void gemm_phase(PG8_LAS unsigned char* lds, const Gemm g, const Sched& S, const Epi& E) {
    const int tid = opaque_tid(), wid = __builtin_amdgcn_readfirstlane(tid >> 6), lane = tid & 63, wr = wid >> 2, wc = wid & 3, fr = lane & 15, fq = lane >> 4;
    const int K = g.K, nt = K / BK;
    unsigned voffA[2], voffB[2];
#pragma unroll
    for (int i = 0; i < 2; ++i) { int R, C; stage_rc(tid * 16 + i * 8192, R, C); const int Rb = Epi::PERM ? (64 * (R >> 5) + perm32(R & 31)) : R;
        voffA[i] = (unsigned)(R * K + C) * 2u; voffB[i] = (unsigned)(Rb * K + C) * 2u; }
    const size_t kstep = (size_t)(BK * 2);
    const size_t hstep = (size_t)HALF * K * 2;
    const size_t hstepB = Epi::PERM ? (size_t)32 * K * 2 : hstep;
    const size_t tstep = 2 * hstep;
    const unsigned ldsw = (unsigned)wid * 1024u;
    const int aoff = lds_byte(wr * 64 + fr, fq * 8), boff = lds_byte(wc * 32 + fr, fq * 8);
#define PG8_SA(b, h) (((b) * 2 + (h)) * HTB)
#define PG8_SB(b, h) ((4 + (b) * 2 + (h)) * HTB)
#define PG8_STAGE(bufoff, gbase, voff) do { _Pragma("unroll") for (int _i = 0; _i < 2; ++_i) \
        __builtin_amdgcn_global_load_lds((const unsigned*)((const char*)(gbase) + (voff)[_i]), (PG8_LAS unsigned*)(lds + (bufoff) + ldsw + _i * 8192), 16, 0, 0); } while (0)
#define PG8_LDA(dst, b, h) do { _Pragma("unroll") for (int m = 0; m < 4; ++m) _Pragma("unroll") for (int k = 0; k < 2; ++k) dst[m][k] = *(const PG8_LAS bf16x8*)(lds + PG8_SA(b, h) + aoff + m * 2048 + k * 1024); } while (0)
#define PG8_LDB(dst, b, h) do { _Pragma("unroll") for (int n = 0; n < 2; ++n) _Pragma("unroll") for (int k = 0; k < 2; ++k) dst[n][k] = *(const PG8_LAS bf16x8*)(lds + PG8_SB(b, h) + boff + n * 2048 + k * 1024); } while (0)
#define PG8_MMA(ai, bj, At, Bt) do { __builtin_amdgcn_s_setprio(1); _Pragma("unroll") for (int m = 0; m < 4; ++m) _Pragma("unroll") for (int n = 0; n < 2; ++n) _Pragma("unroll") for (int k = 0; k < 2; ++k) \
        acc[ai][bj][m][n] = __builtin_amdgcn_mfma_f32_16x16x32_bf16(Bt[n][k], At[m][k], acc[ai][bj][m][n], 0, 0, 0); __builtin_amdgcn_s_setprio(0); } while (0)
#define PG8_WAIT_V(n) asm volatile("s_waitcnt vmcnt(" #n ")" ::: "memory")
#define PG8_WAIT_L(n) asm volatile("s_waitcnt lgkmcnt(" #n ")" ::: "memory")
#define PG8_BAR __builtin_amdgcn_s_barrier()
#define PG8_SCHED __builtin_amdgcn_sched_barrier(0)
    Unit cur, nxt; int ui = 0;
    if (!S.next(0, cur)) return;
    f32x4 acc[2][2][4][2];
#pragma unroll
    for (int a = 0; a < 2; ++a)
#pragma unroll
        for (int b = 0; b < 2; ++b)
#pragma unroll
            for (int m = 0; m < 4; ++m)
#pragma unroll
                for (int n = 0; n < 2; ++n) acc[a][b][m][n] = (f32x4){0.f, 0.f, 0.f, 0.f};
    bf16x8 At[4][2], B0[2][2], B1[2][2];
    const char* cA = (const char*)g.A + (size_t)cur.pm * tstep; const char* cB = (const char*)g.Bt + (size_t)cur.pn * tstep;
    S.a_ready(cur);
    if constexpr (SP2) {
        PG8_STAGE(PG8_SB(0, 0), cB, voffB); PG8_STAGE(PG8_SB(0, 1), cB + hstepB, voffB); PG8_STAGE(PG8_SA(0, 0), cA, voffA); PG8_STAGE(PG8_SA(0, 1), cA + hstep, voffA);
        if (wr == 1) PG8_BAR;
        PG8_WAIT_V(2); PG8_BAR;
        PG8_STAGE(PG8_SB(1, 0), cB + kstep, voffB); PG8_STAGE(PG8_SA(1, 0), cA + kstep, voffA); PG8_STAGE(PG8_SB(1, 1), cB + hstepB + kstep, voffB);
        PG8_WAIT_V(6); PG8_BAR;
    } else {
        PG8_STAGE(PG8_SB(0, 0), cB, voffB); PG8_STAGE(PG8_SA(0, 0), cA, voffA); PG8_STAGE(PG8_SB(0, 1), cB + hstepB, voffB); PG8_STAGE(PG8_SA(0, 1), cA + hstep, voffA);
        if (wr == 1) PG8_BAR;
        PG8_WAIT_V(4); PG8_BAR;
        PG8_STAGE(PG8_SB(1, 0), cB + kstep, voffB); PG8_STAGE(PG8_SA(1, 0), cA + kstep, voffA); PG8_STAGE(PG8_SB(1, 1), cB + hstepB + kstep, voffB);
        PG8_WAIT_V(6); PG8_BAR;
    }
    for (;;) {
        const bool has_next = S.next(ui + 1, nxt);
        const char* nA = has_next ? (const char*)g.A + (size_t)nxt.pm * tstep : cA; const char* nB = has_next ? (const char*)g.Bt + (size_t)nxt.pn * tstep : cB;
        for (int t = 0; t < nt; t += 2) {
            const bool last = (t == nt - 2);
            const char* a1 = cA + (size_t)(t + 1) * kstep;
            const char* a2 = last ? nA : cA + (size_t)(t + 2) * kstep; const char* b2 = last ? nB : cB + (size_t)(t + 2) * kstep;
            const char* a3 = a2 + kstep; const char* b3 = b2 + kstep;
            if (last && has_next) S.a_ready(nxt);
            if constexpr (SP2) {
            PG8_LDB(B0, 0, 0); PG8_LDB(B1, 0, 1); PG8_SCHED; PG8_LDA(At, 0, 0); PG8_STAGE(PG8_SA(1, 1), a1 + hstep, voffA);
            PG8_WAIT_V(8); PG8_WAIT_L(0); PG8_BAR; PG8_MMA(0, 0, At, B0); PG8_MMA(0, 1, At, B1); PG8_BAR; PG8_SCHED;
            PG8_LDA(At, 0, 1); PG8_STAGE(PG8_SB(0, 0), b2, voffB); PG8_STAGE(PG8_SB(0, 1), b2 + hstepB, voffB); PG8_STAGE(PG8_SA(0, 0), a2, voffA);
            PG8_WAIT_V(8); PG8_WAIT_L(0); PG8_BAR; PG8_MMA(1, 0, At, B0); PG8_MMA(1, 1, At, B1); PG8_BAR; PG8_SCHED;
            PG8_LDB(B0, 1, 0); PG8_LDB(B1, 1, 1); PG8_SCHED; PG8_LDA(At, 1, 0); PG8_STAGE(PG8_SA(0, 1), a2 + hstep, voffA);
            PG8_WAIT_V(8); PG8_WAIT_L(0); PG8_BAR; PG8_MMA(0, 0, At, B0); PG8_MMA(0, 1, At, B1); PG8_BAR; PG8_SCHED;
            PG8_LDA(At, 1, 1); PG8_STAGE(PG8_SB(1, 0), b3, voffB); PG8_STAGE(PG8_SB(1, 1), b3 + hstepB, voffB); PG8_STAGE(PG8_SA(1, 0), a3, voffA);
            PG8_WAIT_V(8); PG8_WAIT_L(0); PG8_BAR; PG8_MMA(1, 0, At, B0); PG8_MMA(1, 1, At, B1); PG8_BAR; PG8_SCHED;
            } else {
            PG8_LDB(B0, 0, 0); PG8_SCHED; PG8_LDA(At, 0, 0); PG8_STAGE(PG8_SA(1, 1), a1 + hstep, voffA);
            PG8_WAIT_L(8); PG8_BAR; PG8_WAIT_L(0); PG8_MMA(0, 0, At, B0); PG8_BAR; PG8_SCHED;
            PG8_LDB(B1, 0, 1); PG8_STAGE(PG8_SB(0, 0), b2, voffB);
            PG8_BAR; PG8_WAIT_L(0); PG8_MMA(0, 1, At, B1); PG8_BAR;
            PG8_LDA(At, 0, 1); PG8_STAGE(PG8_SA(0, 0), a2, voffA);
            PG8_BAR; PG8_WAIT_L(0); PG8_MMA(1, 0, At, B0); PG8_BAR; PG8_SCHED;
            PG8_STAGE(PG8_SB(0, 1), b2 + hstepB, voffB);
            PG8_WAIT_V(6); PG8_BAR; PG8_MMA(1, 1, At, B1); PG8_BAR;
            PG8_LDB(B0, 1, 0); PG8_SCHED; PG8_LDA(At, 1, 0); PG8_STAGE(PG8_SA(0, 1), a2 + hstep, voffA);
            PG8_WAIT_L(8); PG8_BAR; PG8_WAIT_L(0); PG8_MMA(0, 0, At, B0); PG8_BAR; PG8_SCHED;
            PG8_LDB(B1, 1, 1); PG8_STAGE(PG8_SB(1, 0), b3, voffB);
            PG8_BAR; PG8_WAIT_L(0); PG8_MMA(0, 1, At, B1); PG8_BAR;
            PG8_LDA(At, 1, 1); PG8_STAGE(PG8_SA(1, 0), a3, voffA);
            PG8_BAR; PG8_WAIT_L(0); PG8_MMA(1, 0, At, B0); PG8_BAR; PG8_SCHED;
            PG8_STAGE(PG8_SB(1, 1), b3 + hstepB, voffB);
            PG8_WAIT_V(6); PG8_BAR; PG8_MMA(1, 1, At, B1); PG8_BAR;
            }
        }
        if constexpr (ALIGN_EPI) { if (wr == 0) PG8_BAR; }
        if constexpr (!Epi::AFTER_DRAIN) { E(acc, cur, wr, wc, fr, fq); S.done(cur); }
        if (!has_next) break;
#pragma unroll
        for (int a = 0; a < 2; ++a)
#pragma unroll
            for (int b = 0; b < 2; ++b)
#pragma unroll
                for (int m = 0; m < 4; ++m)
#pragma unroll
                    for (int n = 0; n < 2; ++n) acc[a][b][m][n] = (f32x4){0.f, 0.f, 0.f, 0.f};
        cur = nxt; cA = nA; cB = nB; ++ui;
        if constexpr (ALIGN_EPI) { if (wr == 1) PG8_BAR; }
    }
    PG8_WAIT_V(0);
    if constexpr (!ALIGN_EPI) { if (wr == 0) PG8_BAR; }
    PG8_BAR;
    if constexpr (Epi::AFTER_DRAIN) { E.fused(acc, cur, wr, wc, fr, fq, lds, wid, lane); S.done(cur); }
#undef PG8_SA
#undef PG8_SB
#undef PG8_STAGE
#undef PG8_LDA
#undef PG8_LDB
#undef PG8_MMA
#undef PG8_WAIT_V
#undef PG8_WAIT_L
#undef PG8_BAR
#undef PG8_SCHED
}
}
#ifndef PG8_SP2
#define PG8_SP2 true
#endif
#ifndef PG8_ALIGN
#define PG8_ALIGN true
#endif
constexpr int NWAVES = 8, NTHR = NWAVES * 64;
#ifndef MK_MULTI
#define MK_MULTI 0
#endif
#ifndef ORA_IDX
#define ORA_IDX 0
#endif
#ifndef ORA_ATT
#define ORA_ATT 0
#endif
#ifndef ORA_ML
#define ORA_ML 0
#endif
constexpr int N_PHASES = 15;
#ifndef ML_CHAIN
#define ML_CHAIN 1
#endif
constexpr int BATCH = 4, T = 2048, DM = 2048, M = BATCH * T, FF = 8192;
constexpr int AH = 16, AG = 4, HD = 128, IH = 16, IDIM = 64, TOPK = 256;
constexpr int ATT_IN = 4176, ATT_N = 4096, SM_N = 80;
constexpr int C_Q = 0, C_K = 2048, C_V = 2560, C_QI = 3072;
constexpr int MH = 8, MDK = 128, MDV = 256, ML_IN = 6160, ML_N = 6144;
constexpr int C_MQ = 0, C_MK = 1024, C_MV = 2048, C_MO = 4096;
constexpr float EPS = 1e-6f, GATE_CAP = 15.0f;
constexpr size_t MiB = 1u << 20;
constexpr size_t WS_CTL = 0, CTL_ZERO_BYTES = 320 * 1024;
constexpr size_t WS_WIN = 1 * MiB, WS_WSM = 17 * MiB, WS_WO = 18 * MiB, WS_WML = 26 * MiB, WS_WG = 50 * MiB, WS_WMO = 51 * MiB;
constexpr size_t WS_WUP0 = 59 * MiB, WS_WUP1 = 91 * MiB, WS_WDN0 = 123 * MiB, WS_WDN1 = 155 * MiB;
constexpr size_t WS_XB = 188 * MiB, WS_PROJ = 220 * MiB, WS_Q = 316 * MiB, WS_K = 348 * MiB, WS_QI = 356 * MiB, WS_KI = 372 * MiB, WS_WI = 373 * MiB, WS_MASK = 374 * MiB;
constexpr size_t WS_GATE = 376 * MiB, WS_ROPE = 377 * MiB, WS_SC = 380 * MiB, WS_O = 444 * MiB, WS_V = 476 * MiB, WS_ML = 484 * MiB, WS_END = 486 * MiB;
constexpr size_t WS_H = 220 * MiB;
static_assert(WS_H + (size_t)M * FF * 2 <= WS_K && WS_PROJ + (size_t)M * ML_N * 2 <= WS_Q && WS_SC + (size_t)BATCH * T * T * 4 <= WS_O, "d_ws map");
constexpr int CW_TMO = 0, CW_CODE = 1, CW_BAR = 4096, CW_SS = 32768;
constexpr int RING_OFF = 0, RING_BYTES = 143360;
constexpr int LDSCTL_OFF = RING_BYTES, MISC_OFF = LDSCTL_OFF + 320;
constexpr int LDS_BYTES = 147456;
#define GAS __attribute__((address_space(1)))
#define LAS __attribute__((address_space(3)))
typedef unsigned short bf16;
typedef unsigned v4u __attribute__((ext_vector_type(4)));
typedef unsigned v2u __attribute__((ext_vector_type(2)));
typedef float f32x4 __attribute__((ext_vector_type(4)));
typedef float f32x16 __attribute__((ext_vector_type(16)));
typedef float f32x2 __attribute__((ext_vector_type(2)));
typedef short bf16x8 __attribute__((ext_vector_type(8)));
typedef short s16x4 __attribute__((ext_vector_type(4)));
typedef GAS unsigned gu32;
typedef GAS unsigned long long gu64;
typedef unsigned long long u64;
#define RLX_AGENT __ATOMIC_RELAXED, __HIP_MEMORY_SCOPE_AGENT
#define LDS_WAIT() asm volatile("s_waitcnt lgkmcnt(0)" ::: "memory")
#define VM_WAIT() asm volatile("s_waitcnt vmcnt(0)" ::: "memory")
__device__ __forceinline__ unsigned f2bf(float f) { unsigned u = __builtin_bit_cast(unsigned, f); return (u + 0x7fffu + ((u >> 16) & 1u)) >> 16; }
__device__ __forceinline__ unsigned pk2(float lo, float hi) { return f2bf(lo) | (f2bf(hi) << 16); }
__device__ __forceinline__ float bf2f(bf16 h) { return __builtin_bit_cast(float, (unsigned)h << 16); }
__device__ __forceinline__ float bflo(unsigned w) { return __builtin_bit_cast(float, w << 16); }
__device__ __forceinline__ float bfhi(unsigned w) { return __builtin_bit_cast(float, w & 0xffff0000u); }
__device__ __forceinline__ unsigned fkey(float f) { const unsigned u = __builtin_bit_cast(unsigned, f); return (u & 0x80000000u) ? ~u : (u | 0x80000000u); }
#define XB_TMO      128
#define XB_XCNT(j)  (256  + 64 * (j))
#define XB_XSUB(j)  (1280 + 64 * (j))
#define XB_XGEN(j)  (2304 + 64 * (j))
#define XB_TOP      3328
#define XB_TOPGEN   3392
#define XCD_BAR_WORDS 3456
#define XB_SPIN_CAP (1u << 18)

__device__ __forceinline__ unsigned xb_ld(unsigned* p)              { return __hip_atomic_load(p, __ATOMIC_RELAXED, __HIP_MEMORY_SCOPE_AGENT); }
__device__ __forceinline__ unsigned xb_add(unsigned* p, unsigned v) { return __hip_atomic_fetch_add(p, v, __ATOMIC_RELAXED, __HIP_MEMORY_SCOPE_AGENT); }
__device__ __forceinline__ unsigned xb_xcc_id() { return (unsigned)__builtin_amdgcn_s_getreg((3 << 11) | 20) & 0xFu; }
#define XB_SPIN(cond, bar) do { unsigned _sp = 0; while (cond) { __builtin_amdgcn_s_sleep(0); \
    if ((++_sp & 255u) == 0u) { if (xb_ld(&(bar)[XB_TMO])) break; if (_sp > XB_SPIN_CAP) { atomicAdd(&(bar)[XB_TMO], 1u); break; } } } } while (0)

struct XcdBarrier {
    unsigned* bar; unsigned x;
    volatile LAS unsigned* st;
};

__device__ __forceinline__ XcdBarrier xcd_barrier_post(unsigned* bar, volatile LAS unsigned* st) {
    XcdBarrier b; b.bar = bar; b.x = xb_xcc_id(); b.st = st;
    if (threadIdx.x == 0) (void)xb_add(&bar[XB_XCNT(b.x)], 1u);
    return b;
}
__device__ __forceinline__ void xcd_barrier_complete(unsigned* bar, unsigned x, unsigned& nloc, unsigned& nx) {
    const unsigned G = gridDim.x * gridDim.y * gridDim.z;
    unsigned sum, cnt, mine, sp = 0u;
    for (;;) {
        sum = 0u; cnt = 0u; mine = 0u;
#pragma unroll
        for (unsigned j = 0; j < 16; ++j) { const unsigned c = xb_ld(&bar[XB_XCNT(j)]); sum += c; cnt += (c > 0u) ? 1u : 0u; mine = (j == x) ? c : mine; }
        if (sum == G) break;
        __builtin_amdgcn_s_sleep(1);
        if ((++sp & 255u) == 0u) { if (xb_ld(&bar[XB_TMO])) break; if (sp > XB_SPIN_CAP) { atomicAdd(&bar[XB_TMO], 1u); break; } }
    }
    nloc = mine > 0u ? mine : 1u; nx = cnt > 0u ? cnt : 1u;
}

__device__ __forceinline__ void xcd_barrier(const XcdBarrier& b) {
    asm volatile("s_waitcnt vmcnt(0)" ::: "memory");
    __syncthreads();
    if (threadIdx.x == 0) {
        unsigned* bar = b.bar;
        __builtin_amdgcn_s_waitcnt(0);
        unsigned nloc = b.st[0], nx = b.st[1];
        if (nloc == 0u) { xcd_barrier_complete(bar, b.x, nloc, nx); b.st[0] = nloc; b.st[1] = nx; }
        const unsigned old = xb_add(&bar[XB_XSUB(b.x)], 1u);
        const unsigned gen = old / nloc;
        if (old + 1u == (gen + 1u) * nloc) {
            __builtin_amdgcn_fence(__ATOMIC_RELEASE, "agent");
            asm volatile("s_waitcnt vmcnt(0)" ::: "memory");
            const unsigned og = xb_add(&bar[XB_TOP], 1u);
            const unsigned tg = og / nx;
            if (og + 1u == (tg + 1u) * nx) xb_add(&bar[XB_TOPGEN], 1u);
            else XB_SPIN(xb_ld(&bar[XB_TOPGEN]) == tg, bar);
            __builtin_amdgcn_fence(__ATOMIC_ACQUIRE, "agent");
            xb_add(&bar[XB_XGEN(b.x)], 1u);
            asm volatile("s_waitcnt vmcnt(0)" ::: "memory");
        } else {
            XB_SPIN(xb_ld(&bar[XB_XGEN(b.x)]) == gen, bar);
            __builtin_amdgcn_fence(__ATOMIC_ACQUIRE, "agent");
            asm volatile("s_waitcnt vmcnt(0)" ::: "memory");
        }
    }
    __syncthreads();
}
struct Args { const float* in[13]; float* out; unsigned char* ws; int ph_lo, ph_hi, li, pad; };
struct Frame {
    LAS unsigned char* lds;
    volatile LAS unsigned* MISC;
    gu32* ctl;
    int tid, lane, wave, vcu, G;
    const float* x; float* out;
    const float *norm_mix, *norm_ffn, *att_w_in, *q_gain, *k_gain, *att_w_out, *ml_w_in, *b_gate, *h_gain, *ml_w_out, *w_up, *w_dn;
    bf16 *WinT, *WsmT, *WoT, *WmlT, *WgT, *WmoT, *WupT0, *WupT1, *WdnT0, *WdnT1;
    bf16 *XB, *PROJ, *Q, *K, *V, *QI, *KI, *O, *H;
    float *WI, *IG, *LF, *SC, *NST, *SCAL; bf16* ST; f32x2 *ROPE_A, *ROPE_I; u64* MASK;
    float *ss0, *ss1, *ss2, *ss3;
};
__device__ __forceinline__ float wave_sum(float v) {
#pragma unroll
    for (int o = 1; o < 64; o <<= 1) v += __shfl_xor(v, o);
    return v;
}
__device__ __forceinline__ unsigned cvtpk2(float lo, float hi) { unsigned r; asm volatile("v_cvt_pk_bf16_f32 %0, %1, %2" : "=v"(r) : "v"(lo), "v"(hi)); return r; }
template <bool NTS = false> __device__ __forceinline__ void tr_item(const float* W, int ldw, int col0, int nvalid, int nblk, int K, const float* gain, float scale, bf16* WT, LAS float* scr, int item, int lane) {
    const int kb = item / nblk, nb = item - kb * nblk, k0 = 64 * kb, n0 = 32 * nb, nn = n0 + (lane & 31), nc = nn < nvalid ? nn : nvalid - 1, c = lane & 7;
    const GAS float* wp = (const GAS float*)W + (size_t)(k0 + (lane >> 5)) * ldw + col0 + nc;
    float v[32];
#pragma unroll
    for (int i = 0; i < 32; ++i) v[i] = __builtin_nontemporal_load(wp + (size_t)(2 * i) * ldw);
    f32x4 g0 = (f32x4){scale, scale, scale, scale}, g1 = g0;
    if (gain) { g0 = *(const GAS f32x4*)(gain + k0 + 8 * c) * scale; g1 = *(const GAS f32x4*)(gain + k0 + 8 * c + 4) * scale; }
    const bool ok = nn < nvalid;
#pragma unroll
    for (int i = 0; i < 32; ++i) scr[(2 * i + (lane >> 5)) * 33 + (lane & 31)] = ok ? v[i] : 0.f;
    LDS_WAIT(); asm volatile("" ::: "memory");
#pragma unroll
    for (int j = 0; j < 4; ++j) { const int n = (lane >> 3) + 8 * j; const LAS float* s = scr + (8 * c) * 33 + n;
        v4u o; o.x = cvtpk2(s[0 * 33] * g0.x, s[1 * 33] * g0.y); o.y = cvtpk2(s[2 * 33] * g0.z, s[3 * 33] * g0.w); o.z = cvtpk2(s[4 * 33] * g1.x, s[5 * 33] * g1.y); o.w = cvtpk2(s[6 * 33] * g1.z, s[7 * 33] * g1.w);
        if (NTS) __builtin_nontemporal_store(o, (GAS v4u*)(WT + (size_t)(n0 + n) * K + k0 + 8 * c)); else *(GAS v4u*)(WT + (size_t)(n0 + n) * K + k0 + 8 * c) = o; }
    LDS_WAIT(); asm volatile("" ::: "memory");
}
__device__ __forceinline__ void p0_prologue(Frame& F) {
    LAS float* scr = (LAS float*)(F.lds + RING_OFF + F.wave * 16384);
    const int gw = F.vcu * NWAVES + F.wave, NGW = F.G * NWAVES;
    constexpr int I0 = 32 * 128, I1 = 32 * 3, I2 = 32 * 64, I3 = 32 * 256, I4 = 128 * 64, I5 = 32 * 32, I6 = 32 * 32, I7 = 32 * 128, I8 = 32 * 1;
#if ML_CHAIN
    constexpr int I9 = 32 * 64, I10 = I3, I11 = I4, NITEMS = I0 + I1 + I2 + I3 + I4 + I5 + I6 + I7 + I8 + I9 + I10 + I11;
#else
    constexpr int NITEMS = I0 + I1 + I2 + I3 + I4 + I5 + I6 + I7 + I8;
#endif
    constexpr float KSC = 0.08838834764831845f;
    for (int it = gw; it < NITEMS; it += NGW) {
        int r = it;
        if (r < I0) { tr_item(F.att_w_in, ATT_IN, 0, ATT_N, 128, DM, F.norm_mix, 1.f, F.WinT, scr, r, F.lane); continue; } r -= I0;
        if (r < I1) { tr_item(F.att_w_in, ATT_IN, ATT_N, SM_N, 3, DM, F.norm_mix, 1.f, F.WsmT, scr, r, F.lane); continue; } r -= I1;
        if (r < I2) { tr_item(F.att_w_out, DM, 0, DM, 64, DM, nullptr, 1.f, F.WoT, scr, r, F.lane); continue; } r -= I2;
        if (r < I3) { tr_item<true>(F.w_up, FF, 0, FF, 256, DM, F.norm_ffn, 1.f, F.WupT0, scr, r, F.lane); continue; } r -= I3;
        if (r < I4) { tr_item<true>(F.w_dn, DM, 0, DM, 64, FF, nullptr, 1.f, F.WdnT0, scr, r, F.lane); continue; } r -= I4;
        if (r < I5) { tr_item<true>(F.ml_w_in, ML_IN, C_MQ, 1024, 32, DM, F.norm_mix + DM, 1.f, F.WmlT, scr, r, F.lane); continue; } r -= I5;
        if (r < I6) { tr_item<true>(F.ml_w_in, ML_IN, C_MK, 1024, 32, DM, F.norm_mix + DM, KSC, F.WmlT + (size_t)C_MK * DM, scr, r, F.lane); continue; } r -= I6;
        if (r < I7) { tr_item<true>(F.ml_w_in, ML_IN, C_MV, 4096, 128, DM, F.norm_mix + DM, 1.f, F.WmlT + (size_t)C_MV * DM, scr, r, F.lane); continue; } r -= I7;
#if ML_CHAIN
        if (r < I8) { tr_item<true>(F.ml_w_in, ML_IN, ML_N, 16, 1, DM, F.norm_mix + DM, 1.f, F.WgT, scr, r, F.lane); continue; } r -= I8;
        if (r < I9) { tr_item<true>(F.ml_w_out, DM, 0, DM, 64, DM, nullptr, 1.f, F.WmoT, scr, r, F.lane); continue; } r -= I9;
        if (r < I10) { tr_item<true>(F.w_up + (size_t)DM * FF, FF, 0, FF, 256, DM, F.norm_ffn + DM, 1.f, F.WupT1, scr, r, F.lane); continue; } r -= I10;
        tr_item<true>(F.w_dn + (size_t)FF * DM, DM, 0, DM, 64, FF, nullptr, 1.f, F.WdnT1, scr, r, F.lane);
#else
        tr_item(F.ml_w_in, ML_IN, ML_N, 16, 1, DM, F.norm_mix + DM, 1.f, F.WgT, scr, r, F.lane);
#endif
    }
    for (int m = gw; m < M; m += NGW) {
        const GAS f32x4* xr = (const GAS f32x4*)(F.x + (size_t)m * DM) + F.lane; GAS u64* o8 = (GAS u64*)(F.XB + (size_t)m * DM) + F.lane;
        f32x4 v[8]; float s = 0.f;
#pragma unroll
        for (int j = 0; j < 8; ++j) { v[j] = __builtin_nontemporal_load(xr + 64 * j); s += (v[j].x * v[j].x + v[j].y * v[j].y) + (v[j].z * v[j].z + v[j].w * v[j].w); }
        s = wave_sum(s); if (F.lane == 0) F.ss0[m] = s;
#pragma unroll
        for (int j = 0; j < 8; ++j) o8[64 * j] = (u64)cvtpk2(v[j].x, v[j].y) | ((u64)cvtpk2(v[j].z, v[j].w) << 32);
    }
    for (int idx = gw * 64 + F.lane; idx < T * 24; idx += NGW * 64) { const int t = idx / 24, i = idx - t * 24;
        if (i < 16) { const float inv = powf(500000.0f, -2.0f * (float)i / 32.0f), a = (float)t * inv; F.ROPE_A[t * 16 + i] = (f32x2){cosf(a), sinf(a)}; }
        else { const int ii = i - 16; const float inv = powf(500000.0f, -2.0f * (float)ii / 16.0f), a = (float)t * inv; F.ROPE_I[t * 8 + ii] = (f32x2){cosf(a), sinf(a)}; } }
}
template <int NT> __device__ __forceinline__ void skinny_mma(Frame& F, const bf16* A, const bf16* Wt, int r0, LAS float* red) {
    const int rt = F.wave & 1, kq = F.wave >> 1, fr = F.lane & 15, fq = F.lane >> 4;
    f32x4 acc[NT];
#pragma unroll
    for (int n = 0; n < NT; ++n) acc[n] = (f32x4){0.f, 0.f, 0.f, 0.f};
    const bf16* ap = A + (size_t)(r0 + rt * 16 + fr) * DM + kq * 512 + fq * 8; const bf16* bp = Wt + (size_t)fr * DM + kq * 512 + fq * 8;
#pragma unroll 4
    for (int ks = 0; ks < 16; ++ks) { const bf16x8 a = *(const bf16x8*)(ap + ks * 32);
#pragma unroll
        for (int n = 0; n < NT; ++n) { const bf16x8 b = *(const bf16x8*)(bp + (size_t)n * 16 * DM + ks * 32); acc[n] = __builtin_amdgcn_mfma_f32_16x16x32_bf16(a, b, acc[n], 0, 0, 0); } }
#pragma unroll
    for (int n = 0; n < NT; ++n)
#pragma unroll
        for (int g = 0; g < 4; ++g) red[((kq * 32 + rt * 16 + 4 * fq + g) * (NT * 16)) + n * 16 + fr] = acc[n][g];
}
__device__ __forceinline__ void skinny_att(Frame& F) {
    LAS float* red = (LAS float*)(F.lds + RING_OFF);
    for (int u = F.vcu; u < M / 32; u += F.G) { const int r0 = u * 32;
        skinny_mma<5>(F, F.XB, F.WsmT, r0, red);
        LDS_WAIT(); __syncthreads();
        const int r = F.tid >> 4, q = F.tid & 15, m = r0 + r, t = m % T; const float rs = __builtin_amdgcn_rsqf(F.ss0[m] * (1.f / DM) + EPS);
#define SMV(c) ((red[(0 * 32 + r) * 80 + (c)] + red[(1 * 32 + r) * 80 + (c)] + red[(2 * 32 + r) * 80 + (c)] + red[(3 * 32 + r) * 80 + (c)]) * rs)
        if (q < 8) { const float a = SMV(q), b = SMV(q + 8); const f32x2 cs = F.ROPE_I[t * 8 + q];
            F.KI[(size_t)m * 64 + q] = (bf16)f2bf(a * cs.x - b * cs.y); F.KI[(size_t)m * 64 + q + 8] = (bf16)f2bf(a * cs.y + b * cs.x); }
#pragma unroll
        for (int e = 0; e < 3; ++e) { const int c = 16 + q * 3 + e; F.KI[(size_t)m * 64 + c] = (bf16)f2bf(SMV(c)); }
        F.WI[(size_t)m * 16 + q] = SMV(64 + q) * 0.03125f;
#undef SMV
        LDS_WAIT(); __syncthreads();
    }
}
__device__ __forceinline__ void skinny_gates(Frame& F) {
    LAS float* red = (LAS float*)(F.lds + RING_OFF);
    for (int u = F.vcu; u < M / 32; u += F.G) { const int r0 = u * 32;
        skinny_mma<1>(F, F.XB, F.WgT, r0, red);
        LDS_WAIT(); __syncthreads();
        const int r = F.tid >> 4, c = F.tid & 15, m = r0 + r, b = m / T, t = m - b * T; const float rs = __builtin_amdgcn_rsqf(F.ss2[m] * (1.f / DM) + EPS);
        float g = (red[(0 * 32 + r) * 16 + c] + red[(1 * 32 + r) * 16 + c] + red[(2 * 32 + r) * 16 + c] + red[(3 * 32 + r) * 16 + c]) * rs + F.b_gate[c];
        g = GATE_CAP * tanhf(g * (1.f / GATE_CAP));
        if (c < 8) F.IG[(size_t)(b * MH + c) * T + t] = g;
        else { const float ls = g >= 0.f ? -log1pf(expf(-g)) : g - log1pf(expf(g)); F.LF[(size_t)(b * MH + c - 8) * T + t] = ls; }
        LDS_WAIT(); __syncthreads();
    }
}
__device__ __forceinline__ void unpack8(const v4u w, float* f) { f[0] = bflo(w.x); f[1] = bfhi(w.x); f[2] = bflo(w.y); f[3] = bfhi(w.y); f[4] = bflo(w.z); f[5] = bfhi(w.z); f[6] = bflo(w.w); f[7] = bfhi(w.w); }
__device__ __forceinline__ v4u pack8f(const float* f) { v4u w; w.x = pk2(f[0], f[1]); w.y = pk2(f[2], f[3]); w.z = pk2(f[4], f[5]); w.w = pk2(f[6], f[7]); return w; }
__device__ __forceinline__ void norm_rope32(Frame& F, const bf16* src, bf16* dst, const float* gain, int t, bool active) {
    float y[32]; float s = 0.f;
    if (active) {
#pragma unroll
        for (int j = 0; j < 4; ++j) unpack8(*(const GAS v4u*)(src + 8 * j), y + 8 * j);
    } else {
#pragma unroll
        for (int e = 0; e < 32; ++e) y[e] = 0.f;
    }
#pragma unroll
    for (int e = 0; e < 32; ++e) s += y[e] * y[e];
    s += __shfl_xor(s, 1); s += __shfl_xor(s, 2);
    const float rs = __builtin_amdgcn_rsqf(s * (1.f / 128.f) + EPS); const int d0 = (F.lane & 3) * 32;
    if (active) {
#pragma unroll
        for (int e = 0; e < 32; ++e) y[e] = y[e] * rs * gain[d0 + e];
        if ((F.lane & 3) == 0) {
#pragma unroll
            for (int i = 0; i < 16; ++i) { const f32x2 cs = F.ROPE_A[t * 16 + i]; const float a = y[i], b = y[i + 16]; y[i] = a * cs.x - b * cs.y; y[i + 16] = a * cs.y + b * cs.x; }
        }
#pragma unroll
        for (int j = 0; j < 4; ++j) *(GAS v4u*)(dst + 8 * j) = pack8f(y + 8 * j);
    }
}
__device__ __forceinline__ void p2_prep(Frame& F) {
    const int gw = F.vcu * NWAVES + F.wave, NGW = F.G * NWAVES;
    for (int m = gw; m < M; m += NGW) { const int t = m % T; const bf16* pr = F.PROJ + (size_t)m * ATT_N;
        norm_rope32(F, pr + C_Q + 32 * F.lane, F.Q + (size_t)m * DM + 32 * F.lane, F.q_gain, t, true);
        norm_rope32(F, pr + C_K + 32 * (F.lane & 15), F.K + (size_t)m * 512 + 32 * (F.lane & 15), F.k_gain, t, F.lane < 16);
        *(GAS v4u*)(F.V + (size_t)m * 512 + 8 * F.lane) = *(const GAS v4u*)(pr + C_V + 8 * F.lane);
        float y[16]; unpack8(*(const GAS v4u*)(pr + C_QI + 16 * F.lane), y); unpack8(*(const GAS v4u*)(pr + C_QI + 16 * F.lane + 8), y + 8);
        if ((F.lane & 3) == 0) {
#pragma unroll
            for (int i = 0; i < 8; ++i) { const f32x2 cs = F.ROPE_I[t * 8 + i]; const float a = y[i], b = y[i + 8]; y[i] = a * cs.x - b * cs.y; y[i + 8] = a * cs.y + b * cs.x; }
        }
        *(GAS v4u*)(F.QI + (size_t)m * 1024 + 16 * F.lane) = pack8f(y); *(GAS v4u*)(F.QI + (size_t)m * 1024 + 16 * F.lane + 8) = pack8f(y + 8);
    }
}
template <bool TWO, int ABL = 0> __device__ __forceinline__ void p3a_tiles(Frame& F, int b, size_t m0, int kt, const LAS unsigned char* qrow, int swz, const LAS float* wl, int r32, int hi) {
    bf16x8 ka[4], kb[4];
    { const bf16* kp = F.KI + ((size_t)b * T + 32 * kt + r32) * 64 + hi * 8;
#pragma unroll
      for (int ks = 0; ks < 4; ++ks) { ka[ks] = *(const GAS bf16x8*)(kp + 16 * ks); if (TWO) kb[ks] = *(const GAS bf16x8*)(kp + (size_t)32 * NWAVES * 64 + 16 * ks); } }
    f32x16 sa, sb;
#pragma unroll
    for (int r = 0; r < 16; ++r) { sa[r] = 0.f; sb[r] = 0.f; }
#pragma unroll 2
    for (int h = 0; h < 16; ++h) { f32x16 da, db; const float wh = wl[r32 * 16 + h];
#pragma unroll
        for (int r = 0; r < 16; ++r) { da[r] = 0.f; db[r] = 0.f; }
#pragma unroll
        for (int ks = 0; ks < 4; ++ks) { const bf16x8 q = *(const LAS bf16x8*)(qrow + (((h * 64 + 16 * ks + 8 * hi) * 2) ^ swz));
            da = __builtin_amdgcn_mfma_f32_32x32x16_bf16(ka[ks], q, da, 0, 0, 0); if (TWO) db = __builtin_amdgcn_mfma_f32_32x32x16_bf16(kb[ks], q, db, 0, 0, 0); }
#pragma unroll
        for (int r = 0; r < 16; ++r) { const float xa = da[r]; const int ia = __float_as_int(xa); sa[r] = fmaf(wh, __int_as_float(ia > 0 ? ia : 0), sa[r]);
            if (TWO) { const float xb = db[r]; const int ib = __float_as_int(xb); sb[r] = fmaf(wh, __int_as_float(ib > 0 ? ib : 0), sb[r]); } } }
    LAS float* tsc = (LAS float*)(F.lds + RING_OFF + 69632 + F.wave * 4608);
    const int trow = F.lane >> 1, th = F.lane & 1;
#pragma unroll
    for (int q4 = 0; q4 < 4; ++q4) *(LAS f32x4*)(tsc + r32 * 36 + 8 * q4 + 4 * hi) = (f32x4){sa[4 * q4], sa[4 * q4 + 1], sa[4 * q4 + 2], sa[4 * q4 + 3]};
    if (ABL != 2) { float* dst = F.SC + (m0 + trow) * T + 32 * kt + 16 * th;
#pragma unroll
      for (int q4 = 0; q4 < 4; ++q4) *(GAS f32x4*)(dst + 4 * q4) = *(const LAS f32x4*)(tsc + trow * 36 + 16 * th + 4 * q4); }
    if (TWO) {
#pragma unroll
        for (int q4 = 0; q4 < 4; ++q4) *(LAS f32x4*)(tsc + r32 * 36 + 8 * q4 + 4 * hi) = (f32x4){sb[4 * q4], sb[4 * q4 + 1], sb[4 * q4 + 2], sb[4 * q4 + 3]};
        float* dst = F.SC + (m0 + trow) * T + 32 * (kt + NWAVES) + 16 * th;
        if (ABL != 2) {
#pragma unroll
        for (int q4 = 0; q4 < 4; ++q4) *(GAS f32x4*)(dst + 4 * q4) = *(const LAS f32x4*)(tsc + trow * 36 + 16 * th + 4 * q4); } }
}
template <int ABL = 0> __device__ __forceinline__ void p3a_segment(Frame& F, int b, int i, int kt0, int kt1) {
    LAS unsigned char* qs = F.lds + RING_OFF;
    LAS float* wl = (LAS float*)(F.lds + RING_OFF + 65536);
    const int r32 = F.lane & 31, hi = F.lane >> 5, t0 = 32 * i; const size_t m0 = (size_t)b * T + t0;
#pragma unroll
    for (int k = 0; k < 8; ++k) { const int p = F.tid + 512 * k, row = p >> 7, ch = p & 127;
        v4u v = *(const GAS v4u*)(F.PROJ + (m0 + row) * ATT_N + C_QI + ch * 8);
        v4u o; o.x = (unsigned)__builtin_amdgcn_update_dpp(0, (int)v.x, 0xB1, 0xf, 0xf, false); o.y = (unsigned)__builtin_amdgcn_update_dpp(0, (int)v.y, 0xB1, 0xf, 0xf, false);
        o.z = (unsigned)__builtin_amdgcn_update_dpp(0, (int)v.z, 0xB1, 0xf, 0xf, false); o.w = (unsigned)__builtin_amdgcn_update_dpp(0, (int)v.w, 0xB1, 0xf, 0xf, false);
        if ((ch & 7) < 2) { float a[8], bq[8]; unpack8((ch & 1) ? o : v, a); unpack8((ch & 1) ? v : o, bq); const f32x2* rp = F.ROPE_I + (size_t)(t0 + row) * 8; float y[8];
#pragma unroll
            for (int e = 0; e < 8; ++e) { const f32x2 cs = rp[e]; y[e] = (ch & 1) ? a[e] * cs.y + bq[e] * cs.x : a[e] * cs.x - bq[e] * cs.y; }
            v = pack8f(y); }
        *(LAS v4u*)(qs + row * 2048 + ((ch * 16) ^ ((row & 15) << 4))) = v; }
    wl[F.tid] = F.WI[(m0 + (F.tid >> 4)) * 16 + (F.tid & 15)];
    LDS_WAIT(); __syncthreads();
    const LAS unsigned char* qrow = qs + r32 * 2048; const int swz = (r32 & 15) << 4;
    if (ABL != 1) for (int kt = kt0 + F.wave; kt < kt1; kt += 2 * NWAVES) { const bool two = kt + NWAVES < kt1;
        if (two) p3a_tiles<true, ABL>(F, b, m0, kt, qrow, swz, wl, r32, hi); else p3a_tiles<false, ABL>(F, b, m0, kt, qrow, swz, wl, r32, hi); }
    LDS_WAIT(); __syncthreads();
}
template <int ABL = 0> __device__ __forceinline__ void p3a_scores(Frame& F) {
    { const int gw = F.vcu * NWAVES + F.wave, NGW = F.G * NWAVES;
      for (int m = gw; m < M; m += NGW) { const int t = m % T; const bf16* pr = F.PROJ + (size_t)m * ATT_N;
          norm_rope32(F, pr + C_K + 32 * (F.lane & 15), F.K + (size_t)m * 512 + 32 * (F.lane & 15), F.k_gain, t, F.lane < 16);
          *(GAS v4u*)(F.V + (size_t)m * 512 + 8 * F.lane) = *(const GAS v4u*)(pr + C_V + 8 * F.lane); } }
    for (int c = F.vcu; c < 256; c += F.G) { const int p = c >> 1, b = p >> 5, i = p & 31;
        if ((c & 1) == 0) p3a_segment<ABL>(F, b, 63 - i, 0, 32);
        else { p3a_segment<ABL>(F, b, 63 - i, 32, 64 - i); p3a_segment<ABL>(F, b, i, 0, i + 1); } }
}
__device__ __forceinline__ void p3b_select(Frame& F) {
    LAS unsigned* hist = (LAS unsigned*)(F.lds + RING_OFF + F.wave * 8192);
    const int gw = F.vcu * NWAVES + F.wave, NGW = F.G * NWAVES, rep = F.lane & 7;
    float sn[32];
#define ROW_OF(e_, t_, m_) const int bb_ = (e_) / T, tt_ = (e_) - bb_ * T, t_ = (bb_ & 1) ? T - 1 - tt_ : tt_, m_ = bb_ * T + t_
#define ROW_LOAD(e_) do { ROW_OF(e_, tl_, ml_); const float* sr_ = F.SC + (size_t)ml_ * T;                                             \
        _Pragma("unroll") for (int j = 0; j < 32; ++j) { const int s = F.lane + 64 * j; sn[j] = __builtin_nontemporal_load(sr_ + (s < tl_ ? s : tl_)); } } while (0)
    if (gw < M) ROW_LOAD(gw);
    for (int e = gw; e < M; e += NGW) { ROW_OF(e, t, m); const int nj = (t >> 6) + 1;
            unsigned k[32];
#pragma unroll
            for (int j = 0; j < 32; ++j) { const int s = F.lane + 64 * j; k[j] = fkey(s <= t ? sn[j] : -__builtin_inff()); }
            if (e + NGW < M) ROW_LOAD(e + NGW);
            unsigned P = 0;
            if (t + 1 > TOPK) { unsigned need = TOPK;
#pragma unroll 1
                for (int p = 0; p < 4; ++p) { const int sh = 24 - 8 * p; const unsigned hmask = p ? (0xffffffffu << (sh + 8)) : 0u;
#pragma unroll
                    for (int z = 0; z < 8; ++z) *(LAS v4u*)(hist + 4 * (F.lane + 64 * z)) = (v4u){0u, 0u, 0u, 0u};
#pragma unroll
                    for (int j = 0; j < 32; ++j) if (j < nj) { if (((k[j] ^ P) & hmask) == 0u) __hip_atomic_fetch_add(hist + (((k[j] >> sh) & 255u) * 8u + rep), 1u, __ATOMIC_RELAXED, __HIP_MEMORY_SCOPE_WORKGROUP); }
                    v4u hb;
                    { const LAS v4u* hp = (const LAS v4u*)(hist + 32 * F.lane);
                      const v4u r0 = hp[0], r1 = hp[1], r2 = hp[2], r3 = hp[3], r4 = hp[4], r5 = hp[5], r6 = hp[6], r7 = hp[7];
                      hb.x = (r0.x + r0.y + r0.z + r0.w) + (r1.x + r1.y + r1.z + r1.w); hb.y = (r2.x + r2.y + r2.z + r2.w) + (r3.x + r3.y + r3.z + r3.w);
                      hb.z = (r4.x + r4.y + r4.z + r4.w) + (r5.x + r5.y + r5.z + r5.w); hb.w = (r6.x + r6.y + r6.z + r6.w) + (r7.x + r7.y + r7.z + r7.w); }
                    const unsigned s4 = hb.x + hb.y + hb.z + hb.w;
                    unsigned ps = s4;
                    ps += (unsigned)__builtin_amdgcn_update_dpp(0, (int)ps, 0x111, 0xf, 0xf, false); ps += (unsigned)__builtin_amdgcn_update_dpp(0, (int)ps, 0x112, 0xf, 0xf, false);
                    ps += (unsigned)__builtin_amdgcn_update_dpp(0, (int)ps, 0x114, 0xf, 0xf, false); ps += (unsigned)__builtin_amdgcn_update_dpp(0, (int)ps, 0x118, 0xf, 0xf, false);
                    ps += (unsigned)__builtin_amdgcn_update_dpp(0, (int)ps, 0x142, 0xa, 0xf, false); ps += (unsigned)__builtin_amdgcn_update_dpp(0, (int)ps, 0x143, 0xc, 0xf, false);
                    const unsigned total = (unsigned)__builtin_amdgcn_readlane((int)ps, 63), above = total - ps;
                    const u64 bm = __ballot(above < need && need <= above + s4); const int src = __builtin_ctzll(bm);
                    const unsigned a3 = above + hb.w, a2 = a3 + hb.z, a1 = a2 + hb.y;
                    unsigned dig, gt;
                    if (need <= a3) { dig = 3; gt = above; } else if (need <= a2) { dig = 2; gt = a3; } else if (need <= a1) { dig = 1; gt = a2; } else { dig = 0; gt = a1; }
                    dig += 4u * F.lane;
                    dig = (unsigned)__builtin_amdgcn_readlane((int)dig, src); gt = (unsigned)__builtin_amdgcn_readlane((int)gt, src);
                    P |= dig << sh; need -= gt; } }
            u64 myw = 0;
#pragma unroll
            for (int j = 0; j < 32; ++j) { const int s = F.lane + 64 * j; const u64 w = __ballot(k[j] >= P && s <= t); if (F.lane == j) myw = w; }
            if (F.lane < 32) F.MASK[(size_t)m * 32 + F.lane] = myw;
    }
#undef ROW_OF
#undef ROW_LOAD
}
#ifndef IDX_FUSED
#define IDX_FUSED 0
#endif
__device__ __forceinline__ unsigned radix_select(const unsigned (&k)[32], int nj, int lane, LAS unsigned* hist) {
    unsigned P = 0, need = TOPK;
#pragma unroll 1
    for (int p = 0; p < 4; ++p) { const int sh = 24 - 8 * p; const unsigned hmask = p ? (0xffffffffu << (sh + 8)) : 0u;
        *(LAS v4u*)(hist + 4 * lane) = (v4u){0u, 0u, 0u, 0u};
#pragma unroll
        for (int j = 0; j < 32; ++j) if (j < nj) { if (((k[j] ^ P) & hmask) == 0u) __hip_atomic_fetch_add(hist + ((k[j] >> sh) & 255u), 1u, __ATOMIC_RELAXED, __HIP_MEMORY_SCOPE_WORKGROUP); }
        const v4u hb = *(const LAS v4u*)(hist + 4 * lane);
        const unsigned s4 = hb.x + hb.y + hb.z + hb.w;
        unsigned ps = s4;
        ps += (unsigned)__builtin_amdgcn_update_dpp(0, (int)ps, 0x111, 0xf, 0xf, false); ps += (unsigned)__builtin_amdgcn_update_dpp(0, (int)ps, 0x112, 0xf, 0xf, false);
        ps += (unsigned)__builtin_amdgcn_update_dpp(0, (int)ps, 0x114, 0xf, 0xf, false); ps += (unsigned)__builtin_amdgcn_update_dpp(0, (int)ps, 0x118, 0xf, 0xf, false);
        ps += (unsigned)__builtin_amdgcn_update_dpp(0, (int)ps, 0x142, 0xa, 0xf, false); ps += (unsigned)__builtin_amdgcn_update_dpp(0, (int)ps, 0x143, 0xc, 0xf, false);
        const unsigned total = (unsigned)__builtin_amdgcn_readlane((int)ps, 63), above = total - ps;
        const u64 bm = __ballot(above < need && need <= above + s4); const int src = __builtin_ctzll(bm);
        const unsigned a3 = above + hb.w, a2 = a3 + hb.z, a1 = a2 + hb.y;
        unsigned dig, gt;
        if (need <= a3) { dig = 3; gt = above; } else if (need <= a2) { dig = 2; gt = a3; } else if (need <= a1) { dig = 1; gt = a2; } else { dig = 0; gt = a1; }
        dig += 4u * lane;
        dig = (unsigned)__builtin_amdgcn_readlane((int)dig, src); gt = (unsigned)__builtin_amdgcn_readlane((int)gt, src);
        P |= dig << sh; need -= gt; }
    return P;
}
__device__ __forceinline__ void p3f_tile(Frame& F, int b, int ti) {
    constexpr int SROW = 2052;
    LAS float* SCL = (LAS float*)(F.lds + RING_OFF);
    LAS unsigned* hist = (LAS unsigned*)(F.lds + RING_OFF + 16 * SROW * 4 + F.wave * 1024);
    static_assert(16 * SROW * 4 + 8 * 1024 <= RING_BYTES, "fused indexer LDS");
    const int lane = F.lane, c16 = lane & 15, kq = lane >> 4, t0 = 16 * ti; const size_t m0 = (size_t)b * T + t0;
#pragma unroll 1
    for (int hh = 0; hh < 2; ++hh) {
        bf16x8 qf[8][2]; float wv[8];
        { const bf16* qp = F.PROJ + (m0 + c16) * ATT_N + C_QI + hh * 512 + 8 * kq; const f32x2* rp = F.ROPE_I + (size_t)(t0 + c16) * 8;
          f32x2 cs[8];
#pragma unroll
          for (int e = 0; e < 8; ++e) cs[e] = rp[e];
#pragma unroll
          for (int h = 0; h < 8; ++h) { v4u v0 = *(const GAS v4u*)(qp + h * 64), v1 = *(const GAS v4u*)(qp + h * 64 + 32);
              v4u o; o.x = (unsigned)__shfl_xor((int)v0.x, 16); o.y = (unsigned)__shfl_xor((int)v0.y, 16); o.z = (unsigned)__shfl_xor((int)v0.z, 16); o.w = (unsigned)__shfl_xor((int)v0.w, 16);
              if (kq < 2) { float a[8], bq[8], y[8]; unpack8(kq ? o : v0, a); unpack8(kq ? v0 : o, bq);
#pragma unroll
                  for (int e = 0; e < 8; ++e) y[e] = kq ? a[e] * cs[e].y + bq[e] * cs[e].x : a[e] * cs[e].x - bq[e] * cs[e].y;
                  v0 = pack8f(y); }
              qf[h][0] = *reinterpret_cast<bf16x8*>(&v0); qf[h][1] = *reinterpret_cast<bf16x8*>(&v1); }
          const float* wp = F.WI + (m0 + c16) * 16 + hh * 8;
#pragma unroll
          for (int h4 = 0; h4 < 2; ++h4) { const f32x4 w4 = *(const GAS f32x4*)(wp + 4 * h4); wv[4 * h4] = w4.x; wv[4 * h4 + 1] = w4.y; wv[4 * h4 + 2] = w4.z; wv[4 * h4 + 3] = w4.w; } }
        bf16x8 a0, a1, n0, n1;
        { const int kt = F.wave; if (kt <= ti) { const bf16* kp = F.KI + ((size_t)b * T + 16 * kt + c16) * 64 + 8 * kq; n0 = *(const GAS bf16x8*)kp; n1 = *(const GAS bf16x8*)(kp + 32); } }
        for (int kt = F.wave; kt <= ti; kt += NWAVES) { const int s0 = 16 * kt;
            a0 = n0; a1 = n1;
            if (kt + NWAVES <= ti) { const bf16* kp = F.KI + ((size_t)b * T + 16 * (kt + NWAVES) + c16) * 64 + 8 * kq; n0 = *(const GAS bf16x8*)kp; n1 = *(const GAS bf16x8*)(kp + 32); }
            LAS f32x4* dst = (LAS f32x4*)(SCL + c16 * SROW + s0 + 4 * kq);
            f32x4 sc = (f32x4){0.f, 0.f, 0.f, 0.f}; if (hh) sc = *dst;
#pragma unroll
            for (int h = 0; h < 8; ++h) { f32x4 d = __builtin_amdgcn_mfma_f32_16x16x32_bf16(a0, qf[h][0], (f32x4){0.f, 0.f, 0.f, 0.f}, 0, 0, 0); d = __builtin_amdgcn_mfma_f32_16x16x32_bf16(a1, qf[h][1], d, 0, 0, 0);
                sc += __builtin_elementwise_max(d, (f32x4){0.f, 0.f, 0.f, 0.f}) * wv[h]; }
            *dst = sc;
        }
    }
    LDS_WAIT(); __syncthreads();
#pragma unroll 1
    for (int rr = 0; rr < 2; ++rr) { const int row = 2 * F.wave + rr, t = t0 + row, nj = (t >> 6) + 1; const LAS float* srow = SCL + row * SROW;
        unsigned k[32];
#pragma unroll
        for (int j = 0; j < 32; ++j) { const int s = lane + 64 * j; k[j] = fkey(s <= t ? srow[s] : -__builtin_inff()); }
        unsigned P = 0;
        if (t + 1 > TOPK) P = radix_select(k, nj, lane, hist);
        u64 myw = 0;
#pragma unroll
        for (int j = 0; j < 32; ++j) { const int s = lane + 64 * j; const u64 w = __ballot(k[j] >= P && s <= t); if (lane == j) myw = w; }
        if (lane < 32) F.MASK[(m0 + row) * 32 + lane] = myw;
    }
    LDS_WAIT(); __syncthreads();
}
__device__ __forceinline__ void p3_fused(Frame& F) {
    { const int gw = F.vcu * NWAVES + F.wave, NGW = F.G * NWAVES;
      for (int m = gw; m < M; m += NGW) { const int t = m % T; const bf16* pr = F.PROJ + (size_t)m * ATT_N;
          norm_rope32(F, pr + C_K + 32 * (F.lane & 15), F.K + (size_t)m * 512 + 32 * (F.lane & 15), F.k_gain, t, F.lane < 16);
          *(GAS v4u*)(F.V + (size_t)m * 512 + 8 * F.lane) = *(const GAS v4u*)(pr + C_V + 8 * F.lane); } }
    for (int u = F.vcu; u < 256; u += F.G) { const int b = u >> 6, i = u & 63; p3f_tile(F, b, 127 - i); p3f_tile(F, b, i); }
}
namespace att {
constexpr int D = 128, NW = 8, QBLK = 32, KVBLK = 64;
constexpr float SCALE = 0.088388347648318440f, THR = 8.f;
constexpr int LDQ = ATT_N, LDK = 512, LDO = DM;
constexpr int SHM_V = KVBLK * D * 2, SHM_K = KVBLK * D * 2, SHM_MASK = 2 * SHM_V + 2 * SHM_K + NW * 64 * 4, MROW = 33 * 8, SHM_ATTN = SHM_MASK + 256 * MROW;
#define KSWZ(row, colB) ((row) * 256 + ((colB) ^ (((row) & 7) << 4)))
#define SBAR() __builtin_amdgcn_sched_barrier(0)
__device__ __forceinline__ int crow(int r, int hi) { return (r & 3) + 8 * (r >> 2) + 4 * hi; }
__device__ __forceinline__ unsigned cvtpk(float lo, float hi) { unsigned r; asm volatile("v_cvt_pk_bf16_f32 %0, %1, %2" : "=v"(r) : "v"(lo), "v"(hi)); return r; }
__device__ __forceinline__ void partialSM(f32x16& p0, f32x16& p1, float& m_reg, float& mn, float& alpha) {
  constexpr float C = SCALE * 1.4426950408889634f;
  float pmax;
  { float m0, m1, m2, m3;
#define MAX3(d, a, b, c) asm volatile("v_max3_f32 %0, %1, %2, %3" : "=v"(d) : "v"(a), "v"(b), "v"(c))
    asm volatile("s_nop 7\n\ts_nop 5\n\tv_max3_f32 %0, %1, %2, %3" : "=v"(m0) : "v"(p0[0]), "v"(p0[1]), "v"(p0[2])); MAX3(m1, p0[3], p0[4], p0[5]); MAX3(m2, p0[6], p0[7], p0[8]); MAX3(m3, p0[9], p0[10], p0[11]);
    MAX3(m0, m0, p0[12], p0[13]); MAX3(m1, m1, p0[14], p0[15]); MAX3(m2, m2, p1[0], p1[1]); MAX3(m3, m3, p1[2], p1[3]);
    MAX3(m0, m0, p1[4], p1[5]); MAX3(m1, m1, p1[6], p1[7]); MAX3(m2, m2, p1[8], p1[9]); MAX3(m3, m3, p1[10], p1[11]);
    MAX3(m0, m0, p1[12], p1[13]); MAX3(m1, m1, p1[14], p1[15]); MAX3(m0, m0, m1, m2); MAX3(pmax, m0, m3, m3);
#undef MAX3
  }
  { auto rr = __builtin_amdgcn_permlane32_swap(__float_as_uint(pmax), __float_as_uint(pmax), false, false);
    pmax = fmaxf(__uint_as_float(rr[0]), __uint_as_float(rr[1])); }
  if (__builtin_expect(__all(pmax - m_reg <= THR / SCALE), 1)) { mn = m_reg; alpha = 1.f; }
  else { mn = fmaxf(m_reg, pmax); alpha = __builtin_amdgcn_exp2f((m_reg - mn) * C); m_reg = mn; }
  float mnC = -mn * C;
  for (int r = 0; r < 16; ++r) p0[r] = fmaf(p0[r], C, mnC); for (int r = 0; r < 16; ++r) p1[r] = fmaf(p1[r], C, mnC);
  for (int r = 0; r < 16; ++r) p0[r] = __builtin_amdgcn_exp2f(p0[r]);
}
__device__ __forceinline__ void finishSM(f32x16& p0, f32x16& p1, float alpha, float& l_reg, bf16x8& pa0, bf16x8& pa1, bf16x8& pa2, bf16x8& pa3) {
  for (int r = 0; r < 16; ++r) p1[r] = __builtin_amdgcn_exp2f(p1[r]);
  float ps = 0; for (int r = 0; r < 16; ++r) ps += p0[r]; for (int r = 0; r < 16; ++r) ps += p1[r];
  { auto rr = __builtin_amdgcn_permlane32_swap(__float_as_uint(ps), __float_as_uint(ps), false, false);
    ps = __uint_as_float(rr[0]) + __uint_as_float(rr[1]); }
  l_reg = l_reg * alpha + ps;
#define PK4(P, BASE, OUT) do { unsigned a0 = cvtpk(P[BASE + 0], P[BASE + 1]), a1 = cvtpk(P[BASE + 2], P[BASE + 3]);   \
    unsigned b0 = cvtpk(P[BASE + 4], P[BASE + 5]), b1 = cvtpk(P[BASE + 6], P[BASE + 7]);                              \
    auto r0 = __builtin_amdgcn_permlane32_swap(a0, b0, false, false); auto r1 = __builtin_amdgcn_permlane32_swap(a1, b1, false, false); \
    v4u w = {r0[0], r1[0], r0[1], r1[1]}; OUT = *reinterpret_cast<bf16x8*>(&w); } while (0)
  PK4(p0, 0, pa0); PK4(p0, 8, pa1); PK4(p1, 0, pa2); PK4(p1, 8, pa3);
#undef PK4
}
__device__ __forceinline__ void qkt(f32x16& p0, f32x16& p1, const bf16* Ks, const bf16x8* qr, int r32, int hi, unsigned mlo, unsigned mhi) {
#ifndef MASKV
#define MASKV 1
#endif
#if MASKV == 0
  const float NEG = -__builtin_inff(); mlo >>= 4 * hi; mhi >>= 4 * hi;
#pragma unroll
  for (int r = 0; r < 16; ++r) { const int c = (r & 3) + 8 * (r >> 2); p0[r] = ((mlo >> c) & 1u) ? 0.f : NEG; p1[r] = ((mhi >> c) & 1u) ? 0.f : NEG; }
#else
  const int nlo = (int)(~mlo >> (4 * hi)), nhi = (int)(~mhi >> (4 * hi));
#pragma unroll
  for (int r = 0; r < 16; ++r) { const int c = (r & 3) + 8 * (r >> 2);
    p0[r] = __uint_as_float((unsigned)__builtin_amdgcn_sbfe(nlo, c, 1) & 0xff800000u); p1[r] = __uint_as_float((unsigned)__builtin_amdgcn_sbfe(nhi, c, 1) & 0xff800000u); }
#endif
#pragma unroll
  for (int d0 = 0; d0 < 8; ++d0) { int cb = (d0 * 16 + hi * 8) * 2;
    bf16x8 b0 = *reinterpret_cast<const bf16x8*>((const char*)Ks + KSWZ(r32, cb));
    bf16x8 b1 = *reinterpret_cast<const bf16x8*>((const char*)Ks + KSWZ(32 + r32, cb));
    p0 = __builtin_amdgcn_mfma_f32_32x32x16_bf16(b0, qr[d0], p0, 0, 0, 0);
    p1 = __builtin_amdgcn_mfma_f32_32x32x16_bf16(b1, qr[d0], p1, 0, 0, 0); }
}
__device__ __forceinline__ int v_st(int k, int c) { const int kk = (k & ~0xC) | ((k & 4) << 1) | ((k & 8) >> 1); return ((kk >> 3) * 4 + (c >> 5)) * 512 + ((kk & 7) * 32 + (c & 31)) * 2; }
__device__ __forceinline__ int v_rd_base(int lane) { return ((lane & 3) << 3) | (((lane >> 2) & 3) << 6) | (((lane >> 4) & 1) << 5) | (((lane >> 5) & 1) << 8); }
constexpr int v_rd_off(int d0, int ks, int half) { return d0 * 512 + ks * 4096 + half * 2048; }
template <int OFF> __device__ __forceinline__ s16x4 tr_read(int vb) {
  s16x4 r; asm volatile("ds_read_b64_tr_b16 %0, %1 offset:%2" : "=&v"(r) : "v"(vb), "i"(OFF) : "memory"); return r;
}
template <int D0> __device__ __forceinline__ void pv_one(f32x16& od, int vb, bf16x8 pa0, bf16x8 pa1, bf16x8 pa2, bf16x8 pa3) {
  const s16x4 l0 = tr_read<v_rd_off(D0, 0, 0)>(vb), h0 = tr_read<v_rd_off(D0, 0, 1)>(vb), l1 = tr_read<v_rd_off(D0, 1, 0)>(vb), h1 = tr_read<v_rd_off(D0, 1, 1)>(vb);
  const s16x4 l2 = tr_read<v_rd_off(D0, 2, 0)>(vb), h2 = tr_read<v_rd_off(D0, 2, 1)>(vb), l3 = tr_read<v_rd_off(D0, 3, 0)>(vb), h3 = tr_read<v_rd_off(D0, 3, 1)>(vb);
  asm volatile("s_waitcnt lgkmcnt(0)" ::: "memory"); SBAR();
#define PK(L, H) (bf16x8){L[0], L[1], L[2], L[3], H[0], H[1], H[2], H[3]}
  od = __builtin_amdgcn_mfma_f32_32x32x16_bf16(pa0, PK(l0, h0), od, 0, 0, 0);
  od = __builtin_amdgcn_mfma_f32_32x32x16_bf16(pa1, PK(l1, h1), od, 0, 0, 0);
  od = __builtin_amdgcn_mfma_f32_32x32x16_bf16(pa2, PK(l2, h2), od, 0, 0, 0);
  od = __builtin_amdgcn_mfma_f32_32x32x16_bf16(pa3, PK(l3, h3), od, 0, 0, 0);
#undef PK
}
__device__ __forceinline__ void pv_d0(f32x16* o, int vb, bf16x8 pa0, bf16x8 pa1, bf16x8 pa2, bf16x8 pa3) {
  pv_one<0>(o[0], vb, pa0, pa1, pa2, pa3); pv_one<1>(o[1], vb, pa0, pa1, pa2, pa3); pv_one<2>(o[2], vb, pa0, pa1, pa2, pa3); pv_one<3>(o[3], vb, pa0, pa1, pa2, pa3);
}
__device__ __forceinline__ void attn_body(const bf16* __restrict__ Qb, const bf16* __restrict__ Kh, const bf16* __restrict__ Vh, bf16* __restrict__ Ob, const u64* __restrict__ mrow, int seq, char* lds,
                                          const float* __restrict__ qgain, const f32x2* __restrict__ ropeA, int tpos0) {
  const int tid = opaque_tid(), wid = tid >> 6, lane = tid & 63, r32 = lane & 31, hi = lane >> 5;
  bf16* V_lds = (bf16*)lds; bf16* K_lds = (bf16*)(lds + 2 * SHM_V);
  float* ws = (float*)(lds + 2 * SHM_V + 2 * SHM_K) + wid * 64; float* li_l = ws; float* al_l = ws + 32;
  float m_reg = -1e30f, l_reg = 0; f32x16 o[4] = {}; bf16x8 qr[8];
  const bf16* Qw = Qb + (long)(wid * QBLK + r32) * LDQ + hi * 8;
  { float x[64]; float s = 0.f;
#pragma unroll
    for (int d0 = 0; d0 < 8; ++d0) unpack8(*reinterpret_cast<const v4u*>(Qw + d0 * 16), x + 8 * d0);
#pragma unroll
    for (int e = 0; e < 64; ++e) s += x[e] * x[e];
    { auto rr = __builtin_amdgcn_permlane32_swap(__float_as_uint(s), __float_as_uint(s), false, false); s = __uint_as_float(rr[0]) + __uint_as_float(rr[1]); }
    const float rs = __builtin_amdgcn_rsqf(s * (1.f / 128.f) + EPS);
#pragma unroll
    for (int d0 = 0; d0 < 8; ++d0) { const f32x4 g0 = *(const f32x4*)(qgain + 16 * d0 + 8 * hi), g1 = *(const f32x4*)(qgain + 16 * d0 + 8 * hi + 4);
        x[8 * d0 + 0] *= rs * g0.x; x[8 * d0 + 1] *= rs * g0.y; x[8 * d0 + 2] *= rs * g0.z; x[8 * d0 + 3] *= rs * g0.w; x[8 * d0 + 4] *= rs * g1.x; x[8 * d0 + 5] *= rs * g1.y; x[8 * d0 + 6] *= rs * g1.z; x[8 * d0 + 7] *= rs * g1.w; }
    const f32x2* rp = ropeA + (size_t)(tpos0 + wid * QBLK + r32) * 16 + 8 * hi;
#pragma unroll
    for (int e = 0; e < 8; ++e) { const f32x2 cs = rp[e]; const float a = x[e], bq = x[8 + e]; x[e] = a * cs.x - bq * cs.y; x[8 + e] = a * cs.y + bq * cs.x; }
#pragma unroll
    for (int d0 = 0; d0 < 8; ++d0) { v4u w = pack8f(x + 8 * d0); qr[d0] = *reinterpret_cast<bf16x8*>(&w); } }
  const char* mw = lds + SHM_MASK + (wid * QBLK + r32) * MROW;
  const int sr = tid >> 4, sc = (tid & 15) * 8, vst0 = v_st(sr, sc), vst1 = v_st(32 + sr, sc);
  const int vb0 = (int)(uintptr_t)V_lds + v_rd_base(lane);
  constexpr int SDEPTH = 2;
  struct { bf16x8 vs0, vs1, ks0, ks1; } sr_[SDEPTH];
#define SLOAD(i, k0) do { sr_[i].vs0 = *reinterpret_cast<const bf16x8*>(&Vh[(long)((k0) + sr) * LDK + sc]); sr_[i].vs1 = *reinterpret_cast<const bf16x8*>(&Vh[(long)((k0) + 32 + sr) * LDK + sc]); \
    sr_[i].ks0 = *reinterpret_cast<const bf16x8*>(&Kh[(long)((k0) + sr) * LDK + sc]); sr_[i].ks1 = *reinterpret_cast<const bf16x8*>(&Kh[(long)((k0) + 32 + sr) * LDK + sc]); } while (0)
#define SWRITE(b, i) do { *(bf16x8*)((char*)V_lds + (b) * SHM_V + vst0) = sr_[i].vs0;          \
    *(bf16x8*)((char*)V_lds + (b) * SHM_V + vst1) = sr_[i].vs1; int kc = sc * 2;               \
    *(bf16x8*)((char*)K_lds + (b) * SHM_K + KSWZ(sr, kc)) = sr_[i].ks0;                       \
    *(bf16x8*)((char*)K_lds + (b) * SHM_K + KSWZ(32 + sr, kc)) = sr_[i].ks1; } while (0)
#define SWAIT() do { if constexpr (SDEPTH == 2) asm volatile("s_waitcnt vmcnt(4)" ::: "memory"); else asm volatile("s_waitcnt vmcnt(0)" ::: "memory"); } while (0)
#define RESC(a) do { if (__any((a) < 1.f)) { if (hi == 0) al_l[r32] = (a); asm volatile("s_waitcnt lgkmcnt(0)" ::: "memory"); \
    for (int d = 0; d < 4; ++d) for (int r = 0; r < 16; ++r) o[d][r] *= al_l[crow(r, hi)]; } } while (0)
  f32x16 pA0, pA1, pB0, pB1; float mnA, mnB, alA, alB; bf16x8 pa0, pa1, pa2, pa3; const int NT = seq / KVBLK;
  constexpr int SE = 0, SO = SDEPTH - 1;
  { const int NTw = seq / KVBLK; for (int e = tid; e < 256 * NTw; e += 512) { const int row = e / NTw, j = e - row * NTw; *(u64*)(lds + SHM_MASK + row * MROW + j * 8) = mrow[(size_t)row * 32 + j]; } }
#define MK(j) (*(const v2u*)(mw + (j) * 8))
  v2u mk;
  SLOAD(SE, 0); asm volatile("s_waitcnt vmcnt(0)" ::: "memory"); SWRITE(0, SE); __syncthreads();
  mk = MK(0); qkt(pA0, pA1, K_lds, qr, r32, hi, mk.x, mk.y); partialSM(pA0, pA1, m_reg, mnA, alA);
  SLOAD(SO, KVBLK); if constexpr (SDEPTH == 2) { if (2 < NT) SLOAD(SE, 2 * KVBLK); }
  SWAIT(); SWRITE(1, SO); __syncthreads();
  for (int j = 1; j + 1 < NT; j += 2) {
    SBAR(); mk = MK(j); qkt(pB0, pB1, (bf16*)((char*)K_lds + SHM_K), qr, r32, hi, mk.x, mk.y);
    finishSM(pA0, pA1, alA, l_reg, pa0, pa1, pa2, pa3); SBAR();
    SLOAD(SO, (j + SDEPTH) * KVBLK); SBAR();
    pv_d0(o, vb0, pa0, pa1, pa2, pa3); partialSM(pB0, pB1, m_reg, mnB, alB);
    __syncthreads(); SWAIT(); SWRITE(0, SE);
    RESC(alB); __syncthreads();
    SBAR(); mk = MK(j + 1); qkt(pA0, pA1, K_lds, qr, r32, hi, mk.x, mk.y);
    finishSM(pB0, pB1, alB, l_reg, pa0, pa1, pa2, pa3); SBAR();
    if (SDEPTH == 1 || j + 3 < NT) SLOAD(SE, (j + 1 + SDEPTH) * KVBLK); SBAR();
    pv_d0(o, vb0 + (int)SHM_V, pa0, pa1, pa2, pa3); partialSM(pA0, pA1, m_reg, mnA, alA);
    __syncthreads(); SWAIT(); SWRITE(1, SO);
    RESC(alA); __syncthreads();
  }
  SBAR(); mk = MK(NT - 1); qkt(pB0, pB1, (bf16*)((char*)K_lds + SHM_K), qr, r32, hi, mk.x, mk.y);
  finishSM(pA0, pA1, alA, l_reg, pa0, pa1, pa2, pa3); SBAR();
  pv_d0(o, vb0, pa0, pa1, pa2, pa3); partialSM(pB0, pB1, m_reg, mnB, alB);
  __syncthreads(); RESC(alB);
  finishSM(pB0, pB1, alB, l_reg, pa0, pa1, pa2, pa3); SBAR();
  pv_d0(o, vb0 + (int)SHM_V, pa0, pa1, pa2, pa3);
  if (hi == 0) li_l[r32] = l_reg; asm volatile("s_waitcnt lgkmcnt(0)" ::: "memory");
  float rli[16];
#pragma unroll
  for (int r = 0; r < 16; ++r) rli[r] = __builtin_amdgcn_rcpf(li_l[crow(r, hi)]);
  bf16* Ow = Ob + (long)(wid * QBLK) * LDO;
#pragma unroll
  for (int r = 0; r < 16; ++r) { const int orow = crow(r, hi);
#pragma unroll
    for (int d0 = 0; d0 < 4; ++d0) { const float v = o[d0][r] * rli[r]; const float vn = __shfl_xor(v, 1);
      if ((r32 & 1) == 0) *(unsigned*)(Ow + (long)orow * LDO + d0 * 32 + r32) = cvtpk(v, vn); } }
#undef MK
#undef SLOAD
#undef SWRITE
#undef SWAIT
#undef RESC
}
#undef KSWZ
#undef SBAR
}
__device__ __forceinline__ void p4_attention(Frame& F, char* lds) {
    static_assert(att::SHM_ATTN <= RING_BYTES, "attention LDS");
    for (int it = F.vcu; it < 256; it += F.G) { const int grp = it >> 4, b = grp >> 2, g = grp & 3, h = g * 4 + ((it >> 2) & 3), x = it & 3;
        for (int pass = 0; pass < 2; ++pass) { const int qb = pass ? x : 7 - x; const size_t row0 = (size_t)b * T + (size_t)qb * 256;
            att::attn_body(F.PROJ + row0 * ATT_N + C_Q + h * HD, F.K + (size_t)b * T * 512 + g * HD, F.V + (size_t)b * T * 512 + g * HD, F.O + row0 * DM + h * HD, F.MASK + row0 * 32, 256 * (qb + 1), lds, F.q_gain, F.ROPE_A, qb * 256);
            __syncthreads(); } }
}
namespace ml {
constexpr int QS = 0, KS = 16384, VS = 32768, PF = 65536, HS = 73728, HROW = 528, MISC = HS + 64 * HROW, PW = MISC + 2048, PWB = 1536, LDS_END_B = PW + 8 * PWB;
constexpr int A_KP = 0, A_VS = 16384, A_BUF = 49152, A_WK = 2 * A_BUF, A_B = A_WK + 8192, A_U = A_B + 8192, A_M = A_U + 8192, A_CH = A_M + 8192, LDS_END_A = A_CH + 1024;
#define SW16(row, colB) ((row) * 256 + ((colB) ^ (((row) & 15) << 4)))
#define SBAR() __builtin_amdgcn_sched_barrier(0)
#define MBAR() do { asm volatile("s_waitcnt lgkmcnt(0)" ::: "memory"); __builtin_amdgcn_s_barrier(); asm volatile("" ::: "memory"); } while (0)
using att::crow; using att::cvtpk; using att::v_st; using att::v_rd_base; using att::tr_read;
__device__ __forceinline__ bf16x8 pk88(const s16x4 l, const s16x4 h) { return (bf16x8){l[0], l[1], l[2], l[3], h[0], h[1], h[2], h[3]}; }
__device__ __forceinline__ bf16x8 pack_acc8(const f32x16& x, int s8) { v4u w = {cvtpk(x[s8 + 0], x[s8 + 1]), cvtpk(x[s8 + 2], x[s8 + 3]), cvtpk(x[s8 + 4], x[s8 + 5]), cvtpk(x[s8 + 6], x[s8 + 7])}; return *reinterpret_cast<bf16x8*>(&w); }
__device__ __forceinline__ v4u wmul8(const v4u k, float w) { v4u o; o.x = cvtpk(bflo(k.x) * w, bfhi(k.x) * w); o.y = cvtpk(bflo(k.y) * w, bfhi(k.y) * w); o.z = cvtpk(bflo(k.z) * w, bfhi(k.z) * w); o.w = cvtpk(bflo(k.w) * w, bfhi(k.w) * w); return o; }
template <int CTRL, int ROWMASK> __device__ __forceinline__ float dppf(float old, float src) {
    return __builtin_bit_cast(float, __builtin_amdgcn_update_dpp(__builtin_bit_cast(int, old), __builtin_bit_cast(int, src), CTRL, ROWMASK, 0xf, false)); }
__device__ __forceinline__ float wave_sum_dpp(float v) {
    v += dppf<0xB1, 0xf>(0.f, v); v += dppf<0x4E, 0xf>(0.f, v); v += dppf<0x141, 0xf>(0.f, v); v += dppf<0x140, 0xf>(0.f, v);
    const int iv = __builtin_bit_cast(int, v);
    return (__builtin_bit_cast(float, __builtin_amdgcn_readlane(iv, 0)) + __builtin_bit_cast(float, __builtin_amdgcn_readlane(iv, 16))) +
           (__builtin_bit_cast(float, __builtin_amdgcn_readlane(iv, 32)) + __builtin_bit_cast(float, __builtin_amdgcn_readlane(iv, 48)));
}
__device__ __forceinline__ float scan_sum64(float x) {
    x += dppf<0x111, 0xf>(0.f, x); x += dppf<0x112, 0xf>(0.f, x); x += dppf<0x114, 0xf>(0.f, x); x += dppf<0x118, 0xf>(0.f, x);
    x += dppf<0x142, 0xa>(0.f, x); x += dppf<0x143, 0xc>(0.f, x); return x;
}
__device__ __forceinline__ float scan_max64(float x) {
    const float NI = -__builtin_inff();
    x = fmaxf(x, dppf<0x111, 0xf>(NI, x)); x = fmaxf(x, dppf<0x112, 0xf>(NI, x)); x = fmaxf(x, dppf<0x114, 0xf>(NI, x)); x = fmaxf(x, dppf<0x118, 0xf>(NI, x));
    x = fmaxf(x, dppf<0x142, 0xa>(NI, x)); x = fmaxf(x, dppf<0x143, 0xc>(NI, x)); return x;
}
template <int I> __device__ __forceinline__ void cupd(f32x16& Xi, int vbK, const bf16x8 (&vB)[4]) {
    const s16x4 l0 = tr_read<I * 512 + 0 * 4096>(vbK), h0 = tr_read<I * 512 + 0 * 4096 + 2048>(vbK), l1 = tr_read<I * 512 + 1 * 4096>(vbK), h1 = tr_read<I * 512 + 1 * 4096 + 2048>(vbK);
    const s16x4 l2 = tr_read<I * 512 + 2 * 4096>(vbK), h2 = tr_read<I * 512 + 2 * 4096 + 2048>(vbK), l3 = tr_read<I * 512 + 3 * 4096>(vbK), h3 = tr_read<I * 512 + 3 * 4096 + 2048>(vbK);
    asm volatile("s_waitcnt lgkmcnt(0)" ::: "memory"); SBAR();
    Xi = __builtin_amdgcn_mfma_f32_32x32x16_bf16(pk88(l0, h0), vB[0], Xi, 0, 0, 0);
    Xi = __builtin_amdgcn_mfma_f32_32x32x16_bf16(pk88(l1, h1), vB[1], Xi, 0, 0, 0);
    Xi = __builtin_amdgcn_mfma_f32_32x32x16_bf16(pk88(l2, h2), vB[2], Xi, 0, 0, 0);
    Xi = __builtin_amdgcn_mfma_f32_32x32x16_bf16(pk88(l3, h3), vB[3], Xi, 0, 0, 0);
}
template <int I> __device__ __forceinline__ void yinter(f32x16& acc, const LAS unsigned char* qrow, int swz, int hi, bf16x8 xb0, bf16x8 xb1) {
    const v2u a00 = *(const LAS v2u*)(qrow + (((I * 32 + 0) * 2) ^ swz) + 8 * hi), a01 = *(const LAS v2u*)(qrow + (((I * 32 + 8) * 2) ^ swz) + 8 * hi);
    const v2u a10 = *(const LAS v2u*)(qrow + (((I * 32 + 16) * 2) ^ swz) + 8 * hi), a11 = *(const LAS v2u*)(qrow + (((I * 32 + 24) * 2) ^ swz) + 8 * hi);
    v4u A0 = {a00.x, a00.y, a01.x, a01.y}, A1 = {a10.x, a10.y, a11.x, a11.y};
    acc = __builtin_amdgcn_mfma_f32_32x32x16_bf16(*reinterpret_cast<bf16x8*>(&A0), xb0, acc, 0, 0, 0);
    acc = __builtin_amdgcn_mfma_f32_32x32x16_bf16(*reinterpret_cast<bf16x8*>(&A1), xb1, acc, 0, 0, 0);
}
}
__device__ __forceinline__ void late_weights(Frame& F, int gw, int NGW) {
    LAS float* scr = (LAS float*)(F.lds + RING_OFF + F.wave * 16384);
    constexpr int I9 = 32 * 64, I10 = 32 * 256, I11 = 128 * 64;
    for (int it = gw; it < I9 + I10 + I11; it += NGW) { int r = it;
        if (r < I9) { tr_item(F.ml_w_out, DM, 0, DM, 64, DM, nullptr, 1.f, F.WmoT, scr, r, F.lane); continue; } r -= I9;
        if (r < I10) { tr_item(F.w_up + (size_t)DM * FF, FF, 0, FF, 256, DM, F.norm_ffn + DM, 1.f, F.WupT1, scr, r, F.lane); continue; } r -= I10;
        tr_item(F.w_dn + (size_t)FF * DM, DM, 0, DM, 64, FF, nullptr, 1.f, F.WdnT1, scr, r, F.lane); }
}
template <int mode> __device__ __forceinline__ void p9a_state(Frame& F) {
    using namespace ml;
    constexpr int NBH = BATCH * MH, NC = T / 64;
    if (F.vcu >= NBH) { if (F.G > NBH && mode != 1) late_weights(F, (F.vcu - NBH) * NWAVES + F.wave, (F.G - NBH) * NWAVES); return; }
    if (mode == 2) return;
    LAS unsigned char* L = F.lds + RING_OFF;
    static_assert(ml::LDS_END_A <= RING_BYTES, "mLSTM pass A LDS");
    const int bh = F.vcu, b = bh / MH, h = bh % MH, w = F.wave, tid = F.tid;
    const size_t mb = (size_t)b * T;
    LAS float* WKL = (LAS float*)(L + A_WK); LAS float* BL = (LAS float*)(L + A_B); LAS float* UL = (LAS float*)(L + A_U); LAS float* MLs = (LAS float*)(L + A_M);
    LAS float* CH = (LAS float*)(L + A_CH);
    const float* igp = F.IG + (size_t)bh * T; const float* lfp = F.LF + (size_t)bh * T;
#pragma unroll
    for (int cc = 0; cc < 4; ++cc) { const int c = 4 * w + cc, t = c * 64 + F.lane; const float ig = igp[t], lf = lfp[t];
        const float bb = scan_sum64(lf), u = ig - bb, Mx = scan_max64(u);
        BL[t] = bb; UL[t] = u; MLs[t] = Mx; if (F.lane == 63) { CH[c] = bb; CH[32 + c] = Mx; } }
    LDS_WAIT(); __syncthreads();
    if (tid == 0) { float m = 0.f; for (int c = 0; c < NC; ++c) { const float mm63 = fmaxf(m, CH[32 + c]); CH[64 + c] = m; CH[96 + c] = __expf(m - mm63); CH[128 + c] = mm63; m = CH[c] + mm63; } }
    LDS_WAIT(); __syncthreads();
    { float* scal = F.SCAL + (size_t)bh * 4 * T;
      for (int t = tid; t < T; t += NTHR) { const int c = t >> 6; const float mst = CH[64 + c], mm = fmaxf(mst, MLs[t]), u = UL[t];
          scal[t] = u; scal[T + t] = mm; scal[2 * T + t] = __expf(mst - mm); scal[3 * T + t] = __expf(-(BL[t] + mm)); WKL[t] = __expf(u - CH[128 + c]); } }
    LDS_WAIT(); __syncthreads();
    f32x16 X[4];
#pragma unroll
    for (int i = 0; i < 4; ++i)
#pragma unroll
        for (int r = 0; r < 16; ++r) X[i][r] = 0.f;
    float nreg = 0.f;
    struct KV { v4u k0, k1, v00, v01, v10, v11; }; KV S0, S1, S2;
    const int lbase = (int)(uintptr_t)L;
#define A_LOAD(cc, S) do { const bf16* rp0 = F.PROJ + (mb + (size_t)(cc) * 64 + sr) * ML_N + sc; const bf16* rp1 = rp0 + 32 * ML_N;                              \
        S.k0 = *(const GAS v4u*)(rp0 + C_MK + h * MDK); S.k1 = *(const GAS v4u*)(rp1 + C_MK + h * MDK);                                                       \
        S.v00 = *(const GAS v4u*)(rp0 + C_MV + h * MDV); S.v01 = *(const GAS v4u*)(rp0 + C_MV + h * MDV + 128); S.v10 = *(const GAS v4u*)(rp1 + C_MV + h * MDV); S.v11 = *(const GAS v4u*)(rp1 + C_MV + h * MDV + 128); } while (0)
#define A_WRITE(cc, S) do { LAS unsigned char* B_ = L + ((cc) & 1) * A_BUF; const float w0 = WKL[(cc) * 64 + sr], w1 = WKL[(cc) * 64 + 32 + sr];            \
        *(LAS v4u*)(B_ + A_KP + v_st(sr, sc)) = wmul8(S.k0, w0); *(LAS v4u*)(B_ + A_KP + v_st(32 + sr, sc)) = wmul8(S.k1, w1);                                \
        *(LAS v4u*)(B_ + A_VS + v_st(sr, sc)) = S.v00; *(LAS v4u*)(B_ + A_VS + 16384 + v_st(sr, sc)) = S.v01;                                                 \
        *(LAS v4u*)(B_ + A_VS + v_st(32 + sr, sc)) = S.v10; *(LAS v4u*)(B_ + A_VS + 16384 + v_st(32 + sr, sc)) = S.v11; } while (0)
    { const int sr = tid >> 4, sc = (tid & 15) * 8; A_LOAD(0, S0); A_WRITE(0, S0); A_LOAD(1, S1); A_LOAD(2, S2); A_LOAD(3, S0); }
    LDS_WAIT(); __syncthreads();
#define A_ITER(cc, SN) do { if ((cc) < NC) {                                                                                                                  \
        int lane_o = F.lane, tid_o = F.tid; asm volatile("" : "+v"(lane_o), "+v"(tid_o));           \
        const int lane = lane_o, sr = tid_o >> 4, sc = (tid_o & 15) * 8;                                                                                         \
        { bf16* st = F.ST + ((((size_t)bh * NC + (cc)) * 8 + w) * 8) * 512 + lane * 8;                                                                           \
          _Pragma("unroll") for (int i = 0; i < 4; ++i) { *(GAS bf16x8*)(st + (i * 2 + 0) * 512) = pack_acc8(X[i], 0); *(GAS bf16x8*)(st + (i * 2 + 1) * 512) = pack_acc8(X[i], 8); } \
          if (w == 4 || w == 5) F.NST[((size_t)bh * NC + (cc)) * 128 + (w - 4) * 64 + lane] = nreg; }                                                            \
        if ((cc) < NC - 1) {                                                                                                                                     \
        const int boff = ((cc) & 1) * A_BUF; const float s_old = CH[96 + (cc)];                                                                                  \
        const int vbK = lbase + boff + A_KP + v_rd_base(lane), vbV = lbase + boff + A_VS + (w >> 2) * 16384 + (w & 3) * 512 + v_rd_base(lane);                   \
        bf16x8 vB[4];                                                                                                                                            \
        { const s16x4 l0 = tr_read<0 * 4096>(vbV), h0 = tr_read<0 * 4096 + 2048>(vbV), l1 = tr_read<1 * 4096>(vbV), h1 = tr_read<1 * 4096 + 2048>(vbV);          \
          const s16x4 l2 = tr_read<2 * 4096>(vbV), h2 = tr_read<2 * 4096 + 2048>(vbV), l3 = tr_read<3 * 4096>(vbV), h3 = tr_read<3 * 4096 + 2048>(vbV);          \
          asm volatile("s_waitcnt lgkmcnt(0)" ::: "memory"); SBAR();                                                                                             \
          vB[0] = pk88(l0, h0); vB[1] = pk88(l1, h1); vB[2] = pk88(l2, h2); vB[3] = pk88(l3, h3); }                                                              \
        _Pragma("unroll") for (int i = 0; i < 4; ++i) _Pragma("unroll") for (int r = 0; r < 16; ++r) X[i][r] *= s_old;                                           \
        cupd<0>(X[0], vbK, vB); cupd<1>(X[1], vbK, vB); cupd<2>(X[2], vbK, vB); cupd<3>(X[3], vbK, vB);                                                          \
        if (w == 4 || w == 5) { const int d = (w - 4) * 64 + lane; float acc = 0.f; const LAS unsigned char* kcol = L + boff + A_KP + ((d >> 5) * 512 + (d & 31) * 2); \
            _Pragma("unroll 1") for (int s8 = 0; s8 < 8; ++s8) {                                                                                                  \
                _Pragma("unroll") for (int e = 0; e < 8; ++e) acc += bf2f(*(const LAS bf16*)(kcol + s8 * 2048 + e * 64)); }                                       \
            nreg = s_old * nreg + acc; }                                                                                                                         \
        if ((cc) + 1 < NC - 1) { A_WRITE((cc) + 1, SN); if ((cc) + 4 < NC - 1) A_LOAD((cc) + 4, SN); }                                                           \
        MBAR(); } } } while (0)
    for (int c = 0; c < NC; c += 3) { A_ITER(c, S1); A_ITER(c + 1, S2); A_ITER(c + 2, S0); }
#undef A_ITER
#undef A_LOAD
#undef A_WRITE
}
__device__ __forceinline__ void p9b_output(Frame& F) {
    using namespace ml;
    constexpr int NC = T / 64, NITEMS = BATCH * MH * NC;
    LAS unsigned char* L = F.lds + RING_OFF;
    static_assert(ml::LDS_END_B <= RING_BYTES, "mLSTM pass B LDS");
    const int w = F.wave, tid = F.tid;
    LAS float* misc = (LAS float*)(L + MISC); LAS float* RSA = misc, * RSB = misc + 64, * QN = misc + 128;
    LAS float* pw = (LAS float*)(L + PW + w * PWB);
    const int lbase = (int)(uintptr_t)L;
    if (tid < 64) RSB[tid] = 0.f;
    f32x4 hg; { const float* gp = F.h_gain + 4 * F.lane; hg = (f32x4){gp[0], gp[1], gp[2], gp[3]}; }
    v4u sq0, sq1, sk0, sk1, sv00, sv01, sv10, sv11; float s_u, s_mm, s_sint, s_nrm; f32x2 s_n;
    LAS float* NBl = misc + 192;
#define B_LOAD(it_) do { const int bh_ = (it_) & 31, c_ = (it_) >> 5, b_ = bh_ / MH, h_ = bh_ % MH;                                                         \
        const bf16* rp0 = F.PROJ + ((size_t)b_ * T + (size_t)c_ * 64 + sr) * ML_N + sc; const bf16* rp1 = rp0 + 32 * ML_N;                                      \
        sq0 = *(const GAS v4u*)(rp0 + C_MQ + h_ * MDK); sq1 = *(const GAS v4u*)(rp1 + C_MQ + h_ * MDK); sk0 = *(const GAS v4u*)(rp0 + C_MK + h_ * MDK); sk1 = *(const GAS v4u*)(rp1 + C_MK + h_ * MDK);   \
        sv00 = *(const GAS v4u*)(rp0 + C_MV + h_ * MDV); sv01 = *(const GAS v4u*)(rp0 + C_MV + h_ * MDV + 128); sv10 = *(const GAS v4u*)(rp1 + C_MV + h_ * MDV); sv11 = *(const GAS v4u*)(rp1 + C_MV + h_ * MDV + 128); \
        const float* sp_ = F.SCAL + (size_t)bh_ * 4 * T + c_ * 64 + lane; s_u = sp_[0]; s_mm = sp_[T]; s_sint = sp_[2 * T]; s_nrm = sp_[3 * T];                                                \
        s_n = *(const GAS f32x2*)(F.NST + ((size_t)bh_ * NC + c_) * 128 + 2 * lane); } while (0)
#define B_WRITE() do { pw[lane] = s_u; pw[64 + lane] = s_mm; if (w == 3) *(LAS f32x2*)(NBl + 2 * lane) = s_n;                                                                                            \
        *(LAS v4u*)(L + QS + SW16(sr, sc * 2)) = sq0; *(LAS v4u*)(L + QS + SW16(32 + sr, sc * 2)) = sq1;                                                \
        *(LAS v4u*)(L + KS + SW16(sr, sc * 2)) = sk0; *(LAS v4u*)(L + KS + SW16(32 + sr, sc * 2)) = sk1;                                                \
        *(LAS v4u*)(L + VS + v_st(sr, sc)) = sv00; *(LAS v4u*)(L + VS + 16384 + v_st(sr, sc)) = sv01;                                                   \
        *(LAS v4u*)(L + VS + v_st(32 + sr, sc)) = sv10; *(LAS v4u*)(L + VS + 16384 + v_st(32 + sr, sc)) = sv11; } while (0)
    int it = F.vcu; if (it >= NITEMS) return;
    float c_sint, c_nrm;
    { const int lane = F.lane, sr = tid >> 4, sc = (tid & 15) * 8; B_LOAD(it); B_WRITE(); c_sint = s_sint; c_nrm = s_nrm; if (it + F.G < NITEMS) B_LOAD(it + F.G); }
    LDS_WAIT(); __syncthreads();
    for (; it < NITEMS; it += F.G) {
        const int bh = it & 31, c = it >> 5, b = bh / MH, h = bh % MH, t0 = c * 64; const size_t mb = (size_t)b * T;
        int lane_o = F.lane, tid_o = F.tid; asm volatile("" : "+v"(lane_o), "+v"(tid_o));
        const int lane = lane_o, r32 = lane & 31, hi = lane >> 5, sr = tid_o >> 4, sc = (tid_o & 15) * 8;
        const int vbV = lbase + VS + (w >> 2) * 16384 + (w & 3) * 512 + v_rd_base(lane);
        bf16x8 xb[4][2];
        { const bf16* st = F.ST + ((((size_t)bh * NC + c) * 8 + w) * 8) * 512 + lane * 8;
#pragma unroll
          for (int i = 0; i < 4; ++i) { xb[i][0] = __builtin_nontemporal_load((const GAS bf16x8*)(st + (i * 2 + 0) * 512)); xb[i][1] = __builtin_nontemporal_load((const GAS bf16x8*)(st + (i * 2 + 1) * 512)); } }
        if (w < 3) { const int lt = w ? 1 : 0, st = w == 2 ? 1 : 0; const int srow = r32 + 32 * st, lrow = r32 + 32 * lt;
            f32x16 p;
#pragma unroll
            for (int r = 0; r < 16; ++r) p[r] = 0.f;
#pragma unroll
            for (int kk = 0; kk < 8; ++kk) { const bf16x8 ka = *(const LAS bf16x8*)(L + KS + SW16(srow, (16 * kk + 8 * hi) * 2)), qb = *(const LAS bf16x8*)(L + QS + SW16(lrow, (16 * kk + 8 * hi) * 2));
                p = __builtin_amdgcn_mfma_f32_32x32x16_bf16(ka, qb, p, 0, 0, 0); }
            const float mml = pw[64 + lrow]; float ps = 0.f;
#pragma unroll
            for (int r = 0; r < 16; ++r) { const int s = crow(r, hi) + 32 * st; const float us = pw[s]; const float wgt = (s <= lrow) ? __expf(us - mml) : 0.f; p[r] *= wgt; ps += p[r]; }
            { auto rr = __builtin_amdgcn_permlane32_swap(__float_as_uint(ps), __float_as_uint(ps), false, false); ps = __uint_as_float(rr[0]) + __uint_as_float(rr[1]); }
            if (hi == 0) { if (st == 0) RSA[lrow] = ps; else RSB[lrow] = ps; }
            bf16x8 pa0, pa1;
#define PK4(P, BASE, OUT) do { unsigned a0 = cvtpk(P[BASE + 0], P[BASE + 1]), a1 = cvtpk(P[BASE + 2], P[BASE + 3]);   \
    unsigned b0 = cvtpk(P[BASE + 4], P[BASE + 5]), b1 = cvtpk(P[BASE + 6], P[BASE + 7]);                              \
    auto r0 = __builtin_amdgcn_permlane32_swap(a0, b0, false, false); auto r1 = __builtin_amdgcn_permlane32_swap(a1, b1, false, false); \
    v4u w_ = {r0[0], r1[0], r0[1], r1[1]}; OUT = *reinterpret_cast<bf16x8*>(&w_); } while (0)
            PK4(p, 0, pa0); PK4(p, 8, pa1);
#undef PK4
            *(LAS bf16x8*)(L + PF + (lt * 4 + 2 * st + 0) * 1024 + lane * 16) = pa0; *(LAS bf16x8*)(L + PF + (lt * 4 + 2 * st + 1) * 1024 + lane * 16) = pa1;
        } else if (w == 3) { const LAS float* nb = NBl; float acc = 0.f;
#pragma unroll 2
            for (int ch = 0; ch < 16; ++ch) { const v4u qv = *(const LAS v4u*)(L + QS + SW16(lane, ch * 16)); const f32x4 n0 = *(const LAS f32x4*)(nb + 8 * ch), n1 = *(const LAS f32x4*)(nb + 8 * ch + 4);
                acc += bflo(qv.x) * n0.x + bfhi(qv.x) * n0.y + bflo(qv.y) * n0.z + bfhi(qv.y) * n0.w + bflo(qv.z) * n1.x + bfhi(qv.z) * n1.y + bflo(qv.w) * n1.z + bfhi(qv.w) * n1.w; }
            QN[lane] = acc;
        }
        MBAR();
        { const float den = RSA[lane] + RSB[lane] + c_sint * QN[lane]; const float rinv = 1.f / fmaxf(fabsf(den), c_nrm); pw[192 + lane] = rinv; pw[256 + lane] = c_sint * rinv; }
        bf16x8 vB[4];
        { const s16x4 l0 = tr_read<0 * 4096>(vbV), h0 = tr_read<0 * 4096 + 2048>(vbV), l1 = tr_read<1 * 4096>(vbV), h1 = tr_read<1 * 4096 + 2048>(vbV);
          const s16x4 l2 = tr_read<2 * 4096>(vbV), h2 = tr_read<2 * 4096 + 2048>(vbV), l3 = tr_read<3 * 4096>(vbV), h3 = tr_read<3 * 4096 + 2048>(vbV);
          asm volatile("s_waitcnt lgkmcnt(0)" ::: "memory"); SBAR();
          vB[0] = pk88(l0, h0); vB[1] = pk88(l1, h1); vB[2] = pk88(l2, h2); vB[3] = pk88(l3, h3); }
        f32x16 aI0, aI1;
#pragma unroll
        for (int r = 0; r < 16; ++r) { aI0[r] = 0.f; aI1[r] = 0.f; }
        { const LAS unsigned char* qrow0 = L + QS + r32 * 256; const LAS unsigned char* qrow1 = qrow0 + 32 * 256; const int swz = (r32 & 15) << 4;
#define YI(I) do { yinter<I>(aI0, qrow0, swz, hi, xb[I][0], xb[I][1]); yinter<I>(aI1, qrow1, swz, hi, xb[I][0], xb[I][1]); } while (0)
          YI(0); YI(1); YI(2); YI(3);
#undef YI
        }
        v2u og[8];
#pragma unroll
        for (int e = 0; e < 8; ++e) og[e] = *(const GAS v2u*)(F.PROJ + (mb + t0 + 8 * w + e) * ML_N + C_MO + h * MDV + 4 * lane);
#pragma unroll
        for (int lt = 0; lt < 2; ++lt) { f32x16 aY;
#pragma unroll
            for (int r = 0; r < 16; ++r) aY[r] = 0.f;
            { const bf16x8 p0 = *(const LAS bf16x8*)(L + PF + (lt * 4 + 0) * 1024 + lane * 16), p1 = *(const LAS bf16x8*)(L + PF + (lt * 4 + 1) * 1024 + lane * 16);
              aY = __builtin_amdgcn_mfma_f32_32x32x16_bf16(p0, vB[0], aY, 0, 0, 0); aY = __builtin_amdgcn_mfma_f32_32x32x16_bf16(p1, vB[1], aY, 0, 0, 0); }
            if (lt == 1) { const bf16x8 p2 = *(const LAS bf16x8*)(L + PF + (4 + 2) * 1024 + lane * 16), p3 = *(const LAS bf16x8*)(L + PF + (4 + 3) * 1024 + lane * 16);
              aY = __builtin_amdgcn_mfma_f32_32x32x16_bf16(p2, vB[2], aY, 0, 0, 0); aY = __builtin_amdgcn_mfma_f32_32x32x16_bf16(p3, vB[3], aY, 0, 0, 0); }
#pragma unroll
            for (int r = 0; r < 16; ++r) { const int l = crow(r, hi) + 32 * lt; const float y = aY[r] * pw[192 + l] + (lt ? aI1[r] : aI0[r]) * pw[256 + l];
                *(LAS bf16*)(L + HS + l * HROW + (32 * w + r32) * 2) = (bf16)f2bf(y); }
        }
        MBAR();
#pragma unroll
        for (int e = 0; e < 8; ++e) { const int l = 8 * w + e; const v2u hv = *(const LAS v2u*)(L + HS + l * HROW + lane * 8);
            const float h0 = bflo(hv.x), h1 = bfhi(hv.x), h2 = bflo(hv.y), h3 = bfhi(hv.y);
            const float ss = wave_sum_dpp((h0 * h0 + h1 * h1) + (h2 * h2 + h3 * h3)); const float rn = __builtin_amdgcn_rsqf(ss * (1.f / MDV) + EPS);
            const float o0 = bflo(og[e].x), o1 = bfhi(og[e].x), o2 = bflo(og[e].y), o3 = bfhi(og[e].y);
            const float y0 = h0 * rn * hg.x / (1.f + __expf(-o0)), y1 = h1 * rn * hg.y / (1.f + __expf(-o1)), y2 = h2 * rn * hg.z / (1.f + __expf(-o2)), y3 = h3 * rn * hg.w / (1.f + __expf(-o3));
            v2u ov; ov.x = cvtpk(y0, y1); ov.y = cvtpk(y2, y3);
            *(GAS v2u*)(F.O + (mb + t0 + l) * DM + h * MDV + 4 * lane) = ov; }
        if (it + F.G < NITEMS) { B_WRITE(); c_sint = s_sint; c_nrm = s_nrm; if (it + 2 * F.G < NITEMS) B_LOAD(it + 2 * F.G); }
        MBAR();
    }
#undef B_LOAD
#undef B_WRITE
}
#undef SW16
#undef SBAR
#undef MBAR
namespace mlh {
constexpr int WREG = 12288, KIMG = 0, VIMG = 8192, XB0 = 8 * WREG, XBSZ = 16384 + 1024, WKO = XB0 + 2 * XBSZ, CHO = WKO + 8192, FLAGO = CHO + 1024, LDS_END = FLAGO + 64;
constexpr int TB = 0, TU = 8192, TM = 16384;
__device__ __forceinline__ int kh_st(int k, int c) { const int kk = (k & ~0xC) | ((k & 4) << 1) | ((k & 8) >> 1); return ((kk >> 3) * 2 + (c >> 5)) * 512 + ((kk & 7) * 32 + (c & 31)) * 2; }
__device__ __forceinline__ int vs_st(int k, int c) { const int kk = (k & ~0xC) | ((k & 4) << 1) | ((k & 8) >> 1); return (kk >> 3) * 512 + ((kk & 7) * 32 + c) * 2; }
using att::tr_read; using att::v_rd_base; using att::cvtpk; using ml::pk88; using ml::pack_acc8; using ml::wmul8; using ml::scan_sum64; using ml::scan_max64;
template <bool WITHN> __device__ __forceinline__ void dhalf(f32x16& D0, f32x16& D1, float& n0, float& n1, int vbK, const bf16x8 (&vB)[4]) {
    const bf16x8 ones = (bf16x8){0x3f80, 0x3f80, 0x3f80, 0x3f80, 0x3f80, 0x3f80, 0x3f80, 0x3f80};
    f32x16 N0, N1;
    if (WITHN) {
#pragma unroll
        for (int r = 0; r < 16; ++r) { N0[r] = 0.f; N1[r] = 0.f; } }
#define DH_STEP(KS) do { const s16x4 l0 = tr_read<0 * 512 + KS * 2048>(vbK), h0 = tr_read<0 * 512 + KS * 2048 + 1024>(vbK), l1 = tr_read<1 * 512 + KS * 2048>(vbK), h1 = tr_read<1 * 512 + KS * 2048 + 1024>(vbK); \
        asm volatile("s_waitcnt lgkmcnt(0)" ::: "memory"); __builtin_amdgcn_sched_barrier(0);                                                                           \
        const bf16x8 a0 = pk88(l0, h0), a1 = pk88(l1, h1);                                                                                                               \
        D0 = __builtin_amdgcn_mfma_f32_32x32x16_bf16(a0, vB[KS], D0, 0, 0, 0); D1 = __builtin_amdgcn_mfma_f32_32x32x16_bf16(a1, vB[KS], D1, 0, 0, 0);                      \
        if (WITHN) { N0 = __builtin_amdgcn_mfma_f32_32x32x16_bf16(ones, a0, N0, 0, 0, 0); N1 = __builtin_amdgcn_mfma_f32_32x32x16_bf16(ones, a1, N1, 0, 0, 0); } } while (0)
    DH_STEP(0); DH_STEP(1); DH_STEP(2); DH_STEP(3);
#undef DH_STEP
    if (WITHN) { n0 = N0[0]; n1 = N1[0]; }
}
}
template <bool WITHN> __device__ __forceinline__ void p10_chain(Frame& F, int bh, int js) {
    using namespace mlh;
    constexpr int NC = T / 64;
    LAS unsigned char* L = F.lds + RING_OFF;
    const int b = bh / MH, h = bh % MH, w = F.wave, lane = F.lane;
    const size_t mb = (size_t)b * T;
    LAS unsigned char* R = L + w * WREG;
    const LAS float* WKL = (const LAS float*)(L + WKO); const LAS float* CH = (const LAS float*)(L + CHO);
    volatile LAS unsigned* flag = (volatile LAS unsigned*)(L + FLAGO);
    const int lbase = (int)(uintptr_t)R;
    const int vbK = lbase + KIMG + v_rd_base(lane), vbV = lbase + VIMG + v_rd_base(lane);
    v4u ka[8], va[4];
    const int krow = lane >> 3, kc16 = lane & 7, vrow = lane >> 2, vc16 = lane & 3;
#define H_LOADK(cc, hh) do { const bf16* kp = F.PROJ + (mb + (size_t)(cc) * 64 + krow) * ML_N + C_MK + h * MDK + (hh) * 64 + 8 * kc16;                      \
        _Pragma("unroll") for (int e = 0; e < 8; ++e) ka[e] = *(const GAS v4u*)(kp + (size_t)(8 * e) * ML_N); } while (0)
#define H_LOADV(cc) do { const bf16* vp = F.PROJ + (mb + (size_t)(cc) * 64 + vrow) * ML_N + C_MV + h * MDV + js * 32 + 8 * vc16;                           \
        _Pragma("unroll") for (int e = 0; e < 4; ++e) va[e] = *(const GAS v4u*)(vp + (size_t)(16 * e) * ML_N); } while (0)
#define H_WRITEK(cc) do { _Pragma("unroll") for (int e = 0; e < 8; ++e) { const int s = 8 * e + krow; *(LAS v4u*)(R + KIMG + kh_st(s, 8 * kc16)) = wmul8(ka[e], WKL[(cc) * 64 + s]); } } while (0)
#define H_WRITEV() do { _Pragma("unroll") for (int e = 0; e < 4; ++e) { const int s = 16 * e + vrow; *(LAS v4u*)(R + VIMG + vs_st(s, 8 * vc16)) = va[e]; } } while (0)
    f32x16 D[4]; float dn[4] = {0.f, 0.f, 0.f, 0.f};
    if (w < NC - 1) { H_LOADK(w, 0); H_LOADV(w); }
#pragma unroll 1
    for (int r = 0; r < NC / 8; ++r) { const int c = w + 8 * r;
        if (c < NC - 1) {
#pragma unroll
            for (int i = 0; i < 4; ++i)
#pragma unroll
                for (int q = 0; q < 16; ++q) D[i][q] = 0.f;
            H_WRITEK(c); H_WRITEV(); H_LOADK(c, 1);
            bf16x8 vB[4];
            { const s16x4 l0 = tr_read<0 * 1024>(vbV), h0 = tr_read<0 * 1024 + 512>(vbV), l1 = tr_read<1 * 1024>(vbV), h1 = tr_read<1 * 1024 + 512>(vbV);
              const s16x4 l2 = tr_read<2 * 1024>(vbV), h2 = tr_read<2 * 1024 + 512>(vbV), l3 = tr_read<3 * 1024>(vbV), h3 = tr_read<3 * 1024 + 512>(vbV);
              asm volatile("s_waitcnt lgkmcnt(0)" ::: "memory"); __builtin_amdgcn_sched_barrier(0);
              vB[0] = pk88(l0, h0); vB[1] = pk88(l1, h1); vB[2] = pk88(l2, h2); vB[3] = pk88(l3, h3); }
            dhalf<WITHN>(D[0], D[1], dn[0], dn[1], vbK, vB);
            H_WRITEK(c);
            if (c + 8 < NC - 1) { H_LOADK(c + 8, 0); }
            dhalf<WITHN>(D[2], D[3], dn[2], dn[3], vbK, vB);
            if (c + 8 < NC - 1) { H_LOADV(c + 8); }
        }
        f32x16 X[4]; float nn[4] = {0.f, 0.f, 0.f, 0.f};
        if (c > 0) { while (*flag < (unsigned)c) __builtin_amdgcn_s_sleep(1);
            asm volatile("" ::: "memory");
            const LAS unsigned char* xb = L + XB0 + (c & 1) * XBSZ;
#pragma unroll
            for (int i = 0; i < 4; ++i)
#pragma unroll
                for (int q = 0; q < 4; ++q) { const f32x4 v = *(const LAS f32x4*)(xb + ((i * 4 + q) * 64 + lane) * 16); X[i][4 * q] = v.x; X[i][4 * q + 1] = v.y; X[i][4 * q + 2] = v.z; X[i][4 * q + 3] = v.w; }
            if (WITHN) {
#pragma unroll
                for (int i = 0; i < 4; ++i) nn[i] = *(const LAS float*)(xb + 16384 + (i * 32 + (lane & 31)) * 4); }
        } else {
#pragma unroll
            for (int i = 0; i < 4; ++i)
#pragma unroll
                for (int q = 0; q < 16; ++q) X[i][q] = 0.f;
        }
        { bf16* st = F.ST + ((((size_t)bh * NC + c) * 8 + js) * 8) * 512 + lane * 8;
#pragma unroll
          for (int i = 0; i < 4; ++i) { *(GAS bf16x8*)(st + (i * 2 + 0) * 512) = pack_acc8(X[i], 0); *(GAS bf16x8*)(st + (i * 2 + 1) * 512) = pack_acc8(X[i], 8); }
          if (WITHN && lane < 32) {
#pragma unroll
              for (int i = 0; i < 4; ++i) F.NST[((size_t)bh * NC + c) * 128 + i * 32 + lane] = nn[i]; } }
        if (c < NC - 1) { const float s_old = CH[96 + c]; LAS unsigned char* xo = L + XB0 + ((c + 1) & 1) * XBSZ;
#pragma unroll
            for (int i = 0; i < 4; ++i)
#pragma unroll
                for (int q = 0; q < 4; ++q) { f32x4 v; v.x = s_old * X[i][4 * q] + D[i][4 * q]; v.y = s_old * X[i][4 * q + 1] + D[i][4 * q + 1]; v.z = s_old * X[i][4 * q + 2] + D[i][4 * q + 2]; v.w = s_old * X[i][4 * q + 3] + D[i][4 * q + 3];
                    *(LAS f32x4*)(xo + ((i * 4 + q) * 64 + lane) * 16) = v; }
            if (WITHN && lane < 32) {
#pragma unroll
                for (int i = 0; i < 4; ++i) *(LAS float*)(xo + 16384 + (i * 32 + lane) * 4) = s_old * nn[i] + dn[i]; }
            asm volatile("s_waitcnt lgkmcnt(0)" ::: "memory");
            if (lane == 0) *flag = (unsigned)(c + 1);
        }
    }
#undef H_LOADK
#undef H_LOADV
#undef H_WRITEK
#undef H_WRITEV
}
__device__ __forceinline__ void p10_state_chain(Frame& F) {
    using namespace mlh;
    constexpr int NC = T / 64;
    static_assert(mlh::LDS_END <= RING_BYTES, "mLSTM chain LDS");
    LAS unsigned char* L = F.lds + RING_OFF;
    for (int it = F.vcu; it < BATCH * MH * 8; it += F.G) { const int bh = it >> 3, js = it & 7, w = F.wave, tid = F.tid;
        LAS float* WKL = (LAS float*)(L + WKO); LAS float* BL = (LAS float*)(L + TB); LAS float* UL = (LAS float*)(L + TU); LAS float* MLs = (LAS float*)(L + TM); LAS float* CH = (LAS float*)(L + CHO);
        const float* igp = F.IG + (size_t)bh * T; const float* lfp = F.LF + (size_t)bh * T;
        if (tid == 0) *(LAS unsigned*)(L + FLAGO) = 0u;
#pragma unroll
        for (int cc = 0; cc < 4; ++cc) { const int c = 4 * w + cc, t = c * 64 + F.lane; const float ig = igp[t], lf = lfp[t];
            const float bb = scan_sum64(lf), u = ig - bb, Mx = scan_max64(u);
            BL[t] = bb; UL[t] = u; MLs[t] = Mx; if (F.lane == 63) { CH[c] = bb; CH[32 + c] = Mx; } }
        LDS_WAIT(); __syncthreads();
        if (tid == 0) { float m = 0.f; for (int c = 0; c < NC; ++c) { const float mm63 = fmaxf(m, CH[32 + c]); CH[64 + c] = m; CH[96 + c] = __expf(m - mm63); CH[128 + c] = mm63; m = CH[c] + mm63; } }
        LDS_WAIT(); __syncthreads();
        { float* scal = F.SCAL + (size_t)bh * 4 * T;
          for (int t = tid; t < T; t += NTHR) { const int c = t >> 6; const float mst = CH[64 + c], mm = fmaxf(mst, MLs[t]), u = UL[t];
              if (js == 0) { scal[t] = u; scal[T + t] = mm; scal[2 * T + t] = __expf(mst - mm); scal[3 * T + t] = __expf(-(BL[t] + mm)); }
              WKL[t] = __expf(u - CH[128 + c]); } }
        LDS_WAIT(); __syncthreads();
        if (js == 0) p10_chain<true>(F, bh, js); else p10_chain<false>(F, bh, js);
        LDS_WAIT(); __syncthreads();
    }
}
#if ORA_IDX
__global__ __launch_bounds__(256) void ora_indexer(const bf16* QI, const bf16* KI, const float* WI, u64* MASK) {
    __shared__ float qi[1024]; __shared__ float sc[2048]; __shared__ float wi[16]; __shared__ unsigned cnt;
    const int m = blockIdx.x, b = m / T, t = m % T, tid = threadIdx.x;
    for (int i = tid; i < 1024; i += 256) qi[i] = bf2f(QI[(size_t)m * 1024 + i]);
    if (tid < 16) wi[tid] = WI[(size_t)m * 16 + tid];
    __syncthreads();
    for (int s = tid; s < T; s += 256) { float v = -__builtin_inff();
        if (s <= t) { float kk[64]; const v4u* kp = (const v4u*)(KI + (size_t)(b * T + s) * 64);
#pragma unroll
            for (int j = 0; j < 8; ++j) unpack8(kp[j], kk + 8 * j);
            v = 0.f;
            for (int h = 0; h < 16; ++h) { float d = 0.f;
#pragma unroll
                for (int e = 0; e < 64; ++e) d += qi[h * 64 + e] * kk[e];
                v += wi[h] * fmaxf(d, 0.f); } }
        sc[s] = v; }
    __syncthreads();
    unsigned k[8];
#pragma unroll
    for (int j = 0; j < 8; ++j) k[j] = fkey(sc[tid + 256 * j]);
    unsigned P = 0;
    for (int bit = 31; bit >= 0; --bit) { const unsigned cand = P | (1u << bit); unsigned c = 0;
#pragma unroll
        for (int j = 0; j < 8; ++j) c += (k[j] >= cand) ? 1u : 0u;
        if (tid == 0) cnt = 0; __syncthreads(); atomicAdd(&cnt, c); __syncthreads(); if (cnt >= (unsigned)TOPK) P = cand; __syncthreads(); }
    if (tid < 32) { u64 w = 0; for (int e = 0; e < 64; ++e) { const int s = 64 * tid + e; if (s <= t && fkey(sc[s]) >= P) w |= (1ull << e); } MASK[(size_t)m * 32 + tid] = w; }
}
#endif
#if ORA_ATT
__global__ __launch_bounds__(128) void ora_attn(const bf16* Q, const bf16* K, const bf16* V, const u64* MASK, bf16* O) {
    __shared__ float q[4][128]; __shared__ int idx[320]; __shared__ float p[4][320]; __shared__ int cnts[128]; __shared__ int total; __shared__ float linv[4];
    const int m = blockIdx.x >> 2, g = blockIdx.x & 3, b = m / T, tid = threadIdx.x;
    for (int r = 0; r < 4; ++r) q[r][tid] = bf2f(Q[(size_t)m * DM + (g * 4 + r) * HD + tid]);
    const unsigned bits = (unsigned)(MASK[(size_t)m * 32 + (tid >> 2)] >> (16 * (tid & 3))) & 0xffffu;
    cnts[tid] = __builtin_popcount(bits); __syncthreads();
    if (tid == 0) { int a = 0; for (int i = 0; i < 128; ++i) { const int c = cnts[i]; cnts[i] = a; a += c; } total = a; }
    __syncthreads();
    { int o = cnts[tid]; for (int e = 0; e < 16; ++e) if ((bits >> e) & 1u) { if (o < 320) idx[o] = 16 * tid + e; ++o; } }
    __syncthreads();
    const int n = total < 320 ? total : 320;
    for (int j = tid; j < n; j += 128) { const bf16* kr = K + (size_t)(b * T + idx[j]) * 512 + g * HD; float d0 = 0, d1 = 0, d2 = 0, d3 = 0;
        for (int e = 0; e < 128; ++e) { const float kv = bf2f(kr[e]); d0 += q[0][e] * kv; d1 += q[1][e] * kv; d2 += q[2][e] * kv; d3 += q[3][e] * kv; }
        const float sc = 0.08838834764831845f; p[0][j] = d0 * sc; p[1][j] = d1 * sc; p[2][j] = d2 * sc; p[3][j] = d3 * sc; }
    __syncthreads();
    if (tid < 4) { float mx = -__builtin_inff(); for (int j = 0; j < n; ++j) mx = fmaxf(mx, p[tid][j]); float s = 0.f; for (int j = 0; j < n; ++j) { const float e = expf(p[tid][j] - mx); p[tid][j] = e; s += e; } linv[tid] = 1.f / s; }
    __syncthreads();
    float o0 = 0, o1 = 0, o2 = 0, o3 = 0;
    for (int j = 0; j < n; ++j) { const float v = bf2f(V[(size_t)(b * T + idx[j]) * 512 + g * HD + tid]); o0 += p[0][j] * v; o1 += p[1][j] * v; o2 += p[2][j] * v; o3 += p[3][j] * v; }
    bf16* op = O + (size_t)m * DM + g * 4 * HD + tid;
    op[0] = (bf16)f2bf(o0 * linv[0]); op[HD] = (bf16)f2bf(o1 * linv[1]); op[2 * HD] = (bf16)f2bf(o2 * linv[2]); op[3 * HD] = (bf16)f2bf(o3 * linv[3]);
}
#endif
#if ORA_ML
__global__ __launch_bounds__(256) void ora_mlstm(const bf16* PROJ, const float* IG, const float* LF, const float* hgain, bf16* A2) {
    __shared__ float qs[128], ks[128], pr[128], red[4];
    const int b = blockIdx.x / MH, h = blockIdx.x % MH, e = threadIdx.x;
    float C[128]; float nd = 0.f, mst = 0.f;
#pragma unroll
    for (int d = 0; d < 128; ++d) C[d] = 0.f;
    const float hg = hgain[e];
    for (int t = 0; t < T; ++t) { const size_t m = (size_t)b * T + t; const bf16* row = PROJ + m * ML_N;
        const float ig = IG[(size_t)(b * MH + h) * T + t], lf = LF[(size_t)(b * MH + h) * T + t];
        const float mn = fmaxf(lf + mst, ig), fo = expf(lf + mst - mn), io = expf(ig - mn);
        if (e < 128) { const float qv = bf2f(row[C_MQ + h * MDK + e]), kv = bf2f(row[C_MK + h * MDK + e]); nd = fo * nd + io * kv; qs[e] = qv; ks[e] = kv; pr[e] = qv * nd; }
        __syncthreads();
        const float v = bf2f(row[C_MV + h * MDV + e]); float num = 0.f, den = 0.f;
#pragma unroll
        for (int d = 0; d < 128; ++d) { C[d] = fo * C[d] + io * ks[d] * v; num += qs[d] * C[d]; den += pr[d]; }
        const float hv = num / fmaxf(fabsf(den), expf(-mn));
        float s2 = wave_sum(hv * hv); if ((e & 63) == 0) red[e >> 6] = s2;
        __syncthreads();
        const float ssq = (red[0] + red[1]) + (red[2] + red[3]); const float rn = __builtin_amdgcn_rsqf(ssq * (1.f / MDV) + EPS);
        const float og = bf2f(row[C_MO + h * MDV + e]); const float sg = 1.f / (1.f + expf(-og));
        A2[m * DM + h * MDV + e] = (bf16)f2bf(sg * hv * rn * hg);
        mst = mn;
        __syncthreads();
    }
}
#endif
__global__ void __launch_bounds__(NTHR, 2) mk_fwd(Args args) {
    extern __shared__ __attribute__((aligned(16))) unsigned char lds[];
    Frame F;
    F.lds = (LAS unsigned char*)lds;
    F.MISC = (volatile LAS unsigned*)(F.lds + MISC_OFF);
    F.tid = threadIdx.x; F.lane = F.tid & 63; F.wave = __builtin_amdgcn_readfirstlane(F.tid >> 6);
    F.G = gridDim.x; { const int bx = blockIdx.x; F.vcu = (F.G % 8 == 0) ? (bx % 8) * (F.G / 8) + bx / 8 : bx; }
    unsigned char* ws = args.ws;
    F.ctl = (gu32*)(ws + WS_CTL);
    F.x = args.in[0]; F.norm_mix = args.in[1]; F.norm_ffn = args.in[2]; F.att_w_in = args.in[3]; F.q_gain = args.in[4]; F.k_gain = args.in[5]; F.att_w_out = args.in[6];
    F.ml_w_in = args.in[7]; F.b_gate = args.in[8]; F.h_gain = args.in[9]; F.ml_w_out = args.in[10]; F.w_up = args.in[11]; F.w_dn = args.in[12]; F.out = args.out;
    F.WinT = (bf16*)(ws + WS_WIN); F.WsmT = (bf16*)(ws + WS_WSM); F.WoT = (bf16*)(ws + WS_WO); F.WmlT = (bf16*)(ws + WS_WML); F.WgT = (bf16*)(ws + WS_WG); F.WmoT = (bf16*)(ws + WS_WMO);
    F.WupT0 = (bf16*)(ws + WS_WUP0); F.WupT1 = (bf16*)(ws + WS_WUP1); F.WdnT0 = (bf16*)(ws + WS_WDN0); F.WdnT1 = (bf16*)(ws + WS_WDN1);
    F.XB = (bf16*)(ws + WS_XB); F.PROJ = (bf16*)(ws + WS_PROJ); F.Q = (bf16*)(ws + WS_Q); F.K = (bf16*)(ws + WS_K); F.V = (bf16*)(ws + WS_V); F.QI = (bf16*)(ws + WS_QI); F.KI = (bf16*)(ws + WS_KI);
    F.O = (bf16*)(ws + WS_O); F.H = (bf16*)(ws + WS_H); F.WI = (float*)(ws + WS_WI); F.IG = (float*)(ws + WS_GATE); F.LF = (float*)(ws + WS_GATE + 512 * 1024); F.SC = (float*)(ws + WS_SC); F.ST = (bf16*)(ws + WS_SC); F.NST = (float*)(ws + WS_ML); F.SCAL = (float*)(ws + WS_ML + MiB);
    F.ROPE_A = (f32x2*)(ws + WS_ROPE); F.ROPE_I = (f32x2*)(ws + WS_ROPE + 512 * 1024); F.MASK = (u64*)(ws + WS_MASK);
    F.ss0 = (float*)(ws + WS_CTL) + CW_SS; F.ss1 = F.ss0 + M; F.ss2 = F.ss1 + M; F.ss3 = F.ss2 + M;
    for (int u = F.tid; u < (LDS_BYTES - LDSCTL_OFF) / 4; u += NTHR) ((LAS unsigned*)(F.lds + LDSCTL_OFF))[u] = 0u;
    __syncthreads();
    XcdBarrier bar; bar.bar = (unsigned*)(F.ctl + CW_BAR); bar.x = 0; bar.st = nullptr;
    if (!MK_MULTI) bar = xcd_barrier_post((unsigned*)(F.ctl + CW_BAR), F.MISC + 8);
    const int lo = args.ph_lo, hi = args.ph_hi;
#ifdef ONLY_PHASE
#define IN(k) ((k) == ONLY_PHASE && lo <= (k) && (k) < hi)
#else
#define IN(k) (lo <= (k) && (k) < hi)
#endif
#define SEAM(k) do { if (IN(k) && IN((k) + 1)) xcd_barrier(bar); } while (0)
#ifndef PROBE_DBL
#define PROBE_DBL (-1)
#endif
#define REPS(k) for (int rep_ = (F.tid = opaque_tid(), F.lane = F.tid & 63, 0); rep_ < ((k) == PROBE_DBL ? 2 : 1); ++rep_, ((k) == PROBE_DBL && rep_ == 1 ? xcd_barrier(bar) : (void)0))
#define DUMMY(k) ((k) == PROBE_DBL && rep_ == 0)
    float* const dummy_out = (float*)(ws + WS_SC);
    if (IN(0)) REPS(0) { p0_prologue(F); } SEAM(0);
    if (IN(1)) REPS(1) { pg8::Gemm g{F.XB, F.WinT, M, ATT_N, DM}; pg8::StaticOrder S; S.init(M, ATT_N, F.G, (int)blockIdx.x);
        pg8::EpiScale<0> E{F.PROJ, ATT_N, F.ss0, 1.f / DM, EPS};
        pg8::gemm_phase<pg8::EpiScale<0>, pg8::StaticOrder, PG8_ALIGN, PG8_SP2>(F.lds + RING_OFF, g, S, E);
        skinny_att(F);
#ifdef PROBE_SK
        xcd_barrier(bar); skinny_att(F);
#endif
        } SEAM(1);
#if IDX_FUSED
    if (IN(3)) REPS(3) {
#if !ORA_IDX
        p3_fused(F);
#endif
    } SEAM(3);
#else
    if (IN(3)) REPS(3) {
#if !ORA_IDX
        p3a_scores(F);
#ifdef PROBE_P3ABL
        xcd_barrier(bar); p3a_scores<PROBE_P3ABL>(F);
#endif
#endif
    } SEAM(3);
    if (IN(4)) REPS(4) {
#if !ORA_IDX
        p3b_select(F);
#endif
    } SEAM(4);
#endif
#ifdef PROBE_BAR
    if (IN(5)) { for (int q = 0; q < 10; ++q) xcd_barrier(bar); }
#endif
    if (IN(5)) REPS(5) {
#if !ORA_ATT
        p4_attention(F, (char*)lds + RING_OFF);
#endif
    } SEAM(5);
    if (IN(6)) REPS(6) { pg8::Gemm g{F.O, F.WoT, M, DM, DM}; pg8::StaticOrder S; S.init(M, DM, F.G, (int)blockIdx.x);
        pg8::EpiRes E{F.XB, DUMMY(6) ? (bf16*)dummy_out : F.XB, nullptr, DUMMY(6) ? F.ss0 + 4 * M : F.ss1, DM};
        pg8::gemm_phase<pg8::EpiRes, pg8::StaticOrder, PG8_ALIGN, PG8_SP2>(F.lds + RING_OFF, g, S, E); } SEAM(6);
#ifdef PROBE_NULLEPI
    if (IN(PROBE_NULLEPI)) { xcd_barrier(bar);
        if (PROBE_NULLEPI == 7) { pg8::Gemm g{F.XB, F.WupT0, M, FF, DM}; pg8::StaticOrder S; S.init(M, FF, F.G, (int)blockIdx.x); pg8::EpiNull E{}; pg8::gemm_phase<pg8::EpiNull, pg8::StaticOrder, PG8_ALIGN, PG8_SP2>(F.lds + RING_OFF, g, S, E); }
        if (PROBE_NULLEPI == 8) { pg8::Gemm g{F.H, F.WdnT0, M, DM, FF}; pg8::StaticOrder S; S.init(M, DM, F.G, (int)blockIdx.x); pg8::EpiNull E{}; pg8::gemm_phase<pg8::EpiNull, pg8::StaticOrder, PG8_ALIGN, PG8_SP2>(F.lds + RING_OFF, g, S, E); }
        xcd_barrier(bar); }
#endif
    if (IN(7)) REPS(7) { pg8::Gemm g{F.XB, F.WupT0, M, FF, DM}; pg8::StaticOrder S; S.init(M, FF, F.G, (int)blockIdx.x);
        pg8::EpiScale<1> E{F.H, FF, F.ss1, 1.f / DM, EPS};
        pg8::gemm_phase<pg8::EpiScale<1>, pg8::StaticOrder, PG8_ALIGN, PG8_SP2>(F.lds + RING_OFF, g, S, E); } SEAM(7);
    if (IN(8)) REPS(8) { pg8::Gemm g{F.H, F.WdnT0, M, DM, FF}; pg8::StaticOrder S; S.init(M, DM, F.G, (int)blockIdx.x);
        pg8::EpiRes E{F.XB, DUMMY(8) ? (bf16*)dummy_out : F.XB, nullptr, DUMMY(8) ? F.ss0 + 4 * M : F.ss2, DM};
        pg8::gemm_phase<pg8::EpiRes, pg8::StaticOrder, PG8_ALIGN, PG8_SP2>(F.lds + RING_OFF, g, S, E); } SEAM(8);
    if (IN(9)) REPS(9) { pg8::Gemm g{F.XB, F.WmlT, M, ML_N, DM}; pg8::StaticOrder S; S.init(M, ML_N, F.G, (int)blockIdx.x);
        pg8::EpiScale<0> E{F.PROJ, ML_N, F.ss2, 1.f / DM, EPS};
        pg8::gemm_phase<pg8::EpiScale<0>, pg8::StaticOrder, PG8_ALIGN, PG8_SP2>(F.lds + RING_OFF, g, S, E);
        skinny_gates(F); } SEAM(9);
    if (IN(10)) REPS(10) {
#if !ORA_ML
#if ML_CHAIN
        p10_state_chain(F);
#else
        p9a_state<0>(F);
#endif
#ifdef PROBE_SUB
        xcd_barrier(bar); p9a_state<PROBE_SUB>(F);
#endif
#endif
    } SEAM(10);
    if (IN(11)) REPS(11) {
#if !ORA_ML
        p9b_output(F);
#endif
    } SEAM(11);
    if (IN(12)) REPS(12) { pg8::Gemm g{F.O, F.WmoT, M, DM, DM}; pg8::StaticOrder S; S.init(M, DM, F.G, (int)blockIdx.x);
        pg8::EpiRes E{F.XB, DUMMY(12) ? (bf16*)dummy_out : F.XB, nullptr, DUMMY(12) ? F.ss0 + 4 * M : F.ss3, DM};
        pg8::gemm_phase<pg8::EpiRes, pg8::StaticOrder, PG8_ALIGN, PG8_SP2>(F.lds + RING_OFF, g, S, E); } SEAM(12);
    if (IN(13)) REPS(13) { pg8::Gemm g{F.XB, F.WupT1, M, FF, DM}; pg8::StaticOrder S; S.init(M, FF, F.G, (int)blockIdx.x);
        pg8::EpiScale<1> E{F.H, FF, F.ss3, 1.f / DM, EPS};
        pg8::gemm_phase<pg8::EpiScale<1>, pg8::StaticOrder, PG8_ALIGN, PG8_SP2>(F.lds + RING_OFF, g, S, E); } SEAM(13);
    if (IN(14)) REPS(14) { pg8::Gemm g{F.H, F.WdnT1, M, DM, FF}; pg8::StaticOrder S; S.init(M, DM, F.G, (int)blockIdx.x);
        pg8::EpiRes E{F.XB, nullptr, DUMMY(14) ? dummy_out : F.out, nullptr, DM};
        pg8::gemm_phase<pg8::EpiRes, pg8::StaticOrder, PG8_ALIGN, PG8_SP2>(F.lds + RING_OFF, g, S, E); }
#undef IN
#undef SEAM
}

extern "C" void kernel_launch(void* const* d_in, const int* in_sizes, int n_in, void* d_out, int out_size, void* d_ws, size_t ws_size, hipStream_t stream) {
    static int grid = 0;
    if (grid == 0) {
        if (n_in != 13 || in_sizes[0] != M * DM || out_size != M * DM || ws_size < WS_END) { fprintf(stderr, "kernel_launch: shape/workspace mismatch (n_in %d, in0 %d, out %d, ws %zu, need %zu)\n", n_in, n_in > 0 ? in_sizes[0] : -1, out_size, ws_size, (size_t)WS_END); grid = -1; return; }
        int dev = 0, cus = 0, per_cu = 0;
        if (hipGetDevice(&dev) != hipSuccess || hipDeviceGetAttribute(&cus, hipDeviceAttributeMultiprocessorCount, dev) != hipSuccess) { grid = -1; return; }
        if (hipFuncSetAttribute((const void*)mk_fwd, hipFuncAttributeMaxDynamicSharedMemorySize, LDS_BYTES) != hipSuccess) { fprintf(stderr, "kernel_launch: hipFuncSetAttribute failed\n"); grid = -1; return; }
        if (hipOccupancyMaxActiveBlocksPerMultiprocessor(&per_cu, (const void*)mk_fwd, NTHR, LDS_BYTES) != hipSuccess || per_cu < 1) fprintf(stderr, "kernel_launch: occupancy query reports %d blocks per CU\n", per_cu);
        (void)hipGetLastError();
        grid = cus;
    }
    if (grid < 0) return;
    if (hipMemsetAsync((char*)d_ws + WS_CTL, 0, CTL_ZERO_BYTES, stream) != hipSuccess) { fprintf(stderr, "kernel_launch: memset failed\n"); return; }
    Args a{};
    for (int i = 0; i < 13; ++i) a.in[i] = (const float*)d_in[i];
    a.out = (float*)d_out; a.ws = (unsigned char*)d_ws;
#if MK_MULTI
    unsigned char* ws = (unsigned char*)d_ws;
    for (int p = 0; p < N_PHASES; ++p) {
        if (p == 4 && ORA_IDX) continue;
        if (p == 3 && ORA_IDX) {
#if ORA_IDX
            hipLaunchKernelGGL(ora_indexer, dim3(M), dim3(256), 0, stream, (const bf16*)(ws + WS_QI), (const bf16*)(ws + WS_KI), (const float*)(ws + WS_WI), (u64*)(ws + WS_MASK));
#endif
            continue; }
        if (p == 5 && ORA_ATT) {
#if ORA_ATT
            hipLaunchKernelGGL(ora_attn, dim3(M * 4), dim3(128), 0, stream, (const bf16*)(ws + WS_Q), (const bf16*)(ws + WS_K), (const bf16*)(ws + WS_V), (const u64*)(ws + WS_MASK), (bf16*)(ws + WS_O));
#endif
            continue; }
        if (p == 11 && ORA_ML) continue;
        if (p == 10 && ORA_ML) {
#if ORA_ML
            hipLaunchKernelGGL(ora_mlstm, dim3(BATCH * MH), dim3(256), 0, stream, (const bf16*)(ws + WS_PROJ), (const float*)(ws + WS_GATE), (const float*)(ws + WS_GATE + 512 * 1024), (const float*)d_in[9], (bf16*)(ws + WS_O));
#endif
            continue; }
        a.ph_lo = p; a.ph_hi = p + 1; a.li = p;
        hipLaunchKernelGGL(mk_fwd, dim3(grid), dim3(NTHR), LDS_BYTES, stream, a);
    }
#else
    a.ph_lo = 0; a.ph_hi = N_PHASES; a.li = 0;
    hipLaunchKernelGGL(mk_fwd, dim3(grid), dim3(NTHR), LDS_BYTES, stream, a);
#endif
    const hipError_t le = hipPeekAtLastError();
    if (le != hipSuccess) fprintf(stderr, "kernel_launch: launch failed: %s\n", hipGetErrorName(le));
}
```

```cpp
#ifndef MK_MULTI
#define MK_MULTI 0
#endif
#ifndef ORA_IDX
#define ORA_IDX 0
#endif
#ifndef ORA_ATT
#define ORA_ATT 0
#endif
#ifndef ORA_ML
#define ORA_ML 0
#endif
#ifndef PROBE_DBL
#define PROBE_DBL (-1)
#endif
#include <hip/hip_runtime.h>
#include <cstdio>
#include <cstdint>
#include <cmath>
__device__ __forceinline__ int opaque_tid() { int t = threadIdx.x; asm volatile("" : "+v"(t)); return t; }
namespace pg8 {
#define PG8_LAS __attribute__((address_space(3)))
typedef unsigned short bf16_t;
typedef short bf16x8 __attribute__((ext_vector_type(8)));
typedef float f32x4 __attribute__((ext_vector_type(4)));
typedef unsigned u32x4 __attribute__((ext_vector_type(4)));
constexpr int BM = 256, BK = 64, HALF = 128, HTB = HALF * BK * 2  , STAGE_BYTES = 8 * HTB, NXCD = 8, WGM = 2;

__host__ __device__ __forceinline__ int lds_byte(int r, int c) { const int st = (r >> 4) * 2 + (c >> 5), rr = r & 15, cc = c & 31, ob = rr * 64 + cc * 2; return st * 1024 + (ob ^ (((ob >> 9) & 1) << 5)); }
__host__ __device__ __forceinline__ void stage_rc(int b, int& R, int& C) { const int st = b / 1024, sb = b % 1024, swz = sb ^ (((sb >> 9) & 1) << 5); R = (st >> 1) * 16 + swz / 64; C = (st & 1) * 32 + (swz % 64) / 2; }
__host__ __device__ __forceinline__ int perm32(int rho) { const int n = rho >> 4, i = rho & 15; return 8 * (i >> 2) + 4 * n + (i & 3); }

struct Unit { int pm, pn; };
struct Gemm { const bf16_t* A; const bf16_t* Bt; int M, N, K; };

struct StaticOrder {
    int nM, nN, nwg, G, c;
    __host__ __device__ void init(int M, int N, int G_, int c_) { nM = M / BM; nN = N / BM; nwg = nM * nN; G = G_; c = c_; }
    __host__ __device__ bool next(int i, Unit& u) const {
        const long L = (long)i * G + c; if (L >= nwg) return false;
        int wgid = (int)L; { const int q = nwg / NXCD, r = nwg % NXCD, xcd = wgid % NXCD, off = wgid / NXCD; wgid = (xcd < r ? xcd * (q + 1) : r * (q + 1) + (xcd - r) * q) + off; }
        const int nig = WGM * nN, gid = wgid / nig, fm = gid * WGM, gsz = (nM - fm) < WGM ? (nM - fm) : WGM;
        u.pm = fm + ((wgid % nig) % gsz); u.pn = (wgid % nig) / gsz; return true;
    }
    __device__ __forceinline__ void a_ready(const Unit&) const {}
    __device__ __forceinline__ void done(const Unit&) const {}
};

__device__ __forceinline__ unsigned cvt_pk_bf16(float lo, float hi) { unsigned r; asm volatile("v_cvt_pk_bf16_f32 %0, %1, %2" : "=v"(r) : "v"(lo), "v"(hi)); return r; }
typedef float f32x2 __attribute__((ext_vector_type(2)));
typedef unsigned u32x2 __attribute__((ext_vector_type(2)));
template <int MODE> struct EpiScale {
    static constexpr bool PERM = true, AFTER_DRAIN = false;
    bf16_t* O; int ldc; const float* ss; float inv_n, eps;
    __device__ __forceinline__ void operator()(const f32x4 (&acc)[2][2][4][2], const Unit& u, int wr, int wc, int fr, int fq) const {
        const int row0 = u.pm * BM + wr * 64 + fr, col0 = u.pn * BM + wc * 64 + 8 * fq;
#pragma unroll
        for (int ai = 0; ai < 2; ++ai)
#pragma unroll
            for (int m = 0; m < 4; ++m) { const int row = row0 + ai * HALF + m * 16; const float rs = __builtin_amdgcn_rsqf(ss[row] * inv_n + eps); const float rs2 = rs * rs;
                bf16_t* rowp = O + (size_t)row * ldc + col0;
#pragma unroll
                for (int bj = 0; bj < 2; ++bj) { f32x4 v0 = acc[ai][bj][m][0], v1 = acc[ai][bj][m][1];
                    if (MODE == 0) { v0 = v0 * rs; v1 = v1 * rs; }
                    else { v0 = __builtin_elementwise_max(v0, (f32x4){0.f, 0.f, 0.f, 0.f}); v1 = __builtin_elementwise_max(v1, (f32x4){0.f, 0.f, 0.f, 0.f}); v0 = v0 * v0 * rs2; v1 = v1 * v1 * rs2; }
                    u32x4 w; w.x = cvt_pk_bf16(v0[0], v0[1]); w.y = cvt_pk_bf16(v0[2], v0[3]); w.z = cvt_pk_bf16(v1[0], v1[1]); w.w = cvt_pk_bf16(v1[2], v1[3]);
                    *(u32x4*)(rowp + bj * 32) = w; } }
    }
};
struct EpiRes {
    static constexpr bool PERM = true, AFTER_DRAIN = false;
    const bf16_t* base; bf16_t* hb; float* outf; float* ss; int ldc;
    __device__ __forceinline__ void operator()(const f32x4 (&acc)[2][2][4][2], const Unit& u, int wr, int wc, int fr, int fq) const {
        const int col0 = u.pn * BM + wc * 64 + 8 * fq;
#pragma unroll
        for (int ai = 0; ai < 2; ++ai)
#pragma unroll
            for (int m = 0; m < 4; ++m) { const int row = u.pm * BM + ai * HALF + wr * 64 + m * 16 + fr; const size_t off = (size_t)row * ldc + col0; float s = 0.f;
#pragma unroll
                for (int bj = 0; bj < 2; ++bj) { const u32x4 bw = *(const u32x4*)(base + off + bj * 32);
                    const f32x4 b0 = {__builtin_bit_cast(float, bw.x << 16), __builtin_bit_cast(float, bw.x & 0xffff0000u), __builtin_bit_cast(float, bw.y << 16), __builtin_bit_cast(float, bw.y & 0xffff0000u)};
                    const f32x4 b1 = {__builtin_bit_cast(float, bw.z << 16), __builtin_bit_cast(float, bw.z & 0xffff0000u), __builtin_bit_cast(float, bw.w << 16), __builtin_bit_cast(float, bw.w & 0xffff0000u)};
                    const f32x4 o0 = b0 + acc[ai][bj][m][0], o1 = b1 + acc[ai][bj][m][1];
                    if (outf) { *(f32x4*)(outf + off + bj * 32) = o0; *(f32x4*)(outf + off + bj * 32 + 4) = o1; }
                    else { u32x4 w; w.x = cvt_pk_bf16(o0[0], o0[1]); w.y = cvt_pk_bf16(o0[2], o0[3]); w.z = cvt_pk_bf16(o1[0], o1[1]); w.w = cvt_pk_bf16(o1[2], o1[3]); *(u32x4*)(hb + off + bj * 32) = w;
                        s += ((o0[0] * o0[0] + o0[1] * o0[1]) + (o0[2] * o0[2] + o0[3] * o0[3])) + ((o1[0] * o1[0] + o1[1] * o1[1]) + (o1[2] * o1[2] + o1[3] * o1[3])); } }
                if (!outf) { s += __shfl_xor(s, 16); s += __shfl_xor(s, 32); if (fq == 0) atomicAdd(ss + row, s); }
                asm volatile("" ::: "memory"); }
    }
};
struct EpiNull {
    static constexpr bool PERM = false, AFTER_DRAIN = false;
    __device__ __forceinline__ void operator()(const f32x4 (&acc)[2][2][4][2], const Unit&, int, int, int, int) const {
#pragma unroll
        for (int ai = 0; ai < 2; ++ai)
#pragma unroll
            for (int bj = 0; bj < 2; ++bj)
#pragma unroll
                for (int m = 0; m < 4; ++m)
#pragma unroll
                    for (int n = 0; n < 2; ++n) asm volatile("" :: "v"(acc[ai][bj][m][n]));
    }
};
template <class Epi, class Sched, bool ALIGN_EPI = false, bool SP2 = false>
__device__ __forceinline__ void gemm_phase(PG8_LAS unsigned char* lds, const Gemm g, const Sched& S, const Epi& E) {
    const int tid = opaque_tid(), wid = __builtin_amdgcn_readfirstlane(tid >> 6), lane = tid & 63, wr = wid >> 2, wc = wid & 3, fr = lane & 15, fq = lane >> 4;
    const int K = g.K, nt = K / BK;
    unsigned voffA[2], voffB[2];
#pragma unroll
    for (int i = 0; i < 2; ++i) { int R, C; stage_rc(tid * 16 + i * 8192, R, C); const int Rb = Epi::PERM ? (64 * (R >> 5) + perm32(R & 31)) : R;
        voffA[i] = (unsigned)(R * K + C) * 2u; voffB[i] = (unsigned)(Rb * K + C) * 2u; }
    const size_t kstep = (size_t)(BK * 2);
    const size_t hstep = (size_t)HALF * K * 2;
    const size_t hstepB = Epi::PERM ? (size_t)32 * K * 2 : hstep;
    const size_t tstep = 2 * hstep;
    const unsigned ldsw = (unsigned)wid * 1024u;
    const int aoff = lds_byte(wr * 64 + fr, fq * 8), boff = lds_byte(wc * 32 + fr, fq * 8);
#define PG8_SA(b, h) (((b) * 2 + (h)) * HTB)
#define PG8_SB(b, h) ((4 + (b) * 2 + (h)) * HTB)
#define PG8_STAGE(bufoff, gbase, voff) do { _Pragma("unroll") for (int _i = 0; _i < 2; ++_i) \
        __builtin_amdgcn_global_load_lds((const unsigned*)((const char*)(gbase) + (voff)[_i]), (PG8_LAS unsigned*)(lds + (bufoff) + ldsw + _i * 8192), 16, 0, 0); } while (0)
#define PG8_LDA(dst, b, h) do { _Pragma("unroll") for (int m = 0; m < 4; ++m) _Pragma("unroll") for (int k = 0; k < 2; ++k) dst[m][k] = *(const PG8_LAS bf16x8*)(lds + PG8_SA(b, h) + aoff + m * 2048 + k * 1024); } while (0)
#define PG8_LDB(dst, b, h) do { _Pragma("unroll") for (int n = 0; n < 2; ++n) _Pragma("unroll") for (int k = 0; k < 2; ++k) dst[n][k] = *(const PG8_LAS bf16x8*)(lds + PG8_SB(b, h) + boff + n * 2048 + k * 1024); } while (0)
#define PG8_MMA(ai, bj, At, Bt) do { __builtin_amdgcn_s_setprio(1); _Pragma("unroll") for (int m = 0; m < 4; ++m) _Pragma("unroll") for (int n = 0; n < 2; ++n) _Pragma("unroll") for (int k = 0; k < 2; ++k) \
        acc[ai][bj][m][n] = __builtin_amdgcn_mfma_f32_16x16x32_bf16(Bt[n][k], At[m][k], acc[ai][bj][m][n], 0, 0, 0); __builtin_amdgcn_s_setprio(0); } while (0)
#define PG8_WAIT_V(n) asm volatile("s_waitcnt vmcnt(" #n ")" ::: "memory")
#define PG8_WAIT_L(n) asm volatile("s_waitcnt lgkmcnt(" #n ")" ::: "memory")
#define PG8_BAR __builtin_amdgcn_s_barrier()
#define PG8_SCHED __builtin_amdgcn_sched_barrier(0)
    Unit cur, nxt; int ui = 0;
    if (!S.next(0, cur)) return;
    f32x4 acc[2][2][4][2];
#pragma unroll
    for (int a = 0; a < 2; ++a)
#pragma unroll
        for (int b = 0; b < 2; ++b)
#pragma unroll
            for (int m = 0; m < 4; ++m)
#pragma unroll
                for (int n = 0; n < 2; ++n) acc[a][b][m][n] = (f32x4){0.f, 0.f, 0.f, 0.f};
    bf16x8 At[4][2], B0[2][2], B1[2][2];
    const char* cA = (const char*)g.A + (size_t)cur.pm * tstep; const char* cB = (const char*)g.Bt + (size_t)cur.pn * tstep;
    S.a_ready(cur);
    if constexpr (SP2) {
        PG8_STAGE(PG8_SB(0, 0), cB, voffB); PG8_STAGE(PG8_SB(0, 1), cB + hstepB, voffB); PG8_STAGE(PG8_SA(0, 0), cA, voffA); PG8_STAGE(PG8_SA(0, 1), cA + hstep, voffA);
        if (wr == 1) PG8_BAR;
        PG8_WAIT_V(2); PG8_BAR;
        PG8_STAGE(PG8_SB(1, 0), cB + kstep, voffB); PG8_STAGE(PG8_SA(1, 0), cA + kstep, voffA); PG8_STAGE(PG8_SB(1, 1), cB + hstepB + kstep, voffB);
        PG8_WAIT_V(6); PG8_BAR;
    } else {
        PG8_STAGE(PG8_SB(0, 0), cB, voffB); PG8_STAGE(PG8_SA(0, 0), cA, voffA); PG8_STAGE(PG8_SB(0, 1), cB + hstepB, voffB); PG8_STAGE(PG8_SA(0, 1), cA + hstep, voffA);
        if (wr == 1) PG8_BAR;
        PG8_WAIT_V(4); PG8_BAR;
        PG8_STAGE(PG8_SB(1, 0), cB + kstep, voffB); PG8_STAGE(PG8_SA(1, 0), cA + kstep, voffA); PG8_STAGE(PG8_SB(1, 1), cB + hstepB + kstep, voffB);
        PG8_WAIT_V(6); PG8_BAR;
    }
    for (;;) {
        const bool has_next = S.next(ui + 1, nxt);
        const char* nA = has_next ? (const char*)g.A + (size_t)nxt.pm * tstep : cA; const char* nB = has_next ? (const char*)g.Bt + (size_t)nxt.pn * tstep : cB;
        for (int t = 0; t < nt; t += 2) {
            const bool last = (t == nt - 2);
            const char* a1 = cA + (size_t)(t + 1) * kstep;
            const char* a2 = last ? nA : cA + (size_t)(t + 2) * kstep; const char* b2 = last ? nB : cB + (size_t)(t + 2) * kstep;
            const char* a3 = a2 + kstep; const char* b3 = b2 + kstep;
            if (last && has_next) S.a_ready(nxt);
            if constexpr (SP2) {
            PG8_LDB(B0, 0, 0); PG8_LDB(B1, 0, 1); PG8_SCHED; PG8_LDA(At, 0, 0); PG8_STAGE(PG8_SA(1, 1), a1 + hstep, voffA);
            PG8_WAIT_V(8); PG8_WAIT_L(0); PG8_BAR; PG8_MMA(0, 0, At, B0); PG8_MMA(0, 1, At, B1); PG8_BAR; PG8_SCHED;
            PG8_LDA(At, 0, 1); PG8_STAGE(PG8_SB(0, 0), b2, voffB); PG8_STAGE(PG8_SB(0, 1), b2 + hstepB, voffB); PG8_STAGE(PG8_SA(0, 0), a2, voffA);
            PG8_WAIT_V(8); PG8_WAIT_L(0); PG8_BAR; PG8_MMA(1, 0, At, B0); PG8_MMA(1, 1, At, B1); PG8_BAR; PG8_SCHED;
            PG8_LDB(B0, 1, 0); PG8_LDB(B1, 1, 1); PG8_SCHED; PG8_LDA(At, 1, 0); PG8_STAGE(PG8_SA(0, 1), a2 + hstep, voffA);
            PG8_WAIT_V(8); PG8_WAIT_L(0); PG8_BAR; PG8_MMA(0, 0, At, B0); PG8_MMA(0, 1, At, B1); PG8_BAR; PG8_SCHED;
            PG8_LDA(At, 1, 1); PG8_STAGE(PG8_SB(1, 0), b3, voffB); PG8_STAGE(PG8_SB(1, 1), b3 + hstepB, voffB); PG8_STAGE(PG8_SA(1, 0), a3, voffA);
            PG8_WAIT_V(8); PG8_WAIT_L(0); PG8_BAR; PG8_MMA(1, 0, At, B0); PG8_MMA(1, 1, At, B1); PG8_BAR; PG8_SCHED;
            } else {
            PG8_LDB(B0, 0, 0); PG8_SCHED; PG8_LDA(At, 0, 0); PG8_STAGE(PG8_SA(1, 1), a1 + hstep, voffA);
            PG8_WAIT_L(8); PG8_BAR; PG8_WAIT_L(0); PG8_MMA(0, 0, At, B0); PG8_BAR; PG8_SCHED;
            PG8_LDB(B1, 0, 1); PG8_STAGE(PG8_SB(0, 0), b2, voffB);
            PG8_BAR; PG8_WAIT_L(0); PG8_MMA(0, 1, At, B1); PG8_BAR;
            PG8_LDA(At, 0, 1); PG8_STAGE(PG8_SA(0, 0), a2, voffA);
            PG8_BAR; PG8_WAIT_L(0); PG8_MMA(1, 0, At, B0); PG8_BAR; PG8_SCHED;
            PG8_STAGE(PG8_SB(0, 1), b2 + hstepB, voffB);
            PG8_WAIT_V(6); PG8_BAR; PG8_MMA(1, 1, At, B1); PG8_BAR;
            PG8_LDB(B0, 1, 0); PG8_SCHED; PG8_LDA(At, 1, 0); PG8_STAGE(PG8_SA(0, 1), a2 + hstep, voffA);
            PG8_WAIT_L(8); PG8_BAR; PG8_WAIT_L(0); PG8_MMA(0, 0, At, B0); PG8_BAR; PG8_SCHED;
            PG8_LDB(B1, 1, 1); PG8_STAGE(PG8_SB(1, 0), b3, voffB);
            PG8_BAR; PG8_WAIT_L(0); PG8_MMA(0, 1, At, B1); PG8_BAR;
            PG8_LDA(At, 1, 1); PG8_STAGE(PG8_SA(1, 0), a3, voffA);
            PG8_BAR; PG8_WAIT_L(0); PG8_MMA(1, 0, At, B0); PG8_BAR; PG8_SCHED;
            PG8_STAGE(PG8_SB(1, 1), b3 + hstepB, voffB);
            PG8_WAIT_V(6); PG8_BAR; PG8_MMA(1, 1, At, B1); PG8_BAR;
            }
        }
        if constexpr (ALIGN_EPI) { if (wr == 0) PG8_BAR; }
        if constexpr (!Epi::AFTER_DRAIN) { E(acc, cur, wr, wc, fr, fq); S.done(cur); }
        if (!has_next) break;
#pragma unroll
        for (int a = 0; a < 2; ++a)
#pragma unroll
            for (int b = 0; b < 2; ++b)
#pragma unroll
                for (int m = 0; m < 4; ++m)
#pragma unroll
                    for (int n = 0; n < 2; ++n) acc[a][b][m][n] = (f32x4){0.f, 0.f, 0.f, 0.f};
        cur = nxt; cA = nA; cB = nB; ++ui;
        if constexpr (ALIGN_EPI) { if (wr == 1) PG8_BAR; }
    }
    PG8_WAIT_V(0);
    if constexpr (!ALIGN_EPI) { if (wr == 0) PG8_BAR; }
    PG8_BAR;
    if constexpr (Epi::AFTER_DRAIN) { E.fused(acc, cur, wr, wc, fr, fq, lds, wid, lane); S.done(cur); }
#undef PG8_SA
#undef PG8_SB
#undef PG8_STAGE
#undef PG8_LDA
#undef PG8_LDB
#undef PG8_MMA
#undef PG8_WAIT_V
#undef PG8_WAIT_L
#undef PG8_BAR
#undef PG8_SCHED
}
}
#ifndef PG8_SP2
#define PG8_SP2 true
#endif
#ifndef PG8_ALIGN
#define PG8_ALIGN true
#endif
constexpr int NWAVES = 8, NTHR = NWAVES * 64;
#ifndef MK_MULTI
#define MK_MULTI 0
#endif
#ifndef ORA_IDX
#define ORA_IDX 0
#endif
#ifndef ORA_ATT
#define ORA_ATT 0
#endif
#ifndef ORA_ML
#define ORA_ML 0
#endif
constexpr int N_PHASES = 15;
#ifndef ML_CHAIN
#define ML_CHAIN 1
#endif
constexpr int BATCH = 4, T = 2048, DM = 2048, M = BATCH * T, FF = 8192;
constexpr int AH = 16, AG = 4, HD = 128, IH = 16, IDIM = 64, TOPK = 256;
constexpr int ATT_IN = 4176, ATT_N = 4096, SM_N = 80;
constexpr int C_Q = 0, C_K = 2048, C_V = 2560, C_QI = 3072;
constexpr int MH = 8, MDK = 128, MDV = 256, ML_IN = 6160, ML_N = 6144;
constexpr int C_MQ = 0, C_MK = 1024, C_MV = 2048, C_MO = 4096;
constexpr float EPS = 1e-6f, GATE_CAP = 15.0f;
constexpr size_t MiB = 1u << 20;
constexpr size_t WS_CTL = 0, CTL_ZERO_BYTES = 320 * 1024;
constexpr size_t WS_WIN = 1 * MiB, WS_WSM = 17 * MiB, WS_WO = 18 * MiB, WS_WML = 26 * MiB, WS_WG = 50 * MiB, WS_WMO = 51 * MiB;
constexpr size_t WS_WUP0 = 59 * MiB, WS_WUP1 = 91 * MiB, WS_WDN0 = 123 * MiB, WS_WDN1 = 155 * MiB;
constexpr size_t WS_XB = 188 * MiB, WS_PROJ = 220 * MiB, WS_Q = 316 * MiB, WS_K = 348 * MiB, WS_QI = 356 * MiB, WS_KI = 372 * MiB, WS_WI = 373 * MiB, WS_MASK = 374 * MiB;
constexpr size_t WS_GATE = 376 * MiB, WS_ROPE = 377 * MiB, WS_SC = 380 * MiB, WS_O = 444 * MiB, WS_V = 476 * MiB, WS_ML = 484 * MiB, WS_END = 486 * MiB;
constexpr size_t WS_H = 220 * MiB;
static_assert(WS_H + (size_t)M * FF * 2 <= WS_K && WS_PROJ + (size_t)M * ML_N * 2 <= WS_Q && WS_SC + (size_t)BATCH * T * T * 4 <= WS_O, "d_ws map");
constexpr int CW_TMO = 0, CW_CODE = 1, CW_BAR = 4096, CW_SS = 32768;
constexpr int RING_OFF = 0, RING_BYTES = 143360;
constexpr int LDSCTL_OFF = RING_BYTES, MISC_OFF = LDSCTL_OFF + 320;
constexpr int LDS_BYTES = 147456;
#define GAS __attribute__((address_space(1)))
#define LAS __attribute__((address_space(3)))
typedef unsigned short bf16;
typedef unsigned v4u __attribute__((ext_vector_type(4)));
typedef unsigned v2u __attribute__((ext_vector_type(2)));
typedef float f32x4 __attribute__((ext_vector_type(4)));
typedef float f32x16 __attribute__((ext_vector_type(16)));
typedef float f32x2 __attribute__((ext_vector_type(2)));
typedef short bf16x8 __attribute__((ext_vector_type(8)));
typedef short s16x4 __attribute__((ext_vector_type(4)));
typedef GAS unsigned gu32;
typedef GAS unsigned long long gu64;
typedef unsigned long long u64;
#define RLX_AGENT __ATOMIC_RELAXED, __HIP_MEMORY_SCOPE_AGENT
#define LDS_WAIT() asm volatile("s_waitcnt lgkmcnt(0)" ::: "memory")
#define VM_WAIT() asm volatile("s_waitcnt vmcnt(0)" ::: "memory")
__device__ __forceinline__ unsigned f2bf(float f) { unsigned u = __builtin_bit_cast(unsigned, f); return (u + 0x7fffu + ((u >> 16) & 1u)) >> 16; }
__device__ __forceinline__ unsigned pk2(float lo, float hi) { return f2bf(lo) | (f2bf(hi) << 16); }
__device__ __forceinline__ float bf2f(bf16 h) { return __builtin_bit_cast(float, (unsigned)h << 16); }
__device__ __forceinline__ float bflo(unsigned w) { return __builtin_bit_cast(float, w << 16); }
__device__ __forceinline__ float bfhi(unsigned w) { return __builtin_bit_cast(float, w & 0xffff0000u); }
__device__ __forceinline__ unsigned fkey(float f) { const unsigned u = __builtin_bit_cast(unsigned, f); return (u & 0x80000000u) ? ~u : (u | 0x80000000u); }
#define XB_TMO      128
#define XB_XCNT(j)  (256  + 64 * (j))
#define XB_XSUB(j)  (1280 + 64 * (j))
#define XB_XGEN(j)  (2304 + 64 * (j))
#define XB_TOP      3328
#define XB_TOPGEN   3392
#define XCD_BAR_WORDS 3456
#define XB_SPIN_CAP (1u << 18)

__device__ __forceinline__ unsigned xb_ld(unsigned* p)              { return __hip_atomic_load(p, __ATOMIC_RELAXED, __HIP_MEMORY_SCOPE_AGENT); }
__device__ __forceinline__ unsigned xb_add(unsigned* p, unsigned v) { return __hip_atomic_fetch_add(p, v, __ATOMIC_RELAXED, __HIP_MEMORY_SCOPE_AGENT); }
__device__ __forceinline__ unsigned xb_xcc_id() { return (unsigned)__builtin_amdgcn_s_getreg((3 << 11) | 20) & 0xFu; }
#define XB_SPIN(cond, bar) do { unsigned _sp = 0; while (cond) { __builtin_amdgcn_s_sleep(0); \
    if ((++_sp & 255u) == 0u) { if (xb_ld(&(bar)[XB_TMO])) break; if (_sp > XB_SPIN_CAP) { atomicAdd(&(bar)[XB_TMO], 1u); break; } } } } while (0)

struct XcdBarrier {
    unsigned* bar; unsigned x;
    volatile LAS unsigned* st;
};

__device__ __forceinline__ XcdBarrier xcd_barrier_post(unsigned* bar, volatile LAS unsigned* st) {
    XcdBarrier b; b.bar = bar; b.x = xb_xcc_id(); b.st = st;
    if (threadIdx.x == 0) (void)xb_add(&bar[XB_XCNT(b.x)], 1u);
    return b;
}
__device__ __forceinline__ void xcd_barrier_complete(unsigned* bar, unsigned x, unsigned& nloc, unsigned& nx) {
    const unsigned G = gridDim.x * gridDim.y * gridDim.z;
    unsigned sum, cnt, mine, sp = 0u;
    for (;;) {
        sum = 0u; cnt = 0u; mine = 0u;
#pragma unroll
        for (unsigned j = 0; j < 16; ++j) { const unsigned c = xb_ld(&bar[XB_XCNT(j)]); sum += c; cnt += (c > 0u) ? 1u : 0u; mine = (j == x) ? c : mine; }
        if (sum == G) break;
        __builtin_amdgcn_s_sleep(1);
        if ((++sp & 255u) == 0u) { if (xb_ld(&bar[XB_TMO])) break; if (sp > XB_SPIN_CAP) { atomicAdd(&bar[XB_TMO], 1u); break; } }
    }
    nloc = mine > 0u ? mine : 1u; nx = cnt > 0u ? cnt : 1u;
}

__device__ __forceinline__ void xcd_barrier(const XcdBarrier& b) {
    asm volatile("s_waitcnt vmcnt(0)" ::: "memory");
    __syncthreads();
    if (threadIdx.x == 0) {
        unsigned* bar = b.bar;
        __builtin_amdgcn_s_waitcnt(0);
        unsigned nloc = b.st[0], nx = b.st[1];
        if (nloc == 0u) { xcd_barrier_complete(bar, b.x, nloc, nx); b.st[0] = nloc; b.st[1] = nx; }
        const unsigned old = xb_add(&bar[XB_XSUB(b.x)], 1u);
        const unsigned gen = old / nloc;
        if (old + 1u == (gen + 1u) * nloc) {
            __builtin_amdgcn_fence(__ATOMIC_RELEASE, "agent");
            asm volatile("s_waitcnt vmcnt(0)" ::: "memory");
            const unsigned og = xb_add(&bar[XB_TOP], 1u);
            const unsigned tg = og / nx;
            if (og + 1u == (tg + 1u) * nx) xb_add(&bar[XB_TOPGEN], 1u);
            else XB_SPIN(xb_ld(&bar[XB_TOPGEN]) == tg, bar);
            __builtin_amdgcn_fence(__ATOMIC_ACQUIRE, "agent");
            xb_add(&bar[XB_XGEN(b.x)], 1u);
            asm volatile("s_waitcnt vmcnt(0)" ::: "memory");
        } else {
            XB_SPIN(xb_ld(&bar[XB_XGEN(b.x)]) == gen, bar);
            __builtin_amdgcn_fence(__ATOMIC_ACQUIRE, "agent");
            asm volatile("s_waitcnt vmcnt(0)" ::: "memory");
        }
    }
    __syncthreads();
}
struct Args { const float* in[13]; float* out; unsigned char* ws; int ph_lo, ph_hi, li, pad; };
struct Frame {
    LAS unsigned char* lds;
    volatile LAS unsigned* MISC;
    gu32* ctl;
    int tid, lane, wave, vcu, G;
    const float* x; float* out;
    const float *norm_mix, *norm_ffn, *att_w_in, *q_gain, *k_gain, *att_w_out, *ml_w_in, *b_gate, *h_gain, *ml_w_out, *w_up, *w_dn;
    bf16 *WinT, *WsmT, *WoT, *WmlT, *WgT, *WmoT, *WupT0, *WupT1, *WdnT0, *WdnT1;
    bf16 *XB, *PROJ, *Q, *K, *V, *QI, *KI, *O, *H;
    float *WI, *IG, *LF, *SC, *NST, *SCAL; bf16* ST; f32x2 *ROPE_A, *ROPE_I; u64* MASK;
    float *ss0, *ss1, *ss2, *ss3;
};
__device__ __forceinline__ float wave_sum(float v) {
#pragma unroll
    for (int o = 1; o < 64; o <<= 1) v += __shfl_xor(v, o);
    return v;
}
__device__ __forceinline__ unsigned cvtpk2(float lo, float hi) { unsigned r; asm volatile("v_cvt_pk_bf16_f32 %0, %1, %2" : "=v"(r) : "v"(lo), "v"(hi)); return r; }
template <bool NTS = false> __device__ __forceinline__ void tr_item(const float* W, int ldw, int col0, int nvalid, int nblk, int K, const float* gain, float scale, bf16* WT, LAS float* scr, int item, int lane) {
    const int kb = item / nblk, nb = item - kb * nblk, k0 = 64 * kb, n0 = 32 * nb, nn = n0 + (lane & 31), nc = nn < nvalid ? nn : nvalid - 1, c = lane & 7;
    const GAS float* wp = (const GAS float*)W + (size_t)(k0 + (lane >> 5)) * ldw + col0 + nc;
    float v[32];
#pragma unroll
    for (int i = 0; i < 32; ++i) v[i] = __builtin_nontemporal_load(wp + (size_t)(2 * i) * ldw);
    f32x4 g0 = (f32x4){scale, scale, scale, scale}, g1 = g0;
    if (gain) { g0 = *(const GAS f32x4*)(gain + k0 + 8 * c) * scale; g1 = *(const GAS f32x4*)(gain + k0 + 8 * c + 4) * scale; }
    const bool ok = nn < nvalid;
#pragma unroll
    for (int i = 0; i < 32; ++i) scr[(2 * i + (lane >> 5)) * 33 + (lane & 31)] = ok ? v[i] : 0.f;
    LDS_WAIT(); asm volatile("" ::: "memory");
#pragma unroll
    for (int j = 0; j < 4; ++j) { const int n = (lane >> 3) + 8 * j; const LAS float* s = scr + (8 * c) * 33 + n;
        v4u o; o.x = cvtpk2(s[0 * 33] * g0.x, s[1 * 33] * g0.y); o.y = cvtpk2(s[2 * 33] * g0.z, s[3 * 33] * g0.w); o.z = cvtpk2(s[4 * 33] * g1.x, s[5 * 33] * g1.y); o.w = cvtpk2(s[6 * 33] * g1.z, s[7 * 33] * g1.w);
        if (NTS) __builtin_nontemporal_store(o, (GAS v4u*)(WT + (size_t)(n0 + n) * K + k0 + 8 * c)); else *(GAS v4u*)(WT + (size_t)(n0 + n) * K + k0 + 8 * c) = o; }
    LDS_WAIT(); asm volatile("" ::: "memory");
}
__device__ __forceinline__ void p0_prologue(Frame& F) {
    LAS float* scr = (LAS float*)(F.lds + RING_OFF + F.wave * 16384);
    const int gw = F.vcu * NWAVES + F.wave, NGW = F.G * NWAVES;
    constexpr int I0 = 32 * 128, I1 = 32 * 3, I2 = 32 * 64, I3 = 32 * 256, I4 = 128 * 64, I5 = 32 * 32, I6 = 32 * 32, I7 = 32 * 128, I8 = 32 * 1;
#if ML_CHAIN
    constexpr int I9 = 32 * 64, I10 = I3, I11 = I4, NITEMS = I0 + I1 + I2 + I3 + I4 + I5 + I6 + I7 + I8 + I9 + I10 + I11;
#else
    constexpr int NITEMS = I0 + I1 + I2 + I3 + I4 + I5 + I6 + I7 + I8;
#endif
    constexpr float KSC = 0.08838834764831845f;
    for (int it = gw; it < NITEMS; it += NGW) {
        int r = it;
        if (r < I0) { tr_item(F.att_w_in, ATT_IN, 0, ATT_N, 128, DM, F.norm_mix, 1.f, F.WinT, scr, r, F.lane); continue; } r -= I0;
        if (r < I1) { tr_item(F.att_w_in, ATT_IN, ATT_N, SM_N, 3, DM, F.norm_mix, 1.f, F.WsmT, scr, r, F.lane); continue; } r -= I1;
        if (r < I2) { tr_item(F.att_w_out, DM, 0, DM, 64, DM, nullptr, 1.f, F.WoT, scr, r, F.lane); continue; } r -= I2;
        if (r < I3) { tr_item<true>(F.w_up, FF, 0, FF, 256, DM, F.norm_ffn, 1.f, F.WupT0, scr, r, F.lane); continue; } r -= I3;
        if (r < I4) { tr_item<true>(F.w_dn, DM, 0, DM, 64, FF, nullptr, 1.f, F.WdnT0, scr, r, F.lane); continue; } r -= I4;
        if (r < I5) { tr_item<true>(F.ml_w_in, ML_IN, C_MQ, 1024, 32, DM, F.norm_mix + DM, 1.f, F.WmlT, scr, r, F.lane); continue; } r -= I5;
        if (r < I6) { tr_item<true>(F.ml_w_in, ML_IN, C_MK, 1024, 32, DM, F.norm_mix + DM, KSC, F.WmlT + (size_t)C_MK * DM, scr, r, F.lane); continue; } r -= I6;
        if (r < I7) { tr_item<true>(F.ml_w_in, ML_IN, C_MV, 4096, 128, DM, F.norm_mix + DM, 1.f, F.WmlT + (size_t)C_MV * DM, scr, r, F.lane); continue; } r -= I7;
#if ML_CHAIN
        if (r < I8) { tr_item<true>(F.ml_w_in, ML_IN, ML_N, 16, 1, DM, F.norm_mix + DM, 1.f, F.WgT, scr, r, F.lane); continue; } r -= I8;
        if (r < I9) { tr_item<true>(F.ml_w_out, DM, 0, DM, 64, DM, nullptr, 1.f, F.WmoT, scr, r, F.lane); continue; } r -= I9;
        if (r < I10) { tr_item<true>(F.w_up + (size_t)DM * FF, FF, 0, FF, 256, DM, F.norm_ffn + DM, 1.f, F.WupT1, scr, r, F.lane); continue; } r -= I10;
        tr_item<true>(F.w_dn + (size_t)FF * DM, DM, 0, DM, 64, FF, nullptr, 1.f, F.WdnT1, scr, r, F.lane);
#else
        tr_item(F.ml_w_in, ML_IN, ML_N, 16, 1, DM, F.norm_mix + DM, 1.f, F.WgT, scr, r, F.lane);
#endif
    }
    for (int m = gw; m < M; m += NGW) {
        const GAS f32x4* xr = (const GAS f32x4*)(F.x + (size_t)m * DM) + F.lane; GAS u64* o8 = (GAS u64*)(F.XB + (size_t)m * DM) + F.lane;
        f32x4 v[8]; float s = 0.f;
#pragma unroll
        for (int j = 0; j < 8; ++j) { v[j] = __builtin_nontemporal_load(xr + 64 * j); s += (v[j].x * v[j].x + v[j].y * v[j].y) + (v[j].z * v[j].z + v[j].w * v[j].w); }
        s = wave_sum(s); if (F.lane == 0) F.ss0[m] = s;
#pragma unroll
        for (int j = 0; j < 8; ++j) o8[64 * j] = (u64)cvtpk2(v[j].x, v[j].y) | ((u64)cvtpk2(v[j].z, v[j].w) << 32);
    }
    for (int idx = gw * 64 + F.lane; idx < T * 24; idx += NGW * 64) { const int t = idx / 24, i = idx - t * 24;
        if (i < 16) { const float inv = powf(500000.0f, -2.0f * (float)i / 32.0f), a = (float)t * inv; F.ROPE_A[t * 16 + i] = (f32x2){cosf(a), sinf(a)}; }
        else { const int ii = i - 16; const float inv = powf(500000.0f, -2.0f * (float)ii / 16.0f), a = (float)t * inv; F.ROPE_I[t * 8 + ii] = (f32x2){cosf(a), sinf(a)}; } }
}
template <int NT> __device__ __forceinline__ void skinny_mma(Frame& F, const bf16* A, const bf16* Wt, int r0, LAS float* red) {
    const int rt = F.wave & 1, kq = F.wave >> 1, fr = F.lane & 15, fq = F.lane >> 4;
    f32x4 acc[NT];
#pragma unroll
    for (int n = 0; n < NT; ++n) acc[n] = (f32x4){0.f, 0.f, 0.f, 0.f};
    const bf16* ap = A + (size_t)(r0 + rt * 16 + fr) * DM + kq * 512 + fq * 8; const bf16* bp = Wt + (size_t)fr * DM + kq * 512 + fq * 8;
#pragma unroll 4
    for (int ks = 0; ks < 16; ++ks) { const bf16x8 a = *(const bf16x8*)(ap + ks * 32);
#pragma unroll
        for (int n = 0; n < NT; ++n) { const bf16x8 b = *(const bf16x8*)(bp + (size_t)n * 16 * DM + ks * 32); acc[n] = __builtin_amdgcn_mfma_f32_16x16x32_bf16(a, b, acc[n], 0, 0, 0); } }
#pragma unroll
    for (int n = 0; n < NT; ++n)
#pragma unroll
        for (int g = 0; g < 4; ++g) red[((kq * 32 + rt * 16 + 4 * fq + g) * (NT * 16)) + n * 16 + fr] = acc[n][g];
}
__device__ __forceinline__ void skinny_att(Frame& F) {
    LAS float* red = (LAS float*)(F.lds + RING_OFF);
    for (int u = F.vcu; u < M / 32; u += F.G) { const int r0 = u * 32;
        skinny_mma<5>(F, F.XB, F.WsmT, r0, red);
        LDS_WAIT(); __syncthreads();
        const int r = F.tid >> 4, q = F.tid & 15, m = r0 + r, t = m % T; const float rs = __builtin_amdgcn_rsqf(F.ss0[m] * (1.f / DM) + EPS);
#define SMV(c) ((red[(0 * 32 + r) * 80 + (c)] + red[(1 * 32 + r) * 80 + (c)] + red[(2 * 32 + r) * 80 + (c)] + red[(3 * 32 + r) * 80 + (c)]) * rs)
        if (q < 8) { const float a = SMV(q), b = SMV(q + 8); const f32x2 cs = F.ROPE_I[t * 8 + q];
            F.KI[(size_t)m * 64 + q] = (bf16)f2bf(a * cs.x - b * cs.y); F.KI[(size_t)m * 64 + q + 8] = (bf16)f2bf(a * cs.y + b * cs.x); }
#pragma unroll
        for (int e = 0; e < 3; ++e) { const int c = 16 + q * 3 + e; F.KI[(size_t)m * 64 + c] = (bf16)f2bf(SMV(c)); }
        F.WI[(size_t)m * 16 + q] = SMV(64 + q) * 0.03125f;
#undef SMV
        LDS_WAIT(); __syncthreads();
    }
}
__device__ __forceinline__ void skinny_gates(Frame& F) {
    LAS float* red = (LAS float*)(F.lds + RING_OFF);
    for (int u = F.vcu; u < M / 32; u += F.G) { const int r0 = u * 32;
        skinny_mma<1>(F, F.XB, F.WgT, r0, red);
        LDS_WAIT(); __syncthreads();
        const int r = F.tid >> 4, c = F.tid & 15, m = r0 + r, b = m / T, t = m - b * T; const float rs = __builtin_amdgcn_rsqf(F.ss2[m] * (1.f / DM) + EPS);
        float g = (red[(0 * 32 + r) * 16 + c] + red[(1 * 32 + r) * 16 + c] + red[(2 * 32 + r) * 16 + c] + red[(3 * 32 + r) * 16 + c]) * rs + F.b_gate[c];
        g = GATE_CAP * tanhf(g * (1.f / GATE_CAP));
        if (c < 8) F.IG[(size_t)(b * MH + c) * T + t] = g;
        else { const float ls = g >= 0.f ? -log1pf(expf(-g)) : g - log1pf(expf(g)); F.LF[(size_t)(b * MH + c - 8) * T + t] = ls; }
        LDS_WAIT(); __syncthreads();
    }
}
__device__ __forceinline__ void unpack8(const v4u w, float* f) { f[0] = bflo(w.x); f[1] = bfhi(w.x); f[2] = bflo(w.y); f[3] = bfhi(w.y); f[4] = bflo(w.z); f[5] = bfhi(w.z); f[6] = bflo(w.w); f[7] = bfhi(w.w); }
__device__ __forceinline__ v4u pack8f(const float* f) { v4u w; w.x = pk2(f[0], f[1]); w.y = pk2(f[2], f[3]); w.z = pk2(f[4], f[5]); w.w = pk2(f[6], f[7]); return w; }
__device__ __forceinline__ void norm_rope32(Frame& F, const bf16* src, bf16* dst, const float* gain, int t, bool active) {
    float y[32]; float s = 0.f;
    if (active) {
#pragma unroll
        for (int j = 0; j < 4; ++j) unpack8(*(const GAS v4u*)(src + 8 * j), y + 8 * j);
    } else {
#pragma unroll
        for (int e = 0; e < 32; ++e) y[e] = 0.f;
    }
#pragma unroll
    for (int e = 0; e < 32; ++e) s += y[e] * y[e];
    s += __shfl_xor(s, 1); s += __shfl_xor(s, 2);
    const float rs = __builtin_amdgcn_rsqf(s * (1.f / 128.f) + EPS); const int d0 = (F.lane & 3) * 32;
    if (active) {
#pragma unroll
        for (int e = 0; e < 32; ++e) y[e] = y[e] * rs * gain[d0 + e];
        if ((F.lane & 3) == 0) {
#pragma unroll
            for (int i = 0; i < 16; ++i) { const f32x2 cs = F.ROPE_A[t * 16 + i]; const float a = y[i], b = y[i + 16]; y[i] = a * cs.x - b * cs.y; y[i + 16] = a * cs.y + b * cs.x; }
        }
#pragma unroll
        for (int j = 0; j < 4; ++j) *(GAS v4u*)(dst + 8 * j) = pack8f(y + 8 * j);
    }
}
__device__ __forceinline__ void p2_prep(Frame& F) {
    const int gw = F.vcu * NWAVES + F.wave, NGW = F.G * NWAVES;
    for (int m = gw; m < M; m += NGW) { const int t = m % T; const bf16* pr = F.PROJ + (size_t)m * ATT_N;
        norm_rope32(F, pr + C_Q + 32 * F.lane, F.Q + (size_t)m * DM + 32 * F.lane, F.q_gain, t, true);
        norm_rope32(F, pr + C_K + 32 * (F.lane & 15), F.K + (size_t)m * 512 + 32 * (F.lane & 15), F.k_gain, t, F.lane < 16);
        *(GAS v4u*)(F.V + (size_t)m * 512 + 8 * F.lane) = *(const GAS v4u*)(pr + C_V + 8 * F.lane);
        float y[16]; unpack8(*(const GAS v4u*)(pr + C_QI + 16 * F.lane), y); unpack8(*(const GAS v4u*)(pr + C_QI + 16 * F.lane + 8), y + 8);
        if ((F.lane & 3) == 0) {
#pragma unroll
            for (int i = 0; i < 8; ++i) { const f32x2 cs = F.ROPE_I[t * 8 + i]; const float a = y[i], b = y[i + 8]; y[i] = a * cs.x - b * cs.y; y[i + 8] = a * cs.y + b * cs.x; }
        }
        *(GAS v4u*)(F.QI + (size_t)m * 1024 + 16 * F.lane) = pack8f(y); *(GAS v4u*)(F.QI + (size_t)m * 1024 + 16 * F.lane + 8) = pack8f(y + 8);
    }
}
template <bool TWO, int ABL = 0> __device__ __forceinline__ void p3a_tiles(Frame& F, int b, size_t m0, int kt, const LAS unsigned char* qrow, int swz, const LAS float* wl, int r32, int hi) {
    bf16x8 ka[4], kb[4];
    { const bf16* kp = F.KI + ((size_t)b * T + 32 * kt + r32) * 64 + hi * 8;
#pragma unroll
      for (int ks = 0; ks < 4; ++ks) { ka[ks] = *(const GAS bf16x8*)(kp + 16 * ks); if (TWO) kb[ks] = *(const GAS bf16x8*)(kp + (size_t)32 * NWAVES * 64 + 16 * ks); } }
    f32x16 sa, sb;
#pragma unroll
    for (int r = 0; r < 16; ++r) { sa[r] = 0.f; sb[r] = 0.f; }
#pragma unroll 2
    for (int h = 0; h < 16; ++h) { f32x16 da, db; const float wh = wl[r32 * 16 + h];
#pragma unroll
        for (int r = 0; r < 16; ++r) { da[r] = 0.f; db[r] = 0.f; }
#pragma unroll
        for (int ks = 0; ks < 4; ++ks) { const bf16x8 q = *(const LAS bf16x8*)(qrow + (((h * 64 + 16 * ks + 8 * hi) * 2) ^ swz));
            da = __builtin_amdgcn_mfma_f32_32x32x16_bf16(ka[ks], q, da, 0, 0, 0); if (TWO) db = __builtin_amdgcn_mfma_f32_32x32x16_bf16(kb[ks], q, db, 0, 0, 0); }
#pragma unroll
        for (int r = 0; r < 16; ++r) { const float xa = da[r]; const int ia = __float_as_int(xa); sa[r] = fmaf(wh, __int_as_float(ia > 0 ? ia : 0), sa[r]);
            if (TWO) { const float xb = db[r]; const int ib = __float_as_int(xb); sb[r] = fmaf(wh, __int_as_float(ib > 0 ? ib : 0), sb[r]); } } }
    LAS float* tsc = (LAS float*)(F.lds + RING_OFF + 69632 + F.wave * 4608);
    const int trow = F.lane >> 1, th = F.lane & 1;
#pragma unroll
    for (int q4 = 0; q4 < 4; ++q4) *(LAS f32x4*)(tsc + r32 * 36 + 8 * q4 + 4 * hi) = (f32x4){sa[4 * q4], sa[4 * q4 + 1], sa[4 * q4 + 2], sa[4 * q4 + 3]};
    if (ABL != 2) { float* dst = F.SC + (m0 + trow) * T + 32 * kt + 16 * th;
#pragma unroll
      for (int q4 = 0; q4 < 4; ++q4) *(GAS f32x4*)(dst + 4 * q4) = *(const LAS f32x4*)(tsc + trow * 36 + 16 * th + 4 * q4); }
    if (TWO) {
#pragma unroll
        for (int q4 = 0; q4 < 4; ++q4) *(LAS f32x4*)(tsc + r32 * 36 + 8 * q4 + 4 * hi) = (f32x4){sb[4 * q4], sb[4 * q4 + 1], sb[4 * q4 + 2], sb[4 * q4 + 3]};
        float* dst = F.SC + (m0 + trow) * T + 32 * (kt + NWAVES) + 16 * th;
        if (ABL != 2) {
#pragma unroll
        for (int q4 = 0; q4 < 4; ++q4) *(GAS f32x4*)(dst + 4 * q4) = *(const LAS f32x4*)(tsc + trow * 36 + 16 * th + 4 * q4); } }
}
template <int ABL = 0> __device__ __forceinline__ void p3a_segment(Frame& F, int b, int i, int kt0, int kt1) {
    LAS unsigned char* qs = F.lds + RING_OFF;
    LAS float* wl = (LAS float*)(F.lds + RING_OFF + 65536);
    const int r32 = F.lane & 31, hi = F.lane >> 5, t0 = 32 * i; const size_t m0 = (size_t)b * T + t0;
#pragma unroll
    for (int k = 0; k < 8; ++k) { const int p = F.tid + 512 * k, row = p >> 7, ch = p & 127;
        v4u v = *(const GAS v4u*)(F.PROJ + (m0 + row) * ATT_N + C_QI + ch * 8);
        v4u o; o.x = (unsigned)__builtin_amdgcn_update_dpp(0, (int)v.x, 0xB1, 0xf, 0xf, false); o.y = (unsigned)__builtin_amdgcn_update_dpp(0, (int)v.y, 0xB1, 0xf, 0xf, false);
        o.z = (unsigned)__builtin_amdgcn_update_dpp(0, (int)v.z, 0xB1, 0xf, 0xf, false); o.w = (unsigned)__builtin_amdgcn_update_dpp(0, (int)v.w, 0xB1, 0xf, 0xf, false);
        if ((ch & 7) < 2) { float a[8], bq[8]; unpack8((ch & 1) ? o : v, a); unpack8((ch & 1) ? v : o, bq); const f32x2* rp = F.ROPE_I + (size_t)(t0 + row) * 8; float y[8];
#pragma unroll
            for (int e = 0; e < 8; ++e) { const f32x2 cs = rp[e]; y[e] = (ch & 1) ? a[e] * cs.y + bq[e] * cs.x : a[e] * cs.x - bq[e] * cs.y; }
            v = pack8f(y); }
        *(LAS v4u*)(qs + row * 2048 + ((ch * 16) ^ ((row & 15) << 4))) = v; }
    wl[F.tid] = F.WI[(m0 + (F.tid >> 4)) * 16 + (F.tid & 15)];
    LDS_WAIT(); __syncthreads();
    const LAS unsigned char* qrow = qs + r32 * 2048; const int swz = (r32 & 15) << 4;
    if (ABL != 1) for (int kt = kt0 + F.wave; kt < kt1; kt += 2 * NWAVES) { const bool two = kt + NWAVES < kt1;
        if (two) p3a_tiles<true, ABL>(F, b, m0, kt, qrow, swz, wl, r32, hi); else p3a_tiles<false, ABL>(F, b, m0, kt, qrow, swz, wl, r32, hi); }
    LDS_WAIT(); __syncthreads();
}
template <int ABL = 0> __device__ __forceinline__ void p3a_scores(Frame& F) {
    { const int gw = F.vcu * NWAVES + F.wave, NGW = F.G * NWAVES;
      for (int m = gw; m < M; m += NGW) { const int t = m % T; const bf16* pr = F.PROJ + (size_t)m * ATT_N;
          norm_rope32(F, pr + C_K + 32 * (F.lane & 15), F.K + (size_t)m * 512 + 32 * (F.lane & 15), F.k_gain, t, F.lane < 16);
          *(GAS v4u*)(F.V + (size_t)m * 512 + 8 * F.lane) = *(const GAS v4u*)(pr + C_V + 8 * F.lane); } }
    for (int c = F.vcu; c < 256; c += F.G) { const int p = c >> 1, b = p >> 5, i = p & 31;
        if ((c & 1) == 0) p3a_segment<ABL>(F, b, 63 - i, 0, 32);
        else { p3a_segment<ABL>(F, b, 63 - i, 32, 64 - i); p3a_segment<ABL>(F, b, i, 0, i + 1); } }
}
__device__ __forceinline__ void p3b_select(Frame& F) {
    LAS unsigned* hist = (LAS unsigned*)(F.lds + RING_OFF + F.wave * 8192);
    const int gw = F.vcu * NWAVES + F.wave, NGW = F.G * NWAVES, rep = F.lane & 7;
    float sn[32];
#define ROW_OF(e_, t_, m_) const int bb_ = (e_) / T, tt_ = (e_) - bb_ * T, t_ = (bb_ & 1) ? T - 1 - tt_ : tt_, m_ = bb_ * T + t_
#define ROW_LOAD(e_) do { ROW_OF(e_, tl_, ml_); const float* sr_ = F.SC + (size_t)ml_ * T;                                             \
        _Pragma("unroll") for (int j = 0; j < 32; ++j) { const int s = F.lane + 64 * j; sn[j] = __builtin_nontemporal_load(sr_ + (s < tl_ ? s : tl_)); } } while (0)
    if (gw < M) ROW_LOAD(gw);
    for (int e = gw; e < M; e += NGW) { ROW_OF(e, t, m); const int nj = (t >> 6) + 1;
            unsigned k[32];
#pragma unroll
            for (int j = 0; j < 32; ++j) { const int s = F.lane + 64 * j; k[j] = fkey(s <= t ? sn[j] : -__builtin_inff()); }
            if (e + NGW < M) ROW_LOAD(e + NGW);
            unsigned P = 0;
            if (t + 1 > TOPK) { unsigned need = TOPK;
#pragma unroll 1
                for (int p = 0; p < 4; ++p) { const int sh = 24 - 8 * p; const unsigned hmask = p ? (0xffffffffu << (sh + 8)) : 0u;
#pragma unroll
                    for (int z = 0; z < 8; ++z) *(LAS v4u*)(hist + 4 * (F.lane + 64 * z)) = (v4u){0u, 0u, 0u, 0u};
#pragma unroll
                    for (int j = 0; j < 32; ++j) if (j < nj) { if (((k[j] ^ P) & hmask) == 0u) __hip_atomic_fetch_add(hist + (((k[j] >> sh) & 255u) * 8u + rep), 1u, __ATOMIC_RELAXED, __HIP_MEMORY_SCOPE_WORKGROUP); }
                    v4u hb;
                    { const LAS v4u* hp = (const LAS v4u*)(hist + 32 * F.lane);
                      const v4u r0 = hp[0], r1 = hp[1], r2 = hp[2], r3 = hp[3], r4 = hp[4], r5 = hp[5], r6 = hp[6], r7 = hp[7];
                      hb.x = (r0.x + r0.y + r0.z + r0.w) + (r1.x + r1.y + r1.z + r1.w); hb.y = (r2.x + r2.y + r2.z + r2.w) + (r3.x + r3.y + r3.z + r3.w);
                      hb.z = (r4.x + r4.y + r4.z + r4.w) + (r5.x + r5.y + r5.z + r5.w); hb.w = (r6.x + r6.y + r6.z + r6.w) + (r7.x + r7.y + r7.z + r7.w); }
                    const unsigned s4 = hb.x + hb.y + hb.z + hb.w;
                    unsigned ps = s4;
                    ps += (unsigned)__builtin_amdgcn_update_dpp(0, (int)ps, 0x111, 0xf, 0xf, false); ps += (unsigned)__builtin_amdgcn_update_dpp(0, (int)ps, 0x112, 0xf, 0xf, false);
                    ps += (unsigned)__builtin_amdgcn_update_dpp(0, (int)ps, 0x114, 0xf, 0xf, false); ps += (unsigned)__builtin_amdgcn_update_dpp(0, (int)ps, 0x118, 0xf, 0xf, false);
                    ps += (unsigned)__builtin_amdgcn_update_dpp(0, (int)ps, 0x142, 0xa, 0xf, false); ps += (unsigned)__builtin_amdgcn_update_dpp(0, (int)ps, 0x143, 0xc, 0xf, false);
                    const unsigned total = (unsigned)__builtin_amdgcn_readlane((int)ps, 63), above = total - ps;
                    const u64 bm = __ballot(above < need && need <= above + s4); const int src = __builtin_ctzll(bm);
                    const unsigned a3 = above + hb.w, a2 = a3 + hb.z, a1 = a2 + hb.y;
                    unsigned dig, gt;
                    if (need <= a3) { dig = 3; gt = above; } else if (need <= a2) { dig = 2; gt = a3; } else if (need <= a1) { dig = 1; gt = a2; } else { dig = 0; gt = a1; }
                    dig += 4u * F.lane;
                    dig = (unsigned)__builtin_amdgcn_readlane((int)dig, src); gt = (unsigned)__builtin_amdgcn_readlane((int)gt, src);
                    P |= dig << sh; need -= gt; } }
            u64 myw = 0;
#pragma unroll
            for (int j = 0; j < 32; ++j) { const int s = F.lane + 64 * j; const u64 w = __ballot(k[j] >= P && s <= t); if (F.lane == j) myw = w; }
            if (F.lane < 32) F.MASK[(size_t)m * 32 + F.lane] = myw;
    }
#undef ROW_OF
#undef ROW_LOAD
}
#ifndef IDX_FUSED
#define IDX_FUSED 0
#endif
__device__ __forceinline__ unsigned radix_select(const unsigned (&k)[32], int nj, int lane, LAS unsigned* hist) {
    unsigned P = 0, need = TOPK;
#pragma unroll 1
    for (int p = 0; p < 4; ++p) { const int sh = 24 - 8 * p; const unsigned hmask = p ? (0xffffffffu << (sh + 8)) : 0u;
        *(LAS v4u*)(hist + 4 * lane) = (v4u){0u, 0u, 0u, 0u};
#pragma unroll
        for (int j = 0; j < 32; ++j) if (j < nj) { if (((k[j] ^ P) & hmask) == 0u) __hip_atomic_fetch_add(hist + ((k[j] >> sh) & 255u), 1u, __ATOMIC_RELAXED, __HIP_MEMORY_SCOPE_WORKGROUP); }
        const v4u hb = *(const LAS v4u*)(hist + 4 * lane);
        const unsigned s4 = hb.x + hb.y + hb.z + hb.w;
        unsigned ps = s4;
        ps += (unsigned)__builtin_amdgcn_update_dpp(0, (int)ps, 0x111, 0xf, 0xf, false); ps += (unsigned)__builtin_amdgcn_update_dpp(0, (int)ps, 0x112, 0xf, 0xf, false);
        ps += (unsigned)__builtin_amdgcn_update_dpp(0, (int)ps, 0x114, 0xf, 0xf, false); ps += (unsigned)__builtin_amdgcn_update_dpp(0, (int)ps, 0x118, 0xf, 0xf, false);
        ps += (unsigned)__builtin_amdgcn_update_dpp(0, (int)ps, 0x142, 0xa, 0xf, false); ps += (unsigned)__builtin_amdgcn_update_dpp(0, (int)ps, 0x143, 0xc, 0xf, false);
        const unsigned total = (unsigned)__builtin_amdgcn_readlane((int)ps, 63), above = total - ps;
        const u64 bm = __ballot(above < need && need <= above + s4); const int src = __builtin_ctzll(bm);
        const unsigned a3 = above + hb.w, a2 = a3 + hb.z, a1 = a2 + hb.y;
        unsigned dig, gt;
        if (need <= a3) { dig = 3; gt = above; } else if (need <= a2) { dig = 2; gt = a3; } else if (need <= a1) { dig = 1; gt = a2; } else { dig = 0; gt = a1; }
        dig += 4u * lane;
        dig = (unsigned)__builtin_amdgcn_readlane((int)dig, src); gt = (unsigned)__builtin_amdgcn_readlane((int)gt, src);
        P |= dig << sh; need -= gt; }
    return P;
}
__device__ __forceinline__ void p3f_tile(Frame& F, int b, int ti) {
    constexpr int SROW = 2052;
    LAS float* SCL = (LAS float*)(F.lds + RING_OFF);
    LAS unsigned* hist = (LAS unsigned*)(F.lds + RING_OFF + 16 * SROW * 4 + F.wave * 1024);
    static_assert(16 * SROW * 4 + 8 * 1024 <= RING_BYTES, "fused indexer LDS");
    const int lane = F.lane, c16 = lane & 15, kq = lane >> 4, t0 = 16 * ti; const size_t m0 = (size_t)b * T + t0;
#pragma unroll 1
    for (int hh = 0; hh < 2; ++hh) {
        bf16x8 qf[8][2]; float wv[8];
        { const bf16* qp = F.PROJ + (m0 + c16) * ATT_N + C_QI + hh * 512 + 8 * kq; const f32x2* rp = F.ROPE_I + (size_t)(t0 + c16) * 8;
          f32x2 cs[8];
#pragma unroll
          for (int e = 0; e < 8; ++e) cs[e] = rp[e];
#pragma unroll
          for (int h = 0; h < 8; ++h) { v4u v0 = *(const GAS v4u*)(qp + h * 64), v1 = *(const GAS v4u*)(qp + h * 64 + 32);
              v4u o; o.x = (unsigned)__shfl_xor((int)v0.x, 16); o.y = (unsigned)__shfl_xor((int)v0.y, 16); o.z = (unsigned)__shfl_xor((int)v0.z, 16); o.w = (unsigned)__shfl_xor((int)v0.w, 16);
              if (kq < 2) { float a[8], bq[8], y[8]; unpack8(kq ? o : v0, a); unpack8(kq ? v0 : o, bq);
#pragma unroll
                  for (int e = 0; e < 8; ++e) y[e] = kq ? a[e] * cs[e].y + bq[e] * cs[e].x : a[e] * cs[e].x - bq[e] * cs[e].y;
                  v0 = pack8f(y); }
              qf[h][0] = *reinterpret_cast<bf16x8*>(&v0); qf[h][1] = *reinterpret_cast<bf16x8*>(&v1); }
          const float* wp = F.WI + (m0 + c16) * 16 + hh * 8;
#pragma unroll
          for (int h4 = 0; h4 < 2; ++h4) { const f32x4 w4 = *(const GAS f32x4*)(wp + 4 * h4); wv[4 * h4] = w4.x; wv[4 * h4 + 1] = w4.y; wv[4 * h4 + 2] = w4.z; wv[4 * h4 + 3] = w4.w; } }
        bf16x8 a0, a1, n0, n1;
        { const int kt = F.wave; if (kt <= ti) { const bf16* kp = F.KI + ((size_t)b * T + 16 * kt + c16) * 64 + 8 * kq; n0 = *(const GAS bf16x8*)kp; n1 = *(const GAS bf16x8*)(kp + 32); } }
        for (int kt = F.wave; kt <= ti; kt += NWAVES) { const int s0 = 16 * kt;
            a0 = n0; a1 = n1;
            if (kt + NWAVES <= ti) { const bf16* kp = F.KI + ((size_t)b * T + 16 * (kt + NWAVES) + c16) * 64 + 8 * kq; n0 = *(const GAS bf16x8*)kp; n1 = *(const GAS bf16x8*)(kp + 32); }
            LAS f32x4* dst = (LAS f32x4*)(SCL + c16 * SROW + s0 + 4 * kq);
            f32x4 sc = (f32x4){0.f, 0.f, 0.f, 0.f}; if (hh) sc = *dst;
#pragma unroll
            for (int h = 0; h < 8; ++h) { f32x4 d = __builtin_amdgcn_mfma_f32_16x16x32_bf16(a0, qf[h][0], (f32x4){0.f, 0.f, 0.f, 0.f}, 0, 0, 0); d = __builtin_amdgcn_mfma_f32_16x16x32_bf16(a1, qf[h][1], d, 0, 0, 0);
                sc += __builtin_elementwise_max(d, (f32x4){0.f, 0.f, 0.f, 0.f}) * wv[h]; }
            *dst = sc;
        }
    }
    LDS_WAIT(); __syncthreads();
#pragma unroll 1
    for (int rr = 0; rr < 2; ++rr) { const int row = 2 * F.wave + rr, t = t0 + row, nj = (t >> 6) + 1; const LAS float* srow = SCL + row * SROW;
        unsigned k[32];
#pragma unroll
        for (int j = 0; j < 32; ++j) { const int s = lane + 64 * j; k[j] = fkey(s <= t ? srow[s] : -__builtin_inff()); }
        unsigned P = 0;
        if (t + 1 > TOPK) P = radix_select(k, nj, lane, hist);
        u64 myw = 0;
#pragma unroll
        for (int j = 0; j < 32; ++j) { const int s = lane + 64 * j; const u64 w = __ballot(k[j] >= P && s <= t); if (lane == j) myw = w; }
        if (lane < 32) F.MASK[(m0 + row) * 32 + lane] = myw;
    }
    LDS_WAIT(); __syncthreads();
}
__device__ __forceinline__ void p3_fused(Frame& F) {
    { const int gw = F.vcu * NWAVES + F.wave, NGW = F.G * NWAVES;
      for (int m = gw; m < M; m += NGW) { const int t = m % T; const bf16* pr = F.PROJ + (size_t)m * ATT_N;
          norm_rope32(F, pr + C_K + 32 * (F.lane & 15), F.K + (size_t)m * 512 + 32 * (F.lane & 15), F.k_gain, t, F.lane < 16);
          *(GAS v4u*)(F.V + (size_t)m * 512 + 8 * F.lane) = *(const GAS v4u*)(pr + C_V + 8 * F.lane); } }
    for (int u = F.vcu; u < 256; u += F.G) { const int b = u >> 6, i = u & 63; p3f_tile(F, b, 127 - i); p3f_tile(F, b, i); }
}
namespace att {
constexpr int D = 128, NW = 8, QBLK = 32, KVBLK = 64;
constexpr float SCALE = 0.088388347648318440f;
constexpr int LDQ = ATT_N, LDK = 512, LDO = DM;
constexpr int SHM_V = KVBLK * D * 2, SHM_K = KVBLK * D * 2, SHM_MASK = 2 * SHM_V + 2 * SHM_K + NW * 64 * 4, MROW = 33 * 8, SHM_ATTN = SHM_MASK + 256 * MROW;
#define KSWZ(row, colB) ((row) * 256 + ((colB) ^ (((row) & 7) << 4)))
#define SBAR() __builtin_amdgcn_sched_barrier(0)
__device__ __forceinline__ int crow(int r, int hi) { return (r & 3) + 8 * (r >> 2) + 4 * hi; }
__device__ __forceinline__ unsigned cvtpk(float lo, float hi) { unsigned r; asm volatile("v_cvt_pk_bf16_f32 %0, %1, %2" : "=v"(r) : "v"(lo), "v"(hi)); return r; }
__device__ __forceinline__ void partialSM(f32x16& p0, f32x16& p1, float negmC) {
  constexpr float C = SCALE * 1.4426950408889634f;
  for (int r = 0; r < 16; ++r) p0[r] = fmaf(p0[r], C, negmC); for (int r = 0; r < 16; ++r) p1[r] = fmaf(p1[r], C, negmC);
  for (int r = 0; r < 16; ++r) p0[r] = __builtin_amdgcn_exp2f(p0[r]);
}
__device__ __forceinline__ void finishSM(f32x16& p0, f32x16& p1, float& l_reg, bf16x8& pa0, bf16x8& pa1, bf16x8& pa2, bf16x8& pa3) {
  for (int r = 0; r < 16; ++r) p1[r] = __builtin_amdgcn_exp2f(p1[r]);
  float ps = 0; for (int r = 0; r < 16; ++r) ps += p0[r]; for (int r = 0; r < 16; ++r) ps += p1[r];
  { auto rr = __builtin_amdgcn_permlane32_swap(__float_as_uint(ps), __float_as_uint(ps), false, false);
    ps = __uint_as_float(rr[0]) + __uint_as_float(rr[1]); }
  l_reg += ps;
#define PK4(P, BASE, OUT) do { unsigned a0 = cvtpk(P[BASE + 0], P[BASE + 1]), a1 = cvtpk(P[BASE + 2], P[BASE + 3]);   \
    unsigned b0 = cvtpk(P[BASE + 4], P[BASE + 5]), b1 = cvtpk(P[BASE + 6], P[BASE + 7]);                              \
    auto r0 = __builtin_amdgcn_permlane32_swap(a0, b0, false, false); auto r1 = __builtin_amdgcn_permlane32_swap(a1, b1, false, false); \
    v4u w = {r0[0], r1[0], r0[1], r1[1]}; OUT = *reinterpret_cast<bf16x8*>(&w); } while (0)
  PK4(p0, 0, pa0); PK4(p0, 8, pa1); PK4(p1, 0, pa2); PK4(p1, 8, pa3);
#undef PK4
}
__device__ __forceinline__ void qkt(f32x16& p0, f32x16& p1, const bf16* Ks, const bf16x8* qr, int r32, int hi, unsigned mlo, unsigned mhi) {
#ifndef MASKV
#define MASKV 1
#endif
#if MASKV == 0
  const float NEG = -__builtin_inff(); mlo >>= 4 * hi; mhi >>= 4 * hi;
#pragma unroll
  for (int r = 0; r < 16; ++r) { const int c = (r & 3) + 8 * (r >> 2); p0[r] = ((mlo >> c) & 1u) ? 0.f : NEG; p1[r] = ((mhi >> c) & 1u) ? 0.f : NEG; }
#else
  const int nlo = (int)(~mlo >> (4 * hi)), nhi = (int)(~mhi >> (4 * hi));
#pragma unroll
  for (int r = 0; r < 16; ++r) { const int c = (r & 3) + 8 * (r >> 2);
    p0[r] = __uint_as_float((unsigned)__builtin_amdgcn_sbfe(nlo, c, 1) & 0xff800000u); p1[r] = __uint_as_float((unsigned)__builtin_amdgcn_sbfe(nhi, c, 1) & 0xff800000u); }
#endif
#pragma unroll
  for (int d0 = 0; d0 < 8; ++d0) { int cb = (d0 * 16 + hi * 8) * 2;
    bf16x8 b0 = *reinterpret_cast<const bf16x8*>((const char*)Ks + KSWZ(r32, cb));
    bf16x8 b1 = *reinterpret_cast<const bf16x8*>((const char*)Ks + KSWZ(32 + r32, cb));
    p0 = __builtin_amdgcn_mfma_f32_32x32x16_bf16(b0, qr[d0], p0, 0, 0, 0);
    p1 = __builtin_amdgcn_mfma_f32_32x32x16_bf16(b1, qr[d0], p1, 0, 0, 0); }
}
__device__ __forceinline__ int v_st(int k, int c) { const int kk = (k & ~0xC) | ((k & 4) << 1) | ((k & 8) >> 1); return ((kk >> 3) * 4 + (c >> 5)) * 512 + ((kk & 7) * 32 + (c & 31)) * 2; }
__device__ __forceinline__ int v_rd_base(int lane) { return ((lane & 3) << 3) | (((lane >> 2) & 3) << 6) | (((lane >> 4) & 1) << 5) | (((lane >> 5) & 1) << 8); }
constexpr int v_rd_off(int d0, int ks, int half) { return d0 * 512 + ks * 4096 + half * 2048; }
template <int OFF> __device__ __forceinline__ s16x4 tr_read(int vb) {
  s16x4 r; asm volatile("ds_read_b64_tr_b16 %0, %1 offset:%2" : "=&v"(r) : "v"(vb), "i"(OFF) : "memory"); return r;
}
template <int D0> __device__ __forceinline__ void pv_one(f32x16& od, int vb, bf16x8 pa0, bf16x8 pa1, bf16x8 pa2, bf16x8 pa3) {
  const s16x4 l0 = tr_read<v_rd_off(D0, 0, 0)>(vb), h0 = tr_read<v_rd_off(D0, 0, 1)>(vb), l1 = tr_read<v_rd_off(D0, 1, 0)>(vb), h1 = tr_read<v_rd_off(D0, 1, 1)>(vb);
  const s16x4 l2 = tr_read<v_rd_off(D0, 2, 0)>(vb), h2 = tr_read<v_rd_off(D0, 2, 1)>(vb), l3 = tr_read<v_rd_off(D0, 3, 0)>(vb), h3 = tr_read<v_rd_off(D0, 3, 1)>(vb);
  asm volatile("s_waitcnt lgkmcnt(0)" ::: "memory"); SBAR();
#define PK(L, H) (bf16x8){L[0], L[1], L[2], L[3], H[0], H[1], H[2], H[3]}
  od = __builtin_amdgcn_mfma_f32_32x32x16_bf16(pa0, PK(l0, h0), od, 0, 0, 0);
  od = __builtin_amdgcn_mfma_f32_32x32x16_bf16(pa1, PK(l1, h1), od, 0, 0, 0);
  od = __builtin_amdgcn_mfma_f32_32x32x16_bf16(pa2, PK(l2, h2), od, 0, 0, 0);
  od = __builtin_amdgcn_mfma_f32_32x32x16_bf16(pa3, PK(l3, h3), od, 0, 0, 0);
#undef PK
}
__device__ __forceinline__ void pv_d0(f32x16* o, int vb, bf16x8 pa0, bf16x8 pa1, bf16x8 pa2, bf16x8 pa3) {
  pv_one<0>(o[0], vb, pa0, pa1, pa2, pa3); pv_one<1>(o[1], vb, pa0, pa1, pa2, pa3); pv_one<2>(o[2], vb, pa0, pa1, pa2, pa3); pv_one<3>(o[3], vb, pa0, pa1, pa2, pa3);
}
__device__ __forceinline__ void attn_body(const bf16* __restrict__ Qb, const bf16* __restrict__ Kh, const bf16* __restrict__ Vh, bf16* __restrict__ Ob, const u64* __restrict__ mrow, int seq, char* lds,
                                          const float* __restrict__ qgain, const float* __restrict__ kgain, const f32x2* __restrict__ ropeA, int tpos0) {
  const int tid = opaque_tid(), wid = tid >> 6, lane = tid & 63, r32 = lane & 31, hi = lane >> 5;
  bf16* V_lds = (bf16*)lds; bf16* K_lds = (bf16*)(lds + 2 * SHM_V);
  float* ws = (float*)(lds + 2 * SHM_V + 2 * SHM_K) + wid * 64; float* li_l = ws;
  float l_reg = 0, negmC; f32x16 o[4] = {}; bf16x8 qr[8];
  const bf16* Qw = Qb + (long)(wid * QBLK + r32) * LDQ + hi * 8;
  { float x[64]; float s = 0.f;
#pragma unroll
    for (int d0 = 0; d0 < 8; ++d0) unpack8(*reinterpret_cast<const v4u*>(Qw + d0 * 16), x + 8 * d0);
#pragma unroll
    for (int e = 0; e < 64; ++e) s += x[e] * x[e];
    { auto rr = __builtin_amdgcn_permlane32_swap(__float_as_uint(s), __float_as_uint(s), false, false); s = __uint_as_float(rr[0]) + __uint_as_float(rr[1]); }
    const float rs = __builtin_amdgcn_rsqf(s * (1.f / 128.f) + EPS);
#pragma unroll
    for (int d0 = 0; d0 < 8; ++d0) { const f32x4 g0 = *(const f32x4*)(qgain + 16 * d0 + 8 * hi), g1 = *(const f32x4*)(qgain + 16 * d0 + 8 * hi + 4);
        x[8 * d0 + 0] *= rs * g0.x; x[8 * d0 + 1] *= rs * g0.y; x[8 * d0 + 2] *= rs * g0.z; x[8 * d0 + 3] *= rs * g0.w; x[8 * d0 + 4] *= rs * g1.x; x[8 * d0 + 5] *= rs * g1.y; x[8 * d0 + 6] *= rs * g1.z; x[8 * d0 + 7] *= rs * g1.w; }
    const f32x2* rp = ropeA + (size_t)(tpos0 + wid * QBLK + r32) * 16 + 8 * hi;
#pragma unroll
    for (int e = 0; e < 8; ++e) { const f32x2 cs = rp[e]; const float a = x[e], bq = x[8 + e]; x[e] = a * cs.x - bq * cs.y; x[8 + e] = a * cs.y + bq * cs.x; }
    { float q2 = 0.f, g2;
#pragma unroll
      for (int e = 0; e < 64; ++e) q2 += x[e] * x[e];
      { auto rr = __builtin_amdgcn_permlane32_swap(__float_as_uint(q2), __float_as_uint(q2), false, false); q2 = __uint_as_float(rr[0]) + __uint_as_float(rr[1]); }
      { const f32x2 kg = *(const f32x2*)(kgain + 2 * lane); g2 = fmaxf(kg.x * kg.x, kg.y * kg.y); }
#pragma unroll
      for (int sh = 1; sh < 64; sh <<= 1) g2 = fmaxf(g2, __shfl_xor(g2, sh));
      negmC = -(SCALE * 1.4426950408889634f * 1.02f) * __builtin_sqrtf(q2 * g2 * 128.f); }
#pragma unroll
    for (int d0 = 0; d0 < 8; ++d0) { v4u w = pack8f(x + 8 * d0); qr[d0] = *reinterpret_cast<bf16x8*>(&w); } }
  const char* mw = lds + SHM_MASK + (wid * QBLK + r32) * MROW;
  const int sr = tid >> 4, sc = (tid & 15) * 8, vst0 = v_st(sr, sc), vst1 = v_st(32 + sr, sc);
  const int vb0 = (int)(uintptr_t)V_lds + v_rd_base(lane);
  constexpr int SDEPTH = 2;
  struct { bf16x8 vs0, vs1, ks0, ks1; } sr_[SDEPTH];
#define SLOAD(i, k0) do { sr_[i].vs0 = *reinterpret_cast<const bf16x8*>(&Vh[(long)((k0) + sr) * LDK + sc]); sr_[i].vs1 = *reinterpret_cast<const bf16x8*>(&Vh[(long)((k0) + 32 + sr) * LDK + sc]); \
    sr_[i].ks0 = *reinterpret_cast<const bf16x8*>(&Kh[(long)((k0) + sr) * LDK + sc]); sr_[i].ks1 = *reinterpret_cast<const bf16x8*>(&Kh[(long)((k0) + 32 + sr) * LDK + sc]); } while (0)
#define SWRITE(b, i) do { *(bf16x8*)((char*)V_lds + (b) * SHM_V + vst0) = sr_[i].vs0;          \
    *(bf16x8*)((char*)V_lds + (b) * SHM_V + vst1) = sr_[i].vs1; int kc = sc * 2;               \
    *(bf16x8*)((char*)K_lds + (b) * SHM_K + KSWZ(sr, kc)) = sr_[i].ks0;                       \
    *(bf16x8*)((char*)K_lds + (b) * SHM_K + KSWZ(32 + sr, kc)) = sr_[i].ks1; } while (0)
#define SWAIT() do { if constexpr (SDEPTH == 2) asm volatile("s_waitcnt vmcnt(4)" ::: "memory"); else asm volatile("s_waitcnt vmcnt(0)" ::: "memory"); } while (0)
  f32x16 pA0, pA1, pB0, pB1; bf16x8 pa0, pa1, pa2, pa3; const int NT = seq / KVBLK;
  constexpr int SE = 0, SO = SDEPTH - 1;
  { const int NTw = seq / KVBLK; for (int e = tid; e < 256 * NTw; e += 512) { const int row = e / NTw, j = e - row * NTw; *(u64*)(lds + SHM_MASK + row * MROW + j * 8) = mrow[(size_t)row * 32 + j]; } }
#define MK(j) (*(const v2u*)(mw + (j) * 8))
  v2u mk;
  SLOAD(SE, 0); asm volatile("s_waitcnt vmcnt(0)" ::: "memory"); SWRITE(0, SE); __syncthreads();
  mk = MK(0); qkt(pA0, pA1, K_lds, qr, r32, hi, mk.x, mk.y); partialSM(pA0, pA1, negmC);
  SLOAD(SO, KVBLK); if constexpr (SDEPTH == 2) { if (2 < NT) SLOAD(SE, 2 * KVBLK); }
  SWAIT(); SWRITE(1, SO); __syncthreads();
  for (int j = 1; j + 1 < NT; j += 2) {
    SBAR(); mk = MK(j); qkt(pB0, pB1, (bf16*)((char*)K_lds + SHM_K), qr, r32, hi, mk.x, mk.y);
    finishSM(pA0, pA1, l_reg, pa0, pa1, pa2, pa3); SBAR();
    SLOAD(SO, (j + SDEPTH) * KVBLK); SBAR();
    pv_d0(o, vb0, pa0, pa1, pa2, pa3); partialSM(pB0, pB1, negmC);
    __syncthreads(); SWAIT(); SWRITE(0, SE);
    __syncthreads();
    SBAR(); mk = MK(j + 1); qkt(pA0, pA1, K_lds, qr, r32, hi, mk.x, mk.y);
    finishSM(pB0, pB1, l_reg, pa0, pa1, pa2, pa3); SBAR();
    if (SDEPTH == 1 || j + 3 < NT) SLOAD(SE, (j + 1 + SDEPTH) * KVBLK); SBAR();
    pv_d0(o, vb0 + (int)SHM_V, pa0, pa1, pa2, pa3); partialSM(pA0, pA1, negmC);
    __syncthreads(); SWAIT(); SWRITE(1, SO);
    __syncthreads();
  }
  SBAR(); mk = MK(NT - 1); qkt(pB0, pB1, (bf16*)((char*)K_lds + SHM_K), qr, r32, hi, mk.x, mk.y);
  finishSM(pA0, pA1, l_reg, pa0, pa1, pa2, pa3); SBAR();
  pv_d0(o, vb0, pa0, pa1, pa2, pa3); partialSM(pB0, pB1, negmC);
  __syncthreads();
  finishSM(pB0, pB1, l_reg, pa0, pa1, pa2, pa3); SBAR();
  pv_d0(o, vb0 + (int)SHM_V, pa0, pa1, pa2, pa3);
  if (hi == 0) li_l[r32] = l_reg; asm volatile("s_waitcnt lgkmcnt(0)" ::: "memory");
  float rli[16];
#pragma unroll
  for (int r = 0; r < 16; ++r) rli[r] = __builtin_amdgcn_rcpf(li_l[crow(r, hi)]);
  bf16* Ow = Ob + (long)(wid * QBLK) * LDO;
#pragma unroll
  for (int r = 0; r < 16; ++r) { const int orow = crow(r, hi);
#pragma unroll
    for (int d0 = 0; d0 < 4; ++d0) { const float v = o[d0][r] * rli[r]; const float vn = __shfl_xor(v, 1);
      if ((r32 & 1) == 0) *(unsigned*)(Ow + (long)orow * LDO + d0 * 32 + r32) = cvtpk(v, vn); } }
#undef MK
#undef SLOAD
#undef SWRITE
#undef SWAIT
}
#undef KSWZ
#undef SBAR
}
__device__ __forceinline__ void p4_attention(Frame& F, char* lds) {
    static_assert(att::SHM_ATTN <= RING_BYTES, "attention LDS");
    for (int it = F.vcu; it < 256; it += F.G) { const int grp = it >> 4, b = grp >> 2, g = grp & 3, h = g * 4 + ((it >> 2) & 3), x = it & 3;
        for (int pass = 0; pass < 2; ++pass) { const int qb = pass ? x : 7 - x; const size_t row0 = (size_t)b * T + (size_t)qb * 256;
            att::attn_body(F.PROJ + row0 * ATT_N + C_Q + h * HD, F.K + (size_t)b * T * 512 + g * HD, F.V + (size_t)b * T * 512 + g * HD, F.O + row0 * DM + h * HD, F.MASK + row0 * 32, 256 * (qb + 1), lds, F.q_gain, F.k_gain, F.ROPE_A, qb * 256);
            __syncthreads(); } }
}
namespace ml {
constexpr int QS = 0, KS = 16384, VS = 32768, PF = 65536, HS = 73728, HROW = 528, MISC = HS + 64 * HROW, PW = MISC + 2048, PWB = 1536, LDS_END_B = PW + 8 * PWB;
constexpr int A_KP = 0, A_VS = 16384, A_BUF = 49152, A_WK = 2 * A_BUF, A_B = A_WK + 8192, A_U = A_B + 8192, A_M = A_U + 8192, A_CH = A_M + 8192, LDS_END_A = A_CH + 1024;
#define SW16(row, colB) ((row) * 256 + ((colB) ^ (((row) & 15) << 4)))
#define SBAR() __builtin_amdgcn_sched_barrier(0)
#define MBAR() do { asm volatile("s_waitcnt lgkmcnt(0)" ::: "memory"); __builtin_amdgcn_s_barrier(); asm volatile("" ::: "memory"); } while (0)
using att::crow; using att::cvtpk; using att::v_st; using att::v_rd_base; using att::tr_read;
__device__ __forceinline__ bf16x8 pk88(const s16x4 l, const s16x4 h) { return (bf16x8){l[0], l[1], l[2], l[3], h[0], h[1], h[2], h[3]}; }
__device__ __forceinline__ bf16x8 pack_acc8(const f32x16& x, int s8) { v4u w = {cvtpk(x[s8 + 0], x[s8 + 1]), cvtpk(x[s8 + 2], x[s8 + 3]), cvtpk(x[s8 + 4], x[s8 + 5]), cvtpk(x[s8 + 6], x[s8 + 7])}; return *reinterpret_cast<bf16x8*>(&w); }
__device__ __forceinline__ v4u wmul8(const v4u k, float w) { v4u o; o.x = cvtpk(bflo(k.x) * w, bfhi(k.x) * w); o.y = cvtpk(bflo(k.y) * w, bfhi(k.y) * w); o.z = cvtpk(bflo(k.z) * w, bfhi(k.z) * w); o.w = cvtpk(bflo(k.w) * w, bfhi(k.w) * w); return o; }
template <int CTRL, int ROWMASK> __device__ __forceinline__ float dppf(float old, float src) {
    return __builtin_bit_cast(float, __builtin_amdgcn_update_dpp(__builtin_bit_cast(int, old), __builtin_bit_cast(int, src), CTRL, ROWMASK, 0xf, false)); }
__device__ __forceinline__ float wave_sum_dpp(float v) {
    v += dppf<0xB1, 0xf>(0.f, v); v += dppf<0x4E, 0xf>(0.f, v); v += dppf<0x141, 0xf>(0.f, v); v += dppf<0x140, 0xf>(0.f, v);
    const int iv = __builtin_bit_cast(int, v);
    return (__builtin_bit_cast(float, __builtin_amdgcn_readlane(iv, 0)) + __builtin_bit_cast(float, __builtin_amdgcn_readlane(iv, 16))) +
           (__builtin_bit_cast(float, __builtin_amdgcn_readlane(iv, 32)) + __builtin_bit_cast(float, __builtin_amdgcn_readlane(iv, 48)));
}
__device__ __forceinline__ float scan_sum64(float x) {
    x += dppf<0x111, 0xf>(0.f, x); x += dppf<0x112, 0xf>(0.f, x); x += dppf<0x114, 0xf>(0.f, x); x += dppf<0x118, 0xf>(0.f, x);
    x += dppf<0x142, 0xa>(0.f, x); x += dppf<0x143, 0xc>(0.f, x); return x;
}
__device__ __forceinline__ float scan_max64(float x) {
    const float NI = -__builtin_inff();
    x = fmaxf(x, dppf<0x111, 0xf>(NI, x)); x = fmaxf(x, dppf<0x112, 0xf>(NI, x)); x = fmaxf(x, dppf<0x114, 0xf>(NI, x)); x = fmaxf(x, dppf<0x118, 0xf>(NI, x));
    x = fmaxf(x, dppf<0x142, 0xa>(NI, x)); x = fmaxf(x, dppf<0x143, 0xc>(NI, x)); return x;
}
template <int I> __device__ __forceinline__ void cupd(f32x16& Xi, int vbK, const bf16x8 (&vB)[4]) {
    const s16x4 l0 = tr_read<I * 512 + 0 * 4096>(vbK), h0 = tr_read<I * 512 + 0 * 4096 + 2048>(vbK), l1 = tr_read<I * 512 + 1 * 4096>(vbK), h1 = tr_read<I * 512 + 1 * 4096 + 2048>(vbK);
    const s16x4 l2 = tr_read<I * 512 + 2 * 4096>(vbK), h2 = tr_read<I * 512 + 2 * 4096 + 2048>(vbK), l3 = tr_read<I * 512 + 3 * 4096>(vbK), h3 = tr_read<I * 512 + 3 * 4096 + 2048>(vbK);
    asm volatile("s_waitcnt lgkmcnt(0)" ::: "memory"); SBAR();
    Xi = __builtin_amdgcn_mfma_f32_32x32x16_bf16(pk88(l0, h0), vB[0], Xi, 0, 0, 0);
    Xi = __builtin_amdgcn_mfma_f32_32x32x16_bf16(pk88(l1, h1), vB[1], Xi, 0, 0, 0);
    Xi = __builtin_amdgcn_mfma_f32_32x32x16_bf16(pk88(l2, h2), vB[2], Xi, 0, 0, 0);
    Xi = __builtin_amdgcn_mfma_f32_32x32x16_bf16(pk88(l3, h3), vB[3], Xi, 0, 0, 0);
}
template <int I> __device__ __forceinline__ void yinter(f32x16& acc, const LAS unsigned char* qrow, int swz, int hi, bf16x8 xb0, bf16x8 xb1) {
    const v2u a00 = *(const LAS v2u*)(qrow + (((I * 32 + 0) * 2) ^ swz) + 8 * hi), a01 = *(const LAS v2u*)(qrow + (((I * 32 + 8) * 2) ^ swz) + 8 * hi);
    const v2u a10 = *(const LAS v2u*)(qrow + (((I * 32 + 16) * 2) ^ swz) + 8 * hi), a11 = *(const LAS v2u*)(qrow + (((I * 32 + 24) * 2) ^ swz) + 8 * hi);
    v4u A0 = {a00.x, a00.y, a01.x, a01.y}, A1 = {a10.x, a10.y, a11.x, a11.y};
    acc = __builtin_amdgcn_mfma_f32_32x32x16_bf16(*reinterpret_cast<bf16x8*>(&A0), xb0, acc, 0, 0, 0);
    acc = __builtin_amdgcn_mfma_f32_32x32x16_bf16(*reinterpret_cast<bf16x8*>(&A1), xb1, acc, 0, 0, 0);
}
}
__device__ __forceinline__ void late_weights(Frame& F, int gw, int NGW) {
    LAS float* scr = (LAS float*)(F.lds + RING_OFF + F.wave * 16384);
    constexpr int I9 = 32 * 64, I10 = 32 * 256, I11 = 128 * 64;
    for (int it = gw; it < I9 + I10 + I11; it += NGW) { int r = it;
        if (r < I9) { tr_item(F.ml_w_out, DM, 0, DM, 64, DM, nullptr, 1.f, F.WmoT, scr, r, F.lane); continue; } r -= I9;
        if (r < I10) { tr_item(F.w_up + (size_t)DM * FF, FF, 0, FF, 256, DM, F.norm_ffn + DM, 1.f, F.WupT1, scr, r, F.lane); continue; } r -= I10;
        tr_item(F.w_dn + (size_t)FF * DM, DM, 0, DM, 64, FF, nullptr, 1.f, F.WdnT1, scr, r, F.lane); }
}
template <int mode> __device__ __forceinline__ void p9a_state(Frame& F) {
    using namespace ml;
    constexpr int NBH = BATCH * MH, NC = T / 64;
    if (F.vcu >= NBH) { if (F.G > NBH && mode != 1) late_weights(F, (F.vcu - NBH) * NWAVES + F.wave, (F.G - NBH) * NWAVES); return; }
    if (mode == 2) return;
    LAS unsigned char* L = F.lds + RING_OFF;
    static_assert(ml::LDS_END_A <= RING_BYTES, "mLSTM pass A LDS");
    const int bh = F.vcu, b = bh / MH, h = bh % MH, w = F.wave, tid = F.tid;
    const size_t mb = (size_t)b * T;
    LAS float* WKL = (LAS float*)(L + A_WK); LAS float* BL = (LAS float*)(L + A_B); LAS float* UL = (LAS float*)(L + A_U); LAS float* MLs = (LAS float*)(L + A_M);
    LAS float* CH = (LAS float*)(L + A_CH);
    const float* igp = F.IG + (size_t)bh * T; const float* lfp = F.LF + (size_t)bh * T;
#pragma unroll
    for (int cc = 0; cc < 4; ++cc) { const int c = 4 * w + cc, t = c * 64 + F.lane; const float ig = igp[t], lf = lfp[t];
        const float bb = scan_sum64(lf), u = ig - bb, Mx = scan_max64(u);
        BL[t] = bb; UL[t] = u; MLs[t] = Mx; if (F.lane == 63) { CH[c] = bb; CH[32 + c] = Mx; } }
    LDS_WAIT(); __syncthreads();
    if (tid == 0) { float m = 0.f; for (int c = 0; c < NC; ++c) { const float mm63 = fmaxf(m, CH[32 + c]); CH[64 + c] = m; CH[96 + c] = __expf(m - mm63); CH[128 + c] = mm63; m = CH[c] + mm63; } }
    LDS_WAIT(); __syncthreads();
    { float* scal = F.SCAL + (size_t)bh * 4 * T;
      for (int t = tid; t < T; t += NTHR) { const int c = t >> 6; const float mst = CH[64 + c], mm = fmaxf(mst, MLs[t]), u = UL[t];
          scal[t] = u; scal[T + t] = mm; scal[2 * T + t] = __expf(mst - mm); scal[3 * T + t] = __expf(-(BL[t] + mm)); WKL[t] = __expf(u - CH[128 + c]); } }
    LDS_WAIT(); __syncthreads();
    f32x16 X[4];
#pragma unroll
    for (int i = 0; i < 4; ++i)
#pragma unroll
        for (int r = 0; r < 16; ++r) X[i][r] = 0.f;
    float nreg = 0.f;
    struct KV { v4u k0, k1, v00, v01, v10, v11; }; KV S0, S1, S2;
    const int lbase = (int)(uintptr_t)L;
#define A_LOAD(cc, S) do { const bf16* rp0 = F.PROJ + (mb + (size_t)(cc) * 64 + sr) * ML_N + sc; const bf16* rp1 = rp0 + 32 * ML_N;                              \
        S.k0 = *(const GAS v4u*)(rp0 + C_MK + h * MDK); S.k1 = *(const GAS v4u*)(rp1 + C_MK + h * MDK);                                                       \
        S.v00 = *(const GAS v4u*)(rp0 + C_MV + h * MDV); S.v01 = *(const GAS v4u*)(rp0 + C_MV + h * MDV + 128); S.v10 = *(const GAS v4u*)(rp1 + C_MV + h * MDV); S.v11 = *(const GAS v4u*)(rp1 + C_MV + h * MDV + 128); } while (0)
#define A_WRITE(cc, S) do { LAS unsigned char* B_ = L + ((cc) & 1) * A_BUF; const float w0 = WKL[(cc) * 64 + sr], w1 = WKL[(cc) * 64 + 32 + sr];            \
        *(LAS v4u*)(B_ + A_KP + v_st(sr, sc)) = wmul8(S.k0, w0); *(LAS v4u*)(B_ + A_KP + v_st(32 + sr, sc)) = wmul8(S.k1, w1);                                \
        *(LAS v4u*)(B_ + A_VS + v_st(sr, sc)) = S.v00; *(LAS v4u*)(B_ + A_VS + 16384 + v_st(sr, sc)) = S.v01;                                                 \
        *(LAS v4u*)(B_ + A_VS + v_st(32 + sr, sc)) = S.v10; *(LAS v4u*)(B_ + A_VS + 16384 + v_st(32 + sr, sc)) = S.v11; } while (0)
    { const int sr = tid >> 4, sc = (tid & 15) * 8; A_LOAD(0, S0); A_WRITE(0, S0); A_LOAD(1, S1); A_LOAD(2, S2); A_LOAD(3, S0); }
    LDS_WAIT(); __syncthreads();
#define A_ITER(cc, SN) do { if ((cc) < NC) {                                                                                                                  \
        int lane_o = F.lane, tid_o = F.tid; asm volatile("" : "+v"(lane_o), "+v"(tid_o));           \
        const int lane = lane_o, sr = tid_o >> 4, sc = (tid_o & 15) * 8;                                                                                         \
        { bf16* st = F.ST + ((((size_t)bh * NC + (cc)) * 8 + w) * 8) * 512 + lane * 8;                                                                           \
          _Pragma("unroll") for (int i = 0; i < 4; ++i) { *(GAS bf16x8*)(st + (i * 2 + 0) * 512) = pack_acc8(X[i], 0); *(GAS bf16x8*)(st + (i * 2 + 1) * 512) = pack_acc8(X[i], 8); } \
          if (w == 4 || w == 5) F.NST[((size_t)bh * NC + (cc)) * 128 + (w - 4) * 64 + lane] = nreg; }                                                            \
        if ((cc) < NC - 1) {                                                                                                                                     \
        const int boff = ((cc) & 1) * A_BUF; const float s_old = CH[96 + (cc)];                                                                                  \
        const int vbK = lbase + boff + A_KP + v_rd_base(lane), vbV = lbase + boff + A_VS + (w >> 2) * 16384 + (w & 3) * 512 + v_rd_base(lane);                   \
        bf16x8 vB[4];                                                                                                                                            \
        { const s16x4 l0 = tr_read<0 * 4096>(vbV), h0 = tr_read<0 * 4096 + 2048>(vbV), l1 = tr_read<1 * 4096>(vbV), h1 = tr_read<1 * 4096 + 2048>(vbV);          \
          const s16x4 l2 = tr_read<2 * 4096>(vbV), h2 = tr_read<2 * 4096 + 2048>(vbV), l3 = tr_read<3 * 4096>(vbV), h3 = tr_read<3 * 4096 + 2048>(vbV);          \
          asm volatile("s_waitcnt lgkmcnt(0)" ::: "memory"); SBAR();                                                                                             \
          vB[0] = pk88(l0, h0); vB[1] = pk88(l1, h1); vB[2] = pk88(l2, h2); vB[3] = pk88(l3, h3); }                                                              \
        _Pragma("unroll") for (int i = 0; i < 4; ++i) _Pragma("unroll") for (int r = 0; r < 16; ++r) X[i][r] *= s_old;                                           \
        cupd<0>(X[0], vbK, vB); cupd<1>(X[1], vbK, vB); cupd<2>(X[2], vbK, vB); cupd<3>(X[3], vbK, vB);                                                          \
        if (w == 4 || w == 5) { const int d = (w - 4) * 64 + lane; float acc = 0.f; const LAS unsigned char* kcol = L + boff + A_KP + ((d >> 5) * 512 + (d & 31) * 2); \
            _Pragma("unroll 1") for (int s8 = 0; s8 < 8; ++s8) {                                                                                                  \
                _Pragma("unroll") for (int e = 0; e < 8; ++e) acc += bf2f(*(const LAS bf16*)(kcol + s8 * 2048 + e * 64)); }                                       \
            nreg = s_old * nreg + acc; }                                                                                                                         \
        if ((cc) + 1 < NC - 1) { A_WRITE((cc) + 1, SN); if ((cc) + 4 < NC - 1) A_LOAD((cc) + 4, SN); }                                                           \
        MBAR(); } } } while (0)
    for (int c = 0; c < NC; c += 3) { A_ITER(c, S1); A_ITER(c + 1, S2); A_ITER(c + 2, S0); }
#undef A_ITER
#undef A_LOAD
#undef A_WRITE
}
__device__ __forceinline__ void p9b_output(Frame& F) {
    using namespace ml;
    constexpr int NC = T / 64, NITEMS = BATCH * MH * NC;
    LAS unsigned char* L = F.lds + RING_OFF;
    static_assert(ml::LDS_END_B <= RING_BYTES, "mLSTM pass B LDS");
    const int w = F.wave, tid = F.tid;
    LAS float* misc = (LAS float*)(L + MISC); LAS float* RSA = misc, * RSB = misc + 64, * QN = misc + 128;
    LAS float* pw = (LAS float*)(L + PW + w * PWB);
    const int lbase = (int)(uintptr_t)L;
    if (tid < 64) RSB[tid] = 0.f;
    f32x4 hg; { const float* gp = F.h_gain + 4 * F.lane; hg = (f32x4){gp[0], gp[1], gp[2], gp[3]}; }
    v4u sq0, sq1, sk0, sk1, sv00, sv01, sv10, sv11; float s_u, s_mm, s_sint, s_nrm; f32x2 s_n;
    LAS float* NBl = misc + 192;
#define B_LOAD(it_) do { const int bh_ = (it_) & 31, c_ = (it_) >> 5, b_ = bh_ / MH, h_ = bh_ % MH;                                                         \
        const bf16* rp0 = F.PROJ + ((size_t)b_ * T + (size_t)c_ * 64 + sr) * ML_N + sc; const bf16* rp1 = rp0 + 32 * ML_N;                                      \
        sq0 = *(const GAS v4u*)(rp0 + C_MQ + h_ * MDK); sq1 = *(const GAS v4u*)(rp1 + C_MQ + h_ * MDK); sk0 = *(const GAS v4u*)(rp0 + C_MK + h_ * MDK); sk1 = *(const GAS v4u*)(rp1 + C_MK + h_ * MDK);   \
        sv00 = *(const GAS v4u*)(rp0 + C_MV + h_ * MDV); sv01 = *(const GAS v4u*)(rp0 + C_MV + h_ * MDV + 128); sv10 = *(const GAS v4u*)(rp1 + C_MV + h_ * MDV); sv11 = *(const GAS v4u*)(rp1 + C_MV + h_ * MDV + 128); \
        const float* sp_ = F.SCAL + (size_t)bh_ * 4 * T + c_ * 64 + lane; s_u = sp_[0]; s_mm = sp_[T]; s_sint = sp_[2 * T]; s_nrm = sp_[3 * T];                                                \
        s_n = *(const GAS f32x2*)(F.NST + ((size_t)bh_ * NC + c_) * 128 + 2 * lane); } while (0)
#define B_WRITE() do { pw[lane] = s_u; pw[64 + lane] = s_mm; if (w == 3) *(LAS f32x2*)(NBl + 2 * lane) = s_n;                                                                                            \
        *(LAS v4u*)(L + QS + SW16(sr, sc * 2)) = sq0; *(LAS v4u*)(L + QS + SW16(32 + sr, sc * 2)) = sq1;                                                \
        *(LAS v4u*)(L + KS + SW16(sr, sc * 2)) = sk0; *(LAS v4u*)(L + KS + SW16(32 + sr, sc * 2)) = sk1;                                                \
        *(LAS v4u*)(L + VS + v_st(sr, sc)) = sv00; *(LAS v4u*)(L + VS + 16384 + v_st(sr, sc)) = sv01;                                                   \
        *(LAS v4u*)(L + VS + v_st(32 + sr, sc)) = sv10; *(LAS v4u*)(L + VS + 16384 + v_st(32 + sr, sc)) = sv11; } while (0)
    int it = F.vcu; if (it >= NITEMS) return;
    float c_sint, c_nrm;
    { const int lane = F.lane, sr = tid >> 4, sc = (tid & 15) * 8; B_LOAD(it); B_WRITE(); c_sint = s_sint; c_nrm = s_nrm; if (it + F.G < NITEMS) B_LOAD(it + F.G); }
    LDS_WAIT(); __syncthreads();
    for (; it < NITEMS; it += F.G) {
        const int bh = it & 31, c = it >> 5, b = bh / MH, h = bh % MH, t0 = c * 64; const size_t mb = (size_t)b * T;
        int lane_o = F.lane, tid_o = F.tid; asm volatile("" : "+v"(lane_o), "+v"(tid_o));
        const int lane = lane_o, r32 = lane & 31, hi = lane >> 5, sr = tid_o >> 4, sc = (tid_o & 15) * 8;
        const int vbV = lbase + VS + (w >> 2) * 16384 + (w & 3) * 512 + v_rd_base(lane);
        bf16x8 xb[4][2];
        { const bf16* st = F.ST + ((((size_t)bh * NC + c) * 8 + w) * 8) * 512 + lane * 8;
#pragma unroll
          for (int i = 0; i < 4; ++i) { xb[i][0] = __builtin_nontemporal_load((const GAS bf16x8*)(st + (i * 2 + 0) * 512)); xb[i][1] = __builtin_nontemporal_load((const GAS bf16x8*)(st + (i * 2 + 1) * 512)); } }
        if (w < 3) { const int lt = w ? 1 : 0, st = w == 2 ? 1 : 0; const int srow = r32 + 32 * st, lrow = r32 + 32 * lt;
            f32x16 p;
#pragma unroll
            for (int r = 0; r < 16; ++r) p[r] = 0.f;
#pragma unroll
            for (int kk = 0; kk < 8; ++kk) { const bf16x8 ka = *(const LAS bf16x8*)(L + KS + SW16(srow, (16 * kk + 8 * hi) * 2)), qb = *(const LAS bf16x8*)(L + QS + SW16(lrow, (16 * kk + 8 * hi) * 2));
                p = __builtin_amdgcn_mfma_f32_32x32x16_bf16(ka, qb, p, 0, 0, 0); }
            const float mml = pw[64 + lrow]; float ps = 0.f;
#pragma unroll
            for (int r = 0; r < 16; ++r) { const int s = crow(r, hi) + 32 * st; const float us = pw[s]; const float wgt = (s <= lrow) ? __expf(us - mml) : 0.f; p[r] *= wgt; ps += p[r]; }
            { auto rr = __builtin_amdgcn_permlane32_swap(__float_as_uint(ps), __float_as_uint(ps), false, false); ps = __uint_as_float(rr[0]) + __uint_as_float(rr[1]); }
            if (hi == 0) { if (st == 0) RSA[lrow] = ps; else RSB[lrow] = ps; }
            bf16x8 pa0, pa1;
#define PK4(P, BASE, OUT) do { unsigned a0 = cvtpk(P[BASE + 0], P[BASE + 1]), a1 = cvtpk(P[BASE + 2], P[BASE + 3]);   \
    unsigned b0 = cvtpk(P[BASE + 4], P[BASE + 5]), b1 = cvtpk(P[BASE + 6], P[BASE + 7]);                              \
    auto r0 = __builtin_amdgcn_permlane32_swap(a0, b0, false, false); auto r1 = __builtin_amdgcn_permlane32_swap(a1, b1, false, false); \
    v4u w_ = {r0[0], r1[0], r0[1], r1[1]}; OUT = *reinterpret_cast<bf16x8*>(&w_); } while (0)
            PK4(p, 0, pa0); PK4(p, 8, pa1);
#undef PK4
            *(LAS bf16x8*)(L + PF + (lt * 4 + 2 * st + 0) * 1024 + lane * 16) = pa0; *(LAS bf16x8*)(L + PF + (lt * 4 + 2 * st + 1) * 1024 + lane * 16) = pa1;
        } else if (w == 3) { const LAS float* nb = NBl; float acc = 0.f;
#pragma unroll 2
            for (int ch = 0; ch < 16; ++ch) { const v4u qv = *(const LAS v4u*)(L + QS + SW16(lane, ch * 16)); const f32x4 n0 = *(const LAS f32x4*)(nb + 8 * ch), n1 = *(const LAS f32x4*)(nb + 8 * ch + 4);
                acc += bflo(qv.x) * n0.x + bfhi(qv.x) * n0.y + bflo(qv.y) * n0.z + bfhi(qv.y) * n0.w + bflo(qv.z) * n1.x + bfhi(qv.z) * n1.y + bflo(qv.w) * n1.z + bfhi(qv.w) * n1.w; }
            QN[lane] = acc;
        }
        MBAR();
        { const float den = RSA[lane] + RSB[lane] + c_sint * QN[lane]; const float rinv = 1.f / fmaxf(fabsf(den), c_nrm); pw[192 + lane] = rinv; pw[256 + lane] = c_sint * rinv; }
        bf16x8 vB[4];
        { const s16x4 l0 = tr_read<0 * 4096>(vbV), h0 = tr_read<0 * 4096 + 2048>(vbV), l1 = tr_read<1 * 4096>(vbV), h1 = tr_read<1 * 4096 + 2048>(vbV);
          const s16x4 l2 = tr_read<2 * 4096>(vbV), h2 = tr_read<2 * 4096 + 2048>(vbV), l3 = tr_read<3 * 4096>(vbV), h3 = tr_read<3 * 4096 + 2048>(vbV);
          asm volatile("s_waitcnt lgkmcnt(0)" ::: "memory"); SBAR();
          vB[0] = pk88(l0, h0); vB[1] = pk88(l1, h1); vB[2] = pk88(l2, h2); vB[3] = pk88(l3, h3); }
        f32x16 aI0, aI1;
#pragma unroll
        for (int r = 0; r < 16; ++r) { aI0[r] = 0.f; aI1[r] = 0.f; }
        { const LAS unsigned char* qrow0 = L + QS + r32 * 256; const LAS unsigned char* qrow1 = qrow0 + 32 * 256; const int swz = (r32 & 15) << 4;
#define YI(I) do { yinter<I>(aI0, qrow0, swz, hi, xb[I][0], xb[I][1]); yinter<I>(aI1, qrow1, swz, hi, xb[I][0], xb[I][1]); } while (0)
          YI(0); YI(1); YI(2); YI(3);
#undef YI
        }
        v2u og[8];
#pragma unroll
        for (int e = 0; e < 8; ++e) og[e] = *(const GAS v2u*)(F.PROJ + (mb + t0 + 8 * w + e) * ML_N + C_MO + h * MDV + 4 * lane);
#pragma unroll
        for (int lt = 0; lt < 2; ++lt) { f32x16 aY;
#pragma unroll
            for (int r = 0; r < 16; ++r) aY[r] = 0.f;
            { const bf16x8 p0 = *(const LAS bf16x8*)(L + PF + (lt * 4 + 0) * 1024 + lane * 16), p1 = *(const LAS bf16x8*)(L + PF + (lt * 4 + 1) * 1024 + lane * 16);
              aY = __builtin_amdgcn_mfma_f32_32x32x16_bf16(p0, vB[0], aY, 0, 0, 0); aY = __builtin_amdgcn_mfma_f32_32x32x16_bf16(p1, vB[1], aY, 0, 0, 0); }
            if (lt == 1) { const bf16x8 p2 = *(const LAS bf16x8*)(L + PF + (4 + 2) * 1024 + lane * 16), p3 = *(const LAS bf16x8*)(L + PF + (4 + 3) * 1024 + lane * 16);
              aY = __builtin_amdgcn_mfma_f32_32x32x16_bf16(p2, vB[2], aY, 0, 0, 0); aY = __builtin_amdgcn_mfma_f32_32x32x16_bf16(p3, vB[3], aY, 0, 0, 0); }
#pragma unroll
            for (int r = 0; r < 16; ++r) { const int l = crow(r, hi) + 32 * lt; const float y = aY[r] * pw[192 + l] + (lt ? aI1[r] : aI0[r]) * pw[256 + l];
                *(LAS bf16*)(L + HS + l * HROW + (32 * w + r32) * 2) = (bf16)f2bf(y); }
        }
        MBAR();
#pragma unroll
        for (int e = 0; e < 8; ++e) { const int l = 8 * w + e; const v2u hv = *(const LAS v2u*)(L + HS + l * HROW + lane * 8);
            const float h0 = bflo(hv.x), h1 = bfhi(hv.x), h2 = bflo(hv.y), h3 = bfhi(hv.y);
            const float ss = wave_sum_dpp((h0 * h0 + h1 * h1) + (h2 * h2 + h3 * h3)); const float rn = __builtin_amdgcn_rsqf(ss * (1.f / MDV) + EPS);
            const float o0 = bflo(og[e].x), o1 = bfhi(og[e].x), o2 = bflo(og[e].y), o3 = bfhi(og[e].y);
            const float y0 = h0 * rn * hg.x / (1.f + __expf(-o0)), y1 = h1 * rn * hg.y / (1.f + __expf(-o1)), y2 = h2 * rn * hg.z / (1.f + __expf(-o2)), y3 = h3 * rn * hg.w / (1.f + __expf(-o3));
            v2u ov; ov.x = cvtpk(y0, y1); ov.y = cvtpk(y2, y3);
            *(GAS v2u*)(F.O + (mb + t0 + l) * DM + h * MDV + 4 * lane) = ov; }
        if (it + F.G < NITEMS) { B_WRITE(); c_sint = s_sint; c_nrm = s_nrm; if (it + 2 * F.G < NITEMS) B_LOAD(it + 2 * F.G); }
        MBAR();
    }
#undef B_LOAD
#undef B_WRITE
}
#undef SW16
#undef SBAR
#undef MBAR
namespace mlh {
constexpr int WREG = 12288, KIMG = 0, VIMG = 8192, XB0 = 8 * WREG, XBSZ = 16384 + 1024, WKO = XB0 + 2 * XBSZ, CHO = WKO + 8192, FLAGO = CHO + 1024, LDS_END = FLAGO + 64;
constexpr int TB = 0, TU = 8192, TM = 16384;
__device__ __forceinline__ int kh_st(int k, int c) { const int kk = (k & ~0xC) | ((k & 4) << 1) | ((k & 8) >> 1); return ((kk >> 3) * 2 + (c >> 5)) * 512 + ((kk & 7) * 32 + (c & 31)) * 2; }
__device__ __forceinline__ int vs_st(int k, int c) { const int kk = (k & ~0xC) | ((k & 4) << 1) | ((k & 8) >> 1); return (kk >> 3) * 512 + ((kk & 7) * 32 + c) * 2; }
using att::tr_read; using att::v_rd_base; using att::cvtpk; using ml::pk88; using ml::pack_acc8; using ml::wmul8; using ml::scan_sum64; using ml::scan_max64;
template <bool WITHN> __device__ __forceinline__ void dhalf(f32x16& D0, f32x16& D1, float& n0, float& n1, int vbK, const bf16x8 (&vB)[4]) {
    const bf16x8 ones = (bf16x8){0x3f80, 0x3f80, 0x3f80, 0x3f80, 0x3f80, 0x3f80, 0x3f80, 0x3f80};
    f32x16 N0, N1;
    if (WITHN) {
#pragma unroll
        for (int r = 0; r < 16; ++r) { N0[r] = 0.f; N1[r] = 0.f; } }
#define DH_STEP(KS) do { const s16x4 l0 = tr_read<0 * 512 + KS * 2048>(vbK), h0 = tr_read<0 * 512 + KS * 2048 + 1024>(vbK), l1 = tr_read<1 * 512 + KS * 2048>(vbK), h1 = tr_read<1 * 512 + KS * 2048 + 1024>(vbK); \
        asm volatile("s_waitcnt lgkmcnt(0)" ::: "memory"); __builtin_amdgcn_sched_barrier(0);                                                                           \
        const bf16x8 a0 = pk88(l0, h0), a1 = pk88(l1, h1);                                                                                                               \
        D0 = __builtin_amdgcn_mfma_f32_32x32x16_bf16(a0, vB[KS], D0, 0, 0, 0); D1 = __builtin_amdgcn_mfma_f32_32x32x16_bf16(a1, vB[KS], D1, 0, 0, 0);                      \
        if (WITHN) { N0 = __builtin_amdgcn_mfma_f32_32x32x16_bf16(ones, a0, N0, 0, 0, 0); N1 = __builtin_amdgcn_mfma_f32_32x32x16_bf16(ones, a1, N1, 0, 0, 0); } } while (0)
    DH_STEP(0); DH_STEP(1); DH_STEP(2); DH_STEP(3);
#undef DH_STEP
    if (WITHN) { n0 = N0[0]; n1 = N1[0]; }
}
}
template <bool WITHN> __device__ __forceinline__ void p10_chain(Frame& F, int bh, int js) {
    using namespace mlh;
    constexpr int NC = T / 64;
    LAS unsigned char* L = F.lds + RING_OFF;
    const int b = bh / MH, h = bh % MH, w = F.wave, lane = F.lane;
    const size_t mb = (size_t)b * T;
    LAS unsigned char* R = L + w * WREG;
    const LAS float* WKL = (const LAS float*)(L + WKO); const LAS float* CH = (const LAS float*)(L + CHO);
    volatile LAS unsigned* flag = (volatile LAS unsigned*)(L + FLAGO);
    const int lbase = (int)(uintptr_t)R;
    const int vbK = lbase + KIMG + v_rd_base(lane), vbV = lbase + VIMG + v_rd_base(lane);
    v4u ka[8], va[4];
    const int krow = lane >> 3, kc16 = lane & 7, vrow = lane >> 2, vc16 = lane & 3;
#define H_LOADK(cc, hh) do { const bf16* kp = F.PROJ + (mb + (size_t)(cc) * 64 + krow) * ML_N + C_MK + h * MDK + (hh) * 64 + 8 * kc16;                      \
        _Pragma("unroll") for (int e = 0; e < 8; ++e) ka[e] = *(const GAS v4u*)(kp + (size_t)(8 * e) * ML_N); } while (0)
#define H_LOADV(cc) do { const bf16* vp = F.PROJ + (mb + (size_t)(cc) * 64 + vrow) * ML_N + C_MV + h * MDV + js * 32 + 8 * vc16;                           \
        _Pragma("unroll") for (int e = 0; e < 4; ++e) va[e] = *(const GAS v4u*)(vp + (size_t)(16 * e) * ML_N); } while (0)
#define H_WRITEK(cc) do { _Pragma("unroll") for (int e = 0; e < 8; ++e) { const int s = 8 * e + krow; *(LAS v4u*)(R + KIMG + kh_st(s, 8 * kc16)) = wmul8(ka[e], WKL[(cc) * 64 + s]); } } while (0)
#define H_WRITEV() do { _Pragma("unroll") for (int e = 0; e < 4; ++e) { const int s = 16 * e + vrow; *(LAS v4u*)(R + VIMG + vs_st(s, 8 * vc16)) = va[e]; } } while (0)
    f32x16 D[4]; float dn[4] = {0.f, 0.f, 0.f, 0.f};
    if (w < NC - 1) { H_LOADK(w, 0); H_LOADV(w); }
#pragma unroll 1
    for (int r = 0; r < NC / 8; ++r) { const int c = w + 8 * r;
        if (c < NC - 1) {
#pragma unroll
            for (int i = 0; i < 4; ++i)
#pragma unroll
                for (int q = 0; q < 16; ++q) D[i][q] = 0.f;
            H_WRITEK(c); H_WRITEV(); H_LOADK(c, 1);
            bf16x8 vB[4];
            { const s16x4 l0 = tr_read<0 * 1024>(vbV), h0 = tr_read<0 * 1024 + 512>(vbV), l1 = tr_read<1 * 1024>(vbV), h1 = tr_read<1 * 1024 + 512>(vbV);
              const s16x4 l2 = tr_read<2 * 1024>(vbV), h2 = tr_read<2 * 1024 + 512>(vbV), l3 = tr_read<3 * 1024>(vbV), h3 = tr_read<3 * 1024 + 512>(vbV);
              asm volatile("s_waitcnt lgkmcnt(0)" ::: "memory"); __builtin_amdgcn_sched_barrier(0);
              vB[0] = pk88(l0, h0); vB[1] = pk88(l1, h1); vB[2] = pk88(l2, h2); vB[3] = pk88(l3, h3); }
            dhalf<WITHN>(D[0], D[1], dn[0], dn[1], vbK, vB);
            H_WRITEK(c);
            if (c + 8 < NC - 1) { H_LOADK(c + 8, 0); }
            dhalf<WITHN>(D[2], D[3], dn[2], dn[3], vbK, vB);
            if (c + 8 < NC - 1) { H_LOADV(c + 8); }
        }
        f32x16 X[4]; float nn[4] = {0.f, 0.f, 0.f, 0.f};
        if (c > 0) { while (*flag < (unsigned)c) __builtin_amdgcn_s_sleep(1);
            asm volatile("" ::: "memory");
            const LAS unsigned char* xb = L + XB0 + (c & 1) * XBSZ;
#pragma unroll
            for (int i = 0; i < 4; ++i)
#pragma unroll
                for (int q = 0; q < 4; ++q) { const f32x4 v = *(const LAS f32x4*)(xb + ((i * 4 + q) * 64 + lane) * 16); X[i][4 * q] = v.x; X[i][4 * q + 1] = v.y; X[i][4 * q + 2] = v.z; X[i][4 * q + 3] = v.w; }
            if (WITHN) {
#pragma unroll
                for (int i = 0; i < 4; ++i) nn[i] = *(const LAS float*)(xb + 16384 + (i * 32 + (lane & 31)) * 4); }
        } else {
#pragma unroll
            for (int i = 0; i < 4; ++i)
#pragma unroll
                for (int q = 0; q < 16; ++q) X[i][q] = 0.f;
        }
        { bf16* st = F.ST + ((((size_t)bh * NC + c) * 8 + js) * 8) * 512 + lane * 8;
#pragma unroll
          for (int i = 0; i < 4; ++i) { *(GAS bf16x8*)(st + (i * 2 + 0) * 512) = pack_acc8(X[i], 0); *(GAS bf16x8*)(st + (i * 2 + 1) * 512) = pack_acc8(X[i], 8); }
          if (WITHN && lane < 32) {
#pragma unroll
              for (int i = 0; i < 4; ++i) F.NST[((size_t)bh * NC + c) * 128 + i * 32 + lane] = nn[i]; } }
        if (c < NC - 1) { const float s_old = CH[96 + c]; LAS unsigned char* xo = L + XB0 + ((c + 1) & 1) * XBSZ;
#pragma unroll
            for (int i = 0; i < 4; ++i)
#pragma unroll
                for (int q = 0; q < 4; ++q) { f32x4 v; v.x = s_old * X[i][4 * q] + D[i][4 * q]; v.y = s_old * X[i][4 * q + 1] + D[i][4 * q + 1]; v.z = s_old * X[i][4 * q + 2] + D[i][4 * q + 2]; v.w = s_old * X[i][4 * q + 3] + D[i][4 * q + 3];
                    *(LAS f32x4*)(xo + ((i * 4 + q) * 64 + lane) * 16) = v; }
            if (WITHN && lane < 32) {
#pragma unroll
                for (int i = 0; i < 4; ++i) *(LAS float*)(xo + 16384 + (i * 32 + lane) * 4) = s_old * nn[i] + dn[i]; }
            asm volatile("s_waitcnt lgkmcnt(0)" ::: "memory");
            if (lane == 0) *flag = (unsigned)(c + 1);
        }
    }
#undef H_LOADK
#undef H_LOADV
#undef H_WRITEK
#undef H_WRITEV
}
__device__ __forceinline__ void p10_state_chain(Frame& F) {
    using namespace mlh;
    constexpr int NC = T / 64;
    static_assert(mlh::LDS_END <= RING_BYTES, "mLSTM chain LDS");
    LAS unsigned char* L = F.lds + RING_OFF;
    for (int it = F.vcu; it < BATCH * MH * 8; it += F.G) { const int bh = it >> 3, js = it & 7, w = F.wave, tid = F.tid;
        LAS float* WKL = (LAS float*)(L + WKO); LAS float* BL = (LAS float*)(L + TB); LAS float* UL = (LAS float*)(L + TU); LAS float* MLs = (LAS float*)(L + TM); LAS float* CH = (LAS float*)(L + CHO);
        const float* igp = F.IG + (size_t)bh * T; const float* lfp = F.LF + (size_t)bh * T;
        if (tid == 0) *(LAS unsigned*)(L + FLAGO) = 0u;
#pragma unroll
        for (int cc = 0; cc < 4; ++cc) { const int c = 4 * w + cc, t = c * 64 + F.lane; const float ig = igp[t], lf = lfp[t];
            const float bb = scan_sum64(lf), u = ig - bb, Mx = scan_max64(u);
            BL[t] = bb; UL[t] = u; MLs[t] = Mx; if (F.lane == 63) { CH[c] = bb; CH[32 + c] = Mx; } }
        LDS_WAIT(); __syncthreads();
        if (tid == 0) { float m = 0.f; for (int c = 0; c < NC; ++c) { const float mm63 = fmaxf(m, CH[32 + c]); CH[64 + c] = m; CH[96 + c] = __expf(m - mm63); CH[128 + c] = mm63; m = CH[c] + mm63; } }
        LDS_WAIT(); __syncthreads();
        { float* scal = F.SCAL + (size_t)bh * 4 * T;
          for (int t = tid; t < T; t += NTHR) { const int c = t >> 6; const float mst = CH[64 + c], mm = fmaxf(mst, MLs[t]), u = UL[t];
              if (js == 0) { scal[t] = u; scal[T + t] = mm; scal[2 * T + t] = __expf(mst - mm); scal[3 * T + t] = __expf(-(BL[t] + mm)); }
              WKL[t] = __expf(u - CH[128 + c]); } }
        LDS_WAIT(); __syncthreads();
        if (js == 0) p10_chain<true>(F, bh, js); else p10_chain<false>(F, bh, js);
        LDS_WAIT(); __syncthreads();
    }
}
#if ORA_IDX
__global__ __launch_bounds__(256) void ora_indexer(const bf16* QI, const bf16* KI, const float* WI, u64* MASK) {
    __shared__ float qi[1024]; __shared__ float sc[2048]; __shared__ float wi[16]; __shared__ unsigned cnt;
    const int m = blockIdx.x, b = m / T, t = m % T, tid = threadIdx.x;
    for (int i = tid; i < 1024; i += 256) qi[i] = bf2f(QI[(size_t)m * 1024 + i]);
    if (tid < 16) wi[tid] = WI[(size_t)m * 16 + tid];
    __syncthreads();
    for (int s = tid; s < T; s += 256) { float v = -__builtin_inff();
        if (s <= t) { float kk[64]; const v4u* kp = (const v4u*)(KI + (size_t)(b * T + s) * 64);
#pragma unroll
            for (int j = 0; j < 8; ++j) unpack8(kp[j], kk + 8 * j);
            v = 0.f;
            for (int h = 0; h < 16; ++h) { float d = 0.f;
#pragma unroll
                for (int e = 0; e < 64; ++e) d += qi[h * 64 + e] * kk[e];
                v += wi[h] * fmaxf(d, 0.f); } }
        sc[s] = v; }
    __syncthreads();
    unsigned k[8];
#pragma unroll
    for (int j = 0; j < 8; ++j) k[j] = fkey(sc[tid + 256 * j]);
    unsigned P = 0;
    for (int bit = 31; bit >= 0; --bit) { const unsigned cand = P | (1u << bit); unsigned c = 0;
#pragma unroll
        for (int j = 0; j < 8; ++j) c += (k[j] >= cand) ? 1u : 0u;
        if (tid == 0) cnt = 0; __syncthreads(); atomicAdd(&cnt, c); __syncthreads(); if (cnt >= (unsigned)TOPK) P = cand; __syncthreads(); }
    if (tid < 32) { u64 w = 0; for (int e = 0; e < 64; ++e) { const int s = 64 * tid + e; if (s <= t && fkey(sc[s]) >= P) w |= (1ull << e); } MASK[(size_t)m * 32 + tid] = w; }
}
#endif
#if ORA_ATT
__global__ __launch_bounds__(128) void ora_attn(const bf16* Q, const bf16* K, const bf16* V, const u64* MASK, bf16* O) {
    __shared__ float q[4][128]; __shared__ int idx[320]; __shared__ float p[4][320]; __shared__ int cnts[128]; __shared__ int total; __shared__ float linv[4];
    const int m = blockIdx.x >> 2, g = blockIdx.x & 3, b = m / T, tid = threadIdx.x;
    for (int r = 0; r < 4; ++r) q[r][tid] = bf2f(Q[(size_t)m * DM + (g * 4 + r) * HD + tid]);
    const unsigned bits = (unsigned)(MASK[(size_t)m * 32 + (tid >> 2)] >> (16 * (tid & 3))) & 0xffffu;
    cnts[tid] = __builtin_popcount(bits); __syncthreads();
    if (tid == 0) { int a = 0; for (int i = 0; i < 128; ++i) { const int c = cnts[i]; cnts[i] = a; a += c; } total = a; }
    __syncthreads();
    { int o = cnts[tid]; for (int e = 0; e < 16; ++e) if ((bits >> e) & 1u) { if (o < 320) idx[o] = 16 * tid + e; ++o; } }
    __syncthreads();
    const int n = total < 320 ? total : 320;
    for (int j = tid; j < n; j += 128) { const bf16* kr = K + (size_t)(b * T + idx[j]) * 512 + g * HD; float d0 = 0, d1 = 0, d2 = 0, d3 = 0;
        for (int e = 0; e < 128; ++e) { const float kv = bf2f(kr[e]); d0 += q[0][e] * kv; d1 += q[1][e] * kv; d2 += q[2][e] * kv; d3 += q[3][e] * kv; }
        const float sc = 0.08838834764831845f; p[0][j] = d0 * sc; p[1][j] = d1 * sc; p[2][j] = d2 * sc; p[3][j] = d3 * sc; }
    __syncthreads();
    if (tid < 4) { float mx = -__builtin_inff(); for (int j = 0; j < n; ++j) mx = fmaxf(mx, p[tid][j]); float s = 0.f; for (int j = 0; j < n; ++j) { const float e = expf(p[tid][j] - mx); p[tid][j] = e; s += e; } linv[tid] = 1.f / s; }
    __syncthreads();
    float o0 = 0, o1 = 0, o2 = 0, o3 = 0;
    for (int j = 0; j < n; ++j) { const float v = bf2f(V[(size_t)(b * T + idx[j]) * 512 + g * HD + tid]); o0 += p[0][j] * v; o1 += p[1][j] * v; o2 += p[2][j] * v; o3 += p[3][j] * v; }
    bf16* op = O + (size_t)m * DM + g * 4 * HD + tid;
    op[0] = (bf16)f2bf(o0 * linv[0]); op[HD] = (bf16)f2bf(o1 * linv[1]); op[2 * HD] = (bf16)f2bf(o2 * linv[2]); op[3 * HD] = (bf16)f2bf(o3 * linv[3]);
}
#endif
#if ORA_ML
__global__ __launch_bounds__(256) void ora_mlstm(const bf16* PROJ, const float* IG, const float* LF, const float* hgain, bf16* A2) {
    __shared__ float qs[128], ks[128], pr[128], red[4];
    const int b = blockIdx.x / MH, h = blockIdx.x % MH, e = threadIdx.x;
    float C[128]; float nd = 0.f, mst = 0.f;
#pragma unroll
    for (int d = 0; d < 128; ++d) C[d] = 0.f;
    const float hg = hgain[e];
    for (int t = 0; t < T; ++t) { const size_t m = (size_t)b * T + t; const bf16* row = PROJ + m * ML_N;
        const float ig = IG[(size_t)(b * MH + h) * T + t], lf = LF[(size_t)(b * MH + h) * T + t];
        const float mn = fmaxf(lf + mst, ig), fo = expf(lf + mst - mn), io = expf(ig - mn);
        if (e < 128) { const float qv = bf2f(row[C_MQ + h * MDK + e]), kv = bf2f(row[C_MK + h * MDK + e]); nd = fo * nd + io * kv; qs[e] = qv; ks[e] = kv; pr[e] = qv * nd; }
        __syncthreads();
        const float v = bf2f(row[C_MV + h * MDV + e]); float num = 0.f, den = 0.f;
#pragma unroll
        for (int d = 0; d < 128; ++d) { C[d] = fo * C[d] + io * ks[d] * v; num += qs[d] * C[d]; den += pr[d]; }
        const float hv = num / fmaxf(fabsf(den), expf(-mn));
        float s2 = wave_sum(hv * hv); if ((e & 63) == 0) red[e >> 6] = s2;
        __syncthreads();
        const float ssq = (red[0] + red[1]) + (red[2] + red[3]); const float rn = __builtin_amdgcn_rsqf(ssq * (1.f / MDV) + EPS);
        const float og = bf2f(row[C_MO + h * MDV + e]); const float sg = 1.f / (1.f + expf(-og));
        A2[m * DM + h * MDV + e] = (bf16)f2bf(sg * hv * rn * hg);
        mst = mn;
        __syncthreads();
    }
}
#endif
__global__ void __launch_bounds__(NTHR, 2) mk_fwd(Args args) {
    extern __shared__ __attribute__((aligned(16))) unsigned char lds[];
    Frame F;
    F.lds = (LAS unsigned char*)lds;
    F.MISC = (volatile LAS unsigned*)(F.lds + MISC_OFF);
    F.tid = threadIdx.x; F.lane = F.tid & 63; F.wave = __builtin_amdgcn_readfirstlane(F.tid >> 6);
    F.G = gridDim.x; { const int bx = blockIdx.x; F.vcu = (F.G % 8 == 0) ? (bx % 8) * (F.G / 8) + bx / 8 : bx; }
    unsigned char* ws = args.ws;
    F.ctl = (gu32*)(ws + WS_CTL);
    F.x = args.in[0]; F.norm_mix = args.in[1]; F.norm_ffn = args.in[2]; F.att_w_in = args.in[3]; F.q_gain = args.in[4]; F.k_gain = args.in[5]; F.att_w_out = args.in[6];
    F.ml_w_in = args.in[7]; F.b_gate = args.in[8]; F.h_gain = args.in[9]; F.ml_w_out = args.in[10]; F.w_up = args.in[11]; F.w_dn = args.in[12]; F.out = args.out;
    F.WinT = (bf16*)(ws + WS_WIN); F.WsmT = (bf16*)(ws + WS_WSM); F.WoT = (bf16*)(ws + WS_WO); F.WmlT = (bf16*)(ws + WS_WML); F.WgT = (bf16*)(ws + WS_WG); F.WmoT = (bf16*)(ws + WS_WMO);
    F.WupT0 = (bf16*)(ws + WS_WUP0); F.WupT1 = (bf16*)(ws + WS_WUP1); F.WdnT0 = (bf16*)(ws + WS_WDN0); F.WdnT1 = (bf16*)(ws + WS_WDN1);
    F.XB = (bf16*)(ws + WS_XB); F.PROJ = (bf16*)(ws + WS_PROJ); F.Q = (bf16*)(ws + WS_Q); F.K = (bf16*)(ws + WS_K); F.V = (bf16*)(ws + WS_V); F.QI = (bf16*)(ws + WS_QI); F.KI = (bf16*)(ws + WS_KI);
    F.O = (bf16*)(ws + WS_O); F.H = (bf16*)(ws + WS_H); F.WI = (float*)(ws + WS_WI); F.IG = (float*)(ws + WS_GATE); F.LF = (float*)(ws + WS_GATE + 512 * 1024); F.SC = (float*)(ws + WS_SC); F.ST = (bf16*)(ws + WS_SC); F.NST = (float*)(ws + WS_ML); F.SCAL = (float*)(ws + WS_ML + MiB);
    F.ROPE_A = (f32x2*)(ws + WS_ROPE); F.ROPE_I = (f32x2*)(ws + WS_ROPE + 512 * 1024); F.MASK = (u64*)(ws + WS_MASK);
    F.ss0 = (float*)(ws + WS_CTL) + CW_SS; F.ss1 = F.ss0 + M; F.ss2 = F.ss1 + M; F.ss3 = F.ss2 + M;
    for (int u = F.tid; u < (LDS_BYTES - LDSCTL_OFF) / 4; u += NTHR) ((LAS unsigned*)(F.lds + LDSCTL_OFF))[u] = 0u;
    __syncthreads();
    XcdBarrier bar; bar.bar = (unsigned*)(F.ctl + CW_BAR); bar.x = 0; bar.st = nullptr;
    if (!MK_MULTI) bar = xcd_barrier_post((unsigned*)(F.ctl + CW_BAR), F.MISC + 8);
    const int lo = args.ph_lo, hi = args.ph_hi;
#ifdef ONLY_PHASE
#define IN(k) ((k) == ONLY_PHASE && lo <= (k) && (k) < hi)
#else
#define IN(k) (lo <= (k) && (k) < hi)
#endif
#define SEAM(k) do { if (IN(k) && IN((k) + 1)) xcd_barrier(bar); } while (0)
#ifndef PROBE_DBL
#define PROBE_DBL (-1)
#endif
#define REPS(k) for (int rep_ = (F.tid = opaque_tid(), F.lane = F.tid & 63, 0); rep_ < ((k) == PROBE_DBL ? 2 : 1); ++rep_, ((k) == PROBE_DBL && rep_ == 1 ? xcd_barrier(bar) : (void)0))
#define DUMMY(k) ((k) == PROBE_DBL && rep_ == 0)
    float* const dummy_out = (float*)(ws + WS_SC);
    if (IN(0)) REPS(0) { p0_prologue(F); } SEAM(0);
    if (IN(1)) REPS(1) { pg8::Gemm g{F.XB, F.WinT, M, ATT_N, DM}; pg8::StaticOrder S; S.init(M, ATT_N, F.G, (int)blockIdx.x);
        pg8::EpiScale<0> E{F.PROJ, ATT_N, F.ss0, 1.f / DM, EPS};
        pg8::gemm_phase<pg8::EpiScale<0>, pg8::StaticOrder, PG8_ALIGN, PG8_SP2>(F.lds + RING_OFF, g, S, E);
        skinny_att(F);
#ifdef PROBE_SK
        xcd_barrier(bar); skinny_att(F);
#endif
        } SEAM(1);
#if IDX_FUSED
    if (IN(3)) REPS(3) {
#if !ORA_IDX
        p3_fused(F);
#endif
    } SEAM(3);
#else
    if (IN(3)) REPS(3) {
#if !ORA_IDX
        p3a_scores(F);
#ifdef PROBE_P3ABL
        xcd_barrier(bar); p3a_scores<PROBE_P3ABL>(F);
#endif
#endif
    } SEAM(3);
    if (IN(4)) REPS(4) {
#if !ORA_IDX
        p3b_select(F);
#endif
    } SEAM(4);
#endif
#ifdef PROBE_BAR
    if (IN(5)) { for (int q = 0; q < 10; ++q) xcd_barrier(bar); }
#endif
    if (IN(5)) REPS(5) {
#if !ORA_ATT
        p4_attention(F, (char*)lds + RING_OFF);
#endif
    } SEAM(5);
    if (IN(6)) REPS(6) { pg8::Gemm g{F.O, F.WoT, M, DM, DM}; pg8::StaticOrder S; S.init(M, DM, F.G, (int)blockIdx.x);
        pg8::EpiRes E{F.XB, DUMMY(6) ? (bf16*)dummy_out : F.XB, nullptr, DUMMY(6) ? F.ss0 + 4 * M : F.ss1, DM};
        pg8::gemm_phase<pg8::EpiRes, pg8::StaticOrder, PG8_ALIGN, PG8_SP2>(F.lds + RING_OFF, g, S, E); } SEAM(6);
#ifdef PROBE_NULLEPI
    if (IN(PROBE_NULLEPI)) { xcd_barrier(bar);
#ifndef PROBE_NULLK
#define PROBE_NULLK DM
#endif
        if (PROBE_NULLEPI == 7) { pg8::Gemm g{F.XB, F.WupT0, M, FF, PROBE_NULLK}; pg8::StaticOrder S; S.init(M, FF, F.G, (int)blockIdx.x); pg8::EpiNull E{}; pg8::gemm_phase<pg8::EpiNull, pg8::StaticOrder, PG8_ALIGN, PG8_SP2>(F.lds + RING_OFF, g, S, E); }
        if (PROBE_NULLEPI == 8) { pg8::Gemm g{F.H, F.WdnT0, M, DM, FF}; pg8::StaticOrder S; S.init(M, DM, F.G, (int)blockIdx.x); pg8::EpiNull E{}; pg8::gemm_phase<pg8::EpiNull, pg8::StaticOrder, PG8_ALIGN, PG8_SP2>(F.lds + RING_OFF, g, S, E); }
        xcd_barrier(bar); }
#endif
    if (IN(7)) REPS(7) { pg8::Gemm g{F.XB, F.WupT0, M, FF, DM}; pg8::StaticOrder S; S.init(M, FF, F.G, (int)blockIdx.x);
        pg8::EpiScale<1> E{F.H, FF, F.ss1, 1.f / DM, EPS};
        pg8::gemm_phase<pg8::EpiScale<1>, pg8::StaticOrder, PG8_ALIGN, PG8_SP2>(F.lds + RING_OFF, g, S, E); } SEAM(7);
    if (IN(8)) REPS(8) { pg8::Gemm g{F.H, F.WdnT0, M, DM, FF}; pg8::StaticOrder S; S.init(M, DM, F.G, (int)blockIdx.x);
        pg8::EpiRes E{F.XB, DUMMY(8) ? (bf16*)dummy_out : F.XB, nullptr, DUMMY(8) ? F.ss0 + 4 * M : F.ss2, DM};
        pg8::gemm_phase<pg8::EpiRes, pg8::StaticOrder, PG8_ALIGN, PG8_SP2>(F.lds + RING_OFF, g, S, E); } SEAM(8);
    if (IN(9)) REPS(9) { pg8::Gemm g{F.XB, F.WmlT, M, ML_N, DM}; pg8::StaticOrder S; S.init(M, ML_N, F.G, (int)blockIdx.x);
        pg8::EpiScale<0> E{F.PROJ, ML_N, F.ss2, 1.f / DM, EPS};
        pg8::gemm_phase<pg8::EpiScale<0>, pg8::StaticOrder, PG8_ALIGN, PG8_SP2>(F.lds + RING_OFF, g, S, E);
        skinny_gates(F); } SEAM(9);
    if (IN(10)) REPS(10) {
#if !ORA_ML
#if ML_CHAIN
        p10_state_chain(F);
#else
        p9a_state<0>(F);
#endif
#ifdef PROBE_SUB
        xcd_barrier(bar); p9a_state<PROBE_SUB>(F);
#endif
#endif
    } SEAM(10);
    if (IN(11)) REPS(11) {
#if !ORA_ML
        p9b_output(F);
#endif
    } SEAM(11);
    if (IN(12)) REPS(12) { pg8::Gemm g{F.O, F.WmoT, M, DM, DM}; pg8::StaticOrder S; S.init(M, DM, F.G, (int)blockIdx.x);
        pg8::EpiRes E{F.XB, DUMMY(12) ? (bf16*)dummy_out : F.XB, nullptr, DUMMY(12) ? F.ss0 + 4 * M : F.ss3, DM};
        pg8::gemm_phase<pg8::EpiRes, pg8::StaticOrder, PG8_ALIGN, PG8_SP2>(F.lds + RING_OFF, g, S, E); } SEAM(12);
    if (IN(13)) REPS(13) { pg8::Gemm g{F.XB, F.WupT1, M, FF, DM}; pg8::StaticOrder S; S.init(M, FF, F.G, (int)blockIdx.x);
        pg8::EpiScale<1> E{F.H, FF, F.ss3, 1.f / DM, EPS};
        pg8::gemm_phase<pg8::EpiScale<1>, pg8::StaticOrder, PG8_ALIGN, PG8_SP2>(F.lds + RING_OFF, g, S, E); } SEAM(13);
    if (IN(14)) REPS(14) { pg8::Gemm g{F.H, F.WdnT1, M, DM, FF}; pg8::StaticOrder S; S.init(M, DM, F.G, (int)blockIdx.x);
        pg8::EpiRes E{F.XB, nullptr, DUMMY(14) ? dummy_out : F.out, nullptr, DM};
        pg8::gemm_phase<pg8::EpiRes, pg8::StaticOrder, PG8_ALIGN, PG8_SP2>(F.lds + RING_OFF, g, S, E); }
#undef IN
#undef SEAM
}

extern "C" void kernel_launch(void* const* d_in, const int* in_sizes, int n_in, void* d_out, int out_size, void* d_ws, size_t ws_size, hipStream_t stream) {
    static int grid = 0;
    if (grid == 0) {
        if (n_in != 13 || in_sizes[0] != M * DM || out_size != M * DM || ws_size < WS_END) { fprintf(stderr, "kernel_launch: shape/workspace mismatch (n_in %d, in0 %d, out %d, ws %zu, need %zu)\n", n_in, n_in > 0 ? in_sizes[0] : -1, out_size, ws_size, (size_t)WS_END); grid = -1; return; }
        int dev = 0, cus = 0, per_cu = 0;
        if (hipGetDevice(&dev) != hipSuccess || hipDeviceGetAttribute(&cus, hipDeviceAttributeMultiprocessorCount, dev) != hipSuccess) { grid = -1; return; }
        if (hipFuncSetAttribute((const void*)mk_fwd, hipFuncAttributeMaxDynamicSharedMemorySize, LDS_BYTES) != hipSuccess) { fprintf(stderr, "kernel_launch: hipFuncSetAttribute failed\n"); grid = -1; return; }
        if (hipOccupancyMaxActiveBlocksPerMultiprocessor(&per_cu, (const void*)mk_fwd, NTHR, LDS_BYTES) != hipSuccess || per_cu < 1) fprintf(stderr, "kernel_launch: occupancy query reports %d blocks per CU\n", per_cu);
        (void)hipGetLastError();
        grid = cus;
    }
    if (grid < 0) return;
    if (hipMemsetAsync((char*)d_ws + WS_CTL, 0, CTL_ZERO_BYTES, stream) != hipSuccess) { fprintf(stderr, "kernel_launch: memset failed\n"); return; }
    Args a{};
    for (int i = 0; i < 13; ++i) a.in[i] = (const float*)d_in[i];
    a.out = (float*)d_out; a.ws = (unsigned char*)d_ws;
#if MK_MULTI
    unsigned char* ws = (unsigned char*)d_ws;
    for (int p = 0; p < N_PHASES; ++p) {
        if (p == 4 && ORA_IDX) continue;
        if (p == 3 && ORA_IDX) {
#if ORA_IDX
            hipLaunchKernelGGL(ora_indexer, dim3(M), dim3(256), 0, stream, (const bf16*)(ws + WS_QI), (const bf16*)(ws + WS_KI), (const float*)(ws + WS_WI), (u64*)(ws + WS_MASK));
#endif
            continue; }
        if (p == 5 && ORA_ATT) {
#if ORA_ATT
            hipLaunchKernelGGL(ora_attn, dim3(M * 4), dim3(128), 0, stream, (const bf16*)(ws + WS_Q), (const bf16*)(ws + WS_K), (const bf16*)(ws + WS_V), (const u64*)(ws + WS_MASK), (bf16*)(ws + WS_O));
#endif
            continue; }
        if (p == 11 && ORA_ML) continue;
        if (p == 10 && ORA_ML) {
#if ORA_ML
            hipLaunchKernelGGL(ora_mlstm, dim3(BATCH * MH), dim3(256), 0, stream, (const bf16*)(ws + WS_PROJ), (const float*)(ws + WS_GATE), (const float*)(ws + WS_GATE + 512 * 1024), (const float*)d_in[9], (bf16*)(ws + WS_O));
#endif
            continue; }
        a.ph_lo = p; a.ph_hi = p + 1; a.li = p;
        hipLaunchKernelGGL(mk_fwd, dim3(grid), dim3(NTHR), LDS_BYTES, stream, a);
    }
#else
    a.ph_lo = 0; a.ph_hi = N_PHASES; a.li = 0;
    hipLaunchKernelGGL(mk_fwd, dim3(grid), dim3(NTHR), LDS_BYTES, stream, a);
#endif
    const hipError_t le = hipPeekAtLastError();
    if (le != hipSuccess) fprintf(stderr, "kernel_launch: launch failed: %s\n", hipGetErrorName(le));
}
```

```cpp
#ifndef MK_MULTI
#define MK_MULTI 0
#endif
#ifndef ORA_IDX
#define ORA_IDX 0
#endif
#ifndef ORA_ATT
#define ORA_ATT 0
#endif
#ifndef ORA_ML
#define ORA_ML 0
#endif
#ifndef PROBE_DBL
#define PROBE_DBL (-1)
#endif
#include <hip/hip_runtime.h>
#include <cstdio>
#include <cstdint>
#include <cmath>
__device__ __forceinline__ int opaque_tid() { int t = threadIdx.x; asm volatile("" : "+v"(t)); return t; }
namespace pg8 {
#define PG8_LAS __attribute__((address_space(3)))
typedef unsigned short bf16_t;
typedef short bf16x8 __attribute__((ext_vector_type(8)));
typedef float f32x4 __attribute__((ext_vector_type(4)));
typedef unsigned u32x4 __attribute__((ext_vector_type(4)));
constexpr int BM = 256, BK = 64, HALF = 128, HTB = HALF * BK * 2  , STAGE_BYTES = 8 * HTB, NXCD = 8, WGM = 2;

__host__ __device__ __forceinline__ int lds_byte(int r, int c) { const int st = (r >> 4) * 2 + (c >> 5), rr = r & 15, cc = c & 31, ob = rr * 64 + cc * 2; return st * 1024 + (ob ^ (((ob >> 9) & 1) << 5)); }
__host__ __device__ __forceinline__ void stage_rc(int b, int& R, int& C) { const int st = b / 1024, sb = b % 1024, swz = sb ^ (((sb >> 9) & 1) << 5); R = (st >> 1) * 16 + swz / 64; C = (st & 1) * 32 + (swz % 64) / 2; }
__host__ __device__ __forceinline__ int perm32(int rho) { const int n = rho >> 4, i = rho & 15; return 8 * (i >> 2) + 4 * n + (i & 3); }

struct Unit { int pm, pn; };
struct Gemm { const bf16_t* A; const bf16_t* Bt; int M, N, K; };

struct StaticOrder {
    int nM, nN, nwg, G, c;
    __host__ __device__ void init(int M, int N, int G_, int c_) { nM = M / BM; nN = N / BM; nwg = nM * nN; G = G_; c = c_; }
    __host__ __device__ bool next(int i, Unit& u) const {
        const long L = (long)i * G + c; if (L >= nwg) return false;
        int wgid = (int)L; { const int q = nwg / NXCD, r = nwg % NXCD, xcd = wgid % NXCD, off = wgid / NXCD; wgid = (xcd < r ? xcd * (q + 1) : r * (q + 1) + (xcd - r) * q) + off; }
        const int nig = WGM * nN, gid = wgid / nig, fm = gid * WGM, gsz = (nM - fm) < WGM ? (nM - fm) : WGM;
        u.pm = fm + ((wgid % nig) % gsz); u.pn = (wgid % nig) / gsz; return true;
    }
    __device__ __forceinline__ void a_ready(const Unit&) const {}
    __device__ __forceinline__ void done(const Unit&) const {}
};

__device__ __forceinline__ unsigned cvt_pk_bf16(float lo, float hi) { unsigned r; asm volatile("v_cvt_pk_bf16_f32 %0, %1, %2" : "=v"(r) : "v"(lo), "v"(hi)); return r; }
typedef float f32x2 __attribute__((ext_vector_type(2)));
typedef unsigned u32x2 __attribute__((ext_vector_type(2)));
template <int MODE> struct EpiScale {
    static constexpr bool PERM = true, AFTER_DRAIN = false;
    bf16_t* O; int ldc; const float* ss; float inv_n, eps;
    __device__ __forceinline__ void operator()(const f32x4 (&acc)[2][2][4][2], const Unit& u, int wr, int wc, int fr, int fq) const {
        const int row0 = u.pm * BM + wr * 64 + fr, col0 = u.pn * BM + wc * 64 + 8 * fq;
#pragma unroll
        for (int ai = 0; ai < 2; ++ai)
#pragma unroll
            for (int m = 0; m < 4; ++m) { const int row = row0 + ai * HALF + m * 16; const float rs = __builtin_amdgcn_rsqf(ss[row] * inv_n + eps); const float rs2 = rs * rs;
                bf16_t* rowp = O + (size_t)row * ldc + col0;
#pragma unroll
                for (int bj = 0; bj < 2; ++bj) { f32x4 v0 = acc[ai][bj][m][0], v1 = acc[ai][bj][m][1];
                    if (MODE == 0) { v0 = v0 * rs; v1 = v1 * rs; }
                    else { v0 = __builtin_elementwise_max(v0, (f32x4){0.f, 0.f, 0.f, 0.f}); v1 = __builtin_elementwise_max(v1, (f32x4){0.f, 0.f, 0.f, 0.f}); v0 = v0 * v0 * rs2; v1 = v1 * v1 * rs2; }
                    u32x4 w; w.x = cvt_pk_bf16(v0[0], v0[1]); w.y = cvt_pk_bf16(v0[2], v0[3]); w.z = cvt_pk_bf16(v1[0], v1[1]); w.w = cvt_pk_bf16(v1[2], v1[3]);
                    *(u32x4*)(rowp + bj * 32) = w; } }
    }
};
struct EpiRes {
    static constexpr bool PERM = true, AFTER_DRAIN = false;
    const bf16_t* base; bf16_t* hb; float* outf; float* ss; int ldc;
    __device__ __forceinline__ void operator()(const f32x4 (&acc)[2][2][4][2], const Unit& u, int wr, int wc, int fr, int fq) const {
        const int col0 = u.pn * BM + wc * 64 + 8 * fq;
#pragma unroll
        for (int ai = 0; ai < 2; ++ai)
#pragma unroll
            for (int m = 0; m < 4; ++m) { const int row = u.pm * BM + ai * HALF + wr * 64 + m * 16 + fr; const size_t off = (size_t)row * ldc + col0; float s = 0.f;
#pragma unroll
                for (int bj = 0; bj < 2; ++bj) { const u32x4 bw = *(const u32x4*)(base + off + bj * 32);
                    const f32x4 b0 = {__builtin_bit_cast(float, bw.x << 16), __builtin_bit_cast(float, bw.x & 0xffff0000u), __builtin_bit_cast(float, bw.y << 16), __builtin_bit_cast(float, bw.y & 0xffff0000u)};
                    const f32x4 b1 = {__builtin_bit_cast(float, bw.z << 16), __builtin_bit_cast(float, bw.z & 0xffff0000u), __builtin_bit_cast(float, bw.w << 16), __builtin_bit_cast(float, bw.w & 0xffff0000u)};
                    const f32x4 o0 = b0 + acc[ai][bj][m][0], o1 = b1 + acc[ai][bj][m][1];
                    if (outf) { *(f32x4*)(outf + off + bj * 32) = o0; *(f32x4*)(outf + off + bj * 32 + 4) = o1; }
                    else { u32x4 w; w.x = cvt_pk_bf16(o0[0], o0[1]); w.y = cvt_pk_bf16(o0[2], o0[3]); w.z = cvt_pk_bf16(o1[0], o1[1]); w.w = cvt_pk_bf16(o1[2], o1[3]); *(u32x4*)(hb + off + bj * 32) = w;
                        s += ((o0[0] * o0[0] + o0[1] * o0[1]) + (o0[2] * o0[2] + o0[3] * o0[3])) + ((o1[0] * o1[0] + o1[1] * o1[1]) + (o1[2] * o1[2] + o1[3] * o1[3])); } }
                if (!outf) { s += __shfl_xor(s, 16); s += __shfl_xor(s, 32); if (fq == 0) atomicAdd(ss + row, s); }
                asm volatile("" ::: "memory"); }
    }
};
struct EpiNull {
    static constexpr bool PERM = false, AFTER_DRAIN = false;
    __device__ __forceinline__ void operator()(const f32x4 (&acc)[2][2][4][2], const Unit&, int, int, int, int) const {
#pragma unroll
        for (int ai = 0; ai < 2; ++ai)
#pragma unroll
            for (int bj = 0; bj < 2; ++bj)
#pragma unroll
                for (int m = 0; m < 4; ++m)
#pragma unroll
                    for (int n = 0; n < 2; ++n) asm volatile("" :: "v"(acc[ai][bj][m][n]));
    }
};
template <class Epi, class Sched, bool ALIGN_EPI = false, bool SP2 = false>
__device__ __forceinline__ void gemm_phase(PG8_LAS unsigned char* lds, const Gemm g, const Sched& S, const Epi& E) {
    const int tid = opaque_tid(), wid = __builtin_amdgcn_readfirstlane(tid >> 6), lane = tid & 63, wr = wid >> 2, wc = wid & 3, fr = lane & 15, fq = lane >> 4;
    const int K = g.K, nt = K / BK;
    unsigned voffA[2], voffB[2];
#pragma unroll
    for (int i = 0; i < 2; ++i) { int R, C; stage_rc(tid * 16 + i * 8192, R, C); const int Rb = Epi::PERM ? (64 * (R >> 5) + perm32(R & 31)) : R;
        voffA[i] = (unsigned)(R * K + C) * 2u; voffB[i] = (unsigned)(Rb * K + C) * 2u; }
    const size_t kstep = (size_t)(BK * 2);
    const size_t hstep = (size_t)HALF * K * 2;
    const size_t hstepB = Epi::PERM ? (size_t)32 * K * 2 : hstep;
    const size_t tstep = 2 * hstep;
    const unsigned ldsw = (unsigned)wid * 1024u;
    const int aoff = lds_byte(wr * 64 + fr, fq * 8), boff = lds_byte(wc * 32 + fr, fq * 8);
#define PG8_SA(b, h) (((b) * 2 + (h)) * HTB)
#define PG8_SB(b, h) ((4 + (b) * 2 + (h)) * HTB)
#define PG8_STAGE(bufoff, gbase, voff) do { _Pragma("unroll") for (int _i = 0; _i < 2; ++_i) \
        __builtin_amdgcn_global_load_lds((const unsigned*)((const char*)(gbase) + (voff)[_i]), (PG8_LAS unsigned*)(lds + (bufoff) + ldsw + _i * 8192), 16, 0, 0); } while (0)
#define PG8_LDA(dst, b, h) do { _Pragma("unroll") for (int m = 0; m < 4; ++m) _Pragma("unroll") for (int k = 0; k < 2; ++k) dst[m][k] = *(const PG8_LAS bf16x8*)(lds + PG8_SA(b, h) + aoff + m * 2048 + k * 1024); } while (0)
#define PG8_LDB(dst, b, h) do { _Pragma("unroll") for (int n = 0; n < 2; ++n) _Pragma("unroll") for (int k = 0; k < 2; ++k) dst[n][k] = *(const PG8_LAS bf16x8*)(lds + PG8_SB(b, h) + boff + n * 2048 + k * 1024); } while (0)
#define PG8_MMA(ai, bj, At, Bt) do { __builtin_amdgcn_s_setprio(1); _Pragma("unroll") for (int m = 0; m < 4; ++m) _Pragma("unroll") for (int n = 0; n < 2; ++n) _Pragma("unroll") for (int k = 0; k < 2; ++k) \
        acc[ai][bj][m][n] = __builtin_amdgcn_mfma_f32_16x16x32_bf16(Bt[n][k], At[m][k], acc[ai][bj][m][n], 0, 0, 0); __builtin_amdgcn_s_setprio(0); } while (0)
#define PG8_WAIT_V(n) asm volatile("s_waitcnt vmcnt(" #n ")" ::: "memory")
#define PG8_WAIT_L(n) asm volatile("s_waitcnt lgkmcnt(" #n ")" ::: "memory")
#define PG8_BAR __builtin_amdgcn_s_barrier()
#define PG8_SCHED __builtin_amdgcn_sched_barrier(0)
    Unit cur, nxt; int ui = 0;
    if (!S.next(0, cur)) return;
    f32x4 acc[2][2][4][2];
#pragma unroll
    for (int a = 0; a < 2; ++a)
#pragma unroll
        for (int b = 0; b < 2; ++b)
#pragma unroll
            for (int m = 0; m < 4; ++m)
#pragma unroll
                for (int n = 0; n < 2; ++n) acc[a][b][m][n] = (f32x4){0.f, 0.f, 0.f, 0.f};
    bf16x8 At[4][2], B0[2][2], B1[2][2];
    const char* cA = (const char*)g.A + (size_t)cur.pm * tstep; const char* cB = (const char*)g.Bt + (size_t)cur.pn * tstep;
    S.a_ready(cur);
    if constexpr (SP2) {
        PG8_STAGE(PG8_SB(0, 0), cB, voffB); PG8_STAGE(PG8_SB(0, 1), cB + hstepB, voffB); PG8_STAGE(PG8_SA(0, 0), cA, voffA); PG8_STAGE(PG8_SA(0, 1), cA + hstep, voffA);
        if (wr == 1) PG8_BAR;
        PG8_WAIT_V(2); PG8_BAR;
        PG8_STAGE(PG8_SB(1, 0), cB + kstep, voffB); PG8_STAGE(PG8_SA(1, 0), cA + kstep, voffA); PG8_STAGE(PG8_SB(1, 1), cB + hstepB + kstep, voffB);
        PG8_WAIT_V(6); PG8_BAR;
    } else {
        PG8_STAGE(PG8_SB(0, 0), cB, voffB); PG8_STAGE(PG8_SA(0, 0), cA, voffA); PG8_STAGE(PG8_SB(0, 1), cB + hstepB, voffB); PG8_STAGE(PG8_SA(0, 1), cA + hstep, voffA);
        if (wr == 1) PG8_BAR;
        PG8_WAIT_V(4); PG8_BAR;
        PG8_STAGE(PG8_SB(1, 0), cB + kstep, voffB); PG8_STAGE(PG8_SA(1, 0), cA + kstep, voffA); PG8_STAGE(PG8_SB(1, 1), cB + hstepB + kstep, voffB);
        PG8_WAIT_V(6); PG8_BAR;
    }
    for (;;) {
        const bool has_next = S.next(ui + 1, nxt);
        const char* nA = has_next ? (const char*)g.A + (size_t)nxt.pm * tstep : cA; const char* nB = has_next ? (const char*)g.Bt + (size_t)nxt.pn * tstep : cB;
        for (int t = 0; t < nt; t += 2) {
            const bool last = (t == nt - 2);
            const char* a1 = cA + (size_t)(t + 1) * kstep;
            const char* a2 = last ? nA : cA + (size_t)(t + 2) * kstep; const char* b2 = last ? nB : cB + (size_t)(t + 2) * kstep;
            const char* a3 = a2 + kstep; const char* b3 = b2 + kstep;
            if (last && has_next) S.a_ready(nxt);
            if constexpr (SP2) {
            PG8_LDB(B0, 0, 0); PG8_LDB(B1, 0, 1); PG8_SCHED; PG8_LDA(At, 0, 0); PG8_STAGE(PG8_SA(1, 1), a1 + hstep, voffA);
            PG8_WAIT_V(8); PG8_WAIT_L(0); PG8_BAR; PG8_MMA(0, 0, At, B0); PG8_MMA(0, 1, At, B1); PG8_BAR; PG8_SCHED;
            PG8_LDA(At, 0, 1); PG8_STAGE(PG8_SB(0, 0), b2, voffB); PG8_STAGE(PG8_SB(0, 1), b2 + hstepB, voffB); PG8_STAGE(PG8_SA(0, 0), a2, voffA);
            PG8_WAIT_V(8); PG8_WAIT_L(0); PG8_BAR; PG8_MMA(1, 0, At, B0); PG8_MMA(1, 1, At, B1); PG8_BAR; PG8_SCHED;
            PG8_LDB(B0, 1, 0); PG8_LDB(B1, 1, 1); PG8_SCHED; PG8_LDA(At, 1, 0); PG8_STAGE(PG8_SA(0, 1), a2 + hstep, voffA);
            PG8_WAIT_V(8); PG8_WAIT_L(0); PG8_BAR; PG8_MMA(0, 0, At, B0); PG8_MMA(0, 1, At, B1); PG8_BAR; PG8_SCHED;
            PG8_LDA(At, 1, 1); PG8_STAGE(PG8_SB(1, 0), b3, voffB); PG8_STAGE(PG8_SB(1, 1), b3 + hstepB, voffB); PG8_STAGE(PG8_SA(1, 0), a3, voffA);
            PG8_WAIT_V(8); PG8_WAIT_L(0); PG8_BAR; PG8_MMA(1, 0, At, B0); PG8_MMA(1, 1, At, B1); PG8_BAR; PG8_SCHED;
            } else {
            PG8_LDB(B0, 0, 0); PG8_SCHED; PG8_LDA(At, 0, 0); PG8_STAGE(PG8_SA(1, 1), a1 + hstep, voffA);
            PG8_WAIT_L(8); PG8_BAR; PG8_WAIT_L(0); PG8_MMA(0, 0, At, B0); PG8_BAR; PG8_SCHED;
            PG8_LDB(B1, 0, 1); PG8_STAGE(PG8_SB(0, 0), b2, voffB);
            PG8_BAR; PG8_WAIT_L(0); PG8_MMA(0, 1, At, B1); PG8_BAR;
            PG8_LDA(At, 0, 1); PG8_STAGE(PG8_SA(0, 0), a2, voffA);
            PG8_BAR; PG8_WAIT_L(0); PG8_MMA(1, 0, At, B0); PG8_BAR; PG8_SCHED;
            PG8_STAGE(PG8_SB(0, 1), b2 + hstepB, voffB);
            PG8_WAIT_V(6); PG8_BAR; PG8_MMA(1, 1, At, B1); PG8_BAR;
            PG8_LDB(B0, 1, 0); PG8_SCHED; PG8_LDA(At, 1, 0); PG8_STAGE(PG8_SA(0, 1), a2 + hstep, voffA);
            PG8_WAIT_L(8); PG8_BAR; PG8_WAIT_L(0); PG8_MMA(0, 0, At, B0); PG8_BAR; PG8_SCHED;
            PG8_LDB(B1, 1, 1); PG8_STAGE(PG8_SB(1, 0), b3, voffB);
            PG8_BAR; PG8_WAIT_L(0); PG8_MMA(0, 1, At, B1); PG8_BAR;
            PG8_LDA(At, 1, 1); PG8_STAGE(PG8_SA(1, 0), a3, voffA);
            PG8_BAR; PG8_WAIT_L(0); PG8_MMA(1, 0, At, B0); PG8_BAR; PG8_SCHED;
            PG8_STAGE(PG8_SB(1, 1), b3 + hstepB, voffB);
            PG8_WAIT_V(6); PG8_BAR; PG8_MMA(1, 1, At, B1); PG8_BAR;
            }
        }
        if constexpr (ALIGN_EPI) { if (wr == 0) PG8_BAR; }
        if constexpr (!Epi::AFTER_DRAIN) { E(acc, cur, wr, wc, fr, fq); S.done(cur); }
        if (!has_next) break;
#pragma unroll
        for (int a = 0; a < 2; ++a)
#pragma unroll
            for (int b = 0; b < 2; ++b)
#pragma unroll
                for (int m = 0; m < 4; ++m)
#pragma unroll
                    for (int n = 0; n < 2; ++n) acc[a][b][m][n] = (f32x4){0.f, 0.f, 0.f, 0.f};
        cur = nxt; cA = nA; cB = nB; ++ui;
        if constexpr (ALIGN_EPI) { if (wr == 1) PG8_BAR; }
    }
    PG8_WAIT_V(0);
    if constexpr (!ALIGN_EPI) { if (wr == 0) PG8_BAR; }
    PG8_BAR;
    if constexpr (Epi::AFTER_DRAIN) { E.fused(acc, cur, wr, wc, fr, fq, lds, wid, lane); S.done(cur); }
#undef PG8_SA
#undef PG8_SB
#undef PG8_STAGE
#undef PG8_LDA
#undef PG8_LDB
#undef PG8_MMA
#undef PG8_WAIT_V
#undef PG8_WAIT_L
#undef PG8_BAR
#undef PG8_SCHED
}
}
#ifndef PG8_SP2
#define PG8_SP2 true
#endif
#ifndef PG8_ALIGN
#define PG8_ALIGN true
#endif
constexpr int NWAVES = 8, NTHR = NWAVES * 64;
#ifndef MK_MULTI
#define MK_MULTI 0
#endif
#ifndef ORA_IDX
#define ORA_IDX 0
#endif
#ifndef ORA_ATT
#define ORA_ATT 0
#endif
#ifndef ORA_ML
#define ORA_ML 0
#endif
#ifndef CVT_STAGGER
#define CVT_STAGGER 1
#endif
constexpr int N_PHASES = 15;
#ifndef ML_CHAIN
#define ML_CHAIN 1
#endif
constexpr int BATCH = 4, T = 2048, DM = 2048, M = BATCH * T, FF = 8192;
constexpr int AH = 16, AG = 4, HD = 128, IH = 16, IDIM = 64, TOPK = 256;
constexpr int ATT_IN = 4176, ATT_N = 4096, SM_N = 80;
constexpr int C_Q = 0, C_K = 2048, C_V = 2560, C_QI = 3072;
constexpr int MH = 8, MDK = 128, MDV = 256, ML_IN = 6160, ML_N = 6144;
constexpr int C_MQ = 0, C_MK = 1024, C_MV = 2048, C_MO = 4096;
constexpr float EPS = 1e-6f, GATE_CAP = 15.0f;
constexpr size_t MiB = 1u << 20;
constexpr size_t WS_CTL = 0, CTL_ZERO_BYTES = 320 * 1024;
constexpr size_t WS_WIN = 1 * MiB, WS_WSM = 17 * MiB, WS_WO = 18 * MiB, WS_WML = 26 * MiB, WS_WG = 50 * MiB, WS_WMO = 51 * MiB;
constexpr size_t WS_WUP0 = 59 * MiB, WS_WUP1 = 91 * MiB, WS_WDN0 = 123 * MiB, WS_WDN1 = 155 * MiB;
constexpr size_t WS_XB = 188 * MiB, WS_PROJ = 220 * MiB, WS_Q = 316 * MiB, WS_K = 348 * MiB, WS_QI = 356 * MiB, WS_KI = 372 * MiB, WS_WI = 373 * MiB, WS_MASK = 374 * MiB;
constexpr size_t WS_GATE = 376 * MiB, WS_ROPE = 377 * MiB, WS_SC = 380 * MiB, WS_O = 444 * MiB, WS_V = 476 * MiB, WS_ML = 484 * MiB, WS_END = 486 * MiB;
constexpr size_t WS_H = 220 * MiB;
static_assert(WS_H + (size_t)M * FF * 2 <= WS_K && WS_PROJ + (size_t)M * ML_N * 2 <= WS_Q && WS_SC + (size_t)BATCH * T * T * 4 <= WS_O, "d_ws map");
constexpr int CW_TMO = 0, CW_CODE = 1, CW_BAR = 4096, CW_SS = 32768;
constexpr int RING_OFF = 0, RING_BYTES = 143360;
constexpr int LDSCTL_OFF = RING_BYTES, MISC_OFF = LDSCTL_OFF + 320;
constexpr int LDS_BYTES = 147456;
#define GAS __attribute__((address_space(1)))
#define LAS __attribute__((address_space(3)))
typedef unsigned short bf16;
typedef unsigned v4u __attribute__((ext_vector_type(4)));
typedef unsigned v2u __attribute__((ext_vector_type(2)));
typedef float f32x4 __attribute__((ext_vector_type(4)));
typedef float f32x16 __attribute__((ext_vector_type(16)));
typedef float f32x2 __attribute__((ext_vector_type(2)));
typedef short bf16x8 __attribute__((ext_vector_type(8)));
typedef short s16x4 __attribute__((ext_vector_type(4)));
typedef GAS unsigned gu32;
typedef GAS unsigned long long gu64;
typedef unsigned long long u64;
#define RLX_AGENT __ATOMIC_RELAXED, __HIP_MEMORY_SCOPE_AGENT
#define LDS_WAIT() asm volatile("s_waitcnt lgkmcnt(0)" ::: "memory")
#define VM_WAIT() asm volatile("s_waitcnt vmcnt(0)" ::: "memory")
__device__ __forceinline__ unsigned f2bf(float f) { unsigned u = __builtin_bit_cast(unsigned, f); return (u + 0x7fffu + ((u >> 16) & 1u)) >> 16; }
__device__ __forceinline__ unsigned pk2(float lo, float hi) { return f2bf(lo) | (f2bf(hi) << 16); }
__device__ __forceinline__ float bf2f(bf16 h) { return __builtin_bit_cast(float, (unsigned)h << 16); }
__device__ __forceinline__ float bflo(unsigned w) { return __builtin_bit_cast(float, w << 16); }
__device__ __forceinline__ float bfhi(unsigned w) { return __builtin_bit_cast(float, w & 0xffff0000u); }
__device__ __forceinline__ unsigned fkey(float f) { const unsigned u = __builtin_bit_cast(unsigned, f); return (u & 0x80000000u) ? ~u : (u | 0x80000000u); }
#define XB_TMO      128
#define XB_XCNT(j)  (256  + 64 * (j))
#define XB_XSUB(j)  (1280 + 64 * (j))
#define XB_XGEN(j)  (2304 + 64 * (j))
#define XB_TOP      3328
#define XB_TOPGEN   3392
#define XCD_BAR_WORDS 3456
#define XB_SPIN_CAP (1u << 18)

__device__ __forceinline__ unsigned xb_ld(unsigned* p)              { return __hip_atomic_load(p, __ATOMIC_RELAXED, __HIP_MEMORY_SCOPE_AGENT); }
__device__ __forceinline__ unsigned xb_add(unsigned* p, unsigned v) { return __hip_atomic_fetch_add(p, v, __ATOMIC_RELAXED, __HIP_MEMORY_SCOPE_AGENT); }
__device__ __forceinline__ unsigned xb_xcc_id() { return (unsigned)__builtin_amdgcn_s_getreg((3 << 11) | 20) & 0xFu; }
#define XB_SPIN(cond, bar) do { unsigned _sp = 0; while (cond) { __builtin_amdgcn_s_sleep(0); \
    if ((++_sp & 255u) == 0u) { if (xb_ld(&(bar)[XB_TMO])) break; if (_sp > XB_SPIN_CAP) { atomicAdd(&(bar)[XB_TMO], 1u); break; } } } } while (0)

struct XcdBarrier {
    unsigned* bar; unsigned x;
    volatile LAS unsigned* st;
};

__device__ __forceinline__ XcdBarrier xcd_barrier_post(unsigned* bar, volatile LAS unsigned* st) {
    XcdBarrier b; b.bar = bar; b.x = xb_xcc_id(); b.st = st;
    if (threadIdx.x == 0) (void)xb_add(&bar[XB_XCNT(b.x)], 1u);
    return b;
}
__device__ __forceinline__ void xcd_barrier_complete(unsigned* bar, unsigned x, unsigned& nloc, unsigned& nx) {
    const unsigned G = gridDim.x * gridDim.y * gridDim.z;
    unsigned sum, cnt, mine, sp = 0u;
    for (;;) {
        sum = 0u; cnt = 0u; mine = 0u;
#pragma unroll
        for (unsigned j = 0; j < 16; ++j) { const unsigned c = xb_ld(&bar[XB_XCNT(j)]); sum += c; cnt += (c > 0u) ? 1u : 0u; mine = (j == x) ? c : mine; }
        if (sum == G) break;
        __builtin_amdgcn_s_sleep(1);
        if ((++sp & 255u) == 0u) { if (xb_ld(&bar[XB_TMO])) break; if (sp > XB_SPIN_CAP) { atomicAdd(&bar[XB_TMO], 1u); break; } }
    }
    nloc = mine > 0u ? mine : 1u; nx = cnt > 0u ? cnt : 1u;
}

__device__ __forceinline__ void xcd_barrier(const XcdBarrier& b) {
    asm volatile("s_waitcnt vmcnt(0)" ::: "memory");
    __syncthreads();
    if (threadIdx.x == 0) {
        unsigned* bar = b.bar;
        __builtin_amdgcn_s_waitcnt(0);
        unsigned nloc = b.st[0], nx = b.st[1];
        if (nloc == 0u) { xcd_barrier_complete(bar, b.x, nloc, nx); b.st[0] = nloc; b.st[1] = nx; }
        const unsigned old = xb_add(&bar[XB_XSUB(b.x)], 1u);
        const unsigned gen = old / nloc;
        if (old + 1u == (gen + 1u) * nloc) {
            __builtin_amdgcn_fence(__ATOMIC_RELEASE, "agent");
            asm volatile("s_waitcnt vmcnt(0)" ::: "memory");
            const unsigned og = xb_add(&bar[XB_TOP], 1u);
            const unsigned tg = og / nx;
            if (og + 1u == (tg + 1u) * nx) xb_add(&bar[XB_TOPGEN], 1u);
            else XB_SPIN(xb_ld(&bar[XB_TOPGEN]) == tg, bar);
            __builtin_amdgcn_fence(__ATOMIC_ACQUIRE, "agent");
            xb_add(&bar[XB_XGEN(b.x)], 1u);
            asm volatile("s_waitcnt vmcnt(0)" ::: "memory");
        } else {
            XB_SPIN(xb_ld(&bar[XB_XGEN(b.x)]) == gen, bar);
            __builtin_amdgcn_fence(__ATOMIC_ACQUIRE, "agent");
            asm volatile("s_waitcnt vmcnt(0)" ::: "memory");
        }
    }
    __syncthreads();
}
struct Args { const float* in[13]; float* out; unsigned char* ws; int ph_lo, ph_hi, li, pad; };
struct Frame {
    LAS unsigned char* lds;
    volatile LAS unsigned* MISC;
    gu32* ctl;
    int tid, lane, wave, vcu, G;
    const float* x; float* out;
    const float *norm_mix, *norm_ffn, *att_w_in, *q_gain, *k_gain, *att_w_out, *ml_w_in, *b_gate, *h_gain, *ml_w_out, *w_up, *w_dn;
    bf16 *WinT, *WsmT, *WoT, *WmlT, *WgT, *WmoT, *WupT0, *WupT1, *WdnT0, *WdnT1;
    bf16 *XB, *PROJ, *Q, *K, *V, *QI, *KI, *O, *H;
    float *WI, *IG, *LF, *SC, *NST, *SCAL; bf16* ST; f32x2 *ROPE_A, *ROPE_I; u64* MASK;
    float *ss0, *ss1, *ss2, *ss3;
};
__device__ __forceinline__ float wave_sum(float v) {
#pragma unroll
    for (int o = 1; o < 64; o <<= 1) v += __shfl_xor(v, o);
    return v;
}
__device__ __forceinline__ unsigned cvtpk2(float lo, float hi) { unsigned r; asm volatile("v_cvt_pk_bf16_f32 %0, %1, %2" : "=v"(r) : "v"(lo), "v"(hi)); return r; }
template <bool NTS = false> __device__ __forceinline__ void tr_item(const float* W, int ldw, int col0, int nvalid, int nblk, int K, const float* gain, float scale, bf16* WT, LAS float* scr, int item, int lane) {
    const int kb = item / nblk, nb = item - kb * nblk, k0 = 64 * kb, n0 = 32 * nb, nn = n0 + (lane & 31), nc = nn < nvalid ? nn : nvalid - 1, c = lane & 7;
    const GAS float* wp = (const GAS float*)W + (size_t)(k0 + (lane >> 5)) * ldw + col0 + nc;
    float v[32];
#pragma unroll
    for (int i = 0; i < 32; ++i) v[i] = __builtin_nontemporal_load(wp + (size_t)(2 * i) * ldw);
    f32x4 g0 = (f32x4){scale, scale, scale, scale}, g1 = g0;
    if (gain) { g0 = *(const GAS f32x4*)(gain + k0 + 8 * c) * scale; g1 = *(const GAS f32x4*)(gain + k0 + 8 * c + 4) * scale; }
    const bool ok = nn < nvalid;
#pragma unroll
    for (int i = 0; i < 32; ++i) scr[(2 * i + (lane >> 5)) * 33 + (lane & 31)] = ok ? v[i] : 0.f;
    LDS_WAIT(); asm volatile("" ::: "memory");
#pragma unroll
    for (int j = 0; j < 4; ++j) { const int n = (lane >> 3) + 8 * j; const LAS float* s = scr + (8 * c) * 33 + n;
        v4u o; o.x = cvtpk2(s[0 * 33] * g0.x, s[1 * 33] * g0.y); o.y = cvtpk2(s[2 * 33] * g0.z, s[3 * 33] * g0.w); o.z = cvtpk2(s[4 * 33] * g1.x, s[5 * 33] * g1.y); o.w = cvtpk2(s[6 * 33] * g1.z, s[7 * 33] * g1.w);
        if (NTS) __builtin_nontemporal_store(o, (GAS v4u*)(WT + (size_t)(n0 + n) * K + k0 + 8 * c)); else *(GAS v4u*)(WT + (size_t)(n0 + n) * K + k0 + 8 * c) = o; }
    LDS_WAIT(); asm volatile("" ::: "memory");
}
namespace cvt {
constexpr int I0 = 32 * 128, I1 = 32 * 3, I2 = 32 * 64, I3 = 32 * 256, I4 = 128 * 64, I5 = 32 * 32, I6 = 32 * 32, I7 = 32 * 128, I8 = 32 * 1, I9 = 32 * 64, I10 = I3, I11 = I4;
constexpr int E1 = I0 + I1, E2 = E1 + I2, E3 = E2 + I3, E4 = E3 + I4, E8 = E4 + I5 + I6 + I7 + I8, E9 = E8 + I9, E10 = E9 + I10, E11 = E10 + I11;
}
__device__ __forceinline__ void cvt_items(Frame& F, int lo, int hi) {
    using namespace cvt;
    const int tid = opaque_tid(), lane = tid & 63, wave = tid >> 6;
    LAS float* scr = (LAS float*)(F.lds + RING_OFF + wave * 16384);
    const int gw = F.vcu * NWAVES + wave, NGW = F.G * NWAVES;
    constexpr float KSC = 0.08838834764831845f;
    for (int it = lo + gw; it < hi; it += NGW) {
        int r = it;
        if (r < I0) { tr_item(F.att_w_in, ATT_IN, 0, ATT_N, 128, DM, F.norm_mix, 1.f, F.WinT, scr, r, lane); continue; } r -= I0;
        if (r < I1) { tr_item(F.att_w_in, ATT_IN, ATT_N, SM_N, 3, DM, F.norm_mix, 1.f, F.WsmT, scr, r, lane); continue; } r -= I1;
        if (r < I2) { tr_item<true>(F.att_w_out, DM, 0, DM, 64, DM, nullptr, 1.f, F.WoT, scr, r, lane); continue; } r -= I2;
        if (r < I3) { tr_item<true>(F.w_up, FF, 0, FF, 256, DM, F.norm_ffn, 1.f, F.WupT0, scr, r, lane); continue; } r -= I3;
        if (r < I4) { tr_item<true>(F.w_dn, DM, 0, DM, 64, FF, nullptr, 1.f, F.WdnT0, scr, r, lane); continue; } r -= I4;
        if (r < I5) { tr_item<true>(F.ml_w_in, ML_IN, C_MQ, 1024, 32, DM, F.norm_mix + DM, 1.f, F.WmlT, scr, r, lane); continue; } r -= I5;
        if (r < I6) { tr_item<true>(F.ml_w_in, ML_IN, C_MK, 1024, 32, DM, F.norm_mix + DM, KSC, F.WmlT + (size_t)C_MK * DM, scr, r, lane); continue; } r -= I6;
        if (r < I7) { tr_item<true>(F.ml_w_in, ML_IN, C_MV, 4096, 128, DM, F.norm_mix + DM, 1.f, F.WmlT + (size_t)C_MV * DM, scr, r, lane); continue; } r -= I7;
        if (r < I8) { tr_item<true>(F.ml_w_in, ML_IN, ML_N, 16, 1, DM, F.norm_mix + DM, 1.f, F.WgT, scr, r, lane); continue; } r -= I8;
        if (r < I9) { tr_item<true>(F.ml_w_out, DM, 0, DM, 64, DM, nullptr, 1.f, F.WmoT, scr, r, lane); continue; } r -= I9;
        if (r < I10) { tr_item<true>(F.w_up + (size_t)DM * FF, FF, 0, FF, 256, DM, F.norm_ffn + DM, 1.f, F.WupT1, scr, r, lane); continue; } r -= I10;
        tr_item<true>(F.w_dn + (size_t)FF * DM, DM, 0, DM, 64, FF, nullptr, 1.f, F.WdnT1, scr, r, lane);
    }
}
__device__ __forceinline__ void cvt_slot(Frame& F, int lo, int hi, bool before) {
#if CVT_STAGGER
    if (((F.vcu & 1) == 0) == before) { __syncthreads(); cvt_items(F, lo, hi); __syncthreads(); }
#endif
}
__device__ __forceinline__ void p0_prologue(Frame& F) {
    const int gw = F.vcu * NWAVES + F.wave, NGW = F.G * NWAVES;
    cvt_items(F, 0, CVT_STAGGER ? cvt::E1 : cvt::E11);
    for (int m = gw; m < M; m += NGW) {
        const GAS f32x4* xr = (const GAS f32x4*)(F.x + (size_t)m * DM) + F.lane; GAS u64* o8 = (GAS u64*)(F.XB + (size_t)m * DM) + F.lane;
        f32x4 v[8]; float s = 0.f;
#pragma unroll
        for (int j = 0; j < 8; ++j) { v[j] = __builtin_nontemporal_load(xr + 64 * j); s += (v[j].x * v[j].x + v[j].y * v[j].y) + (v[j].z * v[j].z + v[j].w * v[j].w); }
        s = wave_sum(s); if (F.lane == 0) F.ss0[m] = s;
#pragma unroll
        for (int j = 0; j < 8; ++j) o8[64 * j] = (u64)cvtpk2(v[j].x, v[j].y) | ((u64)cvtpk2(v[j].z, v[j].w) << 32);
    }
    for (int idx = gw * 64 + F.lane; idx < T * 24; idx += NGW * 64) { const int t = idx / 24, i = idx - t * 24;
        if (i < 16) { const float inv = powf(500000.0f, -2.0f * (float)i / 32.0f), a = (float)t * inv; F.ROPE_A[t * 16 + i] = (f32x2){cosf(a), sinf(a)}; }
        else { const int ii = i - 16; const float inv = powf(500000.0f, -2.0f * (float)ii / 16.0f), a = (float)t * inv; F.ROPE_I[t * 8 + ii] = (f32x2){cosf(a), sinf(a)}; } }
}
template <int NT> __device__ __forceinline__ void skinny_mma(Frame& F, const bf16* A, const bf16* Wt, int r0, LAS float* red) {
    const int rt = F.wave & 1, kq = F.wave >> 1, fr = F.lane & 15, fq = F.lane >> 4;
    f32x4 acc[NT];
#pragma unroll
    for (int n = 0; n < NT; ++n) acc[n] = (f32x4){0.f, 0.f, 0.f, 0.f};
    const bf16* ap = A + (size_t)(r0 + rt * 16 + fr) * DM + kq * 512 + fq * 8; const bf16* bp = Wt + (size_t)fr * DM + kq * 512 + fq * 8;
#pragma unroll 4
    for (int ks = 0; ks < 16; ++ks) { const bf16x8 a = *(const bf16x8*)(ap + ks * 32);
#pragma unroll
        for (int n = 0; n < NT; ++n) { const bf16x8 b = *(const bf16x8*)(bp + (size_t)n * 16 * DM + ks * 32); acc[n] = __builtin_amdgcn_mfma_f32_16x16x32_bf16(a, b, acc[n], 0, 0, 0); } }
#pragma unroll
    for (int n = 0; n < NT; ++n)
#pragma unroll
        for (int g = 0; g < 4; ++g) red[((kq * 32 + rt * 16 + 4 * fq + g) * (NT * 16)) + n * 16 + fr] = acc[n][g];
}
__device__ __forceinline__ void skinny_att(Frame& F) {
    LAS float* red = (LAS float*)(F.lds + RING_OFF);
    for (int u = F.vcu; u < M / 32; u += F.G) { const int r0 = u * 32;
        skinny_mma<5>(F, F.XB, F.WsmT, r0, red);
        LDS_WAIT(); __syncthreads();
        const int r = F.tid >> 4, q = F.tid & 15, m = r0 + r, t = m % T; const float rs = __builtin_amdgcn_rsqf(F.ss0[m] * (1.f / DM) + EPS);
#define SMV(c) ((red[(0 * 32 + r) * 80 + (c)] + red[(1 * 32 + r) * 80 + (c)] + red[(2 * 32 + r) * 80 + (c)] + red[(3 * 32 + r) * 80 + (c)]) * rs)
        if (q < 8) { const float a = SMV(q), b = SMV(q + 8); const f32x2 cs = F.ROPE_I[t * 8 + q];
            F.KI[(size_t)m * 64 + q] = (bf16)f2bf(a * cs.x - b * cs.y); F.KI[(size_t)m * 64 + q + 8] = (bf16)f2bf(a * cs.y + b * cs.x); }
#pragma unroll
        for (int e = 0; e < 3; ++e) { const int c = 16 + q * 3 + e; F.KI[(size_t)m * 64 + c] = (bf16)f2bf(SMV(c)); }
        F.WI[(size_t)m * 16 + q] = SMV(64 + q) * 0.03125f;
#undef SMV
        LDS_WAIT(); __syncthreads();
    }
}
__device__ __forceinline__ void skinny_gates(Frame& F) {
    LAS float* red = (LAS float*)(F.lds + RING_OFF);
    for (int u = F.vcu; u < M / 32; u += F.G) { const int r0 = u * 32;
        skinny_mma<1>(F, F.XB, F.WgT, r0, red);
        LDS_WAIT(); __syncthreads();
        const int r = F.tid >> 4, c = F.tid & 15, m = r0 + r, b = m / T, t = m - b * T; const float rs = __builtin_amdgcn_rsqf(F.ss2[m] * (1.f / DM) + EPS);
        float g = (red[(0 * 32 + r) * 16 + c] + red[(1 * 32 + r) * 16 + c] + red[(2 * 32 + r) * 16 + c] + red[(3 * 32 + r) * 16 + c]) * rs + F.b_gate[c];
        g = GATE_CAP * tanhf(g * (1.f / GATE_CAP));
        if (c < 8) F.IG[(size_t)(b * MH + c) * T + t] = g;
        else { const float ls = g >= 0.f ? -log1pf(expf(-g)) : g - log1pf(expf(g)); F.LF[(size_t)(b * MH + c - 8) * T + t] = ls; }
        LDS_WAIT(); __syncthreads();
    }
}
__device__ __forceinline__ void unpack8(const v4u w, float* f) { f[0] = bflo(w.x); f[1] = bfhi(w.x); f[2] = bflo(w.y); f[3] = bfhi(w.y); f[4] = bflo(w.z); f[5] = bfhi(w.z); f[6] = bflo(w.w); f[7] = bfhi(w.w); }
__device__ __forceinline__ v4u pack8f(const float* f) { v4u w; w.x = pk2(f[0], f[1]); w.y = pk2(f[2], f[3]); w.z = pk2(f[4], f[5]); w.w = pk2(f[6], f[7]); return w; }
__device__ __forceinline__ void norm_rope32(Frame& F, const bf16* src, bf16* dst, const float* gain, int t, bool active) {
    float y[32]; float s = 0.f;
    if (active) {
#pragma unroll
        for (int j = 0; j < 4; ++j) unpack8(*(const GAS v4u*)(src + 8 * j), y + 8 * j);
    } else {
#pragma unroll
        for (int e = 0; e < 32; ++e) y[e] = 0.f;
    }
#pragma unroll
    for (int e = 0; e < 32; ++e) s += y[e] * y[e];
    s += __shfl_xor(s, 1); s += __shfl_xor(s, 2);
    const float rs = __builtin_amdgcn_rsqf(s * (1.f / 128.f) + EPS); const int d0 = (F.lane & 3) * 32;
    if (active) {
#pragma unroll
        for (int e = 0; e < 32; ++e) y[e] = y[e] * rs * gain[d0 + e];
        if ((F.lane & 3) == 0) {
#pragma unroll
            for (int i = 0; i < 16; ++i) { const f32x2 cs = F.ROPE_A[t * 16 + i]; const float a = y[i], b = y[i + 16]; y[i] = a * cs.x - b * cs.y; y[i + 16] = a * cs.y + b * cs.x; }
        }
#pragma unroll
        for (int j = 0; j < 4; ++j) *(GAS v4u*)(dst + 8 * j) = pack8f(y + 8 * j);
    }
}
__device__ __forceinline__ void p2_prep(Frame& F) {
    const int gw = F.vcu * NWAVES + F.wave, NGW = F.G * NWAVES;
    for (int m = gw; m < M; m += NGW) { const int t = m % T; const bf16* pr = F.PROJ + (size_t)m * ATT_N;
        norm_rope32(F, pr + C_Q + 32 * F.lane, F.Q + (size_t)m * DM + 32 * F.lane, F.q_gain, t, true);
        norm_rope32(F, pr + C_K + 32 * (F.lane & 15), F.K + (size_t)m * 512 + 32 * (F.lane & 15), F.k_gain, t, F.lane < 16);
        *(GAS v4u*)(F.V + (size_t)m * 512 + 8 * F.lane) = *(const GAS v4u*)(pr + C_V + 8 * F.lane);
        float y[16]; unpack8(*(const GAS v4u*)(pr + C_QI + 16 * F.lane), y); unpack8(*(const GAS v4u*)(pr + C_QI + 16 * F.lane + 8), y + 8);
        if ((F.lane & 3) == 0) {
#pragma unroll
            for (int i = 0; i < 8; ++i) { const f32x2 cs = F.ROPE_I[t * 8 + i]; const float a = y[i], b = y[i + 8]; y[i] = a * cs.x - b * cs.y; y[i + 8] = a * cs.y + b * cs.x; }
        }
        *(GAS v4u*)(F.QI + (size_t)m * 1024 + 16 * F.lane) = pack8f(y); *(GAS v4u*)(F.QI + (size_t)m * 1024 + 16 * F.lane + 8) = pack8f(y + 8);
    }
}
template <bool TWO, int ABL = 0> __device__ __forceinline__ void p3a_tiles(Frame& F, int b, size_t m0, int kt, const LAS unsigned char* qrow, int swz, const LAS float* wl, int r32, int hi) {
    bf16x8 ka[4], kb[4];
    { const bf16* kp = F.KI + ((size_t)b * T + 32 * kt + r32) * 64 + hi * 8;
#pragma unroll
      for (int ks = 0; ks < 4; ++ks) { ka[ks] = *(const GAS bf16x8*)(kp + 16 * ks); if (TWO) kb[ks] = *(const GAS bf16x8*)(kp + (size_t)32 * NWAVES * 64 + 16 * ks); } }
    f32x16 sa, sb;
#pragma unroll
    for (int r = 0; r < 16; ++r) { sa[r] = 0.f; sb[r] = 0.f; }
#pragma unroll 2
    for (int h = 0; h < 16; ++h) { f32x16 da, db; const float wh = wl[r32 * 16 + h];
#pragma unroll
        for (int r = 0; r < 16; ++r) { da[r] = 0.f; db[r] = 0.f; }
#pragma unroll
        for (int ks = 0; ks < 4; ++ks) { const bf16x8 q = *(const LAS bf16x8*)(qrow + (((h * 64 + 16 * ks + 8 * hi) * 2) ^ swz));
            da = __builtin_amdgcn_mfma_f32_32x32x16_bf16(ka[ks], q, da, 0, 0, 0); if (TWO) db = __builtin_amdgcn_mfma_f32_32x32x16_bf16(kb[ks], q, db, 0, 0, 0); }
#pragma unroll
        for (int r = 0; r < 16; ++r) { const float xa = da[r]; const int ia = __float_as_int(xa); sa[r] = fmaf(wh, __int_as_float(ia > 0 ? ia : 0), sa[r]);
            if (TWO) { const float xb = db[r]; const int ib = __float_as_int(xb); sb[r] = fmaf(wh, __int_as_float(ib > 0 ? ib : 0), sb[r]); } } }
    LAS float* tsc = (LAS float*)(F.lds + RING_OFF + 69632 + F.wave * 4608);
    const int trow = F.lane >> 1, th = F.lane & 1;
#pragma unroll
    for (int q4 = 0; q4 < 4; ++q4) *(LAS f32x4*)(tsc + r32 * 36 + 8 * q4 + 4 * hi) = (f32x4){sa[4 * q4], sa[4 * q4 + 1], sa[4 * q4 + 2], sa[4 * q4 + 3]};
    if (ABL != 2) { float* dst = F.SC + (m0 + trow) * T + 32 * kt + 16 * th;
#pragma unroll
      for (int q4 = 0; q4 < 4; ++q4) *(GAS f32x4*)(dst + 4 * q4) = *(const LAS f32x4*)(tsc + trow * 36 + 16 * th + 4 * q4); }
    if (TWO) {
#pragma unroll
        for (int q4 = 0; q4 < 4; ++q4) *(LAS f32x4*)(tsc + r32 * 36 + 8 * q4 + 4 * hi) = (f32x4){sb[4 * q4], sb[4 * q4 + 1], sb[4 * q4 + 2], sb[4 * q4 + 3]};
        float* dst = F.SC + (m0 + trow) * T + 32 * (kt + NWAVES) + 16 * th;
        if (ABL != 2) {
#pragma unroll
        for (int q4 = 0; q4 < 4; ++q4) *(GAS f32x4*)(dst + 4 * q4) = *(const LAS f32x4*)(tsc + trow * 36 + 16 * th + 4 * q4); } }
}
template <int ABL = 0> __device__ __forceinline__ void p3a_segment(Frame& F, int b, int i, int kt0, int kt1) {
    LAS unsigned char* qs = F.lds + RING_OFF;
    LAS float* wl = (LAS float*)(F.lds + RING_OFF + 65536);
    const int r32 = F.lane & 31, hi = F.lane >> 5, t0 = 32 * i; const size_t m0 = (size_t)b * T + t0;
#pragma unroll
    for (int k = 0; k < 8; ++k) { const int p = F.tid + 512 * k, row = p >> 7, ch = p & 127;
        v4u v = *(const GAS v4u*)(F.PROJ + (m0 + row) * ATT_N + C_QI + ch * 8);
        v4u o; o.x = (unsigned)__builtin_amdgcn_update_dpp(0, (int)v.x, 0xB1, 0xf, 0xf, false); o.y = (unsigned)__builtin_amdgcn_update_dpp(0, (int)v.y, 0xB1, 0xf, 0xf, false);
        o.z = (unsigned)__builtin_amdgcn_update_dpp(0, (int)v.z, 0xB1, 0xf, 0xf, false); o.w = (unsigned)__builtin_amdgcn_update_dpp(0, (int)v.w, 0xB1, 0xf, 0xf, false);
        if ((ch & 7) < 2) { float a[8], bq[8]; unpack8((ch & 1) ? o : v, a); unpack8((ch & 1) ? v : o, bq); const f32x2* rp = F.ROPE_I + (size_t)(t0 + row) * 8; float y[8];
#pragma unroll
            for (int e = 0; e < 8; ++e) { const f32x2 cs = rp[e]; y[e] = (ch & 1) ? a[e] * cs.y + bq[e] * cs.x : a[e] * cs.x - bq[e] * cs.y; }
            v = pack8f(y); }
        *(LAS v4u*)(qs + row * 2048 + ((ch * 16) ^ ((row & 15) << 4))) = v; }
    wl[F.tid] = F.WI[(m0 + (F.tid >> 4)) * 16 + (F.tid & 15)];
    LDS_WAIT(); __syncthreads();
    const LAS unsigned char* qrow = qs + r32 * 2048; const int swz = (r32 & 15) << 4;
    if (ABL != 1) for (int kt = kt0 + F.wave; kt < kt1; kt += 2 * NWAVES) { const bool two = kt + NWAVES < kt1;
        if (two) p3a_tiles<true, ABL>(F, b, m0, kt, qrow, swz, wl, r32, hi); else p3a_tiles<false, ABL>(F, b, m0, kt, qrow, swz, wl, r32, hi); }
    LDS_WAIT(); __syncthreads();
}
template <int ABL = 0> __device__ __forceinline__ void p3a_scores(Frame& F) {
    { const int gw = F.vcu * NWAVES + F.wave, NGW = F.G * NWAVES;
      for (int m = gw; m < M; m += NGW) { const int t = m % T; const bf16* pr = F.PROJ + (size_t)m * ATT_N;
          norm_rope32(F, pr + C_K + 32 * (F.lane & 15), F.K + (size_t)m * 512 + 32 * (F.lane & 15), F.k_gain, t, F.lane < 16);
          *(GAS v4u*)(F.V + (size_t)m * 512 + 8 * F.lane) = *(const GAS v4u*)(pr + C_V + 8 * F.lane); } }
    for (int c = F.vcu; c < 256; c += F.G) { const int p = c >> 1, b = p >> 5, i = p & 31;
        if ((c & 1) == 0) p3a_segment<ABL>(F, b, 63 - i, 0, 32);
        else { p3a_segment<ABL>(F, b, 63 - i, 32, 64 - i); p3a_segment<ABL>(F, b, i, 0, i + 1); } }
}
__device__ __forceinline__ void p3b_select(Frame& F) {
    LAS unsigned* hist = (LAS unsigned*)(F.lds + RING_OFF + F.wave * 8192);
    const int gw = F.vcu * NWAVES + F.wave, NGW = F.G * NWAVES, rep = F.lane & 7;
    float sn[32];
#define ROW_OF(e_, t_, m_) const int bb_ = (e_) / T, tt_ = (e_) - bb_ * T, t_ = (bb_ & 1) ? T - 1 - tt_ : tt_, m_ = bb_ * T + t_
#define ROW_LOAD(e_) do { ROW_OF(e_, tl_, ml_); const float* sr_ = F.SC + (size_t)ml_ * T;                                             \
        _Pragma("unroll") for (int j = 0; j < 32; ++j) { const int s = F.lane + 64 * j; sn[j] = __builtin_nontemporal_load(sr_ + (s < tl_ ? s : tl_)); } } while (0)
    if (gw < M) ROW_LOAD(gw);
    for (int e = gw; e < M; e += NGW) { ROW_OF(e, t, m); const int nj = (t >> 6) + 1;
            unsigned k[32];
#pragma unroll
            for (int j = 0; j < 32; ++j) { const int s = F.lane + 64 * j; k[j] = fkey(s <= t ? sn[j] : -__builtin_inff()); }
            if (e + NGW < M) ROW_LOAD(e + NGW);
            unsigned P = 0;
            if (t + 1 > TOPK) { unsigned need = TOPK;
#pragma unroll 1
                for (int p = 0; p < 4; ++p) { const int sh = 24 - 8 * p; const unsigned hmask = p ? (0xffffffffu << (sh + 8)) : 0u;
#pragma unroll
                    for (int z = 0; z < 8; ++z) *(LAS v4u*)(hist + 4 * (F.lane + 64 * z)) = (v4u){0u, 0u, 0u, 0u};
#pragma unroll
                    for (int j = 0; j < 32; ++j) if (j < nj) { if (((k[j] ^ P) & hmask) == 0u) __hip_atomic_fetch_add(hist + (((k[j] >> sh) & 255u) * 8u + rep), 1u, __ATOMIC_RELAXED, __HIP_MEMORY_SCOPE_WORKGROUP); }
                    v4u hb;
                    { const LAS v4u* hp = (const LAS v4u*)(hist + 32 * F.lane);
                      const v4u r0 = hp[0], r1 = hp[1], r2 = hp[2], r3 = hp[3], r4 = hp[4], r5 = hp[5], r6 = hp[6], r7 = hp[7];
                      hb.x = (r0.x + r0.y + r0.z + r0.w) + (r1.x + r1.y + r1.z + r1.w); hb.y = (r2.x + r2.y + r2.z + r2.w) + (r3.x + r3.y + r3.z + r3.w);
                      hb.z = (r4.x + r4.y + r4.z + r4.w) + (r5.x + r5.y + r5.z + r5.w); hb.w = (r6.x + r6.y + r6.z + r6.w) + (r7.x + r7.y + r7.z + r7.w); }
                    const unsigned s4 = hb.x + hb.y + hb.z + hb.w;
                    unsigned ps = s4;
                    ps += (unsigned)__builtin_amdgcn_update_dpp(0, (int)ps, 0x111, 0xf, 0xf, false); ps += (unsigned)__builtin_amdgcn_update_dpp(0, (int)ps, 0x112, 0xf, 0xf, false);
                    ps += (unsigned)__builtin_amdgcn_update_dpp(0, (int)ps, 0x114, 0xf, 0xf, false); ps += (unsigned)__builtin_amdgcn_update_dpp(0, (int)ps, 0x118, 0xf, 0xf, false);
                    ps += (unsigned)__builtin_amdgcn_update_dpp(0, (int)ps, 0x142, 0xa, 0xf, false); ps += (unsigned)__builtin_amdgcn_update_dpp(0, (int)ps, 0x143, 0xc, 0xf, false);
                    const unsigned total = (unsigned)__builtin_amdgcn_readlane((int)ps, 63), above = total - ps;
                    const u64 bm = __ballot(above < need && need <= above + s4); const int src = __builtin_ctzll(bm);
                    const unsigned a3 = above + hb.w, a2 = a3 + hb.z, a1 = a2 + hb.y;
                    unsigned dig, gt;
                    if (need <= a3) { dig = 3; gt = above; } else if (need <= a2) { dig = 2; gt = a3; } else if (need <= a1) { dig = 1; gt = a2; } else { dig = 0; gt = a1; }
                    dig += 4u * F.lane;
                    dig = (unsigned)__builtin_amdgcn_readlane((int)dig, src); gt = (unsigned)__builtin_amdgcn_readlane((int)gt, src);
                    P |= dig << sh; need -= gt; } }
            u64 myw = 0;
#pragma unroll
            for (int j = 0; j < 32; ++j) { const int s = F.lane + 64 * j; const u64 w = __ballot(k[j] >= P && s <= t); if (F.lane == j) myw = w; }
            if (F.lane < 32) F.MASK[(size_t)m * 32 + F.lane] = myw;
    }
#undef ROW_OF
#undef ROW_LOAD
}
#ifndef IDX_FUSED
#define IDX_FUSED 0
#endif
__device__ __forceinline__ unsigned radix_select(const unsigned (&k)[32], int nj, int lane, LAS unsigned* hist) {
    unsigned P = 0, need = TOPK;
#pragma unroll 1
    for (int p = 0; p < 4; ++p) { const int sh = 24 - 8 * p; const unsigned hmask = p ? (0xffffffffu << (sh + 8)) : 0u;
        *(LAS v4u*)(hist + 4 * lane) = (v4u){0u, 0u, 0u, 0u};
#pragma unroll
        for (int j = 0; j < 32; ++j) if (j < nj) { if (((k[j] ^ P) & hmask) == 0u) __hip_atomic_fetch_add(hist + ((k[j] >> sh) & 255u), 1u, __ATOMIC_RELAXED, __HIP_MEMORY_SCOPE_WORKGROUP); }
        const v4u hb = *(const LAS v4u*)(hist + 4 * lane);
        const unsigned s4 = hb.x + hb.y + hb.z + hb.w;
        unsigned ps = s4;
        ps += (unsigned)__builtin_amdgcn_update_dpp(0, (int)ps, 0x111, 0xf, 0xf, false); ps += (unsigned)__builtin_amdgcn_update_dpp(0, (int)ps, 0x112, 0xf, 0xf, false);
        ps += (unsigned)__builtin_amdgcn_update_dpp(0, (int)ps, 0x114, 0xf, 0xf, false); ps += (unsigned)__builtin_amdgcn_update_dpp(0, (int)ps, 0x118, 0xf, 0xf, false);
        ps += (unsigned)__builtin_amdgcn_update_dpp(0, (int)ps, 0x142, 0xa, 0xf, false); ps += (unsigned)__builtin_amdgcn_update_dpp(0, (int)ps, 0x143, 0xc, 0xf, false);
        const unsigned total = (unsigned)__builtin_amdgcn_readlane((int)ps, 63), above = total - ps;
        const u64 bm = __ballot(above < need && need <= above + s4); const int src = __builtin_ctzll(bm);
        const unsigned a3 = above + hb.w, a2 = a3 + hb.z, a1 = a2 + hb.y;
        unsigned dig, gt;
        if (need <= a3) { dig = 3; gt = above; } else if (need <= a2) { dig = 2; gt = a3; } else if (need <= a1) { dig = 1; gt = a2; } else { dig = 0; gt = a1; }
        dig += 4u * lane;
        dig = (unsigned)__builtin_amdgcn_readlane((int)dig, src); gt = (unsigned)__builtin_amdgcn_readlane((int)gt, src);
        P |= dig << sh; need -= gt; }
    return P;
}
__device__ __forceinline__ void p3f_tile(Frame& F, int b, int ti) {
    constexpr int SROW = 2052;
    LAS float* SCL = (LAS float*)(F.lds + RING_OFF);
    LAS unsigned* hist = (LAS unsigned*)(F.lds + RING_OFF + 16 * SROW * 4 + F.wave * 1024);
    static_assert(16 * SROW * 4 + 8 * 1024 <= RING_BYTES, "fused indexer LDS");
    const int lane = F.lane, c16 = lane & 15, kq = lane >> 4, t0 = 16 * ti; const size_t m0 = (size_t)b * T + t0;
#pragma unroll 1
    for (int hh = 0; hh < 2; ++hh) {
        bf16x8 qf[8][2]; float wv[8];
        { const bf16* qp = F.PROJ + (m0 + c16) * ATT_N + C_QI + hh * 512 + 8 * kq; const f32x2* rp = F.ROPE_I + (size_t)(t0 + c16) * 8;
          f32x2 cs[8];
#pragma unroll
          for (int e = 0; e < 8; ++e) cs[e] = rp[e];
#pragma unroll
          for (int h = 0; h < 8; ++h) { v4u v0 = *(const GAS v4u*)(qp + h * 64), v1 = *(const GAS v4u*)(qp + h * 64 + 32);
              v4u o; o.x = (unsigned)__shfl_xor((int)v0.x, 16); o.y = (unsigned)__shfl_xor((int)v0.y, 16); o.z = (unsigned)__shfl_xor((int)v0.z, 16); o.w = (unsigned)__shfl_xor((int)v0.w, 16);
              if (kq < 2) { float a[8], bq[8], y[8]; unpack8(kq ? o : v0, a); unpack8(kq ? v0 : o, bq);
#pragma unroll
                  for (int e = 0; e < 8; ++e) y[e] = kq ? a[e] * cs[e].y + bq[e] * cs[e].x : a[e] * cs[e].x - bq[e] * cs[e].y;
                  v0 = pack8f(y); }
              qf[h][0] = *reinterpret_cast<bf16x8*>(&v0); qf[h][1] = *reinterpret_cast<bf16x8*>(&v1); }
          const float* wp = F.WI + (m0 + c16) * 16 + hh * 8;
#pragma unroll
          for (int h4 = 0; h4 < 2; ++h4) { const f32x4 w4 = *(const GAS f32x4*)(wp + 4 * h4); wv[4 * h4] = w4.x; wv[4 * h4 + 1] = w4.y; wv[4 * h4 + 2] = w4.z; wv[4 * h4 + 3] = w4.w; } }
        bf16x8 a0, a1, n0, n1;
        { const int kt = F.wave; if (kt <= ti) { const bf16* kp = F.KI + ((size_t)b * T + 16 * kt + c16) * 64 + 8 * kq; n0 = *(const GAS bf16x8*)kp; n1 = *(const GAS bf16x8*)(kp + 32); } }
        for (int kt = F.wave; kt <= ti; kt += NWAVES) { const int s0 = 16 * kt;
            a0 = n0; a1 = n1;
            if (kt + NWAVES <= ti) { const bf16* kp = F.KI + ((size_t)b * T + 16 * (kt + NWAVES) + c16) * 64 + 8 * kq; n0 = *(const GAS bf16x8*)kp; n1 = *(const GAS bf16x8*)(kp + 32); }
            LAS f32x4* dst = (LAS f32x4*)(SCL + c16 * SROW + s0 + 4 * kq);
            f32x4 sc = (f32x4){0.f, 0.f, 0.f, 0.f}; if (hh) sc = *dst;
#pragma unroll
            for (int h = 0; h < 8; ++h) { f32x4 d = __builtin_amdgcn_mfma_f32_16x16x32_bf16(a0, qf[h][0], (f32x4){0.f, 0.f, 0.f, 0.f}, 0, 0, 0); d = __builtin_amdgcn_mfma_f32_16x16x32_bf16(a1, qf[h][1], d, 0, 0, 0);
                sc += __builtin_elementwise_max(d, (f32x4){0.f, 0.f, 0.f, 0.f}) * wv[h]; }
            *dst = sc;
        }
    }
    LDS_WAIT(); __syncthreads();
#pragma unroll 1
    for (int rr = 0; rr < 2; ++rr) { const int row = 2 * F.wave + rr, t = t0 + row, nj = (t >> 6) + 1; const LAS float* srow = SCL + row * SROW;
        unsigned k[32];
#pragma unroll
        for (int j = 0; j < 32; ++j) { const int s = lane + 64 * j; k[j] = fkey(s <= t ? srow[s] : -__builtin_inff()); }
        unsigned P = 0;
        if (t + 1 > TOPK) P = radix_select(k, nj, lane, hist);
        u64 myw = 0;
#pragma unroll
        for (int j = 0; j < 32; ++j) { const int s = lane + 64 * j; const u64 w = __ballot(k[j] >= P && s <= t); if (lane == j) myw = w; }
        if (lane < 32) F.MASK[(m0 + row) * 32 + lane] = myw;
    }
    LDS_WAIT(); __syncthreads();
}
__device__ __forceinline__ void p3_fused(Frame& F) {
    { const int gw = F.vcu * NWAVES + F.wave, NGW = F.G * NWAVES;
      for (int m = gw; m < M; m += NGW) { const int t = m % T; const bf16* pr = F.PROJ + (size_t)m * ATT_N;
          norm_rope32(F, pr + C_K + 32 * (F.lane & 15), F.K + (size_t)m * 512 + 32 * (F.lane & 15), F.k_gain, t, F.lane < 16);
          *(GAS v4u*)(F.V + (size_t)m * 512 + 8 * F.lane) = *(const GAS v4u*)(pr + C_V + 8 * F.lane); } }
    for (int u = F.vcu; u < 256; u += F.G) { const int b = u >> 6, i = u & 63; p3f_tile(F, b, 127 - i); p3f_tile(F, b, i); }
}
namespace att {
constexpr int D = 128, NW = 8, QBLK = 32, KVBLK = 64;
constexpr float SCALE = 0.088388347648318440f;
constexpr int LDQ = ATT_N, LDK = 512, LDO = DM;
constexpr int SHM_V = KVBLK * D * 2, SHM_K = KVBLK * D * 2, SHM_MASK = 2 * SHM_V + 2 * SHM_K + NW * 64 * 4, MROW = 33 * 8, SHM_ATTN = SHM_MASK + 256 * MROW;
#define KSWZ(row, colB) ((row) * 256 + ((colB) ^ (((row) & 7) << 4)))
#define SBAR() __builtin_amdgcn_sched_barrier(0)
__device__ __forceinline__ int crow(int r, int hi) { return (r & 3) + 8 * (r >> 2) + 4 * hi; }
__device__ __forceinline__ unsigned cvtpk(float lo, float hi) { unsigned r; asm volatile("v_cvt_pk_bf16_f32 %0, %1, %2" : "=v"(r) : "v"(lo), "v"(hi)); return r; }
__device__ __forceinline__ void partialSM(f32x16& p0, f32x16& p1) {
  for (int r = 0; r < 16; ++r) p0[r] = __builtin_amdgcn_exp2f(p0[r]);
}
__device__ __forceinline__ void finishSM(f32x16& p0, f32x16& p1, float& l_reg, bf16x8& pa0, bf16x8& pa1, bf16x8& pa2, bf16x8& pa3) {
  for (int r = 0; r < 16; ++r) p1[r] = __builtin_amdgcn_exp2f(p1[r]);
  float ps = 0; for (int r = 0; r < 16; ++r) ps += p0[r]; for (int r = 0; r < 16; ++r) ps += p1[r];
  { auto rr = __builtin_amdgcn_permlane32_swap(__float_as_uint(ps), __float_as_uint(ps), false, false);
    ps = __uint_as_float(rr[0]) + __uint_as_float(rr[1]); }
  l_reg += ps;
#define PK4(P, BASE, OUT) do { unsigned a0 = cvtpk(P[BASE + 0], P[BASE + 1]), a1 = cvtpk(P[BASE + 2], P[BASE + 3]);   \
    unsigned b0 = cvtpk(P[BASE + 4], P[BASE + 5]), b1 = cvtpk(P[BASE + 6], P[BASE + 7]);                              \
    auto r0 = __builtin_amdgcn_permlane32_swap(a0, b0, false, false); auto r1 = __builtin_amdgcn_permlane32_swap(a1, b1, false, false); \
    v4u w = {r0[0], r1[0], r0[1], r1[1]}; OUT = *reinterpret_cast<bf16x8*>(&w); } while (0)
  PK4(p0, 0, pa0); PK4(p0, 8, pa1); PK4(p1, 0, pa2); PK4(p1, 8, pa3);
#undef PK4
}
__device__ __forceinline__ void qkt(f32x16& p0, f32x16& p1, const bf16* Ks, const bf16x8* qr, int r32, int hi, unsigned mlo, unsigned mhi, float negm) {
  const unsigned nlo = ~mlo >> (4 * hi), nhi = ~mhi >> (4 * hi), nb = __float_as_uint(negm);
#pragma unroll
  for (int g = 0; g < 4; ++g) { const unsigned a0 = nlo << (27 - 8 * g), b0 = nlo << (26 - 8 * g), a1 = nhi << (27 - 8 * g), b1 = nhi << (26 - 8 * g);
    p0[4 * g + 0] = __uint_as_float((a0 & 0x08000000u) | nb); p0[4 * g + 1] = __uint_as_float((a0 & 0x10000000u) | nb); p0[4 * g + 2] = __uint_as_float((a0 & 0x20000000u) | nb); p0[4 * g + 3] = __uint_as_float((b0 & 0x20000000u) | nb);
    p1[4 * g + 0] = __uint_as_float((a1 & 0x08000000u) | nb); p1[4 * g + 1] = __uint_as_float((a1 & 0x10000000u) | nb); p1[4 * g + 2] = __uint_as_float((a1 & 0x20000000u) | nb); p1[4 * g + 3] = __uint_as_float((b1 & 0x20000000u) | nb); }
#pragma unroll
  for (int d0 = 0; d0 < 8; ++d0) { int cb = (d0 * 16 + hi * 8) * 2;
    bf16x8 b0 = *reinterpret_cast<const bf16x8*>((const char*)Ks + KSWZ(r32, cb));
    bf16x8 b1 = *reinterpret_cast<const bf16x8*>((const char*)Ks + KSWZ(32 + r32, cb));
    p0 = __builtin_amdgcn_mfma_f32_32x32x16_bf16(b0, qr[d0], p0, 0, 0, 0);
    p1 = __builtin_amdgcn_mfma_f32_32x32x16_bf16(b1, qr[d0], p1, 0, 0, 0); }
}
__device__ __forceinline__ int v_st(int k, int c) { const int kk = (k & ~0xC) | ((k & 4) << 1) | ((k & 8) >> 1); return ((kk >> 3) * 4 + (c >> 5)) * 512 + ((kk & 7) * 32 + (c & 31)) * 2; }
__device__ __forceinline__ int v_rd_base(int lane) { return ((lane & 3) << 3) | (((lane >> 2) & 3) << 6) | (((lane >> 4) & 1) << 5) | (((lane >> 5) & 1) << 8); }
constexpr int v_rd_off(int d0, int ks, int half) { return d0 * 512 + ks * 4096 + half * 2048; }
template <int OFF> __device__ __forceinline__ s16x4 tr_read(int vb) {
  s16x4 r; asm volatile("ds_read_b64_tr_b16 %0, %1 offset:%2" : "=&v"(r) : "v"(vb), "i"(OFF) : "memory"); return r;
}
template <int D0> __device__ __forceinline__ void pv_one(f32x16& od, int vb, bf16x8 pa0, bf16x8 pa1, bf16x8 pa2, bf16x8 pa3) {
  const s16x4 l0 = tr_read<v_rd_off(D0, 0, 0)>(vb), h0 = tr_read<v_rd_off(D0, 0, 1)>(vb), l1 = tr_read<v_rd_off(D0, 1, 0)>(vb), h1 = tr_read<v_rd_off(D0, 1, 1)>(vb);
  const s16x4 l2 = tr_read<v_rd_off(D0, 2, 0)>(vb), h2 = tr_read<v_rd_off(D0, 2, 1)>(vb), l3 = tr_read<v_rd_off(D0, 3, 0)>(vb), h3 = tr_read<v_rd_off(D0, 3, 1)>(vb);
  asm volatile("s_waitcnt lgkmcnt(0)" ::: "memory"); SBAR();
#define PK(L, H) (bf16x8){L[0], L[1], L[2], L[3], H[0], H[1], H[2], H[3]}
  od = __builtin_amdgcn_mfma_f32_32x32x16_bf16(pa0, PK(l0, h0), od, 0, 0, 0);
  od = __builtin_amdgcn_mfma_f32_32x32x16_bf16(pa1, PK(l1, h1), od, 0, 0, 0);
  od = __builtin_amdgcn_mfma_f32_32x32x16_bf16(pa2, PK(l2, h2), od, 0, 0, 0);
  od = __builtin_amdgcn_mfma_f32_32x32x16_bf16(pa3, PK(l3, h3), od, 0, 0, 0);
#undef PK
}
__device__ __forceinline__ void pv_d0(f32x16* o, int vb, bf16x8 pa0, bf16x8 pa1, bf16x8 pa2, bf16x8 pa3) {
  pv_one<0>(o[0], vb, pa0, pa1, pa2, pa3); pv_one<1>(o[1], vb, pa0, pa1, pa2, pa3); pv_one<2>(o[2], vb, pa0, pa1, pa2, pa3); pv_one<3>(o[3], vb, pa0, pa1, pa2, pa3);
}
__device__ __forceinline__ void attn_body(const bf16* __restrict__ Qb, const bf16* __restrict__ Kh, const bf16* __restrict__ Vh, bf16* __restrict__ Ob, const u64* __restrict__ mrow, int seq, char* lds,
                                          const float* __restrict__ qgain, const float* __restrict__ kgain, const f32x2* __restrict__ ropeA, int tpos0) {
  const int tid = opaque_tid(), wid = tid >> 6, lane = tid & 63, r32 = lane & 31, hi = lane >> 5;
  bf16* V_lds = (bf16*)lds; bf16* K_lds = (bf16*)(lds + 2 * SHM_V);
  float* ws = (float*)(lds + 2 * SHM_V + 2 * SHM_K) + wid * 64; float* li_l = ws;
  float l_reg = 0, negmC; f32x16 o[4] = {}; bf16x8 qr[8];
  const bf16* Qw = Qb + (long)(wid * QBLK + r32) * LDQ + hi * 8;
  { float x[64]; float s = 0.f;
#pragma unroll
    for (int d0 = 0; d0 < 8; ++d0) unpack8(*reinterpret_cast<const v4u*>(Qw + d0 * 16), x + 8 * d0);
#pragma unroll
    for (int e = 0; e < 64; ++e) s += x[e] * x[e];
    { auto rr = __builtin_amdgcn_permlane32_swap(__float_as_uint(s), __float_as_uint(s), false, false); s = __uint_as_float(rr[0]) + __uint_as_float(rr[1]); }
    const float rs = __builtin_amdgcn_rsqf(s * (1.f / 128.f) + EPS) * (SCALE * 1.4426950408889634f);
#pragma unroll
    for (int d0 = 0; d0 < 8; ++d0) { const f32x4 g0 = *(const f32x4*)(qgain + 16 * d0 + 8 * hi), g1 = *(const f32x4*)(qgain + 16 * d0 + 8 * hi + 4);
        x[8 * d0 + 0] *= rs * g0.x; x[8 * d0 + 1] *= rs * g0.y; x[8 * d0 + 2] *= rs * g0.z; x[8 * d0 + 3] *= rs * g0.w; x[8 * d0 + 4] *= rs * g1.x; x[8 * d0 + 5] *= rs * g1.y; x[8 * d0 + 6] *= rs * g1.z; x[8 * d0 + 7] *= rs * g1.w; }
    const f32x2* rp = ropeA + (size_t)(tpos0 + wid * QBLK + r32) * 16 + 8 * hi;
#pragma unroll
    for (int e = 0; e < 8; ++e) { const f32x2 cs = rp[e]; const float a = x[e], bq = x[8 + e]; x[e] = a * cs.x - bq * cs.y; x[8 + e] = a * cs.y + bq * cs.x; }
    { float q2 = 0.f, g2;
#pragma unroll
      for (int e = 0; e < 64; ++e) q2 += x[e] * x[e];
      { auto rr = __builtin_amdgcn_permlane32_swap(__float_as_uint(q2), __float_as_uint(q2), false, false); q2 = __uint_as_float(rr[0]) + __uint_as_float(rr[1]); }
      { const f32x2 kg = *(const f32x2*)(kgain + 2 * lane); g2 = fmaxf(kg.x * kg.x, kg.y * kg.y); }
#pragma unroll
      for (int sh = 1; sh < 64; sh <<= 1) g2 = fmaxf(g2, __shfl_xor(g2, sh));
      negmC = -fminf(fmaxf(1.02f * __builtin_sqrtf(q2 * g2 * 128.f), 2.f), 65000.f); }
#pragma unroll
    for (int d0 = 0; d0 < 8; ++d0) { v4u w = pack8f(x + 8 * d0); qr[d0] = *reinterpret_cast<bf16x8*>(&w); } }
  const char* mw = lds + SHM_MASK + (wid * QBLK + r32) * MROW;
  const int sr = tid >> 4, sc = (tid & 15) * 8, vst0 = v_st(sr, sc), vst1 = v_st(32 + sr, sc);
  const int vb0 = (int)(uintptr_t)V_lds + v_rd_base(lane);
  constexpr int SDEPTH = 2;
  struct { bf16x8 vs0, vs1, ks0, ks1; } sr_[SDEPTH];
#define SLOAD(i, k0) do { sr_[i].vs0 = *reinterpret_cast<const bf16x8*>(&Vh[(long)((k0) + sr) * LDK + sc]); sr_[i].vs1 = *reinterpret_cast<const bf16x8*>(&Vh[(long)((k0) + 32 + sr) * LDK + sc]); \
    sr_[i].ks0 = *reinterpret_cast<const bf16x8*>(&Kh[(long)((k0) + sr) * LDK + sc]); sr_[i].ks1 = *reinterpret_cast<const bf16x8*>(&Kh[(long)((k0) + 32 + sr) * LDK + sc]); } while (0)
#define SWRITE(b, i) do { *(bf16x8*)((char*)V_lds + (b) * SHM_V + vst0) = sr_[i].vs0;          \
    *(bf16x8*)((char*)V_lds + (b) * SHM_V + vst1) = sr_[i].vs1; int kc = sc * 2;               \
    *(bf16x8*)((char*)K_lds + (b) * SHM_K + KSWZ(sr, kc)) = sr_[i].ks0;                       \
    *(bf16x8*)((char*)K_lds + (b) * SHM_K + KSWZ(32 + sr, kc)) = sr_[i].ks1; } while (0)
#define SWAIT() do { if constexpr (SDEPTH == 2) asm volatile("s_waitcnt vmcnt(4)" ::: "memory"); else asm volatile("s_waitcnt vmcnt(0)" ::: "memory"); } while (0)
  f32x16 pA0, pA1, pB0, pB1; bf16x8 pa0, pa1, pa2, pa3; const int NT = seq / KVBLK;
  constexpr int SE = 0, SO = SDEPTH - 1;
  { const int NTw = seq / KVBLK; for (int e = tid; e < 256 * NTw; e += 512) { const int row = e / NTw, j = e - row * NTw; *(u64*)(lds + SHM_MASK + row * MROW + j * 8) = mrow[(size_t)row * 32 + j]; } }
#define MK(j) (*(const v2u*)(mw + (j) * 8))
  v2u mk;
  SLOAD(SE, 0); asm volatile("s_waitcnt vmcnt(0)" ::: "memory"); SWRITE(0, SE); __syncthreads();
  mk = MK(0); qkt(pA0, pA1, K_lds, qr, r32, hi, mk.x, mk.y, negmC); partialSM(pA0, pA1);
  SLOAD(SO, KVBLK); if constexpr (SDEPTH == 2) { if (2 < NT) SLOAD(SE, 2 * KVBLK); }
  SWAIT(); SWRITE(1, SO); __syncthreads();
  for (int j = 1; j + 1 < NT; j += 2) {
    SBAR(); mk = MK(j); qkt(pB0, pB1, (bf16*)((char*)K_lds + SHM_K), qr, r32, hi, mk.x, mk.y, negmC);
    finishSM(pA0, pA1, l_reg, pa0, pa1, pa2, pa3); SBAR();
    SLOAD(SO, (j + SDEPTH) * KVBLK); SBAR();
    pv_d0(o, vb0, pa0, pa1, pa2, pa3); partialSM(pB0, pB1);
    __syncthreads(); SWAIT(); SWRITE(0, SE);
    __syncthreads();
    SBAR(); mk = MK(j + 1); qkt(pA0, pA1, K_lds, qr, r32, hi, mk.x, mk.y, negmC);
    finishSM(pB0, pB1, l_reg, pa0, pa1, pa2, pa3); SBAR();
    if (SDEPTH == 1 || j + 3 < NT) SLOAD(SE, (j + 1 + SDEPTH) * KVBLK); SBAR();
    pv_d0(o, vb0 + (int)SHM_V, pa0, pa1, pa2, pa3); partialSM(pA0, pA1);
    __syncthreads(); SWAIT(); SWRITE(1, SO);
    __syncthreads();
  }
  SBAR(); mk = MK(NT - 1); qkt(pB0, pB1, (bf16*)((char*)K_lds + SHM_K), qr, r32, hi, mk.x, mk.y, negmC);
  finishSM(pA0, pA1, l_reg, pa0, pa1, pa2, pa3); SBAR();
  pv_d0(o, vb0, pa0, pa1, pa2, pa3); partialSM(pB0, pB1);
  __syncthreads();
  finishSM(pB0, pB1, l_reg, pa0, pa1, pa2, pa3); SBAR();
  pv_d0(o, vb0 + (int)SHM_V, pa0, pa1, pa2, pa3);
  if (hi == 0) li_l[r32] = l_reg; asm volatile("s_waitcnt lgkmcnt(0)" ::: "memory");
  float rli[16];
#pragma unroll
  for (int r = 0; r < 16; ++r) rli[r] = __builtin_amdgcn_rcpf(li_l[crow(r, hi)]);
  bf16* Ow = Ob + (long)(wid * QBLK) * LDO;
#pragma unroll
  for (int r = 0; r < 16; ++r) { const int orow = crow(r, hi);
#pragma unroll
    for (int d0 = 0; d0 < 4; ++d0) { const float v = o[d0][r] * rli[r]; const float vn = __shfl_xor(v, 1);
      if ((r32 & 1) == 0) *(unsigned*)(Ow + (long)orow * LDO + d0 * 32 + r32) = cvtpk(v, vn); } }
#undef MK
#undef SLOAD
#undef SWRITE
#undef SWAIT
}
#undef KSWZ
#undef SBAR
}
__device__ __forceinline__ void p4_attention(Frame& F, char* lds) {
    static_assert(att::SHM_ATTN <= RING_BYTES, "attention LDS");
    for (int it = F.vcu; it < 256; it += F.G) { const int grp = it >> 4, b = grp >> 2, g = grp & 3, h = g * 4 + ((it >> 2) & 3), x = it & 3;
        for (int pass = 0; pass < 2; ++pass) { const int qb = pass ? x : 7 - x; const size_t row0 = (size_t)b * T + (size_t)qb * 256;
            att::attn_body(F.PROJ + row0 * ATT_N + C_Q + h * HD, F.K + (size_t)b * T * 512 + g * HD, F.V + (size_t)b * T * 512 + g * HD, F.O + row0 * DM + h * HD, F.MASK + row0 * 32, 256 * (qb + 1), lds, F.q_gain, F.k_gain, F.ROPE_A, qb * 256);
            __syncthreads(); } }
}
namespace ml {
constexpr int QS = 0, KS = 16384, VS = 32768, PF = 65536, HS = 73728, HROW = 528, MISC = HS + 64 * HROW, PW = MISC + 2048, PWB = 1536, LDS_END_B = PW + 8 * PWB;
constexpr int A_KP = 0, A_VS = 16384, A_BUF = 49152, A_WK = 2 * A_BUF, A_B = A_WK + 8192, A_U = A_B + 8192, A_M = A_U + 8192, A_CH = A_M + 8192, LDS_END_A = A_CH + 1024;
#define SW16(row, colB) ((row) * 256 + ((colB) ^ (((row) & 15) << 4)))
#define SBAR() __builtin_amdgcn_sched_barrier(0)
#define MBAR() do { asm volatile("s_waitcnt lgkmcnt(0)" ::: "memory"); __builtin_amdgcn_s_barrier(); asm volatile("" ::: "memory"); } while (0)
using att::crow; using att::cvtpk; using att::v_st; using att::v_rd_base; using att::tr_read;
__device__ __forceinline__ bf16x8 pk88(const s16x4 l, const s16x4 h) { return (bf16x8){l[0], l[1], l[2], l[3], h[0], h[1], h[2], h[3]}; }
__device__ __forceinline__ bf16x8 pack_acc8(const f32x16& x, int s8) { v4u w = {cvtpk(x[s8 + 0], x[s8 + 1]), cvtpk(x[s8 + 2], x[s8 + 3]), cvtpk(x[s8 + 4], x[s8 + 5]), cvtpk(x[s8 + 6], x[s8 + 7])}; return *reinterpret_cast<bf16x8*>(&w); }
__device__ __forceinline__ v4u wmul8(const v4u k, float w) { v4u o; o.x = cvtpk(bflo(k.x) * w, bfhi(k.x) * w); o.y = cvtpk(bflo(k.y) * w, bfhi(k.y) * w); o.z = cvtpk(bflo(k.z) * w, bfhi(k.z) * w); o.w = cvtpk(bflo(k.w) * w, bfhi(k.w) * w); return o; }
template <int CTRL, int ROWMASK> __device__ __forceinline__ float dppf(float old, float src) {
    return __builtin_bit_cast(float, __builtin_amdgcn_update_dpp(__builtin_bit_cast(int, old), __builtin_bit_cast(int, src), CTRL, ROWMASK, 0xf, false)); }
__device__ __forceinline__ float wave_sum_dpp(float v) {
    v += dppf<0xB1, 0xf>(0.f, v); v += dppf<0x4E, 0xf>(0.f, v); v += dppf<0x141, 0xf>(0.f, v); v += dppf<0x140, 0xf>(0.f, v);
    const int iv = __builtin_bit_cast(int, v);
    return (__builtin_bit_cast(float, __builtin_amdgcn_readlane(iv, 0)) + __builtin_bit_cast(float, __builtin_amdgcn_readlane(iv, 16))) +
           (__builtin_bit_cast(float, __builtin_amdgcn_readlane(iv, 32)) + __builtin_bit_cast(float, __builtin_amdgcn_readlane(iv, 48)));
}
__device__ __forceinline__ float scan_sum64(float x) {
    x += dppf<0x111, 0xf>(0.f, x); x += dppf<0x112, 0xf>(0.f, x); x += dppf<0x114, 0xf>(0.f, x); x += dppf<0x118, 0xf>(0.f, x);
    x += dppf<0x142, 0xa>(0.f, x); x += dppf<0x143, 0xc>(0.f, x); return x;
}
__device__ __forceinline__ float scan_max64(float x) {
    const float NI = -__builtin_inff();
    x = fmaxf(x, dppf<0x111, 0xf>(NI, x)); x = fmaxf(x, dppf<0x112, 0xf>(NI, x)); x = fmaxf(x, dppf<0x114, 0xf>(NI, x)); x = fmaxf(x, dppf<0x118, 0xf>(NI, x));
    x = fmaxf(x, dppf<0x142, 0xa>(NI, x)); x = fmaxf(x, dppf<0x143, 0xc>(NI, x)); return x;
}
template <int I> __device__ __forceinline__ void cupd(f32x16& Xi, int vbK, const bf16x8 (&vB)[4]) {
    const s16x4 l0 = tr_read<I * 512 + 0 * 4096>(vbK), h0 = tr_read<I * 512 + 0 * 4096 + 2048>(vbK), l1 = tr_read<I * 512 + 1 * 4096>(vbK), h1 = tr_read<I * 512 + 1 * 4096 + 2048>(vbK);
    const s16x4 l2 = tr_read<I * 512 + 2 * 4096>(vbK), h2 = tr_read<I * 512 + 2 * 4096 + 2048>(vbK), l3 = tr_read<I * 512 + 3 * 4096>(vbK), h3 = tr_read<I * 512 + 3 * 4096 + 2048>(vbK);
    asm volatile("s_waitcnt lgkmcnt(0)" ::: "memory"); SBAR();
    Xi = __builtin_amdgcn_mfma_f32_32x32x16_bf16(pk88(l0, h0), vB[0], Xi, 0, 0, 0);
    Xi = __builtin_amdgcn_mfma_f32_32x32x16_bf16(pk88(l1, h1), vB[1], Xi, 0, 0, 0);
    Xi = __builtin_amdgcn_mfma_f32_32x32x16_bf16(pk88(l2, h2), vB[2], Xi, 0, 0, 0);
    Xi = __builtin_amdgcn_mfma_f32_32x32x16_bf16(pk88(l3, h3), vB[3], Xi, 0, 0, 0);
}
template <int I> __device__ __forceinline__ void yinter(f32x16& acc, const LAS unsigned char* qrow, int swz, int hi, bf16x8 xb0, bf16x8 xb1) {
    const v2u a00 = *(const LAS v2u*)(qrow + (((I * 32 + 0) * 2) ^ swz) + 8 * hi), a01 = *(const LAS v2u*)(qrow + (((I * 32 + 8) * 2) ^ swz) + 8 * hi);
    const v2u a10 = *(const LAS v2u*)(qrow + (((I * 32 + 16) * 2) ^ swz) + 8 * hi), a11 = *(const LAS v2u*)(qrow + (((I * 32 + 24) * 2) ^ swz) + 8 * hi);
    v4u A0 = {a00.x, a00.y, a01.x, a01.y}, A1 = {a10.x, a10.y, a11.x, a11.y};
    acc = __builtin_amdgcn_mfma_f32_32x32x16_bf16(*reinterpret_cast<bf16x8*>(&A0), xb0, acc, 0, 0, 0);
    acc = __builtin_amdgcn_mfma_f32_32x32x16_bf16(*reinterpret_cast<bf16x8*>(&A1), xb1, acc, 0, 0, 0);
}
}
__device__ __forceinline__ void late_weights(Frame& F, int gw, int NGW) {
    LAS float* scr = (LAS float*)(F.lds + RING_OFF + F.wave * 16384);
    constexpr int I9 = 32 * 64, I10 = 32 * 256, I11 = 128 * 64;
    for (int it = gw; it < I9 + I10 + I11; it += NGW) { int r = it;
        if (r < I9) { tr_item(F.ml_w_out, DM, 0, DM, 64, DM, nullptr, 1.f, F.WmoT, scr, r, F.lane); continue; } r -= I9;
        if (r < I10) { tr_item(F.w_up + (size_t)DM * FF, FF, 0, FF, 256, DM, F.norm_ffn + DM, 1.f, F.WupT1, scr, r, F.lane); continue; } r -= I10;
        tr_item(F.w_dn + (size_t)FF * DM, DM, 0, DM, 64, FF, nullptr, 1.f, F.WdnT1, scr, r, F.lane); }
}
template <int mode> __device__ __forceinline__ void p9a_state(Frame& F) {
    using namespace ml;
    constexpr int NBH = BATCH * MH, NC = T / 64;
    if (F.vcu >= NBH) { if (F.G > NBH && mode != 1) late_weights(F, (F.vcu - NBH) * NWAVES + F.wave, (F.G - NBH) * NWAVES); return; }
    if (mode == 2) return;
    LAS unsigned char* L = F.lds + RING_OFF;
    static_assert(ml::LDS_END_A <= RING_BYTES, "mLSTM pass A LDS");
    const int bh = F.vcu, b = bh / MH, h = bh % MH, w = F.wave, tid = F.tid;
    const size_t mb = (size_t)b * T;
    LAS float* WKL = (LAS float*)(L + A_WK); LAS float* BL = (LAS float*)(L + A_B); LAS float* UL = (LAS float*)(L + A_U); LAS float* MLs = (LAS float*)(L + A_M);
    LAS float* CH = (LAS float*)(L + A_CH);
    const float* igp = F.IG + (size_t)bh * T; const float* lfp = F.LF + (size_t)bh * T;
#pragma unroll
    for (int cc = 0; cc < 4; ++cc) { const int c = 4 * w + cc, t = c * 64 + F.lane; const float ig = igp[t], lf = lfp[t];
        const float bb = scan_sum64(lf), u = ig - bb, Mx = scan_max64(u);
        BL[t] = bb; UL[t] = u; MLs[t] = Mx; if (F.lane == 63) { CH[c] = bb; CH[32 + c] = Mx; } }
    LDS_WAIT(); __syncthreads();
    if (tid == 0) { float m = 0.f; for (int c = 0; c < NC; ++c) { const float mm63 = fmaxf(m, CH[32 + c]); CH[64 + c] = m; CH[96 + c] = __expf(m - mm63); CH[128 + c] = mm63; m = CH[c] + mm63; } }
    LDS_WAIT(); __syncthreads();
    { float* scal = F.SCAL + (size_t)bh * 4 * T;
      for (int t = tid; t < T; t += NTHR) { const int c = t >> 6; const float mst = CH[64 + c], mm = fmaxf(mst, MLs[t]), u = UL[t];
          scal[t] = u; scal[T + t] = mm; scal[2 * T + t] = __expf(mst - mm); scal[3 * T + t] = __expf(-(BL[t] + mm)); WKL[t] = __expf(u - CH[128 + c]); } }
    LDS_WAIT(); __syncthreads();
    f32x16 X[4];
#pragma unroll
    for (int i = 0; i < 4; ++i)
#pragma unroll
        for (int r = 0; r < 16; ++r) X[i][r] = 0.f;
    float nreg = 0.f;
    struct KV { v4u k0, k1, v00, v01, v10, v11; }; KV S0, S1, S2;
    const int lbase = (int)(uintptr_t)L;
#define A_LOAD(cc, S) do { const bf16* rp0 = F.PROJ + (mb + (size_t)(cc) * 64 + sr) * ML_N + sc; const bf16* rp1 = rp0 + 32 * ML_N;                              \
        S.k0 = *(const GAS v4u*)(rp0 + C_MK + h * MDK); S.k1 = *(const GAS v4u*)(rp1 + C_MK + h * MDK);                                                       \
        S.v00 = *(const GAS v4u*)(rp0 + C_MV + h * MDV); S.v01 = *(const GAS v4u*)(rp0 + C_MV + h * MDV + 128); S.v10 = *(const GAS v4u*)(rp1 + C_MV + h * MDV); S.v11 = *(const GAS v4u*)(rp1 + C_MV + h * MDV + 128); } while (0)
#define A_WRITE(cc, S) do { LAS unsigned char* B_ = L + ((cc) & 1) * A_BUF; const float w0 = WKL[(cc) * 64 + sr], w1 = WKL[(cc) * 64 + 32 + sr];            \
        *(LAS v4u*)(B_ + A_KP + v_st(sr, sc)) = wmul8(S.k0, w0); *(LAS v4u*)(B_ + A_KP + v_st(32 + sr, sc)) = wmul8(S.k1, w1);                                \
        *(LAS v4u*)(B_ + A_VS + v_st(sr, sc)) = S.v00; *(LAS v4u*)(B_ + A_VS + 16384 + v_st(sr, sc)) = S.v01;                                                 \
        *(LAS v4u*)(B_ + A_VS + v_st(32 + sr, sc)) = S.v10; *(LAS v4u*)(B_ + A_VS + 16384 + v_st(32 + sr, sc)) = S.v11; } while (0)
    { const int sr = tid >> 4, sc = (tid & 15) * 8; A_LOAD(0, S0); A_WRITE(0, S0); A_LOAD(1, S1); A_LOAD(2, S2); A_LOAD(3, S0); }
    LDS_WAIT(); __syncthreads();
#define A_ITER(cc, SN) do { if ((cc) < NC) {                                                                                                                  \
        int lane_o = F.lane, tid_o = F.tid; asm volatile("" : "+v"(lane_o), "+v"(tid_o));           \
        const int lane = lane_o, sr = tid_o >> 4, sc = (tid_o & 15) * 8;                                                                                         \
        { bf16* st = F.ST + ((((size_t)bh * NC + (cc)) * 8 + w) * 8) * 512 + lane * 8;                                                                           \
          _Pragma("unroll") for (int i = 0; i < 4; ++i) { *(GAS bf16x8*)(st + (i * 2 + 0) * 512) = pack_acc8(X[i], 0); *(GAS bf16x8*)(st + (i * 2 + 1) * 512) = pack_acc8(X[i], 8); } \
          if (w == 4 || w == 5) F.NST[((size_t)bh * NC + (cc)) * 128 + (w - 4) * 64 + lane] = nreg; }                                                            \
        if ((cc) < NC - 1) {                                                                                                                                     \
        const int boff = ((cc) & 1) * A_BUF; const float s_old = CH[96 + (cc)];                                                                                  \
        const int vbK = lbase + boff + A_KP + v_rd_base(lane), vbV = lbase + boff + A_VS + (w >> 2) * 16384 + (w & 3) * 512 + v_rd_base(lane);                   \
        bf16x8 vB[4];                                                                                                                                            \
        { const s16x4 l0 = tr_read<0 * 4096>(vbV), h0 = tr_read<0 * 4096 + 2048>(vbV), l1 = tr_read<1 * 4096>(vbV), h1 = tr_read<1 * 4096 + 2048>(vbV);          \
          const s16x4 l2 = tr_read<2 * 4096>(vbV), h2 = tr_read<2 * 4096 + 2048>(vbV), l3 = tr_read<3 * 4096>(vbV), h3 = tr_read<3 * 4096 + 2048>(vbV);          \
          asm volatile("s_waitcnt lgkmcnt(0)" ::: "memory"); SBAR();                                                                                             \
          vB[0] = pk88(l0, h0); vB[1] = pk88(l1, h1); vB[2] = pk88(l2, h2); vB[3] = pk88(l3, h3); }                                                              \
        _Pragma("unroll") for (int i = 0; i < 4; ++i) _Pragma("unroll") for (int r = 0; r < 16; ++r) X[i][r] *= s_old;                                           \
        cupd<0>(X[0], vbK, vB); cupd<1>(X[1], vbK, vB); cupd<2>(X[2], vbK, vB); cupd<3>(X[3], vbK, vB);                                                          \
        if (w == 4 || w == 5) { const int d = (w - 4) * 64 + lane; float acc = 0.f; const LAS unsigned char* kcol = L + boff + A_KP + ((d >> 5) * 512 + (d & 31) * 2); \
            _Pragma("unroll 1") for (int s8 = 0; s8 < 8; ++s8) {                                                                                                  \
                _Pragma("unroll") for (int e = 0; e < 8; ++e) acc += bf2f(*(const LAS bf16*)(kcol + s8 * 2048 + e * 64)); }                                       \
            nreg = s_old * nreg + acc; }                                                                                                                         \
        if ((cc) + 1 < NC - 1) { A_WRITE((cc) + 1, SN); if ((cc) + 4 < NC - 1) A_LOAD((cc) + 4, SN); }                                                           \
        MBAR(); } } } while (0)
    for (int c = 0; c < NC; c += 3) { A_ITER(c, S1); A_ITER(c + 1, S2); A_ITER(c + 2, S0); }
#undef A_ITER
#undef A_LOAD
#undef A_WRITE
}
__device__ __forceinline__ void p9b_output(Frame& F) {
    using namespace ml;
    constexpr int NC = T / 64, NITEMS = BATCH * MH * NC;
    LAS unsigned char* L = F.lds + RING_OFF;
    static_assert(ml::LDS_END_B <= RING_BYTES, "mLSTM pass B LDS");
    const int w = F.wave, tid = F.tid;
    LAS float* misc = (LAS float*)(L + MISC); LAS float* RSA = misc, * RSB = misc + 64, * QN = misc + 128;
    LAS float* pw = (LAS float*)(L + PW + w * PWB);
    const int lbase = (int)(uintptr_t)L;
    if (tid < 64) RSB[tid] = 0.f;
    f32x4 hg; { const float* gp = F.h_gain + 4 * F.lane; hg = (f32x4){gp[0], gp[1], gp[2], gp[3]}; }
    v4u sq0, sq1, sk0, sk1, sv00, sv01, sv10, sv11; float s_u, s_mm, s_sint, s_nrm; f32x2 s_n;
    LAS float* NBl = misc + 192;
#define B_LOAD(it_) do { const int bh_ = (it_) & 31, c_ = (it_) >> 5, b_ = bh_ / MH, h_ = bh_ % MH;                                                         \
        const bf16* rp0 = F.PROJ + ((size_t)b_ * T + (size_t)c_ * 64 + sr) * ML_N + sc; const bf16* rp1 = rp0 + 32 * ML_N;                                      \
        sq0 = *(const GAS v4u*)(rp0 + C_MQ + h_ * MDK); sq1 = *(const GAS v4u*)(rp1 + C_MQ + h_ * MDK); sk0 = *(const GAS v4u*)(rp0 + C_MK + h_ * MDK); sk1 = *(const GAS v4u*)(rp1 + C_MK + h_ * MDK);   \
        sv00 = *(const GAS v4u*)(rp0 + C_MV + h_ * MDV); sv01 = *(const GAS v4u*)(rp0 + C_MV + h_ * MDV + 128); sv10 = *(const GAS v4u*)(rp1 + C_MV + h_ * MDV); sv11 = *(const GAS v4u*)(rp1 + C_MV + h_ * MDV + 128); \
        const float* sp_ = F.SCAL + (size_t)bh_ * 4 * T + c_ * 64 + lane; s_u = sp_[0]; s_mm = sp_[T]; s_sint = sp_[2 * T]; s_nrm = sp_[3 * T];                                                \
        s_n = *(const GAS f32x2*)(F.NST + ((size_t)bh_ * NC + c_) * 128 + 2 * lane); } while (0)
#define B_WRITE() do { pw[lane] = s_u; pw[64 + lane] = s_mm; if (w == 3) *(LAS f32x2*)(NBl + 2 * lane) = s_n;                                                                                            \
        *(LAS v4u*)(L + QS + SW16(sr, sc * 2)) = sq0; *(LAS v4u*)(L + QS + SW16(32 + sr, sc * 2)) = sq1;                                                \
        *(LAS v4u*)(L + KS + SW16(sr, sc * 2)) = sk0; *(LAS v4u*)(L + KS + SW16(32 + sr, sc * 2)) = sk1;                                                \
        *(LAS v4u*)(L + VS + v_st(sr, sc)) = sv00; *(LAS v4u*)(L + VS + 16384 + v_st(sr, sc)) = sv01;                                                   \
        *(LAS v4u*)(L + VS + v_st(32 + sr, sc)) = sv10; *(LAS v4u*)(L + VS + 16384 + v_st(32 + sr, sc)) = sv11; } while (0)
    int it = F.vcu; if (it >= NITEMS) return;
    float c_sint, c_nrm;
    { const int lane = F.lane, sr = tid >> 4, sc = (tid & 15) * 8; B_LOAD(it); B_WRITE(); c_sint = s_sint; c_nrm = s_nrm; if (it + F.G < NITEMS) B_LOAD(it + F.G); }
    LDS_WAIT(); __syncthreads();
    for (; it < NITEMS; it += F.G) {
        const int bh = it & 31, c = it >> 5, b = bh / MH, h = bh % MH, t0 = c * 64; const size_t mb = (size_t)b * T;
        int lane_o = F.lane, tid_o = F.tid; asm volatile("" : "+v"(lane_o), "+v"(tid_o));
        const int lane = lane_o, r32 = lane & 31, hi = lane >> 5, sr = tid_o >> 4, sc = (tid_o & 15) * 8;
        const int vbV = lbase + VS + (w >> 2) * 16384 + (w & 3) * 512 + v_rd_base(lane);
        bf16x8 xb[4][2];
        { const bf16* st = F.ST + ((((size_t)bh * NC + c) * 8 + w) * 8) * 512 + lane * 8;
#pragma unroll
          for (int i = 0; i < 4; ++i) { xb[i][0] = __builtin_nontemporal_load((const GAS bf16x8*)(st + (i * 2 + 0) * 512)); xb[i][1] = __builtin_nontemporal_load((const GAS bf16x8*)(st + (i * 2 + 1) * 512)); } }
        if (w < 3) { const int lt = w ? 1 : 0, st = w == 2 ? 1 : 0; const int srow = r32 + 32 * st, lrow = r32 + 32 * lt;
            f32x16 p;
#pragma unroll
            for (int r = 0; r < 16; ++r) p[r] = 0.f;
#pragma unroll
            for (int kk = 0; kk < 8; ++kk) { const bf16x8 ka = *(const LAS bf16x8*)(L + KS + SW16(srow, (16 * kk + 8 * hi) * 2)), qb = *(const LAS bf16x8*)(L + QS + SW16(lrow, (16 * kk + 8 * hi) * 2));
                p = __builtin_amdgcn_mfma_f32_32x32x16_bf16(ka, qb, p, 0, 0, 0); }
            const float mml = pw[64 + lrow]; float ps = 0.f;
#pragma unroll
            for (int r = 0; r < 16; ++r) { const int s = crow(r, hi) + 32 * st; const float us = pw[s]; const float wgt = (s <= lrow) ? __expf(us - mml) : 0.f; p[r] *= wgt; ps += p[r]; }
            { auto rr = __builtin_amdgcn_permlane32_swap(__float_as_uint(ps), __float_as_uint(ps), false, false); ps = __uint_as_float(rr[0]) + __uint_as_float(rr[1]); }
            if (hi == 0) { if (st == 0) RSA[lrow] = ps; else RSB[lrow] = ps; }
            bf16x8 pa0, pa1;
#define PK4(P, BASE, OUT) do { unsigned a0 = cvtpk(P[BASE + 0], P[BASE + 1]), a1 = cvtpk(P[BASE + 2], P[BASE + 3]);   \
    unsigned b0 = cvtpk(P[BASE + 4], P[BASE + 5]), b1 = cvtpk(P[BASE + 6], P[BASE + 7]);                              \
    auto r0 = __builtin_amdgcn_permlane32_swap(a0, b0, false, false); auto r1 = __builtin_amdgcn_permlane32_swap(a1, b1, false, false); \
    v4u w_ = {r0[0], r1[0], r0[1], r1[1]}; OUT = *reinterpret_cast<bf16x8*>(&w_); } while (0)
            PK4(p, 0, pa0); PK4(p, 8, pa1);
#undef PK4
            *(LAS bf16x8*)(L + PF + (lt * 4 + 2 * st + 0) * 1024 + lane * 16) = pa0; *(LAS bf16x8*)(L + PF + (lt * 4 + 2 * st + 1) * 1024 + lane * 16) = pa1;
        } else if (w == 3) { const LAS float* nb = NBl; float acc = 0.f;
#pragma unroll 2
            for (int ch = 0; ch < 16; ++ch) { const v4u qv = *(const LAS v4u*)(L + QS + SW16(lane, ch * 16)); const f32x4 n0 = *(const LAS f32x4*)(nb + 8 * ch), n1 = *(const LAS f32x4*)(nb + 8 * ch + 4);
                acc += bflo(qv.x) * n0.x + bfhi(qv.x) * n0.y + bflo(qv.y) * n0.z + bfhi(qv.y) * n0.w + bflo(qv.z) * n1.x + bfhi(qv.z) * n1.y + bflo(qv.w) * n1.z + bfhi(qv.w) * n1.w; }
            QN[lane] = acc;
        }
        MBAR();
        { const float den = RSA[lane] + RSB[lane] + c_sint * QN[lane]; const float rinv = 1.f / fmaxf(fabsf(den), c_nrm); pw[192 + lane] = rinv; pw[256 + lane] = c_sint * rinv; }
        bf16x8 vB[4];
        { const s16x4 l0 = tr_read<0 * 4096>(vbV), h0 = tr_read<0 * 4096 + 2048>(vbV), l1 = tr_read<1 * 4096>(vbV), h1 = tr_read<1 * 4096 + 2048>(vbV);
          const s16x4 l2 = tr_read<2 * 4096>(vbV), h2 = tr_read<2 * 4096 + 2048>(vbV), l3 = tr_read<3 * 4096>(vbV), h3 = tr_read<3 * 4096 + 2048>(vbV);
          asm volatile("s_waitcnt lgkmcnt(0)" ::: "memory"); SBAR();
          vB[0] = pk88(l0, h0); vB[1] = pk88(l1, h1); vB[2] = pk88(l2, h2); vB[3] = pk88(l3, h3); }
        f32x16 aI0, aI1;
#pragma unroll
        for (int r = 0; r < 16; ++r) { aI0[r] = 0.f; aI1[r] = 0.f; }
        { const LAS unsigned char* qrow0 = L + QS + r32 * 256; const LAS unsigned char* qrow1 = qrow0 + 32 * 256; const int swz = (r32 & 15) << 4;
#define YI(I) do { yinter<I>(aI0, qrow0, swz, hi, xb[I][0], xb[I][1]); yinter<I>(aI1, qrow1, swz, hi, xb[I][0], xb[I][1]); } while (0)
          YI(0); YI(1); YI(2); YI(3);
#undef YI
        }
        v2u og[8];
#pragma unroll
        for (int e = 0; e < 8; ++e) og[e] = *(const GAS v2u*)(F.PROJ + (mb + t0 + 8 * w + e) * ML_N + C_MO + h * MDV + 4 * lane);
#pragma unroll
        for (int lt = 0; lt < 2; ++lt) { f32x16 aY;
#pragma unroll
            for (int r = 0; r < 16; ++r) aY[r] = 0.f;
            { const bf16x8 p0 = *(const LAS bf16x8*)(L + PF + (lt * 4 + 0) * 1024 + lane * 16), p1 = *(const LAS bf16x8*)(L + PF + (lt * 4 + 1) * 1024 + lane * 16);
              aY = __builtin_amdgcn_mfma_f32_32x32x16_bf16(p0, vB[0], aY, 0, 0, 0); aY = __builtin_amdgcn_mfma_f32_32x32x16_bf16(p1, vB[1], aY, 0, 0, 0); }
            if (lt == 1) { const bf16x8 p2 = *(const LAS bf16x8*)(L + PF + (4 + 2) * 1024 + lane * 16), p3 = *(const LAS bf16x8*)(L + PF + (4 + 3) * 1024 + lane * 16);
              aY = __builtin_amdgcn_mfma_f32_32x32x16_bf16(p2, vB[2], aY, 0, 0, 0); aY = __builtin_amdgcn_mfma_f32_32x32x16_bf16(p3, vB[3], aY, 0, 0, 0); }
#pragma unroll
            for (int r = 0; r < 16; ++r) { const int l = crow(r, hi) + 32 * lt; const float y = aY[r] * pw[192 + l] + (lt ? aI1[r] : aI0[r]) * pw[256 + l];
                *(LAS bf16*)(L + HS + l * HROW + (32 * w + r32) * 2) = (bf16)f2bf(y); }
        }
        MBAR();
#pragma unroll
        for (int e = 0; e < 8; ++e) { const int l = 8 * w + e; const v2u hv = *(const LAS v2u*)(L + HS + l * HROW + lane * 8);
            const float h0 = bflo(hv.x), h1 = bfhi(hv.x), h2 = bflo(hv.y), h3 = bfhi(hv.y);
            const float ss = wave_sum_dpp((h0 * h0 + h1 * h1) + (h2 * h2 + h3 * h3)); const float rn = __builtin_amdgcn_rsqf(ss * (1.f / MDV) + EPS);
            const float o0 = bflo(og[e].x), o1 = bfhi(og[e].x), o2 = bflo(og[e].y), o3 = bfhi(og[e].y);
            const float y0 = h0 * rn * hg.x / (1.f + __expf(-o0)), y1 = h1 * rn * hg.y / (1.f + __expf(-o1)), y2 = h2 * rn * hg.z / (1.f + __expf(-o2)), y3 = h3 * rn * hg.w / (1.f + __expf(-o3));
            v2u ov; ov.x = cvtpk(y0, y1); ov.y = cvtpk(y2, y3);
            *(GAS v2u*)(F.O + (mb + t0 + l) * DM + h * MDV + 4 * lane) = ov; }
        if (it + F.G < NITEMS) { B_WRITE(); c_sint = s_sint; c_nrm = s_nrm; if (it + 2 * F.G < NITEMS) B_LOAD(it + 2 * F.G); }
        MBAR();
    }
#undef B_LOAD
#undef B_WRITE
}
#undef SW16
#undef SBAR
#undef MBAR
namespace mlh {
constexpr int WREG = 12288, KIMG = 0, VIMG = 8192, XB0 = 8 * WREG, XBSZ = 16384 + 1024, WKO = XB0 + 2 * XBSZ, CHO = WKO + 8192, FLAGO = CHO + 1024, LDS_END = FLAGO + 64;
constexpr int TB = 0, TU = 8192, TM = 16384;
__device__ __forceinline__ int kh_st(int k, int c) { const int kk = (k & ~0xC) | ((k & 4) << 1) | ((k & 8) >> 1); return ((kk >> 3) * 2 + (c >> 5)) * 512 + ((kk & 7) * 32 + (c & 31)) * 2; }
__device__ __forceinline__ int vs_st(int k, int c) { const int kk = (k & ~0xC) | ((k & 4) << 1) | ((k & 8) >> 1); return (kk >> 3) * 512 + ((kk & 7) * 32 + c) * 2; }
using att::tr_read; using att::v_rd_base; using att::cvtpk; using ml::pk88; using ml::pack_acc8; using ml::wmul8; using ml::scan_sum64; using ml::scan_max64;
template <bool WITHN> __device__ __forceinline__ void dhalf(f32x16& D0, f32x16& D1, float& n0, float& n1, int vbK, const bf16x8 (&vB)[4]) {
    const bf16x8 ones = (bf16x8){0x3f80, 0x3f80, 0x3f80, 0x3f80, 0x3f80, 0x3f80, 0x3f80, 0x3f80};
    f32x16 N0, N1;
    if (WITHN) {
#pragma unroll
        for (int r = 0; r < 16; ++r) { N0[r] = 0.f; N1[r] = 0.f; } }
#define DH_STEP(KS) do { const s16x4 l0 = tr_read<0 * 512 + KS * 2048>(vbK), h0 = tr_read<0 * 512 + KS * 2048 + 1024>(vbK), l1 = tr_read<1 * 512 + KS * 2048>(vbK), h1 = tr_read<1 * 512 + KS * 2048 + 1024>(vbK); \
        asm volatile("s_waitcnt lgkmcnt(0)" ::: "memory"); __builtin_amdgcn_sched_barrier(0);                                                                           \
        const bf16x8 a0 = pk88(l0, h0), a1 = pk88(l1, h1);                                                                                                               \
        D0 = __builtin_amdgcn_mfma_f32_32x32x16_bf16(a0, vB[KS], D0, 0, 0, 0); D1 = __builtin_amdgcn_mfma_f32_32x32x16_bf16(a1, vB[KS], D1, 0, 0, 0);                      \
        if (WITHN) { N0 = __builtin_amdgcn_mfma_f32_32x32x16_bf16(ones, a0, N0, 0, 0, 0); N1 = __builtin_amdgcn_mfma_f32_32x32x16_bf16(ones, a1, N1, 0, 0, 0); } } while (0)
    DH_STEP(0); DH_STEP(1); DH_STEP(2); DH_STEP(3);
#undef DH_STEP
    if (WITHN) { n0 = N0[0]; n1 = N1[0]; }
}
}
template <bool WITHN> __device__ __forceinline__ void p10_chain(Frame& F, int bh, int js) {
    using namespace mlh;
    constexpr int NC = T / 64;
    LAS unsigned char* L = F.lds + RING_OFF;
    const int b = bh / MH, h = bh % MH, w = F.wave, lane = F.lane;
    const size_t mb = (size_t)b * T;
    LAS unsigned char* R = L + w * WREG;
    const LAS float* WKL = (const LAS float*)(L + WKO); const LAS float* CH = (const LAS float*)(L + CHO);
    volatile LAS unsigned* flag = (volatile LAS unsigned*)(L + FLAGO);
    const int lbase = (int)(uintptr_t)R;
    const int vbK = lbase + KIMG + v_rd_base(lane), vbV = lbase + VIMG + v_rd_base(lane);
    v4u ka[8], va[4];
    const int krow = lane >> 3, kc16 = lane & 7, vrow = lane >> 2, vc16 = lane & 3;
#define H_LOADK(cc, hh) do { const bf16* kp = F.PROJ + (mb + (size_t)(cc) * 64 + krow) * ML_N + C_MK + h * MDK + (hh) * 64 + 8 * kc16;                      \
        _Pragma("unroll") for (int e = 0; e < 8; ++e) ka[e] = *(const GAS v4u*)(kp + (size_t)(8 * e) * ML_N); } while (0)
#define H_LOADV(cc) do { const bf16* vp = F.PROJ + (mb + (size_t)(cc) * 64 + vrow) * ML_N + C_MV + h * MDV + js * 32 + 8 * vc16;                           \
        _Pragma("unroll") for (int e = 0; e < 4; ++e) va[e] = *(const GAS v4u*)(vp + (size_t)(16 * e) * ML_N); } while (0)
#define H_WRITEK(cc) do { _Pragma("unroll") for (int e = 0; e < 8; ++e) { const int s = 8 * e + krow; *(LAS v4u*)(R + KIMG + kh_st(s, 8 * kc16)) = wmul8(ka[e], WKL[(cc) * 64 + s]); } } while (0)
#define H_WRITEV() do { _Pragma("unroll") for (int e = 0; e < 4; ++e) { const int s = 16 * e + vrow; *(LAS v4u*)(R + VIMG + vs_st(s, 8 * vc16)) = va[e]; } } while (0)
    f32x16 D[4]; float dn[4] = {0.f, 0.f, 0.f, 0.f};
    if (w < NC - 1) { H_LOADK(w, 0); H_LOADV(w); }
#pragma unroll 1
    for (int r = 0; r < NC / 8; ++r) { const int c = w + 8 * r;
        if (c < NC - 1) {
#pragma unroll
            for (int i = 0; i < 4; ++i)
#pragma unroll
                for (int q = 0; q < 16; ++q) D[i][q] = 0.f;
            H_WRITEK(c); H_WRITEV(); H_LOADK(c, 1);
            bf16x8 vB[4];
            { const s16x4 l0 = tr_read<0 * 1024>(vbV), h0 = tr_read<0 * 1024 + 512>(vbV), l1 = tr_read<1 * 1024>(vbV), h1 = tr_read<1 * 1024 + 512>(vbV);
              const s16x4 l2 = tr_read<2 * 1024>(vbV), h2 = tr_read<2 * 1024 + 512>(vbV), l3 = tr_read<3 * 1024>(vbV), h3 = tr_read<3 * 1024 + 512>(vbV);
              asm volatile("s_waitcnt lgkmcnt(0)" ::: "memory"); __builtin_amdgcn_sched_barrier(0);
              vB[0] = pk88(l0, h0); vB[1] = pk88(l1, h1); vB[2] = pk88(l2, h2); vB[3] = pk88(l3, h3); }
            dhalf<WITHN>(D[0], D[1], dn[0], dn[1], vbK, vB);
            H_WRITEK(c);
            if (c + 8 < NC - 1) { H_LOADK(c + 8, 0); }
            dhalf<WITHN>(D[2], D[3], dn[2], dn[3], vbK, vB);
            if (c + 8 < NC - 1) { H_LOADV(c + 8); }
        }
        f32x16 X[4]; float nn[4] = {0.f, 0.f, 0.f, 0.f};
        if (c > 0) { while (*flag < (unsigned)c) __builtin_amdgcn_s_sleep(1);
            asm volatile("" ::: "memory");
            const LAS unsigned char* xb = L + XB0 + (c & 1) * XBSZ;
#pragma unroll
            for (int i = 0; i < 4; ++i)
#pragma unroll
                for (int q = 0; q < 4; ++q) { const f32x4 v = *(const LAS f32x4*)(xb + ((i * 4 + q) * 64 + lane) * 16); X[i][4 * q] = v.x; X[i][4 * q + 1] = v.y; X[i][4 * q + 2] = v.z; X[i][4 * q + 3] = v.w; }
            if (WITHN) {
#pragma unroll
                for (int i = 0; i < 4; ++i) nn[i] = *(const LAS float*)(xb + 16384 + (i * 32 + (lane & 31)) * 4); }
        } else {
#pragma unroll
            for (int i = 0; i < 4; ++i)
#pragma unroll
                for (int q = 0; q < 16; ++q) X[i][q] = 0.f;
        }
        { bf16* st = F.ST + ((((size_t)bh * NC + c) * 8 + js) * 8) * 512 + lane * 8;
#pragma unroll
          for (int i = 0; i < 4; ++i) { *(GAS bf16x8*)(st + (i * 2 + 0) * 512) = pack_acc8(X[i], 0); *(GAS bf16x8*)(st + (i * 2 + 1) * 512) = pack_acc8(X[i], 8); }
          if (WITHN && lane < 32) {
#pragma unroll
              for (int i = 0; i < 4; ++i) F.NST[((size_t)bh * NC + c) * 128 + i * 32 + lane] = nn[i]; } }
        if (c < NC - 1) { const float s_old = CH[96 + c]; LAS unsigned char* xo = L + XB0 + ((c + 1) & 1) * XBSZ;
#pragma unroll
            for (int i = 0; i < 4; ++i)
#pragma unroll
                for (int q = 0; q < 4; ++q) { f32x4 v; v.x = s_old * X[i][4 * q] + D[i][4 * q]; v.y = s_old * X[i][4 * q + 1] + D[i][4 * q + 1]; v.z = s_old * X[i][4 * q + 2] + D[i][4 * q + 2]; v.w = s_old * X[i][4 * q + 3] + D[i][4 * q + 3];
                    *(LAS f32x4*)(xo + ((i * 4 + q) * 64 + lane) * 16) = v; }
            if (WITHN && lane < 32) {
#pragma unroll
                for (int i = 0; i < 4; ++i) *(LAS float*)(xo + 16384 + (i * 32 + lane) * 4) = s_old * nn[i] + dn[i]; }
            asm volatile("s_waitcnt lgkmcnt(0)" ::: "memory");
            if (lane == 0) *flag = (unsigned)(c + 1);
        }
    }
#undef H_LOADK
#undef H_LOADV
#undef H_WRITEK
#undef H_WRITEV
}
__device__ __forceinline__ void p10_state_chain(Frame& F) {
    using namespace mlh;
    constexpr int NC = T / 64;
    static_assert(mlh::LDS_END <= RING_BYTES, "mLSTM chain LDS");
    LAS unsigned char* L = F.lds + RING_OFF;
    for (int it = F.vcu; it < BATCH * MH * 8; it += F.G) { const int bh = it >> 3, js = it & 7, w = F.wave, tid = F.tid;
        LAS float* WKL = (LAS float*)(L + WKO); LAS float* BL = (LAS float*)(L + TB); LAS float* UL = (LAS float*)(L + TU); LAS float* MLs = (LAS float*)(L + TM); LAS float* CH = (LAS float*)(L + CHO);
        const float* igp = F.IG + (size_t)bh * T; const float* lfp = F.LF + (size_t)bh * T;
        if (tid == 0) *(LAS unsigned*)(L + FLAGO) = 0u;
#pragma unroll
        for (int cc = 0; cc < 4; ++cc) { const int c = 4 * w + cc, t = c * 64 + F.lane; const float ig = igp[t], lf = lfp[t];
            const float bb = scan_sum64(lf), u = ig - bb, Mx = scan_max64(u);
            BL[t] = bb; UL[t] = u; MLs[t] = Mx; if (F.lane == 63) { CH[c] = bb; CH[32 + c] = Mx; } }
        LDS_WAIT(); __syncthreads();
        if (tid == 0) { float m = 0.f; for (int c = 0; c < NC; ++c) { const float mm63 = fmaxf(m, CH[32 + c]); CH[64 + c] = m; CH[96 + c] = __expf(m - mm63); CH[128 + c] = mm63; m = CH[c] + mm63; } }
        LDS_WAIT(); __syncthreads();
        { float* scal = F.SCAL + (size_t)bh * 4 * T;
          for (int t = tid; t < T; t += NTHR) { const int c = t >> 6; const float mst = CH[64 + c], mm = fmaxf(mst, MLs[t]), u = UL[t];
              if (js == 0) { scal[t] = u; scal[T + t] = mm; scal[2 * T + t] = __expf(mst - mm); scal[3 * T + t] = __expf(-(BL[t] + mm)); }
              WKL[t] = __expf(u - CH[128 + c]); } }
        LDS_WAIT(); __syncthreads();
        if (js == 0) p10_chain<true>(F, bh, js); else p10_chain<false>(F, bh, js);
        LDS_WAIT(); __syncthreads();
    }
}
#if ORA_IDX
__global__ __launch_bounds__(256) void ora_indexer(const bf16* QI, const bf16* KI, const float* WI, u64* MASK) {
    __shared__ float qi[1024]; __shared__ float sc[2048]; __shared__ float wi[16]; __shared__ unsigned cnt;
    const int m = blockIdx.x, b = m / T, t = m % T, tid = threadIdx.x;
    for (int i = tid; i < 1024; i += 256) qi[i] = bf2f(QI[(size_t)m * 1024 + i]);
    if (tid < 16) wi[tid] = WI[(size_t)m * 16 + tid];
    __syncthreads();
    for (int s = tid; s < T; s += 256) { float v = -__builtin_inff();
        if (s <= t) { float kk[64]; const v4u* kp = (const v4u*)(KI + (size_t)(b * T + s) * 64);
#pragma unroll
            for (int j = 0; j < 8; ++j) unpack8(kp[j], kk + 8 * j);
            v = 0.f;
            for (int h = 0; h < 16; ++h) { float d = 0.f;
#pragma unroll
                for (int e = 0; e < 64; ++e) d += qi[h * 64 + e] * kk[e];
                v += wi[h] * fmaxf(d, 0.f); } }
        sc[s] = v; }
    __syncthreads();
    unsigned k[8];
#pragma unroll
    for (int j = 0; j < 8; ++j) k[j] = fkey(sc[tid + 256 * j]);
    unsigned P = 0;
    for (int bit = 31; bit >= 0; --bit) { const unsigned cand = P | (1u << bit); unsigned c = 0;
#pragma unroll
        for (int j = 0; j < 8; ++j) c += (k[j] >= cand) ? 1u : 0u;
        if (tid == 0) cnt = 0; __syncthreads(); atomicAdd(&cnt, c); __syncthreads(); if (cnt >= (unsigned)TOPK) P = cand; __syncthreads(); }
    if (tid < 32) { u64 w = 0; for (int e = 0; e < 64; ++e) { const int s = 64 * tid + e; if (s <= t && fkey(sc[s]) >= P) w |= (1ull << e); } MASK[(size_t)m * 32 + tid] = w; }
}
#endif
#if ORA_ATT
__global__ __launch_bounds__(128) void ora_attn(const bf16* Q, const bf16* K, const bf16* V, const u64* MASK, bf16* O) {
    __shared__ float q[4][128]; __shared__ int idx[320]; __shared__ float p[4][320]; __shared__ int cnts[128]; __shared__ int total; __shared__ float linv[4];
    const int m = blockIdx.x >> 2, g = blockIdx.x & 3, b = m / T, tid = threadIdx.x;
    for (int r = 0; r < 4; ++r) q[r][tid] = bf2f(Q[(size_t)m * DM + (g * 4 + r) * HD + tid]);
    const unsigned bits = (unsigned)(MASK[(size_t)m * 32 + (tid >> 2)] >> (16 * (tid & 3))) & 0xffffu;
    cnts[tid] = __builtin_popcount(bits); __syncthreads();
    if (tid == 0) { int a = 0; for (int i = 0; i < 128; ++i) { const int c = cnts[i]; cnts[i] = a; a += c; } total = a; }
    __syncthreads();
    { int o = cnts[tid]; for (int e = 0; e < 16; ++e) if ((bits >> e) & 1u) { if (o < 320) idx[o] = 16 * tid + e; ++o; } }
    __syncthreads();
    const int n = total < 320 ? total : 320;
    for (int j = tid; j < n; j += 128) { const bf16* kr = K + (size_t)(b * T + idx[j]) * 512 + g * HD; float d0 = 0, d1 = 0, d2 = 0, d3 = 0;
        for (int e = 0; e < 128; ++e) { const float kv = bf2f(kr[e]); d0 += q[0][e] * kv; d1 += q[1][e] * kv; d2 += q[2][e] * kv; d3 += q[3][e] * kv; }
        const float sc = 0.08838834764831845f; p[0][j] = d0 * sc; p[1][j] = d1 * sc; p[2][j] = d2 * sc; p[3][j] = d3 * sc; }
    __syncthreads();
    if (tid < 4) { float mx = -__builtin_inff(); for (int j = 0; j < n; ++j) mx = fmaxf(mx, p[tid][j]); float s = 0.f; for (int j = 0; j < n; ++j) { const float e = expf(p[tid][j] - mx); p[tid][j] = e; s += e; } linv[tid] = 1.f / s; }
    __syncthreads();
    float o0 = 0, o1 = 0, o2 = 0, o3 = 0;
    for (int j = 0; j < n; ++j) { const float v = bf2f(V[(size_t)(b * T + idx[j]) * 512 + g * HD + tid]); o0 += p[0][j] * v; o1 += p[1][j] * v; o2 += p[2][j] * v; o3 += p[3][j] * v; }
    bf16* op = O + (size_t)m * DM + g * 4 * HD + tid;
    op[0] = (bf16)f2bf(o0 * linv[0]); op[HD] = (bf16)f2bf(o1 * linv[1]); op[2 * HD] = (bf16)f2bf(o2 * linv[2]); op[3 * HD] = (bf16)f2bf(o3 * linv[3]);
}
#endif
#if ORA_ML
__global__ __launch_bounds__(256) void ora_mlstm(const bf16* PROJ, const float* IG, const float* LF, const float* hgain, bf16* A2) {
    __shared__ float qs[128], ks[128], pr[128], red[4];
    const int b = blockIdx.x / MH, h = blockIdx.x % MH, e = threadIdx.x;
    float C[128]; float nd = 0.f, mst = 0.f;
#pragma unroll
    for (int d = 0; d < 128; ++d) C[d] = 0.f;
    const float hg = hgain[e];
    for (int t = 0; t < T; ++t) { const size_t m = (size_t)b * T + t; const bf16* row = PROJ + m * ML_N;
        const float ig = IG[(size_t)(b * MH + h) * T + t], lf = LF[(size_t)(b * MH + h) * T + t];
        const float mn = fmaxf(lf + mst, ig), fo = expf(lf + mst - mn), io = expf(ig - mn);
        if (e < 128) { const float qv = bf2f(row[C_MQ + h * MDK + e]), kv = bf2f(row[C_MK + h * MDK + e]); nd = fo * nd + io * kv; qs[e] = qv; ks[e] = kv; pr[e] = qv * nd; }
        __syncthreads();
        const float v = bf2f(row[C_MV + h * MDV + e]); float num = 0.f, den = 0.f;
#pragma unroll
        for (int d = 0; d < 128; ++d) { C[d] = fo * C[d] + io * ks[d] * v; num += qs[d] * C[d]; den += pr[d]; }
        const float hv = num / fmaxf(fabsf(den), expf(-mn));
        float s2 = wave_sum(hv * hv); if ((e & 63) == 0) red[e >> 6] = s2;
        __syncthreads();
        const float ssq = (red[0] + red[1]) + (red[2] + red[3]); const float rn = __builtin_amdgcn_rsqf(ssq * (1.f / MDV) + EPS);
        const float og = bf2f(row[C_MO + h * MDV + e]); const float sg = 1.f / (1.f + expf(-og));
        A2[m * DM + h * MDV + e] = (bf16)f2bf(sg * hv * rn * hg);
        mst = mn;
        __syncthreads();
    }
}
#endif
__global__ void __launch_bounds__(NTHR, 2) mk_fwd(Args args) {
    extern __shared__ __attribute__((aligned(16))) unsigned char lds[];
    Frame F;
    F.lds = (LAS unsigned char*)lds;
    F.MISC = (volatile LAS unsigned*)(F.lds + MISC_OFF);
    F.tid = threadIdx.x; F.lane = F.tid & 63; F.wave = __builtin_amdgcn_readfirstlane(F.tid >> 6);
    F.G = gridDim.x; { const int bx = blockIdx.x; F.vcu = (F.G % 8 == 0) ? (bx % 8) * (F.G / 8) + bx / 8 : bx; }
    unsigned char* ws = args.ws;
    F.ctl = (gu32*)(ws + WS_CTL);
    F.x = args.in[0]; F.norm_mix = args.in[1]; F.norm_ffn = args.in[2]; F.att_w_in = args.in[3]; F.q_gain = args.in[4]; F.k_gain = args.in[5]; F.att_w_out = args.in[6];
    F.ml_w_in = args.in[7]; F.b_gate = args.in[8]; F.h_gain = args.in[9]; F.ml_w_out = args.in[10]; F.w_up = args.in[11]; F.w_dn = args.in[12]; F.out = args.out;
    F.WinT = (bf16*)(ws + WS_WIN); F.WsmT = (bf16*)(ws + WS_WSM); F.WoT = (bf16*)(ws + WS_WO); F.WmlT = (bf16*)(ws + WS_WML); F.WgT = (bf16*)(ws + WS_WG); F.WmoT = (bf16*)(ws + WS_WMO);
    F.WupT0 = (bf16*)(ws + WS_WUP0); F.WupT1 = (bf16*)(ws + WS_WUP1); F.WdnT0 = (bf16*)(ws + WS_WDN0); F.WdnT1 = (bf16*)(ws + WS_WDN1);
    F.XB = (bf16*)(ws + WS_XB); F.PROJ = (bf16*)(ws + WS_PROJ); F.Q = (bf16*)(ws + WS_Q); F.K = (bf16*)(ws + WS_K); F.V = (bf16*)(ws + WS_V); F.QI = (bf16*)(ws + WS_QI); F.KI = (bf16*)(ws + WS_KI);
    F.O = (bf16*)(ws + WS_O); F.H = (bf16*)(ws + WS_H); F.WI = (float*)(ws + WS_WI); F.IG = (float*)(ws + WS_GATE); F.LF = (float*)(ws + WS_GATE + 512 * 1024); F.SC = (float*)(ws + WS_SC); F.ST = (bf16*)(ws + WS_SC); F.NST = (float*)(ws + WS_ML); F.SCAL = (float*)(ws + WS_ML + MiB);
    F.ROPE_A = (f32x2*)(ws + WS_ROPE); F.ROPE_I = (f32x2*)(ws + WS_ROPE + 512 * 1024); F.MASK = (u64*)(ws + WS_MASK);
    F.ss0 = (float*)(ws + WS_CTL) + CW_SS; F.ss1 = F.ss0 + M; F.ss2 = F.ss1 + M; F.ss3 = F.ss2 + M;
    for (int u = F.tid; u < (LDS_BYTES - LDSCTL_OFF) / 4; u += NTHR) ((LAS unsigned*)(F.lds + LDSCTL_OFF))[u] = 0u;
    __syncthreads();
    XcdBarrier bar; bar.bar = (unsigned*)(F.ctl + CW_BAR); bar.x = 0; bar.st = nullptr;
    if (!MK_MULTI) bar = xcd_barrier_post((unsigned*)(F.ctl + CW_BAR), F.MISC + 8);
    const int lo = args.ph_lo, hi = args.ph_hi;
#ifdef ONLY_PHASE
#define IN(k) ((k) == ONLY_PHASE && lo <= (k) && (k) < hi)
#else
#define IN(k) (lo <= (k) && (k) < hi)
#endif
#define SEAM(k) do { if (IN(k) && IN((k) + 1)) xcd_barrier(bar); } while (0)
#ifndef PROBE_DBL
#define PROBE_DBL (-1)
#endif
#define REPS(k) for (int rep_ = (F.tid = opaque_tid(), F.lane = F.tid & 63, 0); rep_ < ((k) == PROBE_DBL ? 2 : 1); ++rep_, ((k) == PROBE_DBL && rep_ == 1 ? xcd_barrier(bar) : (void)0))
#define DUMMY(k) ((k) == PROBE_DBL && rep_ == 0)
    float* const dummy_out = (float*)(ws + WS_SC);
    if (IN(0)) REPS(0) { p0_prologue(F); } SEAM(0);
    if (IN(1)) REPS(1) { cvt_slot(F, cvt::E1, cvt::E3, true); pg8::Gemm g{F.XB, F.WinT, M, ATT_N, DM}; pg8::StaticOrder S; S.init(M, ATT_N, F.G, (int)blockIdx.x);
        pg8::EpiScale<0> E{F.PROJ, ATT_N, F.ss0, 1.f / DM, EPS};
        pg8::gemm_phase<pg8::EpiScale<0>, pg8::StaticOrder, PG8_ALIGN, PG8_SP2>(F.lds + RING_OFF, g, S, E);
        skinny_att(F);
#ifdef PROBE_SK
        xcd_barrier(bar); skinny_att(F);
#endif
        cvt_slot(F, cvt::E1, cvt::E3, false); } SEAM(1);
#if IDX_FUSED
    if (IN(3)) REPS(3) {
#if !ORA_IDX
        p3_fused(F);
#endif
    } SEAM(3);
#else
    if (IN(3)) REPS(3) {
#if !ORA_IDX
        p3a_scores(F);
#ifdef PROBE_P3ABL
        xcd_barrier(bar); p3a_scores<PROBE_P3ABL>(F);
#endif
#endif
    } SEAM(3);
    if (IN(4)) REPS(4) {
#if !ORA_IDX
        p3b_select(F);
#endif
    } SEAM(4);
#endif
#ifdef PROBE_BAR
    if (IN(5)) { for (int q = 0; q < 10; ++q) xcd_barrier(bar); }
#endif
    if (IN(5)) REPS(5) {
#if !ORA_ATT
        cvt_slot(F, cvt::E3, cvt::E4, true);
        p4_attention(F, (char*)lds + RING_OFF);
        cvt_slot(F, cvt::E3, cvt::E4, false);
#endif
    } SEAM(5);
    if (IN(6)) REPS(6) { cvt_slot(F, cvt::E4, cvt::E8, true); pg8::Gemm g{F.O, F.WoT, M, DM, DM}; pg8::StaticOrder S; S.init(M, DM, F.G, (int)blockIdx.x);
        pg8::EpiRes E{F.XB, DUMMY(6) ? (bf16*)dummy_out : F.XB, nullptr, DUMMY(6) ? F.ss0 + 4 * M : F.ss1, DM};
        pg8::gemm_phase<pg8::EpiRes, pg8::StaticOrder, PG8_ALIGN, PG8_SP2>(F.lds + RING_OFF, g, S, E); cvt_slot(F, cvt::E4, cvt::E8, false); } SEAM(6);
#ifdef PROBE_NULLEPI
    if (IN(PROBE_NULLEPI)) { xcd_barrier(bar);
#ifndef PROBE_NULLK
#define PROBE_NULLK DM
#endif
        if (PROBE_NULLEPI == 7) { pg8::Gemm g{F.XB, F.WupT0, M, FF, PROBE_NULLK}; pg8::StaticOrder S; S.init(M, FF, F.G, (int)blockIdx.x); pg8::EpiNull E{}; pg8::gemm_phase<pg8::EpiNull, pg8::StaticOrder, PG8_ALIGN, PG8_SP2>(F.lds + RING_OFF, g, S, E); }
        if (PROBE_NULLEPI == 8) { pg8::Gemm g{F.H, F.WdnT0, M, DM, FF}; pg8::StaticOrder S; S.init(M, DM, F.G, (int)blockIdx.x); pg8::EpiNull E{}; pg8::gemm_phase<pg8::EpiNull, pg8::StaticOrder, PG8_ALIGN, PG8_SP2>(F.lds + RING_OFF, g, S, E); }
        xcd_barrier(bar); }
#endif
    if (IN(7)) REPS(7) { cvt_slot(F, cvt::E8, cvt::E10, true); pg8::Gemm g{F.XB, F.WupT0, M, FF, DM}; pg8::StaticOrder S; S.init(M, FF, F.G, (int)blockIdx.x);
        pg8::EpiScale<1> E{F.H, FF, F.ss1, 1.f / DM, EPS};
        pg8::gemm_phase<pg8::EpiScale<1>, pg8::StaticOrder, PG8_ALIGN, PG8_SP2>(F.lds + RING_OFF, g, S, E); cvt_slot(F, cvt::E8, cvt::E10, false); } SEAM(7);
    if (IN(8)) REPS(8) { cvt_slot(F, cvt::E10, cvt::E11, true); pg8::Gemm g{F.H, F.WdnT0, M, DM, FF}; pg8::StaticOrder S; S.init(M, DM, F.G, (int)blockIdx.x);
        pg8::EpiRes E{F.XB, DUMMY(8) ? (bf16*)dummy_out : F.XB, nullptr, DUMMY(8) ? F.ss0 + 4 * M : F.ss2, DM};
        pg8::gemm_phase<pg8::EpiRes, pg8::StaticOrder, PG8_ALIGN, PG8_SP2>(F.lds + RING_OFF, g, S, E); cvt_slot(F, cvt::E10, cvt::E11, false); } SEAM(8);
    if (IN(9)) REPS(9) { pg8::Gemm g{F.XB, F.WmlT, M, ML_N, DM}; pg8::StaticOrder S; S.init(M, ML_N, F.G, (int)blockIdx.x);
        pg8::EpiScale<0> E{F.PROJ, ML_N, F.ss2, 1.f / DM, EPS};
        pg8::gemm_phase<pg8::EpiScale<0>, pg8::StaticOrder, PG8_ALIGN, PG8_SP2>(F.lds + RING_OFF, g, S, E);
        skinny_gates(F); } SEAM(9);
    if (IN(10)) REPS(10) {
#if !ORA_ML
#if ML_CHAIN
        p10_state_chain(F);
#else
        p9a_state<0>(F);
#endif
#ifdef PROBE_SUB
        xcd_barrier(bar); p9a_state<PROBE_SUB>(F);
#endif
#endif
    } SEAM(10);
    if (IN(11)) REPS(11) {
#if !ORA_ML
        p9b_output(F);
#endif
    } SEAM(11);
    if (IN(12)) REPS(12) { pg8::Gemm g{F.O, F.WmoT, M, DM, DM}; pg8::StaticOrder S; S.init(M, DM, F.G, (int)blockIdx.x);
        pg8::EpiRes E{F.XB, DUMMY(12) ? (bf16*)dummy_out : F.XB, nullptr, DUMMY(12) ? F.ss0 + 4 * M : F.ss3, DM};
        pg8::gemm_phase<pg8::EpiRes, pg8::StaticOrder, PG8_ALIGN, PG8_SP2>(F.lds + RING_OFF, g, S, E); } SEAM(12);
    if (IN(13)) REPS(13) { pg8::Gemm g{F.XB, F.WupT1, M, FF, DM}; pg8::StaticOrder S; S.init(M, FF, F.G, (int)blockIdx.x);
        pg8::EpiScale<1> E{F.H, FF, F.ss3, 1.f / DM, EPS};
        pg8::gemm_phase<pg8::EpiScale<1>, pg8::StaticOrder, PG8_ALIGN, PG8_SP2>(F.lds + RING_OFF, g, S, E); } SEAM(13);
    if (IN(14)) REPS(14) { pg8::Gemm g{F.H, F.WdnT1, M, DM, FF}; pg8::StaticOrder S; S.init(M, DM, F.G, (int)blockIdx.x);
        pg8::EpiRes E{F.XB, nullptr, DUMMY(14) ? dummy_out : F.out, nullptr, DM};
        pg8::gemm_phase<pg8::EpiRes, pg8::StaticOrder, PG8_ALIGN, PG8_SP2>(F.lds + RING_OFF, g, S, E); }
#undef IN
#undef SEAM
}

extern "C" void kernel_launch(void* const* d_in, const int* in_sizes, int n_in, void* d_out, int out_size, void* d_ws, size_t ws_size, hipStream_t stream) {
    static int grid = 0;
    if (grid == 0) {
        if (n_in != 13 || in_sizes[0] != M * DM || out_size != M * DM || ws_size < WS_END) { fprintf(stderr, "kernel_launch: shape/workspace mismatch (n_in %d, in0 %d, out %d, ws %zu, need %zu)\n", n_in, n_in > 0 ? in_sizes[0] : -1, out_size, ws_size, (size_t)WS_END); grid = -1; return; }
        int dev = 0, cus = 0, per_cu = 0;
        if (hipGetDevice(&dev) != hipSuccess || hipDeviceGetAttribute(&cus, hipDeviceAttributeMultiprocessorCount, dev) != hipSuccess) { grid = -1; return; }
        if (hipFuncSetAttribute((const void*)mk_fwd, hipFuncAttributeMaxDynamicSharedMemorySize, LDS_BYTES) != hipSuccess) { fprintf(stderr, "kernel_launch: hipFuncSetAttribute failed\n"); grid = -1; return; }
        if (hipOccupancyMaxActiveBlocksPerMultiprocessor(&per_cu, (const void*)mk_fwd, NTHR, LDS_BYTES) != hipSuccess || per_cu < 1) fprintf(stderr, "kernel_launch: occupancy query reports %d blocks per CU\n", per_cu);
        (void)hipGetLastError();
        grid = cus;
    }
    if (grid < 0) return;
    if (hipMemsetAsync((char*)d_ws + WS_CTL, 0, CTL_ZERO_BYTES, stream) != hipSuccess) { fprintf(stderr, "kernel_launch: memset failed\n"); return; }
    Args a{};
    for (int i = 0; i < 13; ++i) a.in[i] = (const float*)d_in[i];
    a.out = (float*)d_out; a.ws = (unsigned char*)d_ws;
#if MK_MULTI
    unsigned char* ws = (unsigned char*)d_ws;
    for (int p = 0; p < N_PHASES; ++p) {
        if (p == 4 && ORA_IDX) continue;
        if (p == 3 && ORA_IDX) {
#if ORA_IDX
            hipLaunchKernelGGL(ora_indexer, dim3(M), dim3(256), 0, stream, (const bf16*)(ws + WS_QI), (const bf16*)(ws + WS_KI), (const float*)(ws + WS_WI), (u64*)(ws + WS_MASK));
#endif
            continue; }
        if (p == 5 && ORA_ATT) {
#if ORA_ATT
            hipLaunchKernelGGL(ora_attn, dim3(M * 4), dim3(128), 0, stream, (const bf16*)(ws + WS_Q), (const bf16*)(ws + WS_K), (const bf16*)(ws + WS_V), (const u64*)(ws + WS_MASK), (bf16*)(ws + WS_O));
#endif
            continue; }
        if (p == 11 && ORA_ML) continue;
        if (p == 10 && ORA_ML) {
#if ORA_ML
            hipLaunchKernelGGL(ora_mlstm, dim3(BATCH * MH), dim3(256), 0, stream, (const bf16*)(ws + WS_PROJ), (const float*)(ws + WS_GATE), (const float*)(ws + WS_GATE + 512 * 1024), (const float*)d_in[9], (bf16*)(ws + WS_O));
#endif
            continue; }
        a.ph_lo = p; a.ph_hi = p + 1; a.li = p;
        hipLaunchKernelGGL(mk_fwd, dim3(grid), dim3(NTHR), LDS_BYTES, stream, a);
    }
#else
    a.ph_lo = 0; a.ph_hi = N_PHASES; a.li = 0;
    hipLaunchKernelGGL(mk_fwd, dim3(grid), dim3(NTHR), LDS_BYTES, stream, a);
#endif
    const hipError_t le = hipPeekAtLastError();
    if (le != hipSuccess) fprintf(stderr, "kernel_launch: launch failed: %s\n", hipGetErrorName(le));
}
```

```cpp
#ifndef MK_MULTI
#define MK_MULTI 0
#endif
#ifndef ORA_IDX
#define ORA_IDX 0
#endif
#ifndef ORA_ATT
#define ORA_ATT 0
#endif
#ifndef ORA_ML
#define ORA_ML 0
#endif
#ifndef PROBE_DBL
#define PROBE_DBL (-1)
#endif
#include <hip/hip_runtime.h>
#include <cstdio>
#include <cstdint>
#include <cmath>
__device__ __forceinline__ int opaque_tid() { int t = threadIdx.x; asm volatile("" : "+v"(t)); return t; }
namespace pg8 {
#define PG8_LAS __attribute__((address_space(3)))
typedef unsigned short bf16_t;
typedef short bf16x8 __attribute__((ext_vector_type(8)));
typedef float f32x4 __attribute__((ext_vector_type(4)));
typedef unsigned u32x4 __attribute__((ext_vector_type(4)));
constexpr int BM = 256, BK = 64, HALF = 128, HTB = HALF * BK * 2  , STAGE_BYTES = 8 * HTB, NXCD = 8, WGM = 2;

__host__ __device__ __forceinline__ int lds_byte(int r, int c) { const int st = (r >> 4) * 2 + (c >> 5), rr = r & 15, cc = c & 31, ob = rr * 64 + cc * 2; return st * 1024 + (ob ^ (((ob >> 9) & 1) << 5)); }
__host__ __device__ __forceinline__ void stage_rc(int b, int& R, int& C) { const int st = b / 1024, sb = b % 1024, swz = sb ^ (((sb >> 9) & 1) << 5); R = (st >> 1) * 16 + swz / 64; C = (st & 1) * 32 + (swz % 64) / 2; }
__host__ __device__ __forceinline__ int perm32(int rho) { const int n = rho >> 4, i = rho & 15; return 8 * (i >> 2) + 4 * n + (i & 3); }

struct Unit { int pm, pn; };
struct Gemm { const bf16_t* A; const bf16_t* Bt; int M, N, K; };

struct StaticOrder {
    int nM, nN, nwg, G, c;
    __host__ __device__ void init(int M, int N, int G_, int c_) { nM = M / BM; nN = N / BM; nwg = nM * nN; G = G_; c = c_; }
    __host__ __device__ bool next(int i, Unit& u) const {
        const long L = (long)i * G + c; if (L >= nwg) return false;
        int wgid = (int)L; { const int q = nwg / NXCD, r = nwg % NXCD, xcd = wgid % NXCD, off = wgid / NXCD; wgid = (xcd < r ? xcd * (q + 1) : r * (q + 1) + (xcd - r) * q) + off; }
        const int nig = WGM * nN, gid = wgid / nig, fm = gid * WGM, gsz = (nM - fm) < WGM ? (nM - fm) : WGM;
        u.pm = fm + ((wgid % nig) % gsz); u.pn = (wgid % nig) / gsz; return true;
    }
    __device__ __forceinline__ void a_ready(const Unit&) const {}
    __device__ __forceinline__ void done(const Unit&) const {}
};

__device__ __forceinline__ unsigned cvt_pk_bf16(float lo, float hi) { unsigned r; asm volatile("v_cvt_pk_bf16_f32 %0, %1, %2" : "=v"(r) : "v"(lo), "v"(hi)); return r; }
typedef float f32x2 __attribute__((ext_vector_type(2)));
typedef unsigned u32x2 __attribute__((ext_vector_type(2)));
template <int MODE> struct EpiScale {
    static constexpr bool PERM = true, AFTER_DRAIN = false;
    bf16_t* O; int ldc; const float* ss; float inv_n, eps;
    __device__ __forceinline__ void operator()(const f32x4 (&acc)[2][2][4][2], const Unit& u, int wr, int wc, int fr, int fq) const {
        const int row0 = u.pm * BM + wr * 64 + fr, col0 = u.pn * BM + wc * 64 + 8 * fq;
#pragma unroll
        for (int ai = 0; ai < 2; ++ai)
#pragma unroll
            for (int m = 0; m < 4; ++m) { const int row = row0 + ai * HALF + m * 16; const float rs = __builtin_amdgcn_rsqf(ss[row] * inv_n + eps); const float rs2 = rs * rs;
                bf16_t* rowp = O + (size_t)row * ldc + col0;
#pragma unroll
                for (int bj = 0; bj < 2; ++bj) { f32x4 v0 = acc[ai][bj][m][0], v1 = acc[ai][bj][m][1];
                    if (MODE == 0) { v0 = v0 * rs; v1 = v1 * rs; }
                    else { v0 = __builtin_elementwise_max(v0, (f32x4){0.f, 0.f, 0.f, 0.f}); v1 = __builtin_elementwise_max(v1, (f32x4){0.f, 0.f, 0.f, 0.f}); v0 = v0 * v0 * rs2; v1 = v1 * v1 * rs2; }
                    u32x4 w; w.x = cvt_pk_bf16(v0[0], v0[1]); w.y = cvt_pk_bf16(v0[2], v0[3]); w.z = cvt_pk_bf16(v1[0], v1[1]); w.w = cvt_pk_bf16(v1[2], v1[3]);
                    *(u32x4*)(rowp + bj * 32) = w; } }
    }
};
struct EpiRes {
    static constexpr bool PERM = true, AFTER_DRAIN = false;
    const bf16_t* base; bf16_t* hb; float* outf; float* ss; int ldc;
    __device__ __forceinline__ void operator()(const f32x4 (&acc)[2][2][4][2], const Unit& u, int wr, int wc, int fr, int fq) const {
        const int col0 = u.pn * BM + wc * 64 + 8 * fq;
#pragma unroll
        for (int ai = 0; ai < 2; ++ai)
#pragma unroll
            for (int m = 0; m < 4; ++m) { const int row = u.pm * BM + ai * HALF + wr * 64 + m * 16 + fr; const size_t off = (size_t)row * ldc + col0; float s = 0.f;
#pragma unroll
                for (int bj = 0; bj < 2; ++bj) { const u32x4 bw = *(const u32x4*)(base + off + bj * 32);
                    const f32x4 b0 = {__builtin_bit_cast(float, bw.x << 16), __builtin_bit_cast(float, bw.x & 0xffff0000u), __builtin_bit_cast(float, bw.y << 16), __builtin_bit_cast(float, bw.y & 0xffff0000u)};
                    const f32x4 b1 = {__builtin_bit_cast(float, bw.z << 16), __builtin_bit_cast(float, bw.z & 0xffff0000u), __builtin_bit_cast(float, bw.w << 16), __builtin_bit_cast(float, bw.w & 0xffff0000u)};
                    const f32x4 o0 = b0 + acc[ai][bj][m][0], o1 = b1 + acc[ai][bj][m][1];
                    if (outf) { *(f32x4*)(outf + off + bj * 32) = o0; *(f32x4*)(outf + off + bj * 32 + 4) = o1; }
                    else { u32x4 w; w.x = cvt_pk_bf16(o0[0], o0[1]); w.y = cvt_pk_bf16(o0[2], o0[3]); w.z = cvt_pk_bf16(o1[0], o1[1]); w.w = cvt_pk_bf16(o1[2], o1[3]); *(u32x4*)(hb + off + bj * 32) = w;
                        s += ((o0[0] * o0[0] + o0[1] * o0[1]) + (o0[2] * o0[2] + o0[3] * o0[3])) + ((o1[0] * o1[0] + o1[1] * o1[1]) + (o1[2] * o1[2] + o1[3] * o1[3])); } }
                if (!outf) { s += __shfl_xor(s, 16); s += __shfl_xor(s, 32); if (fq == 0) atomicAdd(ss + row, s); }
                asm volatile("" ::: "memory"); }
    }
};
struct EpiNull {
    static constexpr bool PERM = false, AFTER_DRAIN = false;
    __device__ __forceinline__ void operator()(const f32x4 (&acc)[2][2][4][2], const Unit&, int, int, int, int) const {
#pragma unroll
        for (int ai = 0; ai < 2; ++ai)
#pragma unroll
            for (int bj = 0; bj < 2; ++bj)
#pragma unroll
                for (int m = 0; m < 4; ++m)
#pragma unroll
                    for (int n = 0; n < 2; ++n) asm volatile("" :: "v"(acc[ai][bj][m][n]));
    }
};
template <class Epi, class Sched, bool ALIGN_EPI = false, bool SP2 = false>
__device__ __forceinline__ void gemm_phase(PG8_LAS unsigned char* lds, const Gemm g, const Sched& S, const Epi& E) {
    const int tid = opaque_tid(), wid = __builtin_amdgcn_readfirstlane(tid >> 6), lane = tid & 63, wr = wid >> 2, wc = wid & 3, fr = lane & 15, fq = lane >> 4;
    const int K = g.K, nt = K / BK;
    unsigned voffA[2], voffB[2];
#pragma unroll
    for (int i = 0; i < 2; ++i) { int R, C; stage_rc(tid * 16 + i * 8192, R, C); const int Rb = Epi::PERM ? (64 * (R >> 5) + perm32(R & 31)) : R;
        voffA[i] = (unsigned)(R * K + C) * 2u; voffB[i] = (unsigned)(Rb * K + C) * 2u; }
    const size_t kstep = (size_t)(BK * 2);
    const size_t hstep = (size_t)HALF * K * 2;
    const size_t hstepB = Epi::PERM ? (size_t)32 * K * 2 : hstep;
    const size_t tstep = 2 * hstep;
    const unsigned ldsw = (unsigned)wid * 1024u;
    const int aoff = lds_byte(wr * 64 + fr, fq * 8), boff = lds_byte(wc * 32 + fr, fq * 8);
#define PG8_SA(b, h) (((b) * 2 + (h)) * HTB)
#define PG8_SB(b, h) ((4 + (b) * 2 + (h)) * HTB)
#define PG8_STAGE(bufoff, gbase, voff) do { _Pragma("unroll") for (int _i = 0; _i < 2; ++_i) \
        __builtin_amdgcn_global_load_lds((const unsigned*)((const char*)(gbase) + (voff)[_i]), (PG8_LAS unsigned*)(lds + (bufoff) + ldsw + _i * 8192), 16, 0, 0); } while (0)
#define PG8_LDA(dst, b, h) do { _Pragma("unroll") for (int m = 0; m < 4; ++m) _Pragma("unroll") for (int k = 0; k < 2; ++k) dst[m][k] = *(const PG8_LAS bf16x8*)(lds + PG8_SA(b, h) + aoff + m * 2048 + k * 1024); } while (0)
#define PG8_LDB(dst, b, h) do { _Pragma("unroll") for (int n = 0; n < 2; ++n) _Pragma("unroll") for (int k = 0; k < 2; ++k) dst[n][k] = *(const PG8_LAS bf16x8*)(lds + PG8_SB(b, h) + boff + n * 2048 + k * 1024); } while (0)
#define PG8_MMA(ai, bj, At, Bt) do { __builtin_amdgcn_s_setprio(1); _Pragma("unroll") for (int m = 0; m < 4; ++m) _Pragma("unroll") for (int n = 0; n < 2; ++n) _Pragma("unroll") for (int k = 0; k < 2; ++k) \
        acc[ai][bj][m][n] = __builtin_amdgcn_mfma_f32_16x16x32_bf16(Bt[n][k], At[m][k], acc[ai][bj][m][n], 0, 0, 0); __builtin_amdgcn_s_setprio(0); } while (0)
#define PG8_WAIT_V(n) asm volatile("s_waitcnt vmcnt(" #n ")" ::: "memory")
#define PG8_WAIT_L(n) asm volatile("s_waitcnt lgkmcnt(" #n ")" ::: "memory")
#define PG8_BAR __builtin_amdgcn_s_barrier()
#define PG8_SCHED __builtin_amdgcn_sched_barrier(0)
    Unit cur, nxt; int ui = 0;
    if (!S.next(0, cur)) return;
    f32x4 acc[2][2][4][2];
#pragma unroll
    for (int a = 0; a < 2; ++a)
#pragma unroll
        for (int b = 0; b < 2; ++b)
#pragma unroll
            for (int m = 0; m < 4; ++m)
#pragma unroll
                for (int n = 0; n < 2; ++n) acc[a][b][m][n] = (f32x4){0.f, 0.f, 0.f, 0.f};
    bf16x8 At[4][2], B0[2][2], B1[2][2];
    const char* cA = (const char*)g.A + (size_t)cur.pm * tstep; const char* cB = (const char*)g.Bt + (size_t)cur.pn * tstep;
    S.a_ready(cur);
    if constexpr (SP2) {
        PG8_STAGE(PG8_SB(0, 0), cB, voffB); PG8_STAGE(PG8_SB(0, 1), cB + hstepB, voffB); PG8_STAGE(PG8_SA(0, 0), cA, voffA); PG8_STAGE(PG8_SA(0, 1), cA + hstep, voffA);
        if (wr == 1) PG8_BAR;
        PG8_WAIT_V(2); PG8_BAR;
        PG8_STAGE(PG8_SB(1, 0), cB + kstep, voffB); PG8_STAGE(PG8_SA(1, 0), cA + kstep, voffA); PG8_STAGE(PG8_SB(1, 1), cB + hstepB + kstep, voffB);
        PG8_WAIT_V(6); PG8_BAR;
    } else {
        PG8_STAGE(PG8_SB(0, 0), cB, voffB); PG8_STAGE(PG8_SA(0, 0), cA, voffA); PG8_STAGE(PG8_SB(0, 1), cB + hstepB, voffB); PG8_STAGE(PG8_SA(0, 1), cA + hstep, voffA);
        if (wr == 1) PG8_BAR;
        PG8_WAIT_V(4); PG8_BAR;
        PG8_STAGE(PG8_SB(1, 0), cB + kstep, voffB); PG8_STAGE(PG8_SA(1, 0), cA + kstep, voffA); PG8_STAGE(PG8_SB(1, 1), cB + hstepB + kstep, voffB);
        PG8_WAIT_V(6); PG8_BAR;
    }
    for (;;) {
        const bool has_next = S.next(ui + 1, nxt);
        const char* nA = has_next ? (const char*)g.A + (size_t)nxt.pm * tstep : cA; const char* nB = has_next ? (const char*)g.Bt + (size_t)nxt.pn * tstep : cB;
        for (int t = 0; t < nt; t += 2) {
            const bool last = (t == nt - 2);
            const char* a1 = cA + (size_t)(t + 1) * kstep;
            const char* a2 = last ? nA : cA + (size_t)(t + 2) * kstep; const char* b2 = last ? nB : cB + (size_t)(t + 2) * kstep;
            const char* a3 = a2 + kstep; const char* b3 = b2 + kstep;
            if (last && has_next) S.a_ready(nxt);
            if constexpr (SP2) {
            PG8_LDB(B0, 0, 0); PG8_LDB(B1, 0, 1); PG8_SCHED; PG8_LDA(At, 0, 0); PG8_STAGE(PG8_SA(1, 1), a1 + hstep, voffA);
            PG8_WAIT_V(8); PG8_WAIT_L(0); PG8_BAR; PG8_MMA(0, 0, At, B0); PG8_MMA(0, 1, At, B1); PG8_BAR; PG8_SCHED;
            PG8_LDA(At, 0, 1); PG8_STAGE(PG8_SB(0, 0), b2, voffB); PG8_STAGE(PG8_SB(0, 1), b2 + hstepB, voffB); PG8_STAGE(PG8_SA(0, 0), a2, voffA);
            PG8_WAIT_V(8); PG8_WAIT_L(0); PG8_BAR; PG8_MMA(1, 0, At, B0); PG8_MMA(1, 1, At, B1); PG8_BAR; PG8_SCHED;
            PG8_LDB(B0, 1, 0); PG8_LDB(B1, 1, 1); PG8_SCHED; PG8_LDA(At, 1, 0); PG8_STAGE(PG8_SA(0, 1), a2 + hstep, voffA);
            PG8_WAIT_V(8); PG8_WAIT_L(0); PG8_BAR; PG8_MMA(0, 0, At, B0); PG8_MMA(0, 1, At, B1); PG8_BAR; PG8_SCHED;
            PG8_LDA(At, 1, 1); PG8_STAGE(PG8_SB(1, 0), b3, voffB); PG8_STAGE(PG8_SB(1, 1), b3 + hstepB, voffB); PG8_STAGE(PG8_SA(1, 0), a3, voffA);
            PG8_WAIT_V(8); PG8_WAIT_L(0); PG8_BAR; PG8_MMA(1, 0, At, B0); PG8_MMA(1, 1, At, B1); PG8_BAR; PG8_SCHED;
            } else {
            PG8_LDB(B0, 0, 0); PG8_SCHED; PG8_LDA(At, 0, 0); PG8_STAGE(PG8_SA(1, 1), a1 + hstep, voffA);
            PG8_WAIT_L(8); PG8_BAR; PG8_WAIT_L(0); PG8_MMA(0, 0, At, B0); PG8_BAR; PG8_SCHED;
            PG8_LDB(B1, 0, 1); PG8_STAGE(PG8_SB(0, 0), b2, voffB);
            PG8_BAR; PG8_WAIT_L(0); PG8_MMA(0, 1, At, B1); PG8_BAR;
            PG8_LDA(At, 0, 1); PG8_STAGE(PG8_SA(0, 0), a2, voffA);
            PG8_BAR; PG8_WAIT_L(0); PG8_MMA(1, 0, At, B0); PG8_BAR; PG8_SCHED;
            PG8_STAGE(PG8_SB(0, 1), b2 + hstepB, voffB);
            PG8_WAIT_V(6); PG8_BAR; PG8_MMA(1, 1, At, B1); PG8_BAR;
            PG8_LDB(B0, 1, 0); PG8_SCHED; PG8_LDA(At, 1, 0); PG8_STAGE(PG8_SA(0, 1), a2 + hstep, voffA);
            PG8_WAIT_L(8); PG8_BAR; PG8_WAIT_L(0); PG8_MMA(0, 0, At, B0); PG8_BAR; PG8_SCHED;
            PG8_LDB(B1, 1, 1); PG8_STAGE(PG8_SB(1, 0), b3, voffB);
            PG8_BAR; PG8_WAIT_L(0); PG8_MMA(0, 1, At, B1); PG8_BAR;
            PG8_LDA(At, 1, 1); PG8_STAGE(PG8_SA(1, 0), a3, voffA);
            PG8_BAR; PG8_WAIT_L(0); PG8_MMA(1, 0, At, B0); PG8_BAR; PG8_SCHED;
            PG8_STAGE(PG8_SB(1, 1), b3 + hstepB, voffB);
            PG8_WAIT_V(6); PG8_BAR; PG8_MMA(1, 1, At, B1); PG8_BAR;
            }
        }
        if constexpr (ALIGN_EPI) { if (wr == 0) PG8_BAR; }
        if constexpr (!Epi::AFTER_DRAIN) { E(acc, cur, wr, wc, fr, fq); S.done(cur); }
        if (!has_next) break;
#pragma unroll
        for (int a = 0; a < 2; ++a)
#pragma unroll
            for (int b = 0; b < 2; ++b)
#pragma unroll
                for (int m = 0; m < 4; ++m)
#pragma unroll
                    for (int n = 0; n < 2; ++n) acc[a][b][m][n] = (f32x4){0.f, 0.f, 0.f, 0.f};
        cur = nxt; cA = nA; cB = nB; ++ui;
        if constexpr (ALIGN_EPI) { if (wr == 1) PG8_BAR; }
    }
    PG8_WAIT_V(0);
    if constexpr (!ALIGN_EPI) { if (wr == 0) PG8_BAR; }
    PG8_BAR;
    if constexpr (Epi::AFTER_DRAIN) { E.fused(acc, cur, wr, wc, fr, fq, lds, wid, lane); S.done(cur); }
#undef PG8_SA
#undef PG8_SB
#undef PG8_STAGE
#undef PG8_LDA
#undef PG8_LDB
#undef PG8_MMA
#undef PG8_WAIT_V
#undef PG8_WAIT_L
#undef PG8_BAR
#undef PG8_SCHED
}
}
#ifndef PG8_SP2
#define PG8_SP2 true
#endif
#ifndef PG8_ALIGN
#define PG8_ALIGN true
#endif
constexpr int NWAVES = 8, NTHR = NWAVES * 64;
#ifndef MK_MULTI
#define MK_MULTI 0
#endif
#ifndef ORA_IDX
#define ORA_IDX 0
#endif
#ifndef ORA_ATT
#define ORA_ATT 0
#endif
#ifndef ORA_ML
#define ORA_ML 0
#endif
#ifndef CVT_STAGGER
#define CVT_STAGGER 1
#endif
constexpr int N_PHASES = 15;
#ifndef ML_CHAIN
#define ML_CHAIN 1
#endif
constexpr int BATCH = 4, T = 2048, DM = 2048, M = BATCH * T, FF = 8192;
constexpr int AH = 16, AG = 4, HD = 128, IH = 16, IDIM = 64, TOPK = 256;
constexpr int ATT_IN = 4176, ATT_N = 4096, SM_N = 80;
constexpr int C_Q = 0, C_K = 2048, C_V = 2560, C_QI = 3072;
constexpr int MH = 8, MDK = 128, MDV = 256, ML_IN = 6160, ML_N = 6144;
constexpr int C_MQ = 0, C_MK = 1024, C_MV = 2048, C_MO = 4096;
constexpr float EPS = 1e-6f, GATE_CAP = 15.0f;
constexpr size_t MiB = 1u << 20;
constexpr size_t WS_CTL = 0, CTL_ZERO_BYTES = 320 * 1024;
constexpr size_t WS_WIN = 1 * MiB, WS_WSM = 17 * MiB, WS_WO = 18 * MiB, WS_WML = 26 * MiB, WS_WG = 50 * MiB, WS_WMO = 51 * MiB;
constexpr size_t WS_WUP0 = 59 * MiB, WS_WUP1 = 91 * MiB, WS_WDN0 = 123 * MiB, WS_WDN1 = 155 * MiB;
constexpr size_t WS_XB = 188 * MiB, WS_PROJ = 220 * MiB, WS_Q = 316 * MiB, WS_K = 348 * MiB, WS_QI = 356 * MiB, WS_KI = 372 * MiB, WS_WI = 373 * MiB, WS_MASK = 374 * MiB;
constexpr size_t WS_GATE = 376 * MiB, WS_ROPE = 377 * MiB, WS_SC = 380 * MiB, WS_O = 444 * MiB, WS_V = 476 * MiB, WS_ML = 484 * MiB, WS_END = 486 * MiB;
constexpr size_t WS_H = 220 * MiB;
static_assert(WS_H + (size_t)M * FF * 2 <= WS_K && WS_PROJ + (size_t)M * ML_N * 2 <= WS_Q && WS_SC + (size_t)BATCH * T * T * 4 <= WS_O, "d_ws map");
constexpr int CW_TMO = 0, CW_CODE = 1, CW_BAR = 4096, CW_SS = 32768;
constexpr int RING_OFF = 0, RING_BYTES = 143360;
constexpr int LDSCTL_OFF = RING_BYTES, MISC_OFF = LDSCTL_OFF + 320;
constexpr int LDS_BYTES = 147456;
#define GAS __attribute__((address_space(1)))
#define LAS __attribute__((address_space(3)))
typedef unsigned short bf16;
typedef unsigned v4u __attribute__((ext_vector_type(4)));
typedef unsigned v2u __attribute__((ext_vector_type(2)));
typedef float f32x4 __attribute__((ext_vector_type(4)));
typedef float f32x16 __attribute__((ext_vector_type(16)));
typedef float f32x2 __attribute__((ext_vector_type(2)));
typedef short bf16x8 __attribute__((ext_vector_type(8)));
typedef short s16x4 __attribute__((ext_vector_type(4)));
typedef GAS unsigned gu32;
typedef GAS unsigned long long gu64;
typedef unsigned long long u64;
#define RLX_AGENT __ATOMIC_RELAXED, __HIP_MEMORY_SCOPE_AGENT
#define LDS_WAIT() asm volatile("s_waitcnt lgkmcnt(0)" ::: "memory")
#define VM_WAIT() asm volatile("s_waitcnt vmcnt(0)" ::: "memory")
__device__ __forceinline__ unsigned f2bf(float f) { unsigned u = __builtin_bit_cast(unsigned, f); return (u + 0x7fffu + ((u >> 16) & 1u)) >> 16; }
__device__ __forceinline__ unsigned pk2(float lo, float hi) { return f2bf(lo) | (f2bf(hi) << 16); }
__device__ __forceinline__ float bf2f(bf16 h) { return __builtin_bit_cast(float, (unsigned)h << 16); }
__device__ __forceinline__ float bflo(unsigned w) { return __builtin_bit_cast(float, w << 16); }
__device__ __forceinline__ float bfhi(unsigned w) { return __builtin_bit_cast(float, w & 0xffff0000u); }
__device__ __forceinline__ unsigned fkey(float f) { const unsigned u = __builtin_bit_cast(unsigned, f); return (u & 0x80000000u) ? ~u : (u | 0x80000000u); }
#define XB_TMO      128
#define XB_XCNT(j)  (256  + 64 * (j))
#define XB_XSUB(j)  (1280 + 64 * (j))
#define XB_XGEN(j)  (2304 + 64 * (j))
#define XB_TOP      3328
#define XB_TOPGEN   3392
#define XCD_BAR_WORDS 3456
#define XB_SPIN_CAP (1u << 18)

__device__ __forceinline__ unsigned xb_ld(unsigned* p)              { return __hip_atomic_load(p, __ATOMIC_RELAXED, __HIP_MEMORY_SCOPE_AGENT); }
__device__ __forceinline__ unsigned xb_add(unsigned* p, unsigned v) { return __hip_atomic_fetch_add(p, v, __ATOMIC_RELAXED, __HIP_MEMORY_SCOPE_AGENT); }
__device__ __forceinline__ unsigned xb_xcc_id() { return (unsigned)__builtin_amdgcn_s_getreg((3 << 11) | 20) & 0xFu; }
#define XB_SPIN(cond, bar) do { unsigned _sp = 0; while (cond) { __builtin_amdgcn_s_sleep(0); \
    if ((++_sp & 255u) == 0u) { if (xb_ld(&(bar)[XB_TMO])) break; if (_sp > XB_SPIN_CAP) { atomicAdd(&(bar)[XB_TMO], 1u); break; } } } } while (0)

struct XcdBarrier {
    unsigned* bar; unsigned x;
    volatile LAS unsigned* st;
};

__device__ __forceinline__ XcdBarrier xcd_barrier_post(unsigned* bar, volatile LAS unsigned* st) {
    XcdBarrier b; b.bar = bar; b.x = xb_xcc_id(); b.st = st;
    if (threadIdx.x == 0) (void)xb_add(&bar[XB_XCNT(b.x)], 1u);
    return b;
}
__device__ __forceinline__ void xcd_barrier_complete(unsigned* bar, unsigned x, unsigned& nloc, unsigned& nx) {
    const unsigned G = gridDim.x * gridDim.y * gridDim.z;
    unsigned sum, cnt, mine, sp = 0u;
    for (;;) {
        sum = 0u; cnt = 0u; mine = 0u;
#pragma unroll
        for (unsigned j = 0; j < 16; ++j) { const unsigned c = xb_ld(&bar[XB_XCNT(j)]); sum += c; cnt += (c > 0u) ? 1u : 0u; mine = (j == x) ? c : mine; }
        if (sum == G) break;
        __builtin_amdgcn_s_sleep(1);
        if ((++sp & 255u) == 0u) { if (xb_ld(&bar[XB_TMO])) break; if (sp > XB_SPIN_CAP) { atomicAdd(&bar[XB_TMO], 1u); break; } }
    }
    nloc = mine > 0u ? mine : 1u; nx = cnt > 0u ? cnt : 1u;
}

__device__ __forceinline__ void xcd_barrier(const XcdBarrier& b) {
    asm volatile("s_waitcnt vmcnt(0)" ::: "memory");
    __syncthreads();
    if (threadIdx.x == 0) {
        unsigned* bar = b.bar;
        __builtin_amdgcn_s_waitcnt(0);
        unsigned nloc = b.st[0], nx = b.st[1];
        if (nloc == 0u) { xcd_barrier_complete(bar, b.x, nloc, nx); b.st[0] = nloc; b.st[1] = nx; }
        const unsigned old = xb_add(&bar[XB_XSUB(b.x)], 1u);
        const unsigned gen = old / nloc;
        if (old + 1u == (gen + 1u) * nloc) {
            __builtin_amdgcn_fence(__ATOMIC_RELEASE, "agent");
            asm volatile("s_waitcnt vmcnt(0)" ::: "memory");
            const unsigned og = xb_add(&bar[XB_TOP], 1u);
            const unsigned tg = og / nx;
            if (og + 1u == (tg + 1u) * nx) xb_add(&bar[XB_TOPGEN], 1u);
            else XB_SPIN(xb_ld(&bar[XB_TOPGEN]) == tg, bar);
            __builtin_amdgcn_fence(__ATOMIC_ACQUIRE, "agent");
            xb_add(&bar[XB_XGEN(b.x)], 1u);
            asm volatile("s_waitcnt vmcnt(0)" ::: "memory");
        } else {
            XB_SPIN(xb_ld(&bar[XB_XGEN(b.x)]) == gen, bar);
            __builtin_amdgcn_fence(__ATOMIC_ACQUIRE, "agent");
            asm volatile("s_waitcnt vmcnt(0)" ::: "memory");
        }
    }
    __syncthreads();
}
struct Args { const float* in[13]; float* out; unsigned char* ws; int ph_lo, ph_hi, li, pad; };
struct Frame {
    LAS unsigned char* lds;
    volatile LAS unsigned* MISC;
    gu32* ctl;
    int tid, lane, wave, vcu, G;
    const float* x; float* out;
    const float *norm_mix, *norm_ffn, *att_w_in, *q_gain, *k_gain, *att_w_out, *ml_w_in, *b_gate, *h_gain, *ml_w_out, *w_up, *w_dn;
    bf16 *WinT, *WsmT, *WoT, *WmlT, *WgT, *WmoT, *WupT0, *WupT1, *WdnT0, *WdnT1;
    bf16 *XB, *PROJ, *Q, *K, *V, *QI, *KI, *O, *H;
    float *WI, *IG, *LF, *SC, *NST, *SCAL; bf16* ST; f32x2 *ROPE_A, *ROPE_I; u64* MASK;
    float *ss0, *ss1, *ss2, *ss3;
};
__device__ __forceinline__ float wave_sum(float v) {
#pragma unroll
    for (int o = 1; o < 64; o <<= 1) v += __shfl_xor(v, o);
    return v;
}
__device__ __forceinline__ unsigned cvtpk2(float lo, float hi) { unsigned r; asm volatile("v_cvt_pk_bf16_f32 %0, %1, %2" : "=v"(r) : "v"(lo), "v"(hi)); return r; }
template <bool NTS = false> __device__ __forceinline__ void tr_item(const float* W, int ldw, int col0, int nvalid, int nblk, int K, const float* gain, float scale, bf16* WT, LAS float* scr, int item, int lane) {
    const int kb = item / nblk, nb = item - kb * nblk, k0 = 64 * kb, n0 = 32 * nb, nn = n0 + (lane & 31), nc = nn < nvalid ? nn : nvalid - 1, c = lane & 7;
    const GAS float* wp = (const GAS float*)W + (size_t)(k0 + (lane >> 5)) * ldw + col0 + nc;
    float v[32];
#pragma unroll
    for (int i = 0; i < 32; ++i) v[i] = __builtin_nontemporal_load(wp + (size_t)(2 * i) * ldw);
    f32x4 g0 = (f32x4){scale, scale, scale, scale}, g1 = g0;
    if (gain) { g0 = *(const GAS f32x4*)(gain + k0 + 8 * c) * scale; g1 = *(const GAS f32x4*)(gain + k0 + 8 * c + 4) * scale; }
    const bool ok = nn < nvalid;
#pragma unroll
    for (int i = 0; i < 32; ++i) scr[(2 * i + (lane >> 5)) * 33 + (lane & 31)] = ok ? v[i] : 0.f;
    LDS_WAIT(); asm volatile("" ::: "memory");
#pragma unroll
    for (int j = 0; j < 4; ++j) { const int n = (lane >> 3) + 8 * j; const LAS float* s = scr + (8 * c) * 33 + n;
        v4u o; o.x = cvtpk2(s[0 * 33] * g0.x, s[1 * 33] * g0.y); o.y = cvtpk2(s[2 * 33] * g0.z, s[3 * 33] * g0.w); o.z = cvtpk2(s[4 * 33] * g1.x, s[5 * 33] * g1.y); o.w = cvtpk2(s[6 * 33] * g1.z, s[7 * 33] * g1.w);
        if (NTS) __builtin_nontemporal_store(o, (GAS v4u*)(WT + (size_t)(n0 + n) * K + k0 + 8 * c)); else *(GAS v4u*)(WT + (size_t)(n0 + n) * K + k0 + 8 * c) = o; }
    LDS_WAIT(); asm volatile("" ::: "memory");
}
namespace cvt {
constexpr int I0 = 32 * 128, I1 = 32 * 3, I2 = 32 * 64, I3 = 32 * 256, I4 = 128 * 64, I5 = 32 * 32, I6 = 32 * 32, I7 = 32 * 128, I8 = 32 * 1, I9 = 32 * 64, I10 = I3, I11 = I4;
constexpr int E1 = I0 + I1, E2 = E1 + I2, E3 = E2 + I3, E4 = E3 + I4, E8 = E4 + I5 + I6 + I7 + I8, E9 = E8 + I9, E10 = E9 + I10, E11 = E10 + I11;
}
struct TrJob { const float* W; const float* gain; bf16* WT; float scale; int ldw, col0, nvalid, nblk, K, item; bool nts; };
__device__ __forceinline__ TrJob tr_job(const Frame& F, int it) {
    using namespace cvt;
    constexpr float KSC = 0.08838834764831845f;
    int r = it;
    if (r < I0) return TrJob{F.att_w_in, F.norm_mix, F.WinT, 1.f, ATT_IN, 0, ATT_N, 128, DM, r, false}; r -= I0;
    if (r < I1) return TrJob{F.att_w_in, F.norm_mix, F.WsmT, 1.f, ATT_IN, ATT_N, SM_N, 3, DM, r, false}; r -= I1;
    if (r < I2) return TrJob{F.att_w_out, nullptr, F.WoT, 1.f, DM, 0, DM, 64, DM, r, true}; r -= I2;
    if (r < I3) return TrJob{F.w_up, F.norm_ffn, F.WupT0, 1.f, FF, 0, FF, 256, DM, r, true}; r -= I3;
    if (r < I4) return TrJob{F.w_dn, nullptr, F.WdnT0, 1.f, DM, 0, DM, 64, FF, r, true}; r -= I4;
    if (r < I5) return TrJob{F.ml_w_in, F.norm_mix + DM, F.WmlT, 1.f, ML_IN, C_MQ, 1024, 32, DM, r, true}; r -= I5;
    if (r < I6) return TrJob{F.ml_w_in, F.norm_mix + DM, F.WmlT + (size_t)C_MK * DM, KSC, ML_IN, C_MK, 1024, 32, DM, r, true}; r -= I6;
    if (r < I7) return TrJob{F.ml_w_in, F.norm_mix + DM, F.WmlT + (size_t)C_MV * DM, 1.f, ML_IN, C_MV, 4096, 128, DM, r, true}; r -= I7;
    if (r < I8) return TrJob{F.ml_w_in, F.norm_mix + DM, F.WgT, 1.f, ML_IN, ML_N, 16, 1, DM, r, true}; r -= I8;
    if (r < I9) return TrJob{F.ml_w_out, nullptr, F.WmoT, 1.f, DM, 0, DM, 64, DM, r, true}; r -= I9;
    if (r < I10) return TrJob{F.w_up + (size_t)DM * FF, F.norm_ffn + DM, F.WupT1, 1.f, FF, 0, FF, 256, DM, r, true}; r -= I10;
    return TrJob{F.w_dn + (size_t)FF * DM, nullptr, F.WdnT1, 1.f, DM, 0, DM, 64, FF, r, true};
}
#define TR_LOAD(J, V) do { const int kb_ = (J).item / (J).nblk, nb_ = (J).item - kb_ * (J).nblk, nn_ = 32 * nb_ + (lane & 31), nc_ = nn_ < (J).nvalid ? nn_ : (J).nvalid - 1;                   \
    const GAS float* wp_ = (const GAS float*)(J).W + (size_t)(64 * kb_ + (lane >> 5)) * (J).ldw + (J).col0 + nc_;                                                                                  \
    _Pragma("unroll") for (int i = 0; i < 32; ++i) V[i] = __builtin_nontemporal_load(wp_ + (size_t)(2 * i) * (J).ldw); } while (0)
#define TR_FINISH(J, V) do { const int kb_ = (J).item / (J).nblk, nb_ = (J).item - kb_ * (J).nblk, k0_ = 64 * kb_, n0_ = 32 * nb_, c_ = lane & 7; const bool ok_ = n0_ + (lane & 31) < (J).nvalid;    \
    f32x4 g0_ = (f32x4){(J).scale, (J).scale, (J).scale, (J).scale}, g1_ = g0_;                                                                                                                   \
    if ((J).gain) { g0_ = *(const GAS f32x4*)((J).gain + k0_ + 8 * c_) * (J).scale; g1_ = *(const GAS f32x4*)((J).gain + k0_ + 8 * c_ + 4) * (J).scale; }                                        \
    _Pragma("unroll") for (int i = 0; i < 32; ++i) scr[(2 * i + (lane >> 5)) * 33 + (lane & 31)] = ok_ ? V[i] : 0.f;                                                                               \
    LDS_WAIT(); asm volatile("" ::: "memory");                                                                                                                                                     \
    _Pragma("unroll") for (int j = 0; j < 4; ++j) { const int n_ = (lane >> 3) + 8 * j; const LAS float* s_ = scr + (8 * c_) * 33 + n_;                                                           \
        v4u o_; o_.x = cvtpk2(s_[0 * 33] * g0_.x, s_[1 * 33] * g0_.y); o_.y = cvtpk2(s_[2 * 33] * g0_.z, s_[3 * 33] * g0_.w); o_.z = cvtpk2(s_[4 * 33] * g1_.x, s_[5 * 33] * g1_.y); o_.w = cvtpk2(s_[6 * 33] * g1_.z, s_[7 * 33] * g1_.w); \
        GAS v4u* d_ = (GAS v4u*)((J).WT + (size_t)(n0_ + n_) * (J).K + k0_ + 8 * c_);                                                                                                             \
        if ((J).nts) __builtin_nontemporal_store(o_, d_); else *d_ = o_; }                                                                                                                         \
    LDS_WAIT(); asm volatile("" ::: "memory"); } while (0)
__device__ __forceinline__ void cvt_items(Frame& F, int lo, int hi) {
    const int tid = opaque_tid(), lane = tid & 63, wave = tid >> 6;
    LAS float* scr = (LAS float*)(F.lds + RING_OFF + wave * 16384);
    const int gw = F.vcu * NWAVES + wave, NGW = F.G * NWAVES;
    int it = lo + gw; if (it >= hi) return;
    float va[32], vb[32]; TrJob ja = tr_job(F, it), jb = ja;
    TR_LOAD(ja, va);
    for (;;) {
        it += NGW; const bool more1 = it < hi; if (more1) { jb = tr_job(F, it); TR_LOAD(jb, vb); }
        TR_FINISH(ja, va); if (!more1) break;
        it += NGW; const bool more2 = it < hi; if (more2) { ja = tr_job(F, it); TR_LOAD(ja, va); }
        TR_FINISH(jb, vb); if (!more2) break;
    }
}
#undef TR_LOAD
#undef TR_FINISH
__device__ __forceinline__ void cvt_slot(Frame& F, int lo, int hi, bool before) {
#if CVT_STAGGER
    if (((F.vcu & 1) == 0) == before) { __syncthreads(); cvt_items(F, lo, hi); __syncthreads(); }
#endif
}
__device__ __forceinline__ void p0_prologue(Frame& F) {
    const int gw = F.vcu * NWAVES + F.wave, NGW = F.G * NWAVES;
    cvt_items(F, 0, CVT_STAGGER ? cvt::E1 : cvt::E11);
    for (int m = gw; m < M; m += NGW) {
        const GAS f32x4* xr = (const GAS f32x4*)(F.x + (size_t)m * DM) + F.lane; GAS u64* o8 = (GAS u64*)(F.XB + (size_t)m * DM) + F.lane;
        f32x4 v[8]; float s = 0.f;
#pragma unroll
        for (int j = 0; j < 8; ++j) { v[j] = __builtin_nontemporal_load(xr + 64 * j); s += (v[j].x * v[j].x + v[j].y * v[j].y) + (v[j].z * v[j].z + v[j].w * v[j].w); }
        s = wave_sum(s); if (F.lane == 0) F.ss0[m] = s;
#pragma unroll
        for (int j = 0; j < 8; ++j) o8[64 * j] = (u64)cvtpk2(v[j].x, v[j].y) | ((u64)cvtpk2(v[j].z, v[j].w) << 32);
    }
    for (int idx = gw * 64 + F.lane; idx < T * 24; idx += NGW * 64) { const int t = idx / 24, i = idx - t * 24;
        if (i < 16) { const float inv = powf(500000.0f, -2.0f * (float)i / 32.0f), a = (float)t * inv; F.ROPE_A[t * 16 + i] = (f32x2){cosf(a), sinf(a)}; }
        else { const int ii = i - 16; const float inv = powf(500000.0f, -2.0f * (float)ii / 16.0f), a = (float)t * inv; F.ROPE_I[t * 8 + ii] = (f32x2){cosf(a), sinf(a)}; } }
}
template <int NT> __device__ __forceinline__ void skinny_mma(Frame& F, const bf16* A, const bf16* Wt, int r0, LAS float* red) {
    const int rt = F.wave & 1, kq = F.wave >> 1, fr = F.lane & 15, fq = F.lane >> 4;
    f32x4 acc[NT];
#pragma unroll
    for (int n = 0; n < NT; ++n) acc[n] = (f32x4){0.f, 0.f, 0.f, 0.f};
    const bf16* ap = A + (size_t)(r0 + rt * 16 + fr) * DM + kq * 512 + fq * 8; const bf16* bp = Wt + (size_t)fr * DM + kq * 512 + fq * 8;
#pragma unroll 4
    for (int ks = 0; ks < 16; ++ks) { const bf16x8 a = *(const bf16x8*)(ap + ks * 32);
#pragma unroll
        for (int n = 0; n < NT; ++n) { const bf16x8 b = *(const bf16x8*)(bp + (size_t)n * 16 * DM + ks * 32); acc[n] = __builtin_amdgcn_mfma_f32_16x16x32_bf16(a, b, acc[n], 0, 0, 0); } }
#pragma unroll
    for (int n = 0; n < NT; ++n)
#pragma unroll
        for (int g = 0; g < 4; ++g) red[((kq * 32 + rt * 16 + 4 * fq + g) * (NT * 16)) + n * 16 + fr] = acc[n][g];
}
__device__ __forceinline__ void skinny_att(Frame& F) {
    LAS float* red = (LAS float*)(F.lds + RING_OFF);
    for (int u = F.vcu; u < M / 32; u += F.G) { const int r0 = u * 32;
        skinny_mma<5>(F, F.XB, F.WsmT, r0, red);
        LDS_WAIT(); __syncthreads();
        const int r = F.tid >> 4, q = F.tid & 15, m = r0 + r, t = m % T; const float rs = __builtin_amdgcn_rsqf(F.ss0[m] * (1.f / DM) + EPS);
#define SMV(c) ((red[(0 * 32 + r) * 80 + (c)] + red[(1 * 32 + r) * 80 + (c)] + red[(2 * 32 + r) * 80 + (c)] + red[(3 * 32 + r) * 80 + (c)]) * rs)
        if (q < 8) { const float a = SMV(q), b = SMV(q + 8); const f32x2 cs = F.ROPE_I[t * 8 + q];
            F.KI[(size_t)m * 64 + q] = (bf16)f2bf(a * cs.x - b * cs.y); F.KI[(size_t)m * 64 + q + 8] = (bf16)f2bf(a * cs.y + b * cs.x); }
#pragma unroll
        for (int e = 0; e < 3; ++e) { const int c = 16 + q * 3 + e; F.KI[(size_t)m * 64 + c] = (bf16)f2bf(SMV(c)); }
        F.WI[(size_t)m * 16 + q] = SMV(64 + q) * 0.03125f;
#undef SMV
        LDS_WAIT(); __syncthreads();
    }
}
__device__ __forceinline__ void skinny_gates(Frame& F) {
    LAS float* red = (LAS float*)(F.lds + RING_OFF);
    for (int u = F.vcu; u < M / 32; u += F.G) { const int r0 = u * 32;
        skinny_mma<1>(F, F.XB, F.WgT, r0, red);
        LDS_WAIT(); __syncthreads();
        const int r = F.tid >> 4, c = F.tid & 15, m = r0 + r, b = m / T, t = m - b * T; const float rs = __builtin_amdgcn_rsqf(F.ss2[m] * (1.f / DM) + EPS);
        float g = (red[(0 * 32 + r) * 16 + c] + red[(1 * 32 + r) * 16 + c] + red[(2 * 32 + r) * 16 + c] + red[(3 * 32 + r) * 16 + c]) * rs + F.b_gate[c];
        g = GATE_CAP * tanhf(g * (1.f / GATE_CAP));
        if (c < 8) F.IG[(size_t)(b * MH + c) * T + t] = g;
        else { const float ls = g >= 0.f ? -log1pf(expf(-g)) : g - log1pf(expf(g)); F.LF[(size_t)(b * MH + c - 8) * T + t] = ls; }
        LDS_WAIT(); __syncthreads();
    }
}
__device__ __forceinline__ void unpack8(const v4u w, float* f) { f[0] = bflo(w.x); f[1] = bfhi(w.x); f[2] = bflo(w.y); f[3] = bfhi(w.y); f[4] = bflo(w.z); f[5] = bfhi(w.z); f[6] = bflo(w.w); f[7] = bfhi(w.w); }
__device__ __forceinline__ v4u pack8f(const float* f) { v4u w; w.x = pk2(f[0], f[1]); w.y = pk2(f[2], f[3]); w.z = pk2(f[4], f[5]); w.w = pk2(f[6], f[7]); return w; }
__device__ __forceinline__ void norm_rope32(Frame& F, const bf16* src, bf16* dst, const float* gain, int t, bool active) {
    float y[32]; float s = 0.f;
    if (active) {
#pragma unroll
        for (int j = 0; j < 4; ++j) unpack8(*(const GAS v4u*)(src + 8 * j), y + 8 * j);
    } else {
#pragma unroll
        for (int e = 0; e < 32; ++e) y[e] = 0.f;
    }
#pragma unroll
    for (int e = 0; e < 32; ++e) s += y[e] * y[e];
    s += __shfl_xor(s, 1); s += __shfl_xor(s, 2);
    const float rs = __builtin_amdgcn_rsqf(s * (1.f / 128.f) + EPS); const int d0 = (F.lane & 3) * 32;
    if (active) {
#pragma unroll
        for (int e = 0; e < 32; ++e) y[e] = y[e] * rs * gain[d0 + e];
        if ((F.lane & 3) == 0) {
#pragma unroll
            for (int i = 0; i < 16; ++i) { const f32x2 cs = F.ROPE_A[t * 16 + i]; const float a = y[i], b = y[i + 16]; y[i] = a * cs.x - b * cs.y; y[i + 16] = a * cs.y + b * cs.x; }
        }
#pragma unroll
        for (int j = 0; j < 4; ++j) *(GAS v4u*)(dst + 8 * j) = pack8f(y + 8 * j);
    }
}
__device__ __forceinline__ void p2_prep(Frame& F) {
    const int gw = F.vcu * NWAVES + F.wave, NGW = F.G * NWAVES;
    for (int m = gw; m < M; m += NGW) { const int t = m % T; const bf16* pr = F.PROJ + (size_t)m * ATT_N;
        norm_rope32(F, pr + C_Q + 32 * F.lane, F.Q + (size_t)m * DM + 32 * F.lane, F.q_gain, t, true);
        norm_rope32(F, pr + C_K + 32 * (F.lane & 15), F.K + (size_t)m * 512 + 32 * (F.lane & 15), F.k_gain, t, F.lane < 16);
        *(GAS v4u*)(F.V + (size_t)m * 512 + 8 * F.lane) = *(const GAS v4u*)(pr + C_V + 8 * F.lane);
        float y[16]; unpack8(*(const GAS v4u*)(pr + C_QI + 16 * F.lane), y); unpack8(*(const GAS v4u*)(pr + C_QI + 16 * F.lane + 8), y + 8);
        if ((F.lane & 3) == 0) {
#pragma unroll
            for (int i = 0; i < 8; ++i) { const f32x2 cs = F.ROPE_I[t * 8 + i]; const float a = y[i], b = y[i + 8]; y[i] = a * cs.x - b * cs.y; y[i + 8] = a * cs.y + b * cs.x; }
        }
        *(GAS v4u*)(F.QI + (size_t)m * 1024 + 16 * F.lane) = pack8f(y); *(GAS v4u*)(F.QI + (size_t)m * 1024 + 16 * F.lane + 8) = pack8f(y + 8);
    }
}
template <bool TWO, int ABL = 0> __device__ __forceinline__ void p3a_tiles(Frame& F, int b, size_t m0, int kt, const LAS unsigned char* qrow, int swz, const LAS float* wl, int r32, int hi) {
    bf16x8 ka[4], kb[4];
    { const bf16* kp = F.KI + ((size_t)b * T + 32 * kt + r32) * 64 + hi * 8;
#pragma unroll
      for (int ks = 0; ks < 4; ++ks) { ka[ks] = *(const GAS bf16x8*)(kp + 16 * ks); if (TWO) kb[ks] = *(const GAS bf16x8*)(kp + (size_t)32 * NWAVES * 64 + 16 * ks); } }
    f32x16 sa, sb;
#pragma unroll
    for (int r = 0; r < 16; ++r) { sa[r] = 0.f; sb[r] = 0.f; }
#pragma unroll 2
    for (int h = 0; h < 16; ++h) { f32x16 da, db; const float wh = wl[r32 * 16 + h];
#pragma unroll
        for (int r = 0; r < 16; ++r) { da[r] = 0.f; db[r] = 0.f; }
#pragma unroll
        for (int ks = 0; ks < 4; ++ks) { const bf16x8 q = *(const LAS bf16x8*)(qrow + (((h * 64 + 16 * ks + 8 * hi) * 2) ^ swz));
            da = __builtin_amdgcn_mfma_f32_32x32x16_bf16(ka[ks], q, da, 0, 0, 0); if (TWO) db = __builtin_amdgcn_mfma_f32_32x32x16_bf16(kb[ks], q, db, 0, 0, 0); }
#pragma unroll
        for (int r = 0; r < 16; ++r) { const float xa = da[r]; const int ia = __float_as_int(xa); sa[r] = fmaf(wh, __int_as_float(ia > 0 ? ia : 0), sa[r]);
            if (TWO) { const float xb = db[r]; const int ib = __float_as_int(xb); sb[r] = fmaf(wh, __int_as_float(ib > 0 ? ib : 0), sb[r]); } } }
    LAS float* tsc = (LAS float*)(F.lds + RING_OFF + 69632 + F.wave * 4608);
    const int trow = F.lane >> 1, th = F.lane & 1;
#pragma unroll
    for (int q4 = 0; q4 < 4; ++q4) *(LAS f32x4*)(tsc + r32 * 36 + 8 * q4 + 4 * hi) = (f32x4){sa[4 * q4], sa[4 * q4 + 1], sa[4 * q4 + 2], sa[4 * q4 + 3]};
    if (ABL != 2) { float* dst = F.SC + (m0 + trow) * T + 32 * kt + 16 * th;
#pragma unroll
      for (int q4 = 0; q4 < 4; ++q4) *(GAS f32x4*)(dst + 4 * q4) = *(const LAS f32x4*)(tsc + trow * 36 + 16 * th + 4 * q4); }
    if (TWO) {
#pragma unroll
        for (int q4 = 0; q4 < 4; ++q4) *(LAS f32x4*)(tsc + r32 * 36 + 8 * q4 + 4 * hi) = (f32x4){sb[4 * q4], sb[4 * q4 + 1], sb[4 * q4 + 2], sb[4 * q4 + 3]};
        float* dst = F.SC + (m0 + trow) * T + 32 * (kt + NWAVES) + 16 * th;
        if (ABL != 2) {
#pragma unroll
        for (int q4 = 0; q4 < 4; ++q4) *(GAS f32x4*)(dst + 4 * q4) = *(const LAS f32x4*)(tsc + trow * 36 + 16 * th + 4 * q4); } }
}
template <int ABL = 0> __device__ __forceinline__ void p3a_segment(Frame& F, int b, int i, int kt0, int kt1) {
    LAS unsigned char* qs = F.lds + RING_OFF;
    LAS float* wl = (LAS float*)(F.lds + RING_OFF + 65536);
    const int r32 = F.lane & 31, hi = F.lane >> 5, t0 = 32 * i; const size_t m0 = (size_t)b * T + t0;
#pragma unroll
    for (int k = 0; k < 8; ++k) { const int p = F.tid + 512 * k, row = p >> 7, ch = p & 127;
        v4u v = *(const GAS v4u*)(F.PROJ + (m0 + row) * ATT_N + C_QI + ch * 8);
        v4u o; o.x = (unsigned)__builtin_amdgcn_update_dpp(0, (int)v.x, 0xB1, 0xf, 0xf, false); o.y = (unsigned)__builtin_amdgcn_update_dpp(0, (int)v.y, 0xB1, 0xf, 0xf, false);
        o.z = (unsigned)__builtin_amdgcn_update_dpp(0, (int)v.z, 0xB1, 0xf, 0xf, false); o.w = (unsigned)__builtin_amdgcn_update_dpp(0, (int)v.w, 0xB1, 0xf, 0xf, false);
        if ((ch & 7) < 2) { float a[8], bq[8]; unpack8((ch & 1) ? o : v, a); unpack8((ch & 1) ? v : o, bq); const f32x2* rp = F.ROPE_I + (size_t)(t0 + row) * 8; float y[8];
#pragma unroll
            for (int e = 0; e < 8; ++e) { const f32x2 cs = rp[e]; y[e] = (ch & 1) ? a[e] * cs.y + bq[e] * cs.x : a[e] * cs.x - bq[e] * cs.y; }
            v = pack8f(y); }
        *(LAS v4u*)(qs + row * 2048 + ((ch * 16) ^ ((row & 15) << 4))) = v; }
    wl[F.tid] = F.WI[(m0 + (F.tid >> 4)) * 16 + (F.tid & 15)];
    LDS_WAIT(); __syncthreads();
    const LAS unsigned char* qrow = qs + r32 * 2048; const int swz = (r32 & 15) << 4;
    if (ABL != 1) for (int kt = kt0 + F.wave; kt < kt1; kt += 2 * NWAVES) { const bool two = kt + NWAVES < kt1;
        if (two) p3a_tiles<true, ABL>(F, b, m0, kt, qrow, swz, wl, r32, hi); else p3a_tiles<false, ABL>(F, b, m0, kt, qrow, swz, wl, r32, hi); }
    LDS_WAIT(); __syncthreads();
}
template <int ABL = 0> __device__ __forceinline__ void p3a_scores(Frame& F) {
    { const int gw = F.vcu * NWAVES + F.wave, NGW = F.G * NWAVES;
      for (int m = gw; m < M; m += NGW) { const int t = m % T; const bf16* pr = F.PROJ + (size_t)m * ATT_N;
          norm_rope32(F, pr + C_K + 32 * (F.lane & 15), F.K + (size_t)m * 512 + 32 * (F.lane & 15), F.k_gain, t, F.lane < 16);
          *(GAS v4u*)(F.V + (size_t)m * 512 + 8 * F.lane) = *(const GAS v4u*)(pr + C_V + 8 * F.lane); } }
    for (int c = F.vcu; c < 256; c += F.G) { const int p = c >> 1, b = p >> 5, i = p & 31;
        if ((c & 1) == 0) p3a_segment<ABL>(F, b, 63 - i, 0, 32);
        else { p3a_segment<ABL>(F, b, 63 - i, 32, 64 - i); p3a_segment<ABL>(F, b, i, 0, i + 1); } }
}
__device__ __forceinline__ void p3b_select(Frame& F) {
    LAS unsigned* hist = (LAS unsigned*)(F.lds + RING_OFF + F.wave * 8192);
    const int gw = F.vcu * NWAVES + F.wave, NGW = F.G * NWAVES, rep = F.lane & 7;
    float sn[32];
#define ROW_OF(e_, t_, m_) const int bb_ = (e_) / T, tt_ = (e_) - bb_ * T, t_ = (bb_ & 1) ? T - 1 - tt_ : tt_, m_ = bb_ * T + t_
#define ROW_LOAD(e_) do { ROW_OF(e_, tl_, ml_); const float* sr_ = F.SC + (size_t)ml_ * T;                                             \
        _Pragma("unroll") for (int j = 0; j < 32; ++j) { const int s = F.lane + 64 * j; sn[j] = __builtin_nontemporal_load(sr_ + (s < tl_ ? s : tl_)); } } while (0)
    if (gw < M) ROW_LOAD(gw);
    for (int e = gw; e < M; e += NGW) { ROW_OF(e, t, m); const int nj = (t >> 6) + 1;
            unsigned k[32];
#pragma unroll
            for (int j = 0; j < 32; ++j) { const int s = F.lane + 64 * j; k[j] = fkey(s <= t ? sn[j] : -__builtin_inff()); }
            if (e + NGW < M) ROW_LOAD(e + NGW);
            unsigned P = 0;
            if (t + 1 > TOPK) { unsigned need = TOPK;
#pragma unroll 1
                for (int p = 0; p < 4; ++p) { const int sh = 24 - 8 * p; const unsigned hmask = p ? (0xffffffffu << (sh + 8)) : 0u;
#pragma unroll
                    for (int z = 0; z < 8; ++z) *(LAS v4u*)(hist + 4 * (F.lane + 64 * z)) = (v4u){0u, 0u, 0u, 0u};
#pragma unroll
                    for (int j = 0; j < 32; ++j) if (j < nj) { if (((k[j] ^ P) & hmask) == 0u) __hip_atomic_fetch_add(hist + (((k[j] >> sh) & 255u) * 8u + rep), 1u, __ATOMIC_RELAXED, __HIP_MEMORY_SCOPE_WORKGROUP); }
                    v4u hb;
                    { const LAS v4u* hp = (const LAS v4u*)(hist + 32 * F.lane);
                      const v4u r0 = hp[0], r1 = hp[1], r2 = hp[2], r3 = hp[3], r4 = hp[4], r5 = hp[5], r6 = hp[6], r7 = hp[7];
                      hb.x = (r0.x + r0.y + r0.z + r0.w) + (r1.x + r1.y + r1.z + r1.w); hb.y = (r2.x + r2.y + r2.z + r2.w) + (r3.x + r3.y + r3.z + r3.w);
                      hb.z = (r4.x + r4.y + r4.z + r4.w) + (r5.x + r5.y + r5.z + r5.w); hb.w = (r6.x + r6.y + r6.z + r6.w) + (r7.x + r7.y + r7.z + r7.w); }
                    const unsigned s4 = hb.x + hb.y + hb.z + hb.w;
                    unsigned ps = s4;
                    ps += (unsigned)__builtin_amdgcn_update_dpp(0, (int)ps, 0x111, 0xf, 0xf, false); ps += (unsigned)__builtin_amdgcn_update_dpp(0, (int)ps, 0x112, 0xf, 0xf, false);
                    ps += (unsigned)__builtin_amdgcn_update_dpp(0, (int)ps, 0x114, 0xf, 0xf, false); ps += (unsigned)__builtin_amdgcn_update_dpp(0, (int)ps, 0x118, 0xf, 0xf, false);
                    ps += (unsigned)__builtin_amdgcn_update_dpp(0, (int)ps, 0x142, 0xa, 0xf, false); ps += (unsigned)__builtin_amdgcn_update_dpp(0, (int)ps, 0x143, 0xc, 0xf, false);
                    const unsigned total = (unsigned)__builtin_amdgcn_readlane((int)ps, 63), above = total - ps;
                    const u64 bm = __ballot(above < need && need <= above + s4); const int src = __builtin_ctzll(bm);
                    const unsigned a3 = above + hb.w, a2 = a3 + hb.z, a1 = a2 + hb.y;
                    unsigned dig, gt;
                    if (need <= a3) { dig = 3; gt = above; } else if (need <= a2) { dig = 2; gt = a3; } else if (need <= a1) { dig = 1; gt = a2; } else { dig = 0; gt = a1; }
                    dig += 4u * F.lane;
                    dig = (unsigned)__builtin_amdgcn_readlane((int)dig, src); gt = (unsigned)__builtin_amdgcn_readlane((int)gt, src);
                    P |= dig << sh; need -= gt; } }
            u64 myw = 0;
#pragma unroll
            for (int j = 0; j < 32; ++j) { const int s = F.lane + 64 * j; const u64 w = __ballot(k[j] >= P && s <= t); if (F.lane == j) myw = w; }
            if (F.lane < 32) F.MASK[(size_t)m * 32 + F.lane] = myw;
    }
#undef ROW_OF
#undef ROW_LOAD
}
#ifndef IDX_FUSED
#define IDX_FUSED 0
#endif
__device__ __forceinline__ unsigned radix_select(const unsigned (&k)[32], int nj, int lane, LAS unsigned* hist) {
    unsigned P = 0, need = TOPK;
#pragma unroll 1
    for (int p = 0; p < 4; ++p) { const int sh = 24 - 8 * p; const unsigned hmask = p ? (0xffffffffu << (sh + 8)) : 0u;
        *(LAS v4u*)(hist + 4 * lane) = (v4u){0u, 0u, 0u, 0u};
#pragma unroll
        for (int j = 0; j < 32; ++j) if (j < nj) { if (((k[j] ^ P) & hmask) == 0u) __hip_atomic_fetch_add(hist + ((k[j] >> sh) & 255u), 1u, __ATOMIC_RELAXED, __HIP_MEMORY_SCOPE_WORKGROUP); }
        const v4u hb = *(const LAS v4u*)(hist + 4 * lane);
        const unsigned s4 = hb.x + hb.y + hb.z + hb.w;
        unsigned ps = s4;
        ps += (unsigned)__builtin_amdgcn_update_dpp(0, (int)ps, 0x111, 0xf, 0xf, false); ps += (unsigned)__builtin_amdgcn_update_dpp(0, (int)ps, 0x112, 0xf, 0xf, false);
        ps += (unsigned)__builtin_amdgcn_update_dpp(0, (int)ps, 0x114, 0xf, 0xf, false); ps += (unsigned)__builtin_amdgcn_update_dpp(0, (int)ps, 0x118, 0xf, 0xf, false);
        ps += (unsigned)__builtin_amdgcn_update_dpp(0, (int)ps, 0x142, 0xa, 0xf, false); ps += (unsigned)__builtin_amdgcn_update_dpp(0, (int)ps, 0x143, 0xc, 0xf, false);
        const unsigned total = (unsigned)__builtin_amdgcn_readlane((int)ps, 63), above = total - ps;
        const u64 bm = __ballot(above < need && need <= above + s4); const int src = __builtin_ctzll(bm);
        const unsigned a3 = above + hb.w, a2 = a3 + hb.z, a1 = a2 + hb.y;
        unsigned dig, gt;
        if (need <= a3) { dig = 3; gt = above; } else if (need <= a2) { dig = 2; gt = a3; } else if (need <= a1) { dig = 1; gt = a2; } else { dig = 0; gt = a1; }
        dig += 4u * lane;
        dig = (unsigned)__builtin_amdgcn_readlane((int)dig, src); gt = (unsigned)__builtin_amdgcn_readlane((int)gt, src);
        P |= dig << sh; need -= gt; }
    return P;
}
__device__ __forceinline__ void p3f_tile(Frame& F, int b, int ti) {
    constexpr int SROW = 2052;
    LAS float* SCL = (LAS float*)(F.lds + RING_OFF);
    LAS unsigned* hist = (LAS unsigned*)(F.lds + RING_OFF + 16 * SROW * 4 + F.wave * 1024);
    static_assert(16 * SROW * 4 + 8 * 1024 <= RING_BYTES, "fused indexer LDS");
    const int lane = F.lane, c16 = lane & 15, kq = lane >> 4, t0 = 16 * ti; const size_t m0 = (size_t)b * T + t0;
#pragma unroll 1
    for (int hh = 0; hh < 2; ++hh) {
        bf16x8 qf[8][2]; float wv[8];
        { const bf16* qp = F.PROJ + (m0 + c16) * ATT_N + C_QI + hh * 512 + 8 * kq; const f32x2* rp = F.ROPE_I + (size_t)(t0 + c16) * 8;
          f32x2 cs[8];
#pragma unroll
          for (int e = 0; e < 8; ++e) cs[e] = rp[e];
#pragma unroll
          for (int h = 0; h < 8; ++h) { v4u v0 = *(const GAS v4u*)(qp + h * 64), v1 = *(const GAS v4u*)(qp + h * 64 + 32);
              v4u o; o.x = (unsigned)__shfl_xor((int)v0.x, 16); o.y = (unsigned)__shfl_xor((int)v0.y, 16); o.z = (unsigned)__shfl_xor((int)v0.z, 16); o.w = (unsigned)__shfl_xor((int)v0.w, 16);
              if (kq < 2) { float a[8], bq[8], y[8]; unpack8(kq ? o : v0, a); unpack8(kq ? v0 : o, bq);
#pragma unroll
                  for (int e = 0; e < 8; ++e) y[e] = kq ? a[e] * cs[e].y + bq[e] * cs[e].x : a[e] * cs[e].x - bq[e] * cs[e].y;
                  v0 = pack8f(y); }
              qf[h][0] = *reinterpret_cast<bf16x8*>(&v0); qf[h][1] = *reinterpret_cast<bf16x8*>(&v1); }
          const float* wp = F.WI + (m0 + c16) * 16 + hh * 8;
#pragma unroll
          for (int h4 = 0; h4 < 2; ++h4) { const f32x4 w4 = *(const GAS f32x4*)(wp + 4 * h4); wv[4 * h4] = w4.x; wv[4 * h4 + 1] = w4.y; wv[4 * h4 + 2] = w4.z; wv[4 * h4 + 3] = w4.w; } }
        bf16x8 a0, a1, n0, n1;
        { const int kt = F.wave; if (kt <= ti) { const bf16* kp = F.KI + ((size_t)b * T + 16 * kt + c16) * 64 + 8 * kq; n0 = *(const GAS bf16x8*)kp; n1 = *(const GAS bf16x8*)(kp + 32); } }
        for (int kt = F.wave; kt <= ti; kt += NWAVES) { const int s0 = 16 * kt;
            a0 = n0; a1 = n1;
            if (kt + NWAVES <= ti) { const bf16* kp = F.KI + ((size_t)b * T + 16 * (kt + NWAVES) + c16) * 64 + 8 * kq; n0 = *(const GAS bf16x8*)kp; n1 = *(const GAS bf16x8*)(kp + 32); }
            LAS f32x4* dst = (LAS f32x4*)(SCL + c16 * SROW + s0 + 4 * kq);
            f32x4 sc = (f32x4){0.f, 0.f, 0.f, 0.f}; if (hh) sc = *dst;
#pragma unroll
            for (int h = 0; h < 8; ++h) { f32x4 d = __builtin_amdgcn_mfma_f32_16x16x32_bf16(a0, qf[h][0], (f32x4){0.f, 0.f, 0.f, 0.f}, 0, 0, 0); d = __builtin_amdgcn_mfma_f32_16x16x32_bf16(a1, qf[h][1], d, 0, 0, 0);
                sc += __builtin_elementwise_max(d, (f32x4){0.f, 0.f, 0.f, 0.f}) * wv[h]; }
            *dst = sc;
        }
    }
    LDS_WAIT(); __syncthreads();
#pragma unroll 1
    for (int rr = 0; rr < 2; ++rr) { const int row = 2 * F.wave + rr, t = t0 + row, nj = (t >> 6) + 1; const LAS float* srow = SCL + row * SROW;
        unsigned k[32];
#pragma unroll
        for (int j = 0; j < 32; ++j) { const int s = lane + 64 * j; k[j] = fkey(s <= t ? srow[s] : -__builtin_inff()); }
        unsigned P = 0;
        if (t + 1 > TOPK) P = radix_select(k, nj, lane, hist);
        u64 myw = 0;
#pragma unroll
        for (int j = 0; j < 32; ++j) { const int s = lane + 64 * j; const u64 w = __ballot(k[j] >= P && s <= t); if (lane == j) myw = w; }
        if (lane < 32) F.MASK[(m0 + row) * 32 + lane] = myw;
    }
    LDS_WAIT(); __syncthreads();
}
__device__ __forceinline__ void p3_fused(Frame& F) {
    { const int gw = F.vcu * NWAVES + F.wave, NGW = F.G * NWAVES;
      for (int m = gw; m < M; m += NGW) { const int t = m % T; const bf16* pr = F.PROJ + (size_t)m * ATT_N;
          norm_rope32(F, pr + C_K + 32 * (F.lane & 15), F.K + (size_t)m * 512 + 32 * (F.lane & 15), F.k_gain, t, F.lane < 16);
          *(GAS v4u*)(F.V + (size_t)m * 512 + 8 * F.lane) = *(const GAS v4u*)(pr + C_V + 8 * F.lane); } }
    for (int u = F.vcu; u < 256; u += F.G) { const int b = u >> 6, i = u & 63; p3f_tile(F, b, 127 - i); p3f_tile(F, b, i); }
}
namespace att {
constexpr int D = 128, NW = 8, QBLK = 32, KVBLK = 64;
constexpr float SCALE = 0.088388347648318440f;
constexpr int LDQ = ATT_N, LDK = 512, LDO = DM;
constexpr int SHM_V = KVBLK * D * 2, SHM_K = KVBLK * D * 2, SHM_MASK = 2 * SHM_V + 2 * SHM_K + NW * 64 * 4, MROW = 33 * 8, SHM_ATTN = SHM_MASK + 256 * MROW;
#define KSWZ(row, colB) ((row) * 256 + ((colB) ^ (((row) & 7) << 4)))
#define SBAR() __builtin_amdgcn_sched_barrier(0)
__device__ __forceinline__ int crow(int r, int hi) { return (r & 3) + 8 * (r >> 2) + 4 * hi; }
__device__ __forceinline__ unsigned cvtpk(float lo, float hi) { unsigned r; asm volatile("v_cvt_pk_bf16_f32 %0, %1, %2" : "=v"(r) : "v"(lo), "v"(hi)); return r; }
__device__ __forceinline__ void partialSM(f32x16& p0, f32x16& p1) {
  for (int r = 0; r < 16; ++r) p0[r] = __builtin_amdgcn_exp2f(p0[r]);
}
__device__ __forceinline__ void finishSM(f32x16& p0, f32x16& p1, float& l_reg, bf16x8& pa0, bf16x8& pa1, bf16x8& pa2, bf16x8& pa3) {
  for (int r = 0; r < 16; ++r) p1[r] = __builtin_amdgcn_exp2f(p1[r]);
  float ps = 0; for (int r = 0; r < 16; ++r) ps += p0[r]; for (int r = 0; r < 16; ++r) ps += p1[r];
  { auto rr = __builtin_amdgcn_permlane32_swap(__float_as_uint(ps), __float_as_uint(ps), false, false);
    ps = __uint_as_float(rr[0]) + __uint_as_float(rr[1]); }
  l_reg += ps;
#define PK4(P, BASE, OUT) do { unsigned a0 = cvtpk(P[BASE + 0], P[BASE + 1]), a1 = cvtpk(P[BASE + 2], P[BASE + 3]);   \
    unsigned b0 = cvtpk(P[BASE + 4], P[BASE + 5]), b1 = cvtpk(P[BASE + 6], P[BASE + 7]);                              \
    auto r0 = __builtin_amdgcn_permlane32_swap(a0, b0, false, false); auto r1 = __builtin_amdgcn_permlane32_swap(a1, b1, false, false); \
    v4u w = {r0[0], r1[0], r0[1], r1[1]}; OUT = *reinterpret_cast<bf16x8*>(&w); } while (0)
  PK4(p0, 0, pa0); PK4(p0, 8, pa1); PK4(p1, 0, pa2); PK4(p1, 8, pa3);
#undef PK4
}
__device__ __forceinline__ void qkt(f32x16& p0, f32x16& p1, const bf16* Ks, const bf16x8* qr, int r32, int hi, unsigned mlo, unsigned mhi, float negm) {
  const unsigned nlo = ~mlo >> (4 * hi), nhi = ~mhi >> (4 * hi), nb = __float_as_uint(negm);
#pragma unroll
  for (int g = 0; g < 4; ++g) { const unsigned a0 = nlo << (27 - 8 * g), b0 = nlo << (26 - 8 * g), a1 = nhi << (27 - 8 * g), b1 = nhi << (26 - 8 * g);
    p0[4 * g + 0] = __uint_as_float((a0 & 0x08000000u) | nb); p0[4 * g + 1] = __uint_as_float((a0 & 0x10000000u) | nb); p0[4 * g + 2] = __uint_as_float((a0 & 0x20000000u) | nb); p0[4 * g + 3] = __uint_as_float((b0 & 0x20000000u) | nb);
    p1[4 * g + 0] = __uint_as_float((a1 & 0x08000000u) | nb); p1[4 * g + 1] = __uint_as_float((a1 & 0x10000000u) | nb); p1[4 * g + 2] = __uint_as_float((a1 & 0x20000000u) | nb); p1[4 * g + 3] = __uint_as_float((b1 & 0x20000000u) | nb); }
#pragma unroll
  for (int d0 = 0; d0 < 8; ++d0) { int cb = (d0 * 16 + hi * 8) * 2;
    bf16x8 b0 = *reinterpret_cast<const bf16x8*>((const char*)Ks + KSWZ(r32, cb));
    bf16x8 b1 = *reinterpret_cast<const bf16x8*>((const char*)Ks + KSWZ(32 + r32, cb));
    p0 = __builtin_amdgcn_mfma_f32_32x32x16_bf16(b0, qr[d0], p0, 0, 0, 0);
    p1 = __builtin_amdgcn_mfma_f32_32x32x16_bf16(b1, qr[d0], p1, 0, 0, 0); }
}
__device__ __forceinline__ int v_st(int k, int c) { const int kk = (k & ~0xC) | ((k & 4) << 1) | ((k & 8) >> 1); return ((kk >> 3) * 4 + (c >> 5)) * 512 + ((kk & 7) * 32 + (c & 31)) * 2; }
__device__ __forceinline__ int v_rd_base(int lane) { return ((lane & 3) << 3) | (((lane >> 2) & 3) << 6) | (((lane >> 4) & 1) << 5) | (((lane >> 5) & 1) << 8); }
constexpr int v_rd_off(int d0, int ks, int half) { return d0 * 512 + ks * 4096 + half * 2048; }
template <int OFF> __device__ __forceinline__ s16x4 tr_read(int vb) {
  s16x4 r; asm volatile("ds_read_b64_tr_b16 %0, %1 offset:%2" : "=&v"(r) : "v"(vb), "i"(OFF) : "memory"); return r;
}
template <int D0> __device__ __forceinline__ void pv_one(f32x16& od, int vb, bf16x8 pa0, bf16x8 pa1, bf16x8 pa2, bf16x8 pa3) {
  const s16x4 l0 = tr_read<v_rd_off(D0, 0, 0)>(vb), h0 = tr_read<v_rd_off(D0, 0, 1)>(vb), l1 = tr_read<v_rd_off(D0, 1, 0)>(vb), h1 = tr_read<v_rd_off(D0, 1, 1)>(vb);
  const s16x4 l2 = tr_read<v_rd_off(D0, 2, 0)>(vb), h2 = tr_read<v_rd_off(D0, 2, 1)>(vb), l3 = tr_read<v_rd_off(D0, 3, 0)>(vb), h3 = tr_read<v_rd_off(D0, 3, 1)>(vb);
  asm volatile("s_waitcnt lgkmcnt(0)" ::: "memory"); SBAR();
#define PK(L, H) (bf16x8){L[0], L[1], L[2], L[3], H[0], H[1], H[2], H[3]}
  od = __builtin_amdgcn_mfma_f32_32x32x16_bf16(pa0, PK(l0, h0), od, 0, 0, 0);
  od = __builtin_amdgcn_mfma_f32_32x32x16_bf16(pa1, PK(l1, h1), od, 0, 0, 0);
  od = __builtin_amdgcn_mfma_f32_32x32x16_bf16(pa2, PK(l2, h2), od, 0, 0, 0);
  od = __builtin_amdgcn_mfma_f32_32x32x16_bf16(pa3, PK(l3, h3), od, 0, 0, 0);
#undef PK
}
__device__ __forceinline__ void pv_d0(f32x16* o, int vb, bf16x8 pa0, bf16x8 pa1, bf16x8 pa2, bf16x8 pa3) {
  pv_one<0>(o[0], vb, pa0, pa1, pa2, pa3); pv_one<1>(o[1], vb, pa0, pa1, pa2, pa3); pv_one<2>(o[2], vb, pa0, pa1, pa2, pa3); pv_one<3>(o[3], vb, pa0, pa1, pa2, pa3);
}
__device__ __forceinline__ void attn_body(const bf16* __restrict__ Qb, const bf16* __restrict__ Kh, const bf16* __restrict__ Vh, bf16* __restrict__ Ob, const u64* __restrict__ mrow, int seq, char* lds,
                                          const float* __restrict__ qgain, const float* __restrict__ kgain, const f32x2* __restrict__ ropeA, int tpos0) {
  const int tid = opaque_tid(), wid = tid >> 6, lane = tid & 63, r32 = lane & 31, hi = lane >> 5;
  bf16* V_lds = (bf16*)lds; bf16* K_lds = (bf16*)(lds + 2 * SHM_V);
  float* ws = (float*)(lds + 2 * SHM_V + 2 * SHM_K) + wid * 64; float* li_l = ws;
  float l_reg = 0, negmC; f32x16 o[4] = {}; bf16x8 qr[8];
  const bf16* Qw = Qb + (long)(wid * QBLK + r32) * LDQ + hi * 8;
  { float x[64]; float s = 0.f;
#pragma unroll
    for (int d0 = 0; d0 < 8; ++d0) unpack8(*reinterpret_cast<const v4u*>(Qw + d0 * 16), x + 8 * d0);
#pragma unroll
    for (int e = 0; e < 64; ++e) s += x[e] * x[e];
    { auto rr = __builtin_amdgcn_permlane32_swap(__float_as_uint(s), __float_as_uint(s), false, false); s = __uint_as_float(rr[0]) + __uint_as_float(rr[1]); }
    const float rs = __builtin_amdgcn_rsqf(s * (1.f / 128.f) + EPS) * (SCALE * 1.4426950408889634f);
#pragma unroll
    for (int d0 = 0; d0 < 8; ++d0) { const f32x4 g0 = *(const f32x4*)(qgain + 16 * d0 + 8 * hi), g1 = *(const f32x4*)(qgain + 16 * d0 + 8 * hi + 4);
        x[8 * d0 + 0] *= rs * g0.x; x[8 * d0 + 1] *= rs * g0.y; x[8 * d0 + 2] *= rs * g0.z; x[8 * d0 + 3] *= rs * g0.w; x[8 * d0 + 4] *= rs * g1.x; x[8 * d0 + 5] *= rs * g1.y; x[8 * d0 + 6] *= rs * g1.z; x[8 * d0 + 7] *= rs * g1.w; }
    const f32x2* rp = ropeA + (size_t)(tpos0 + wid * QBLK + r32) * 16 + 8 * hi;
#pragma unroll
    for (int e = 0; e < 8; ++e) { const f32x2 cs = rp[e]; const float a = x[e], bq = x[8 + e]; x[e] = a * cs.x - bq * cs.y; x[8 + e] = a * cs.y + bq * cs.x; }
    { float q2 = 0.f, g2;
#pragma unroll
      for (int e = 0; e < 64; ++e) q2 += x[e] * x[e];
      { auto rr = __builtin_amdgcn_permlane32_swap(__float_as_uint(q2), __float_as_uint(q2), false, false); q2 = __uint_as_float(rr[0]) + __uint_as_float(rr[1]); }
      { const f32x2 kg = *(const f32x2*)(kgain + 2 * lane); g2 = fmaxf(kg.x * kg.x, kg.y * kg.y); }
#pragma unroll
      for (int sh = 1; sh < 64; sh <<= 1) g2 = fmaxf(g2, __shfl_xor(g2, sh));
      negmC = -fminf(fmaxf(1.02f * __builtin_sqrtf(q2 * g2 * 128.f), 2.f), 65000.f); }
#pragma unroll
    for (int d0 = 0; d0 < 8; ++d0) { v4u w = pack8f(x + 8 * d0); qr[d0] = *reinterpret_cast<bf16x8*>(&w); } }
  const char* mw = lds + SHM_MASK + (wid * QBLK + r32) * MROW;
  const int sr = tid >> 4, sc = (tid & 15) * 8, vst0 = v_st(sr, sc), vst1 = v_st(32 + sr, sc);
  const int vb0 = (int)(uintptr_t)V_lds + v_rd_base(lane);
  constexpr int SDEPTH = 2;
  struct { bf16x8 vs0, vs1, ks0, ks1; } sr_[SDEPTH];
#define SLOAD(i, k0) do { sr_[i].vs0 = *reinterpret_cast<const bf16x8*>(&Vh[(long)((k0) + sr) * LDK + sc]); sr_[i].vs1 = *reinterpret_cast<const bf16x8*>(&Vh[(long)((k0) + 32 + sr) * LDK + sc]); \
    sr_[i].ks0 = *reinterpret_cast<const bf16x8*>(&Kh[(long)((k0) + sr) * LDK + sc]); sr_[i].ks1 = *reinterpret_cast<const bf16x8*>(&Kh[(long)((k0) + 32 + sr) * LDK + sc]); } while (0)
#define SWRITE(b, i) do { *(bf16x8*)((char*)V_lds + (b) * SHM_V + vst0) = sr_[i].vs0;          \
    *(bf16x8*)((char*)V_lds + (b) * SHM_V + vst1) = sr_[i].vs1; int kc = sc * 2;               \
    *(bf16x8*)((char*)K_lds + (b) * SHM_K + KSWZ(sr, kc)) = sr_[i].ks0;                       \
    *(bf16x8*)((char*)K_lds + (b) * SHM_K + KSWZ(32 + sr, kc)) = sr_[i].ks1; } while (0)
#define SWAIT() do { if constexpr (SDEPTH == 2) asm volatile("s_waitcnt vmcnt(4)" ::: "memory"); else asm volatile("s_waitcnt vmcnt(0)" ::: "memory"); } while (0)
  f32x16 pA0, pA1, pB0, pB1; bf16x8 pa0, pa1, pa2, pa3; const int NT = seq / KVBLK;
  constexpr int SE = 0, SO = SDEPTH - 1;
  { const int NTw = seq / KVBLK; for (int e = tid; e < 256 * NTw; e += 512) { const int row = e / NTw, j = e - row * NTw; *(u64*)(lds + SHM_MASK + row * MROW + j * 8) = mrow[(size_t)row * 32 + j]; } }
#define MK(j) (*(const v2u*)(mw + (j) * 8))
  v2u mk;
  SLOAD(SE, 0); asm volatile("s_waitcnt vmcnt(0)" ::: "memory"); SWRITE(0, SE); __syncthreads();
  mk = MK(0); qkt(pA0, pA1, K_lds, qr, r32, hi, mk.x, mk.y, negmC); partialSM(pA0, pA1);
  SLOAD(SO, KVBLK); if constexpr (SDEPTH == 2) { if (2 < NT) SLOAD(SE, 2 * KVBLK); }
  SWAIT(); SWRITE(1, SO); __syncthreads();
  for (int j = 1; j + 1 < NT; j += 2) {
    SBAR(); mk = MK(j); qkt(pB0, pB1, (bf16*)((char*)K_lds + SHM_K), qr, r32, hi, mk.x, mk.y, negmC);
    finishSM(pA0, pA1, l_reg, pa0, pa1, pa2, pa3); SBAR();
    SLOAD(SO, (j + SDEPTH) * KVBLK); SBAR();
    pv_d0(o, vb0, pa0, pa1, pa2, pa3); partialSM(pB0, pB1);
    __syncthreads(); SWAIT(); SWRITE(0, SE);
    __syncthreads();
    SBAR(); mk = MK(j + 1); qkt(pA0, pA1, K_lds, qr, r32, hi, mk.x, mk.y, negmC);
    finishSM(pB0, pB1, l_reg, pa0, pa1, pa2, pa3); SBAR();
    if (SDEPTH == 1 || j + 3 < NT) SLOAD(SE, (j + 1 + SDEPTH) * KVBLK); SBAR();
    pv_d0(o, vb0 + (int)SHM_V, pa0, pa1, pa2, pa3); partialSM(pA0, pA1);
    __syncthreads(); SWAIT(); SWRITE(1, SO);
    __syncthreads();
  }
  SBAR(); mk = MK(NT - 1); qkt(pB0, pB1, (bf16*)((char*)K_lds + SHM_K), qr, r32, hi, mk.x, mk.y, negmC);
  finishSM(pA0, pA1, l_reg, pa0, pa1, pa2, pa3); SBAR();
  pv_d0(o, vb0, pa0, pa1, pa2, pa3); partialSM(pB0, pB1);
  __syncthreads();
  finishSM(pB0, pB1, l_reg, pa0, pa1, pa2, pa3); SBAR();
  pv_d0(o, vb0 + (int)SHM_V, pa0, pa1, pa2, pa3);
  if (hi == 0) li_l[r32] = l_reg; asm volatile("s_waitcnt lgkmcnt(0)" ::: "memory");
  float rli[16];
#pragma unroll
  for (int r = 0; r < 16; ++r) rli[r] = __builtin_amdgcn_rcpf(li_l[crow(r, hi)]);
  bf16* Ow = Ob + (long)(wid * QBLK) * LDO;
#pragma unroll
  for (int r = 0; r < 16; ++r) { const int orow = crow(r, hi);
#pragma unroll
    for (int d0 = 0; d0 < 4; ++d0) { const float v = o[d0][r] * rli[r]; const float vn = __shfl_xor(v, 1);
      if ((r32 & 1) == 0) *(unsigned*)(Ow + (long)orow * LDO + d0 * 32 + r32) = cvtpk(v, vn); } }
#undef MK
#undef SLOAD
#undef SWRITE
#undef SWAIT
}
#undef KSWZ
#undef SBAR
}
__device__ __forceinline__ void p4_attention(Frame& F, char* lds) {
    static_assert(att::SHM_ATTN <= RING_BYTES, "attention LDS");
    for (int it = F.vcu; it < 256; it += F.G) { const int grp = it >> 4, b = grp >> 2, g = grp & 3, h = g * 4 + ((it >> 2) & 3), x = it & 3;
        for (int pass = 0; pass < 2; ++pass) { const int qb = pass ? x : 7 - x; const size_t row0 = (size_t)b * T + (size_t)qb * 256;
            att::attn_body(F.PROJ + row0 * ATT_N + C_Q + h * HD, F.K + (size_t)b * T * 512 + g * HD, F.V + (size_t)b * T * 512 + g * HD, F.O + row0 * DM + h * HD, F.MASK + row0 * 32, 256 * (qb + 1), lds, F.q_gain, F.k_gain, F.ROPE_A, qb * 256);
            __syncthreads(); } }
}
namespace ml {
constexpr int QS = 0, KS = 16384, VS = 32768, PF = 65536, HS = 73728, HROW = 528, MISC = HS + 64 * HROW, PW = MISC + 2048, PWB = 1536, LDS_END_B = PW + 8 * PWB;
constexpr int A_KP = 0, A_VS = 16384, A_BUF = 49152, A_WK = 2 * A_BUF, A_B = A_WK + 8192, A_U = A_B + 8192, A_M = A_U + 8192, A_CH = A_M + 8192, LDS_END_A = A_CH + 1024;
#define SW16(row, colB) ((row) * 256 + ((colB) ^ (((row) & 15) << 4)))
#define SBAR() __builtin_amdgcn_sched_barrier(0)
#define MBAR() do { asm volatile("s_waitcnt lgkmcnt(0)" ::: "memory"); __builtin_amdgcn_s_barrier(); asm volatile("" ::: "memory"); } while (0)
using att::crow; using att::cvtpk; using att::v_st; using att::v_rd_base; using att::tr_read;
__device__ __forceinline__ bf16x8 pk88(const s16x4 l, const s16x4 h) { return (bf16x8){l[0], l[1], l[2], l[3], h[0], h[1], h[2], h[3]}; }
__device__ __forceinline__ bf16x8 pack_acc8(const f32x16& x, int s8) { v4u w = {cvtpk(x[s8 + 0], x[s8 + 1]), cvtpk(x[s8 + 2], x[s8 + 3]), cvtpk(x[s8 + 4], x[s8 + 5]), cvtpk(x[s8 + 6], x[s8 + 7])}; return *reinterpret_cast<bf16x8*>(&w); }
__device__ __forceinline__ v4u wmul8(const v4u k, float w) { v4u o; o.x = cvtpk(bflo(k.x) * w, bfhi(k.x) * w); o.y = cvtpk(bflo(k.y) * w, bfhi(k.y) * w); o.z = cvtpk(bflo(k.z) * w, bfhi(k.z) * w); o.w = cvtpk(bflo(k.w) * w, bfhi(k.w) * w); return o; }
template <int CTRL, int ROWMASK> __device__ __forceinline__ float dppf(float old, float src) {
    return __builtin_bit_cast(float, __builtin_amdgcn_update_dpp(__builtin_bit_cast(int, old), __builtin_bit_cast(int, src), CTRL, ROWMASK, 0xf, false)); }
__device__ __forceinline__ float wave_sum_dpp(float v) {
    v += dppf<0xB1, 0xf>(0.f, v); v += dppf<0x4E, 0xf>(0.f, v); v += dppf<0x141, 0xf>(0.f, v); v += dppf<0x140, 0xf>(0.f, v);
    const int iv = __builtin_bit_cast(int, v);
    return (__builtin_bit_cast(float, __builtin_amdgcn_readlane(iv, 0)) + __builtin_bit_cast(float, __builtin_amdgcn_readlane(iv, 16))) +
           (__builtin_bit_cast(float, __builtin_amdgcn_readlane(iv, 32)) + __builtin_bit_cast(float, __builtin_amdgcn_readlane(iv, 48)));
}
__device__ __forceinline__ float scan_sum64(float x) {
    x += dppf<0x111, 0xf>(0.f, x); x += dppf<0x112, 0xf>(0.f, x); x += dppf<0x114, 0xf>(0.f, x); x += dppf<0x118, 0xf>(0.f, x);
    x += dppf<0x142, 0xa>(0.f, x); x += dppf<0x143, 0xc>(0.f, x); return x;
}
__device__ __forceinline__ float scan_max64(float x) {
    const float NI = -__builtin_inff();
    x = fmaxf(x, dppf<0x111, 0xf>(NI, x)); x = fmaxf(x, dppf<0x112, 0xf>(NI, x)); x = fmaxf(x, dppf<0x114, 0xf>(NI, x)); x = fmaxf(x, dppf<0x118, 0xf>(NI, x));
    x = fmaxf(x, dppf<0x142, 0xa>(NI, x)); x = fmaxf(x, dppf<0x143, 0xc>(NI, x)); return x;
}
template <int I> __device__ __forceinline__ void cupd(f32x16& Xi, int vbK, const bf16x8 (&vB)[4]) {
    const s16x4 l0 = tr_read<I * 512 + 0 * 4096>(vbK), h0 = tr_read<I * 512 + 0 * 4096 + 2048>(vbK), l1 = tr_read<I * 512 + 1 * 4096>(vbK), h1 = tr_read<I * 512 + 1 * 4096 + 2048>(vbK);
    const s16x4 l2 = tr_read<I * 512 + 2 * 4096>(vbK), h2 = tr_read<I * 512 + 2 * 4096 + 2048>(vbK), l3 = tr_read<I * 512 + 3 * 4096>(vbK), h3 = tr_read<I * 512 + 3 * 4096 + 2048>(vbK);
    asm volatile("s_waitcnt lgkmcnt(0)" ::: "memory"); SBAR();
    Xi = __builtin_amdgcn_mfma_f32_32x32x16_bf16(pk88(l0, h0), vB[0], Xi, 0, 0, 0);
    Xi = __builtin_amdgcn_mfma_f32_32x32x16_bf16(pk88(l1, h1), vB[1], Xi, 0, 0, 0);
    Xi = __builtin_amdgcn_mfma_f32_32x32x16_bf16(pk88(l2, h2), vB[2], Xi, 0, 0, 0);
    Xi = __builtin_amdgcn_mfma_f32_32x32x16_bf16(pk88(l3, h3), vB[3], Xi, 0, 0, 0);
}
template <int I> __device__ __forceinline__ void yinter(f32x16& acc, const LAS unsigned char* qrow, int swz, int hi, bf16x8 xb0, bf16x8 xb1) {
    const v2u a00 = *(const LAS v2u*)(qrow + (((I * 32 + 0) * 2) ^ swz) + 8 * hi), a01 = *(const LAS v2u*)(qrow + (((I * 32 + 8) * 2) ^ swz) + 8 * hi);
    const v2u a10 = *(const LAS v2u*)(qrow + (((I * 32 + 16) * 2) ^ swz) + 8 * hi), a11 = *(const LAS v2u*)(qrow + (((I * 32 + 24) * 2) ^ swz) + 8 * hi);
    v4u A0 = {a00.x, a00.y, a01.x, a01.y}, A1 = {a10.x, a10.y, a11.x, a11.y};
    acc = __builtin_amdgcn_mfma_f32_32x32x16_bf16(*reinterpret_cast<bf16x8*>(&A0), xb0, acc, 0, 0, 0);
    acc = __builtin_amdgcn_mfma_f32_32x32x16_bf16(*reinterpret_cast<bf16x8*>(&A1), xb1, acc, 0, 0, 0);
}
}
__device__ __forceinline__ void late_weights(Frame& F, int gw, int NGW) {
    LAS float* scr = (LAS float*)(F.lds + RING_OFF + F.wave * 16384);
    constexpr int I9 = 32 * 64, I10 = 32 * 256, I11 = 128 * 64;
    for (int it = gw; it < I9 + I10 + I11; it += NGW) { int r = it;
        if (r < I9) { tr_item(F.ml_w_out, DM, 0, DM, 64, DM, nullptr, 1.f, F.WmoT, scr, r, F.lane); continue; } r -= I9;
        if (r < I10) { tr_item(F.w_up + (size_t)DM * FF, FF, 0, FF, 256, DM, F.norm_ffn + DM, 1.f, F.WupT1, scr, r, F.lane); continue; } r -= I10;
        tr_item(F.w_dn + (size_t)FF * DM, DM, 0, DM, 64, FF, nullptr, 1.f, F.WdnT1, scr, r, F.lane); }
}
template <int mode> __device__ __forceinline__ void p9a_state(Frame& F) {
    using namespace ml;
    constexpr int NBH = BATCH * MH, NC = T / 64;
    if (F.vcu >= NBH) { if (F.G > NBH && mode != 1) late_weights(F, (F.vcu - NBH) * NWAVES + F.wave, (F.G - NBH) * NWAVES); return; }
    if (mode == 2) return;
    LAS unsigned char* L = F.lds + RING_OFF;
    static_assert(ml::LDS_END_A <= RING_BYTES, "mLSTM pass A LDS");
    const int bh = F.vcu, b = bh / MH, h = bh % MH, w = F.wave, tid = F.tid;
    const size_t mb = (size_t)b * T;
    LAS float* WKL = (LAS float*)(L + A_WK); LAS float* BL = (LAS float*)(L + A_B); LAS float* UL = (LAS float*)(L + A_U); LAS float* MLs = (LAS float*)(L + A_M);
    LAS float* CH = (LAS float*)(L + A_CH);
    const float* igp = F.IG + (size_t)bh * T; const float* lfp = F.LF + (size_t)bh * T;
#pragma unroll
    for (int cc = 0; cc < 4; ++cc) { const int c = 4 * w + cc, t = c * 64 + F.lane; const float ig = igp[t], lf = lfp[t];
        const float bb = scan_sum64(lf), u = ig - bb, Mx = scan_max64(u);
        BL[t] = bb; UL[t] = u; MLs[t] = Mx; if (F.lane == 63) { CH[c] = bb; CH[32 + c] = Mx; } }
    LDS_WAIT(); __syncthreads();
    if (tid == 0) { float m = 0.f; for (int c = 0; c < NC; ++c) { const float mm63 = fmaxf(m, CH[32 + c]); CH[64 + c] = m; CH[96 + c] = __expf(m - mm63); CH[128 + c] = mm63; m = CH[c] + mm63; } }
    LDS_WAIT(); __syncthreads();
    { float* scal = F.SCAL + (size_t)bh * 4 * T;
      for (int t = tid; t < T; t += NTHR) { const int c = t >> 6; const float mst = CH[64 + c], mm = fmaxf(mst, MLs[t]), u = UL[t];
          scal[t] = u; scal[T + t] = mm; scal[2 * T + t] = __expf(mst - mm); scal[3 * T + t] = __expf(-(BL[t] + mm)); WKL[t] = __expf(u - CH[128 + c]); } }
    LDS_WAIT(); __syncthreads();
    f32x16 X[4];
#pragma unroll
    for (int i = 0; i < 4; ++i)
#pragma unroll
        for (int r = 0; r < 16; ++r) X[i][r] = 0.f;
    float nreg = 0.f;
    struct KV { v4u k0, k1, v00, v01, v10, v11; }; KV S0, S1, S2;
    const int lbase = (int)(uintptr_t)L;
#define A_LOAD(cc, S) do { const bf16* rp0 = F.PROJ + (mb + (size_t)(cc) * 64 + sr) * ML_N + sc; const bf16* rp1 = rp0 + 32 * ML_N;                              \
        S.k0 = *(const GAS v4u*)(rp0 + C_MK + h * MDK); S.k1 = *(const GAS v4u*)(rp1 + C_MK + h * MDK);                                                       \
        S.v00 = *(const GAS v4u*)(rp0 + C_MV + h * MDV); S.v01 = *(const GAS v4u*)(rp0 + C_MV + h * MDV + 128); S.v10 = *(const GAS v4u*)(rp1 + C_MV + h * MDV); S.v11 = *(const GAS v4u*)(rp1 + C_MV + h * MDV + 128); } while (0)
#define A_WRITE(cc, S) do { LAS unsigned char* B_ = L + ((cc) & 1) * A_BUF; const float w0 = WKL[(cc) * 64 + sr], w1 = WKL[(cc) * 64 + 32 + sr];            \
        *(LAS v4u*)(B_ + A_KP + v_st(sr, sc)) = wmul8(S.k0, w0); *(LAS v4u*)(B_ + A_KP + v_st(32 + sr, sc)) = wmul8(S.k1, w1);                                \
        *(LAS v4u*)(B_ + A_VS + v_st(sr, sc)) = S.v00; *(LAS v4u*)(B_ + A_VS + 16384 + v_st(sr, sc)) = S.v01;                                                 \
        *(LAS v4u*)(B_ + A_VS + v_st(32 + sr, sc)) = S.v10; *(LAS v4u*)(B_ + A_VS + 16384 + v_st(32 + sr, sc)) = S.v11; } while (0)
    { const int sr = tid >> 4, sc = (tid & 15) * 8; A_LOAD(0, S0); A_WRITE(0, S0); A_LOAD(1, S1); A_LOAD(2, S2); A_LOAD(3, S0); }
    LDS_WAIT(); __syncthreads();
#define A_ITER(cc, SN) do { if ((cc) < NC) {                                                                                                                  \
        int lane_o = F.lane, tid_o = F.tid; asm volatile("" : "+v"(lane_o), "+v"(tid_o));           \
        const int lane = lane_o, sr = tid_o >> 4, sc = (tid_o & 15) * 8;                                                                                         \
        { bf16* st = F.ST + ((((size_t)bh * NC + (cc)) * 8 + w) * 8) * 512 + lane * 8;                                                                           \
          _Pragma("unroll") for (int i = 0; i < 4; ++i) { *(GAS bf16x8*)(st + (i * 2 + 0) * 512) = pack_acc8(X[i], 0); *(GAS bf16x8*)(st + (i * 2 + 1) * 512) = pack_acc8(X[i], 8); } \
          if (w == 4 || w == 5) F.NST[((size_t)bh * NC + (cc)) * 128 + (w - 4) * 64 + lane] = nreg; }                                                            \
        if ((cc) < NC - 1) {                                                                                                                                     \
        const int boff = ((cc) & 1) * A_BUF; const float s_old = CH[96 + (cc)];                                                                                  \
        const int vbK = lbase + boff + A_KP + v_rd_base(lane), vbV = lbase + boff + A_VS + (w >> 2) * 16384 + (w & 3) * 512 + v_rd_base(lane);                   \
        bf16x8 vB[4];                                                                                                                                            \
        { const s16x4 l0 = tr_read<0 * 4096>(vbV), h0 = tr_read<0 * 4096 + 2048>(vbV), l1 = tr_read<1 * 4096>(vbV), h1 = tr_read<1 * 4096 + 2048>(vbV);          \
          const s16x4 l2 = tr_read<2 * 4096>(vbV), h2 = tr_read<2 * 4096 + 2048>(vbV), l3 = tr_read<3 * 4096>(vbV), h3 = tr_read<3 * 4096 + 2048>(vbV);          \
          asm volatile("s_waitcnt lgkmcnt(0)" ::: "memory"); SBAR();                                                                                             \
          vB[0] = pk88(l0, h0); vB[1] = pk88(l1, h1); vB[2] = pk88(l2, h2); vB[3] = pk88(l3, h3); }                                                              \
        _Pragma("unroll") for (int i = 0; i < 4; ++i) _Pragma("unroll") for (int r = 0; r < 16; ++r) X[i][r] *= s_old;                                           \
        cupd<0>(X[0], vbK, vB); cupd<1>(X[1], vbK, vB); cupd<2>(X[2], vbK, vB); cupd<3>(X[3], vbK, vB);                                                          \
        if (w == 4 || w == 5) { const int d = (w - 4) * 64 + lane; float acc = 0.f; const LAS unsigned char* kcol = L + boff + A_KP + ((d >> 5) * 512 + (d & 31) * 2); \
            _Pragma("unroll 1") for (int s8 = 0; s8 < 8; ++s8) {                                                                                                  \
                _Pragma("unroll") for (int e = 0; e < 8; ++e) acc += bf2f(*(const LAS bf16*)(kcol + s8 * 2048 + e * 64)); }                                       \
            nreg = s_old * nreg + acc; }                                                                                                                         \
        if ((cc) + 1 < NC - 1) { A_WRITE((cc) + 1, SN); if ((cc) + 4 < NC - 1) A_LOAD((cc) + 4, SN); }                                                           \
        MBAR(); } } } while (0)
    for (int c = 0; c < NC; c += 3) { A_ITER(c, S1); A_ITER(c + 1, S2); A_ITER(c + 2, S0); }
#undef A_ITER
#undef A_LOAD
#undef A_WRITE
}
__device__ __forceinline__ void p9b_output(Frame& F) {
    using namespace ml;
    constexpr int NC = T / 64, NITEMS = BATCH * MH * NC;
    LAS unsigned char* L = F.lds + RING_OFF;
    static_assert(ml::LDS_END_B <= RING_BYTES, "mLSTM pass B LDS");
    const int w = F.wave, tid = F.tid;
    LAS float* misc = (LAS float*)(L + MISC); LAS float* RSA = misc, * RSB = misc + 64, * QN = misc + 128;
    LAS float* pw = (LAS float*)(L + PW + w * PWB);
    const int lbase = (int)(uintptr_t)L;
    if (tid < 64) RSB[tid] = 0.f;
    f32x4 hg; { const float* gp = F.h_gain + 4 * F.lane; hg = (f32x4){gp[0], gp[1], gp[2], gp[3]}; }
    v4u sq0, sq1, sk0, sk1, sv00, sv01, sv10, sv11; float s_u, s_mm, s_sint, s_nrm; f32x2 s_n;
    LAS float* NBl = misc + 192;
#define B_LOAD(it_) do { const int bh_ = (it_) & 31, c_ = (it_) >> 5, b_ = bh_ / MH, h_ = bh_ % MH;                                                         \
        const bf16* rp0 = F.PROJ + ((size_t)b_ * T + (size_t)c_ * 64 + sr) * ML_N + sc; const bf16* rp1 = rp0 + 32 * ML_N;                                      \
        sq0 = *(const GAS v4u*)(rp0 + C_MQ + h_ * MDK); sq1 = *(const GAS v4u*)(rp1 + C_MQ + h_ * MDK); sk0 = *(const GAS v4u*)(rp0 + C_MK + h_ * MDK); sk1 = *(const GAS v4u*)(rp1 + C_MK + h_ * MDK);   \
        sv00 = *(const GAS v4u*)(rp0 + C_MV + h_ * MDV); sv01 = *(const GAS v4u*)(rp0 + C_MV + h_ * MDV + 128); sv10 = *(const GAS v4u*)(rp1 + C_MV + h_ * MDV); sv11 = *(const GAS v4u*)(rp1 + C_MV + h_ * MDV + 128); \
        const float* sp_ = F.SCAL + (size_t)bh_ * 4 * T + c_ * 64 + lane; s_u = sp_[0]; s_mm = sp_[T]; s_sint = sp_[2 * T]; s_nrm = sp_[3 * T];                                                \
        s_n = *(const GAS f32x2*)(F.NST + ((size_t)bh_ * NC + c_) * 128 + 2 * lane); } while (0)
#define B_WRITE() do { pw[lane] = s_u; pw[64 + lane] = s_mm; if (w == 3) *(LAS f32x2*)(NBl + 2 * lane) = s_n;                                                                                            \
        *(LAS v4u*)(L + QS + SW16(sr, sc * 2)) = sq0; *(LAS v4u*)(L + QS + SW16(32 + sr, sc * 2)) = sq1;                                                \
        *(LAS v4u*)(L + KS + SW16(sr, sc * 2)) = sk0; *(LAS v4u*)(L + KS + SW16(32 + sr, sc * 2)) = sk1;                                                \
        *(LAS v4u*)(L + VS + v_st(sr, sc)) = sv00; *(LAS v4u*)(L + VS + 16384 + v_st(sr, sc)) = sv01;                                                   \
        *(LAS v4u*)(L + VS + v_st(32 + sr, sc)) = sv10; *(LAS v4u*)(L + VS + 16384 + v_st(32 + sr, sc)) = sv11; } while (0)
    int it = F.vcu; if (it >= NITEMS) return;
    float c_sint, c_nrm;
    { const int lane = F.lane, sr = tid >> 4, sc = (tid & 15) * 8; B_LOAD(it); B_WRITE(); c_sint = s_sint; c_nrm = s_nrm; if (it + F.G < NITEMS) B_LOAD(it + F.G); }
    LDS_WAIT(); __syncthreads();
    for (; it < NITEMS; it += F.G) {
        const int bh = it & 31, c = it >> 5, b = bh / MH, h = bh % MH, t0 = c * 64; const size_t mb = (size_t)b * T;
        int lane_o = F.lane, tid_o = F.tid; asm volatile("" : "+v"(lane_o), "+v"(tid_o));
        const int lane = lane_o, r32 = lane & 31, hi = lane >> 5, sr = tid_o >> 4, sc = (tid_o & 15) * 8;
        const int vbV = lbase + VS + (w >> 2) * 16384 + (w & 3) * 512 + v_rd_base(lane);
        bf16x8 xb[4][2];
        { const bf16* st = F.ST + ((((size_t)bh * NC + c) * 8 + w) * 8) * 512 + lane * 8;
#pragma unroll
          for (int i = 0; i < 4; ++i) { xb[i][0] = __builtin_nontemporal_load((const GAS bf16x8*)(st + (i * 2 + 0) * 512)); xb[i][1] = __builtin_nontemporal_load((const GAS bf16x8*)(st + (i * 2 + 1) * 512)); } }
        if (w < 3) { const int lt = w ? 1 : 0, st = w == 2 ? 1 : 0; const int srow = r32 + 32 * st, lrow = r32 + 32 * lt;
            f32x16 p;
#pragma unroll
            for (int r = 0; r < 16; ++r) p[r] = 0.f;
#pragma unroll
            for (int kk = 0; kk < 8; ++kk) { const bf16x8 ka = *(const LAS bf16x8*)(L + KS + SW16(srow, (16 * kk + 8 * hi) * 2)), qb = *(const LAS bf16x8*)(L + QS + SW16(lrow, (16 * kk + 8 * hi) * 2));
                p = __builtin_amdgcn_mfma_f32_32x32x16_bf16(ka, qb, p, 0, 0, 0); }
            const float mml = pw[64 + lrow]; float ps = 0.f;
#pragma unroll
            for (int r = 0; r < 16; ++r) { const int s = crow(r, hi) + 32 * st; const float us = pw[s]; const float wgt = (s <= lrow) ? __expf(us - mml) : 0.f; p[r] *= wgt; ps += p[r]; }
            { auto rr = __builtin_amdgcn_permlane32_swap(__float_as_uint(ps), __float_as_uint(ps), false, false); ps = __uint_as_float(rr[0]) + __uint_as_float(rr[1]); }
            if (hi == 0) { if (st == 0) RSA[lrow] = ps; else RSB[lrow] = ps; }
            bf16x8 pa0, pa1;
#define PK4(P, BASE, OUT) do { unsigned a0 = cvtpk(P[BASE + 0], P[BASE + 1]), a1 = cvtpk(P[BASE + 2], P[BASE + 3]);   \
    unsigned b0 = cvtpk(P[BASE + 4], P[BASE + 5]), b1 = cvtpk(P[BASE + 6], P[BASE + 7]);                              \
    auto r0 = __builtin_amdgcn_permlane32_swap(a0, b0, false, false); auto r1 = __builtin_amdgcn_permlane32_swap(a1, b1, false, false); \
    v4u w_ = {r0[0], r1[0], r0[1], r1[1]}; OUT = *reinterpret_cast<bf16x8*>(&w_); } while (0)
            PK4(p, 0, pa0); PK4(p, 8, pa1);
#undef PK4
            *(LAS bf16x8*)(L + PF + (lt * 4 + 2 * st + 0) * 1024 + lane * 16) = pa0; *(LAS bf16x8*)(L + PF + (lt * 4 + 2 * st + 1) * 1024 + lane * 16) = pa1;
        } else if (w == 3) { const LAS float* nb = NBl; float acc = 0.f;
#pragma unroll 2
            for (int ch = 0; ch < 16; ++ch) { const v4u qv = *(const LAS v4u*)(L + QS + SW16(lane, ch * 16)); const f32x4 n0 = *(const LAS f32x4*)(nb + 8 * ch), n1 = *(const LAS f32x4*)(nb + 8 * ch + 4);
                acc += bflo(qv.x) * n0.x + bfhi(qv.x) * n0.y + bflo(qv.y) * n0.z + bfhi(qv.y) * n0.w + bflo(qv.z) * n1.x + bfhi(qv.z) * n1.y + bflo(qv.w) * n1.z + bfhi(qv.w) * n1.w; }
            QN[lane] = acc;
        }
        MBAR();
        { const float den = RSA[lane] + RSB[lane] + c_sint * QN[lane]; const float rinv = 1.f / fmaxf(fabsf(den), c_nrm); pw[192 + lane] = rinv; pw[256 + lane] = c_sint * rinv; }
        bf16x8 vB[4];
        { const s16x4 l0 = tr_read<0 * 4096>(vbV), h0 = tr_read<0 * 4096 + 2048>(vbV), l1 = tr_read<1 * 4096>(vbV), h1 = tr_read<1 * 4096 + 2048>(vbV);
          const s16x4 l2 = tr_read<2 * 4096>(vbV), h2 = tr_read<2 * 4096 + 2048>(vbV), l3 = tr_read<3 * 4096>(vbV), h3 = tr_read<3 * 4096 + 2048>(vbV);
          asm volatile("s_waitcnt lgkmcnt(0)" ::: "memory"); SBAR();
          vB[0] = pk88(l0, h0); vB[1] = pk88(l1, h1); vB[2] = pk88(l2, h2); vB[3] = pk88(l3, h3); }
        f32x16 aI0, aI1;
#pragma unroll
        for (int r = 0; r < 16; ++r) { aI0[r] = 0.f; aI1[r] = 0.f; }
        { const LAS unsigned char* qrow0 = L + QS + r32 * 256; const LAS unsigned char* qrow1 = qrow0 + 32 * 256; const int swz = (r32 & 15) << 4;
#define YI(I) do { yinter<I>(aI0, qrow0, swz, hi, xb[I][0], xb[I][1]); yinter<I>(aI1, qrow1, swz, hi, xb[I][0], xb[I][1]); } while (0)
          YI(0); YI(1); YI(2); YI(3);
#undef YI
        }
        v2u og[8];
#pragma unroll
        for (int e = 0; e < 8; ++e) og[e] = *(const GAS v2u*)(F.PROJ + (mb + t0 + 8 * w + e) * ML_N + C_MO + h * MDV + 4 * lane);
#pragma unroll
        for (int lt = 0; lt < 2; ++lt) { f32x16 aY;
#pragma unroll
            for (int r = 0; r < 16; ++r) aY[r] = 0.f;
            { const bf16x8 p0 = *(const LAS bf16x8*)(L + PF + (lt * 4 + 0) * 1024 + lane * 16), p1 = *(const LAS bf16x8*)(L + PF + (lt * 4 + 1) * 1024 + lane * 16);
              aY = __builtin_amdgcn_mfma_f32_32x32x16_bf16(p0, vB[0], aY, 0, 0, 0); aY = __builtin_amdgcn_mfma_f32_32x32x16_bf16(p1, vB[1], aY, 0, 0, 0); }
            if (lt == 1) { const bf16x8 p2 = *(const LAS bf16x8*)(L + PF + (4 + 2) * 1024 + lane * 16), p3 = *(const LAS bf16x8*)(L + PF + (4 + 3) * 1024 + lane * 16);
              aY = __builtin_amdgcn_mfma_f32_32x32x16_bf16(p2, vB[2], aY, 0, 0, 0); aY = __builtin_amdgcn_mfma_f32_32x32x16_bf16(p3, vB[3], aY, 0, 0, 0); }
#pragma unroll
            for (int r = 0; r < 16; ++r) { const int l = crow(r, hi) + 32 * lt; const float y = aY[r] * pw[192 + l] + (lt ? aI1[r] : aI0[r]) * pw[256 + l];
                *(LAS bf16*)(L + HS + l * HROW + (32 * w + r32) * 2) = (bf16)f2bf(y); }
        }
        MBAR();
#pragma unroll
        for (int e = 0; e < 8; ++e) { const int l = 8 * w + e; const v2u hv = *(const LAS v2u*)(L + HS + l * HROW + lane * 8);
            const float h0 = bflo(hv.x), h1 = bfhi(hv.x), h2 = bflo(hv.y), h3 = bfhi(hv.y);
            const float ss = wave_sum_dpp((h0 * h0 + h1 * h1) + (h2 * h2 + h3 * h3)); const float rn = __builtin_amdgcn_rsqf(ss * (1.f / MDV) + EPS);
            const float o0 = bflo(og[e].x), o1 = bfhi(og[e].x), o2 = bflo(og[e].y), o3 = bfhi(og[e].y);
            const float y0 = h0 * rn * hg.x / (1.f + __expf(-o0)), y1 = h1 * rn * hg.y / (1.f + __expf(-o1)), y2 = h2 * rn * hg.z / (1.f + __expf(-o2)), y3 = h3 * rn * hg.w / (1.f + __expf(-o3));
            v2u ov; ov.x = cvtpk(y0, y1); ov.y = cvtpk(y2, y3);
            *(GAS v2u*)(F.O + (mb + t0 + l) * DM + h * MDV + 4 * lane) = ov; }
        if (it + F.G < NITEMS) { B_WRITE(); c_sint = s_sint; c_nrm = s_nrm; if (it + 2 * F.G < NITEMS) B_LOAD(it + 2 * F.G); }
        MBAR();
    }
#undef B_LOAD
#undef B_WRITE
}
#undef SW16
#undef SBAR
#undef MBAR
namespace mlh {
constexpr int WREG = 12288, KIMG = 0, VIMG = 8192, XB0 = 8 * WREG, XBSZ = 16384 + 1024, WKO = XB0 + 2 * XBSZ, CHO = WKO + 8192, FLAGO = CHO + 1024, LDS_END = FLAGO + 64;
constexpr int TB = 0, TU = 8192, TM = 16384;
__device__ __forceinline__ int kh_st(int k, int c) { const int kk = (k & ~0xC) | ((k & 4) << 1) | ((k & 8) >> 1); return ((kk >> 3) * 2 + (c >> 5)) * 512 + ((kk & 7) * 32 + (c & 31)) * 2; }
__device__ __forceinline__ int vs_st(int k, int c) { const int kk = (k & ~0xC) | ((k & 4) << 1) | ((k & 8) >> 1); return (kk >> 3) * 512 + ((kk & 7) * 32 + c) * 2; }
using att::tr_read; using att::v_rd_base; using att::cvtpk; using ml::pk88; using ml::pack_acc8; using ml::wmul8; using ml::scan_sum64; using ml::scan_max64;
template <bool WITHN> __device__ __forceinline__ void dhalf(f32x16& D0, f32x16& D1, float& n0, float& n1, int vbK, const bf16x8 (&vB)[4]) {
    const bf16x8 ones = (bf16x8){0x3f80, 0x3f80, 0x3f80, 0x3f80, 0x3f80, 0x3f80, 0x3f80, 0x3f80};
    f32x16 N0, N1;
    if (WITHN) {
#pragma unroll
        for (int r = 0; r < 16; ++r) { N0[r] = 0.f; N1[r] = 0.f; } }
#define DH_STEP(KS) do { const s16x4 l0 = tr_read<0 * 512 + KS * 2048>(vbK), h0 = tr_read<0 * 512 + KS * 2048 + 1024>(vbK), l1 = tr_read<1 * 512 + KS * 2048>(vbK), h1 = tr_read<1 * 512 + KS * 2048 + 1024>(vbK); \
        asm volatile("s_waitcnt lgkmcnt(0)" ::: "memory"); __builtin_amdgcn_sched_barrier(0);                                                                           \
        const bf16x8 a0 = pk88(l0, h0), a1 = pk88(l1, h1);                                                                                                               \
        D0 = __builtin_amdgcn_mfma_f32_32x32x16_bf16(a0, vB[KS], D0, 0, 0, 0); D1 = __builtin_amdgcn_mfma_f32_32x32x16_bf16(a1, vB[KS], D1, 0, 0, 0);                      \
        if (WITHN) { N0 = __builtin_amdgcn_mfma_f32_32x32x16_bf16(ones, a0, N0, 0, 0, 0); N1 = __builtin_amdgcn_mfma_f32_32x32x16_bf16(ones, a1, N1, 0, 0, 0); } } while (0)
    DH_STEP(0); DH_STEP(1); DH_STEP(2); DH_STEP(3);
#undef DH_STEP
    if (WITHN) { n0 = N0[0]; n1 = N1[0]; }
}
}
template <bool WITHN> __device__ __forceinline__ void p10_chain(Frame& F, int bh, int js) {
    using namespace mlh;
    constexpr int NC = T / 64;
    LAS unsigned char* L = F.lds + RING_OFF;
    const int b = bh / MH, h = bh % MH, w = F.wave, lane = F.lane;
    const size_t mb = (size_t)b * T;
    LAS unsigned char* R = L + w * WREG;
    const LAS float* WKL = (const LAS float*)(L + WKO); const LAS float* CH = (const LAS float*)(L + CHO);
    volatile LAS unsigned* flag = (volatile LAS unsigned*)(L + FLAGO);
    const int lbase = (int)(uintptr_t)R;
    const int vbK = lbase + KIMG + v_rd_base(lane), vbV = lbase + VIMG + v_rd_base(lane);
    v4u ka[8], va[4];
    const int krow = lane >> 3, kc16 = lane & 7, vrow = lane >> 2, vc16 = lane & 3;
#define H_LOADK(cc, hh) do { const bf16* kp = F.PROJ + (mb + (size_t)(cc) * 64 + krow) * ML_N + C_MK + h * MDK + (hh) * 64 + 8 * kc16;                      \
        _Pragma("unroll") for (int e = 0; e < 8; ++e) ka[e] = *(const GAS v4u*)(kp + (size_t)(8 * e) * ML_N); } while (0)
#define H_LOADV(cc) do { const bf16* vp = F.PROJ + (mb + (size_t)(cc) * 64 + vrow) * ML_N + C_MV + h * MDV + js * 32 + 8 * vc16;                           \
        _Pragma("unroll") for (int e = 0; e < 4; ++e) va[e] = *(const GAS v4u*)(vp + (size_t)(16 * e) * ML_N); } while (0)
#define H_WRITEK(cc) do { _Pragma("unroll") for (int e = 0; e < 8; ++e) { const int s = 8 * e + krow; *(LAS v4u*)(R + KIMG + kh_st(s, 8 * kc16)) = wmul8(ka[e], WKL[(cc) * 64 + s]); } } while (0)
#define H_WRITEV() do { _Pragma("unroll") for (int e = 0; e < 4; ++e) { const int s = 16 * e + vrow; *(LAS v4u*)(R + VIMG + vs_st(s, 8 * vc16)) = va[e]; } } while (0)
    f32x16 D[4]; float dn[4] = {0.f, 0.f, 0.f, 0.f};
    if (w < NC - 1) { H_LOADK(w, 0); H_LOADV(w); }
#pragma unroll 1
    for (int r = 0; r < NC / 8; ++r) { const int c = w + 8 * r;
        if (c < NC - 1) {
#pragma unroll
            for (int i = 0; i < 4; ++i)
#pragma unroll
                for (int q = 0; q < 16; ++q) D[i][q] = 0.f;
            H_WRITEK(c); H_WRITEV(); H_LOADK(c, 1);
            bf16x8 vB[4];
            { const s16x4 l0 = tr_read<0 * 1024>(vbV), h0 = tr_read<0 * 1024 + 512>(vbV), l1 = tr_read<1 * 1024>(vbV), h1 = tr_read<1 * 1024 + 512>(vbV);
              const s16x4 l2 = tr_read<2 * 1024>(vbV), h2 = tr_read<2 * 1024 + 512>(vbV), l3 = tr_read<3 * 1024>(vbV), h3 = tr_read<3 * 1024 + 512>(vbV);
              asm volatile("s_waitcnt lgkmcnt(0)" ::: "memory"); __builtin_amdgcn_sched_barrier(0);
              vB[0] = pk88(l0, h0); vB[1] = pk88(l1, h1); vB[2] = pk88(l2, h2); vB[3] = pk88(l3, h3); }
            dhalf<WITHN>(D[0], D[1], dn[0], dn[1], vbK, vB);
            H_WRITEK(c);
            if (c + 8 < NC - 1) { H_LOADK(c + 8, 0); }
            dhalf<WITHN>(D[2], D[3], dn[2], dn[3], vbK, vB);
            if (c + 8 < NC - 1) { H_LOADV(c + 8); }
        }
        f32x16 X[4]; float nn[4] = {0.f, 0.f, 0.f, 0.f};
        if (c > 0) { while (*flag < (unsigned)c) __builtin_amdgcn_s_sleep(1);
            asm volatile("" ::: "memory");
            const LAS unsigned char* xb = L + XB0 + (c & 1) * XBSZ;
#pragma unroll
            for (int i = 0; i < 4; ++i)
#pragma unroll
                for (int q = 0; q < 4; ++q) { const f32x4 v = *(const LAS f32x4*)(xb + ((i * 4 + q) * 64 + lane) * 16); X[i][4 * q] = v.x; X[i][4 * q + 1] = v.y; X[i][4 * q + 2] = v.z; X[i][4 * q + 3] = v.w; }
            if (WITHN) {
#pragma unroll
                for (int i = 0; i < 4; ++i) nn[i] = *(const LAS float*)(xb + 16384 + (i * 32 + (lane & 31)) * 4); }
        } else {
#pragma unroll
            for (int i = 0; i < 4; ++i)
#pragma unroll
                for (int q = 0; q < 16; ++q) X[i][q] = 0.f;
        }
        { bf16* st = F.ST + ((((size_t)bh * NC + c) * 8 + js) * 8) * 512 + lane * 8;
#pragma unroll
          for (int i = 0; i < 4; ++i) { *(GAS bf16x8*)(st + (i * 2 + 0) * 512) = pack_acc8(X[i], 0); *(GAS bf16x8*)(st + (i * 2 + 1) * 512) = pack_acc8(X[i], 8); }
          if (WITHN && lane < 32) {
#pragma unroll
              for (int i = 0; i < 4; ++i) F.NST[((size_t)bh * NC + c) * 128 + i * 32 + lane] = nn[i]; } }
        if (c < NC - 1) { const float s_old = CH[96 + c]; LAS unsigned char* xo = L + XB0 + ((c + 1) & 1) * XBSZ;
#pragma unroll
            for (int i = 0; i < 4; ++i)
#pragma unroll
                for (int q = 0; q < 4; ++q) { f32x4 v; v.x = s_old * X[i][4 * q] + D[i][4 * q]; v.y = s_old * X[i][4 * q + 1] + D[i][4 * q + 1]; v.z = s_old * X[i][4 * q + 2] + D[i][4 * q + 2]; v.w = s_old * X[i][4 * q + 3] + D[i][4 * q + 3];
                    *(LAS f32x4*)(xo + ((i * 4 + q) * 64 + lane) * 16) = v; }
            if (WITHN && lane < 32) {
#pragma unroll
                for (int i = 0; i < 4; ++i) *(LAS float*)(xo + 16384 + (i * 32 + lane) * 4) = s_old * nn[i] + dn[i]; }
            asm volatile("s_waitcnt lgkmcnt(0)" ::: "memory");
            if (lane == 0) *flag = (unsigned)(c + 1);
        }
    }
#undef H_LOADK
#undef H_LOADV
#undef H_WRITEK
#undef H_WRITEV
}
__device__ __forceinline__ void p10_state_chain(Frame& F) {
    using namespace mlh;
    constexpr int NC = T / 64;
    static_assert(mlh::LDS_END <= RING_BYTES, "mLSTM chain LDS");
    LAS unsigned char* L = F.lds + RING_OFF;
    for (int it = F.vcu; it < BATCH * MH * 8; it += F.G) { const int bh = it >> 3, js = it & 7, w = F.wave, tid = F.tid;
        LAS float* WKL = (LAS float*)(L + WKO); LAS float* BL = (LAS float*)(L + TB); LAS float* UL = (LAS float*)(L + TU); LAS float* MLs = (LAS float*)(L + TM); LAS float* CH = (LAS float*)(L + CHO);
        const float* igp = F.IG + (size_t)bh * T; const float* lfp = F.LF + (size_t)bh * T;
        if (tid == 0) *(LAS unsigned*)(L + FLAGO) = 0u;
#pragma unroll
        for (int cc = 0; cc < 4; ++cc) { const int c = 4 * w + cc, t = c * 64 + F.lane; const float ig = igp[t], lf = lfp[t];
            const float bb = scan_sum64(lf), u = ig - bb, Mx = scan_max64(u);
            BL[t] = bb; UL[t] = u; MLs[t] = Mx; if (F.lane == 63) { CH[c] = bb; CH[32 + c] = Mx; } }
        LDS_WAIT(); __syncthreads();
        if (tid == 0) { float m = 0.f; for (int c = 0; c < NC; ++c) { const float mm63 = fmaxf(m, CH[32 + c]); CH[64 + c] = m; CH[96 + c] = __expf(m - mm63); CH[128 + c] = mm63; m = CH[c] + mm63; } }
        LDS_WAIT(); __syncthreads();
        { float* scal = F.SCAL + (size_t)bh * 4 * T;
          for (int t = tid; t < T; t += NTHR) { const int c = t >> 6; const float mst = CH[64 + c], mm = fmaxf(mst, MLs[t]), u = UL[t];
              if (js == 0) { scal[t] = u; scal[T + t] = mm; scal[2 * T + t] = __expf(mst - mm); scal[3 * T + t] = __expf(-(BL[t] + mm)); }
              WKL[t] = __expf(u - CH[128 + c]); } }
        LDS_WAIT(); __syncthreads();
        if (js == 0) p10_chain<true>(F, bh, js); else p10_chain<false>(F, bh, js);
        LDS_WAIT(); __syncthreads();
    }
}
#if ORA_IDX
__global__ __launch_bounds__(256) void ora_indexer(const bf16* QI, const bf16* KI, const float* WI, u64* MASK) {
    __shared__ float qi[1024]; __shared__ float sc[2048]; __shared__ float wi[16]; __shared__ unsigned cnt;
    const int m = blockIdx.x, b = m / T, t = m % T, tid = threadIdx.x;
    for (int i = tid; i < 1024; i += 256) qi[i] = bf2f(QI[(size_t)m * 1024 + i]);
    if (tid < 16) wi[tid] = WI[(size_t)m * 16 + tid];
    __syncthreads();
    for (int s = tid; s < T; s += 256) { float v = -__builtin_inff();
        if (s <= t) { float kk[64]; const v4u* kp = (const v4u*)(KI + (size_t)(b * T + s) * 64);
#pragma unroll
            for (int j = 0; j < 8; ++j) unpack8(kp[j], kk + 8 * j);
            v = 0.f;
            for (int h = 0; h < 16; ++h) { float d = 0.f;
#pragma unroll
                for (int e = 0; e < 64; ++e) d += qi[h * 64 + e] * kk[e];
                v += wi[h] * fmaxf(d, 0.f); } }
        sc[s] = v; }
    __syncthreads();
    unsigned k[8];
#pragma unroll
    for (int j = 0; j < 8; ++j) k[j] = fkey(sc[tid + 256 * j]);
    unsigned P = 0;
    for (int bit = 31; bit >= 0; --bit) { const unsigned cand = P | (1u << bit); unsigned c = 0;
#pragma unroll
        for (int j = 0; j < 8; ++j) c += (k[j] >= cand) ? 1u : 0u;
        if (tid == 0) cnt = 0; __syncthreads(); atomicAdd(&cnt, c); __syncthreads(); if (cnt >= (unsigned)TOPK) P = cand; __syncthreads(); }
    if (tid < 32) { u64 w = 0; for (int e = 0; e < 64; ++e) { const int s = 64 * tid + e; if (s <= t && fkey(sc[s]) >= P) w |= (1ull << e); } MASK[(size_t)m * 32 + tid] = w; }
}
#endif
#if ORA_ATT
__global__ __launch_bounds__(128) void ora_attn(const bf16* Q, const bf16* K, const bf16* V, const u64* MASK, bf16* O) {
    __shared__ float q[4][128]; __shared__ int idx[320]; __shared__ float p[4][320]; __shared__ int cnts[128]; __shared__ int total; __shared__ float linv[4];
    const int m = blockIdx.x >> 2, g = blockIdx.x & 3, b = m / T, tid = threadIdx.x;
    for (int r = 0; r < 4; ++r) q[r][tid] = bf2f(Q[(size_t)m * DM + (g * 4 + r) * HD + tid]);
    const unsigned bits = (unsigned)(MASK[(size_t)m * 32 + (tid >> 2)] >> (16 * (tid & 3))) & 0xffffu;
    cnts[tid] = __builtin_popcount(bits); __syncthreads();
    if (tid == 0) { int a = 0; for (int i = 0; i < 128; ++i) { const int c = cnts[i]; cnts[i] = a; a += c; } total = a; }
    __syncthreads();
    { int o = cnts[tid]; for (int e = 0; e < 16; ++e) if ((bits >> e) & 1u) { if (o < 320) idx[o] = 16 * tid + e; ++o; } }
    __syncthreads();
    const int n = total < 320 ? total : 320;
    for (int j = tid; j < n; j += 128) { const bf16* kr = K + (size_t)(b * T + idx[j]) * 512 + g * HD; float d0 = 0, d1 = 0, d2 = 0, d3 = 0;
        for (int e = 0; e < 128; ++e) { const float kv = bf2f(kr[e]); d0 += q[0][e] * kv; d1 += q[1][e] * kv; d2 += q[2][e] * kv; d3 += q[3][e] * kv; }
        const float sc = 0.08838834764831845f; p[0][j] = d0 * sc; p[1][j] = d1 * sc; p[2][j] = d2 * sc; p[3][j] = d3 * sc; }
    __syncthreads();
    if (tid < 4) { float mx = -__builtin_inff(); for (int j = 0; j < n; ++j) mx = fmaxf(mx, p[tid][j]); float s = 0.f; for (int j = 0; j < n; ++j) { const float e = expf(p[tid][j] - mx); p[tid][j] = e; s += e; } linv[tid] = 1.f / s; }
    __syncthreads();
    float o0 = 0, o1 = 0, o2 = 0, o3 = 0;
    for (int j = 0; j < n; ++j) { const float v = bf2f(V[(size_t)(b * T + idx[j]) * 512 + g * HD + tid]); o0 += p[0][j] * v; o1 += p[1][j] * v; o2 += p[2][j] * v; o3 += p[3][j] * v; }
    bf16* op = O + (size_t)m * DM + g * 4 * HD + tid;
    op[0] = (bf16)f2bf(o0 * linv[0]); op[HD] = (bf16)f2bf(o1 * linv[1]); op[2 * HD] = (bf16)f2bf(o2 * linv[2]); op[3 * HD] = (bf16)f2bf(o3 * linv[3]);
}
#endif
#if ORA_ML
__global__ __launch_bounds__(256) void ora_mlstm(const bf16* PROJ, const float* IG, const float* LF, const float* hgain, bf16* A2) {
    __shared__ float qs[128], ks[128], pr[128], red[4];
    const int b = blockIdx.x / MH, h = blockIdx.x % MH, e = threadIdx.x;
    float C[128]; float nd = 0.f, mst = 0.f;
#pragma unroll
    for (int d = 0; d < 128; ++d) C[d] = 0.f;
    const float hg = hgain[e];
    for (int t = 0; t < T; ++t) { const size_t m = (size_t)b * T + t; const bf16* row = PROJ + m * ML_N;
        const float ig = IG[(size_t)(b * MH + h) * T + t], lf = LF[(size_t)(b * MH + h) * T + t];
        const float mn = fmaxf(lf + mst, ig), fo = expf(lf + mst - mn), io = expf(ig - mn);
        if (e < 128) { const float qv = bf2f(row[C_MQ + h * MDK + e]), kv = bf2f(row[C_MK + h * MDK + e]); nd = fo * nd + io * kv; qs[e] = qv; ks[e] = kv; pr[e] = qv * nd; }
        __syncthreads();
        const float v = bf2f(row[C_MV + h * MDV + e]); float num = 0.f, den = 0.f;
#pragma unroll
        for (int d = 0; d < 128; ++d) { C[d] = fo * C[d] + io * ks[d] * v; num += qs[d] * C[d]; den += pr[d]; }
        const float hv = num / fmaxf(fabsf(den), expf(-mn));
        float s2 = wave_sum(hv * hv); if ((e & 63) == 0) red[e >> 6] = s2;
        __syncthreads();
        const float ssq = (red[0] + red[1]) + (red[2] + red[3]); const float rn = __builtin_amdgcn_rsqf(ssq * (1.f / MDV) + EPS);
        const float og = bf2f(row[C_MO + h * MDV + e]); const float sg = 1.f / (1.f + expf(-og));
        A2[m * DM + h * MDV + e] = (bf16)f2bf(sg * hv * rn * hg);
        mst = mn;
        __syncthreads();
    }
}
#endif
__global__ void __launch_bounds__(NTHR, 2) mk_fwd(Args args) {
    extern __shared__ __attribute__((aligned(16))) unsigned char lds[];
    Frame F;
    F.lds = (LAS unsigned char*)lds;
    F.MISC = (volatile LAS unsigned*)(F.lds + MISC_OFF);
    F.tid = threadIdx.x; F.lane = F.tid & 63; F.wave = __builtin_amdgcn_readfirstlane(F.tid >> 6);
    F.G = gridDim.x; { const int bx = blockIdx.x; F.vcu = (F.G % 8 == 0) ? (bx % 8) * (F.G / 8) + bx / 8 : bx; }
    unsigned char* ws = args.ws;
    F.ctl = (gu32*)(ws + WS_CTL);
    F.x = args.in[0]; F.norm_mix = args.in[1]; F.norm_ffn = args.in[2]; F.att_w_in = args.in[3]; F.q_gain = args.in[4]; F.k_gain = args.in[5]; F.att_w_out = args.in[6];
    F.ml_w_in = args.in[7]; F.b_gate = args.in[8]; F.h_gain = args.in[9]; F.ml_w_out = args.in[10]; F.w_up = args.in[11]; F.w_dn = args.in[12]; F.out = args.out;
    F.WinT = (bf16*)(ws + WS_WIN); F.WsmT = (bf16*)(ws + WS_WSM); F.WoT = (bf16*)(ws + WS_WO); F.WmlT = (bf16*)(ws + WS_WML); F.WgT = (bf16*)(ws + WS_WG); F.WmoT = (bf16*)(ws + WS_WMO);
    F.WupT0 = (bf16*)(ws + WS_WUP0); F.WupT1 = (bf16*)(ws + WS_WUP1); F.WdnT0 = (bf16*)(ws + WS_WDN0); F.WdnT1 = (bf16*)(ws + WS_WDN1);
    F.XB = (bf16*)(ws + WS_XB); F.PROJ = (bf16*)(ws + WS_PROJ); F.Q = (bf16*)(ws + WS_Q); F.K = (bf16*)(ws + WS_K); F.V = (bf16*)(ws + WS_V); F.QI = (bf16*)(ws + WS_QI); F.KI = (bf16*)(ws + WS_KI);
    F.O = (bf16*)(ws + WS_O); F.H = (bf16*)(ws + WS_H); F.WI = (float*)(ws + WS_WI); F.IG = (float*)(ws + WS_GATE); F.LF = (float*)(ws + WS_GATE + 512 * 1024); F.SC = (float*)(ws + WS_SC); F.ST = (bf16*)(ws + WS_SC); F.NST = (float*)(ws + WS_ML); F.SCAL = (float*)(ws + WS_ML + MiB);
    F.ROPE_A = (f32x2*)(ws + WS_ROPE); F.ROPE_I = (f32x2*)(ws + WS_ROPE + 512 * 1024); F.MASK = (u64*)(ws + WS_MASK);
    F.ss0 = (float*)(ws + WS_CTL) + CW_SS; F.ss1 = F.ss0 + M; F.ss2 = F.ss1 + M; F.ss3 = F.ss2 + M;
    for (int u = F.tid; u < (LDS_BYTES - LDSCTL_OFF) / 4; u += NTHR) ((LAS unsigned*)(F.lds + LDSCTL_OFF))[u] = 0u;
    __syncthreads();
    XcdBarrier bar; bar.bar = (unsigned*)(F.ctl + CW_BAR); bar.x = 0; bar.st = nullptr;
    if (!MK_MULTI) bar = xcd_barrier_post((unsigned*)(F.ctl + CW_BAR), F.MISC + 8);
    const int lo = args.ph_lo, hi = args.ph_hi;
#ifdef ONLY_PHASE
#define IN(k) ((k) == ONLY_PHASE && lo <= (k) && (k) < hi)
#else
#define IN(k) (lo <= (k) && (k) < hi)
#endif
#define SEAM(k) do { if (IN(k) && IN((k) + 1)) xcd_barrier(bar); } while (0)
#ifndef PROBE_DBL
#define PROBE_DBL (-1)
#endif
#define REPS(k) for (int rep_ = (F.tid = opaque_tid(), F.lane = F.tid & 63, 0); rep_ < ((k) == PROBE_DBL ? 2 : 1); ++rep_, ((k) == PROBE_DBL && rep_ == 1 ? xcd_barrier(bar) : (void)0))
#define DUMMY(k) ((k) == PROBE_DBL && rep_ == 0)
    float* const dummy_out = (float*)(ws + WS_SC);
    if (IN(0)) REPS(0) { p0_prologue(F); } SEAM(0);
    if (IN(1)) REPS(1) { cvt_slot(F, cvt::E1, cvt::E3, true); pg8::Gemm g{F.XB, F.WinT, M, ATT_N, DM}; pg8::StaticOrder S; S.init(M, ATT_N, F.G, (int)blockIdx.x);
        pg8::EpiScale<0> E{F.PROJ, ATT_N, F.ss0, 1.f / DM, EPS};
        pg8::gemm_phase<pg8::EpiScale<0>, pg8::StaticOrder, PG8_ALIGN, PG8_SP2>(F.lds + RING_OFF, g, S, E);
        skinny_att(F);
#ifdef PROBE_SK
        xcd_barrier(bar); skinny_att(F);
#endif
        cvt_slot(F, cvt::E1, cvt::E3, false); } SEAM(1);
#if IDX_FUSED
    if (IN(3)) REPS(3) {
#if !ORA_IDX
        p3_fused(F);
#endif
    } SEAM(3);
#else
    if (IN(3)) REPS(3) {
#if !ORA_IDX
        p3a_scores(F);
#ifdef PROBE_P3ABL
        xcd_barrier(bar); p3a_scores<PROBE_P3ABL>(F);
#endif
#endif
    } SEAM(3);
    if (IN(4)) REPS(4) {
#if !ORA_IDX
        p3b_select(F);
#endif
    } SEAM(4);
#endif
#ifdef PROBE_BAR
    if (IN(5)) { for (int q = 0; q < 10; ++q) xcd_barrier(bar); }
#endif
    if (IN(5)) REPS(5) {
#if !ORA_ATT
        cvt_slot(F, cvt::E3, cvt::E4, true);
        p4_attention(F, (char*)lds + RING_OFF);
        cvt_slot(F, cvt::E3, cvt::E4, false);
#endif
    } SEAM(5);
    if (IN(6)) REPS(6) { cvt_slot(F, cvt::E4, cvt::E8, true); pg8::Gemm g{F.O, F.WoT, M, DM, DM}; pg8::StaticOrder S; S.init(M, DM, F.G, (int)blockIdx.x);
        pg8::EpiRes E{F.XB, DUMMY(6) ? (bf16*)dummy_out : F.XB, nullptr, DUMMY(6) ? F.ss0 + 4 * M : F.ss1, DM};
        pg8::gemm_phase<pg8::EpiRes, pg8::StaticOrder, PG8_ALIGN, PG8_SP2>(F.lds + RING_OFF, g, S, E); cvt_slot(F, cvt::E4, cvt::E8, false); } SEAM(6);
#ifdef PROBE_NULLEPI
    if (IN(PROBE_NULLEPI)) { xcd_barrier(bar);
#ifndef PROBE_NULLK
#define PROBE_NULLK DM
#endif
        if (PROBE_NULLEPI == 7) { pg8::Gemm g{F.XB, F.WupT0, M, FF, PROBE_NULLK}; pg8::StaticOrder S; S.init(M, FF, F.G, (int)blockIdx.x); pg8::EpiNull E{}; pg8::gemm_phase<pg8::EpiNull, pg8::StaticOrder, PG8_ALIGN, PG8_SP2>(F.lds + RING_OFF, g, S, E); }
        if (PROBE_NULLEPI == 8) { pg8::Gemm g{F.H, F.WdnT0, M, DM, FF}; pg8::StaticOrder S; S.init(M, DM, F.G, (int)blockIdx.x); pg8::EpiNull E{}; pg8::gemm_phase<pg8::EpiNull, pg8::StaticOrder, PG8_ALIGN, PG8_SP2>(F.lds + RING_OFF, g, S, E); }
        xcd_barrier(bar); }
#endif
    if (IN(7)) REPS(7) { cvt_slot(F, cvt::E8, cvt::E10, true); pg8::Gemm g{F.XB, F.WupT0, M, FF, DM}; pg8::StaticOrder S; S.init(M, FF, F.G, (int)blockIdx.x);
        pg8::EpiScale<1> E{F.H, FF, F.ss1, 1.f / DM, EPS};
        pg8::gemm_phase<pg8::EpiScale<1>, pg8::StaticOrder, PG8_ALIGN, PG8_SP2>(F.lds + RING_OFF, g, S, E); cvt_slot(F, cvt::E8, cvt::E10, false); } SEAM(7);
    if (IN(8)) REPS(8) { cvt_slot(F, cvt::E10, cvt::E11, true); pg8::Gemm g{F.H, F.WdnT0, M, DM, FF}; pg8::StaticOrder S; S.init(M, DM, F.G, (int)blockIdx.x);
        pg8::EpiRes E{F.XB, DUMMY(8) ? (bf16*)dummy_out : F.XB, nullptr, DUMMY(8) ? F.ss0 + 4 * M : F.ss2, DM};
        pg8::gemm_phase<pg8::EpiRes, pg8::StaticOrder, PG8_ALIGN, PG8_SP2>(F.lds + RING_OFF, g, S, E); cvt_slot(F, cvt::E10, cvt::E11, false); } SEAM(8);
    if (IN(9)) REPS(9) { pg8::Gemm g{F.XB, F.WmlT, M, ML_N, DM}; pg8::StaticOrder S; S.init(M, ML_N, F.G, (int)blockIdx.x);
        pg8::EpiScale<0> E{F.PROJ, ML_N, F.ss2, 1.f / DM, EPS};
        pg8::gemm_phase<pg8::EpiScale<0>, pg8::StaticOrder, PG8_ALIGN, PG8_SP2>(F.lds + RING_OFF, g, S, E);
        skinny_gates(F); } SEAM(9);
    if (IN(10)) REPS(10) {
#if !ORA_ML
#if ML_CHAIN
        p10_state_chain(F);
#else
        p9a_state<0>(F);
#endif
#ifdef PROBE_SUB
        xcd_barrier(bar); p9a_state<PROBE_SUB>(F);
#endif
#endif
    } SEAM(10);
    if (IN(11)) REPS(11) {
#if !ORA_ML
        p9b_output(F);
#endif
    } SEAM(11);
    if (IN(12)) REPS(12) { pg8::Gemm g{F.O, F.WmoT, M, DM, DM}; pg8::StaticOrder S; S.init(M, DM, F.G, (int)blockIdx.x);
        pg8::EpiRes E{F.XB, DUMMY(12) ? (bf16*)dummy_out : F.XB, nullptr, DUMMY(12) ? F.ss0 + 4 * M : F.ss3, DM};
        pg8::gemm_phase<pg8::EpiRes, pg8::StaticOrder, PG8_ALIGN, PG8_SP2>(F.lds + RING_OFF, g, S, E); } SEAM(12);
    if (IN(13)) REPS(13) { pg8::Gemm g{F.XB, F.WupT1, M, FF, DM}; pg8::StaticOrder S; S.init(M, FF, F.G, (int)blockIdx.x);
        pg8::EpiScale<1> E{F.H, FF, F.ss3, 1.f / DM, EPS};
        pg8::gemm_phase<pg8::EpiScale<1>, pg8::StaticOrder, PG8_ALIGN, PG8_SP2>(F.lds + RING_OFF, g, S, E); } SEAM(13);
    if (IN(14)) REPS(14) { pg8::Gemm g{F.H, F.WdnT1, M, DM, FF}; pg8::StaticOrder S; S.init(M, DM, F.G, (int)blockIdx.x);
        pg8::EpiRes E{F.XB, nullptr, DUMMY(14) ? dummy_out : F.out, nullptr, DM};
        pg8::gemm_phase<pg8::EpiRes, pg8::StaticOrder, PG8_ALIGN, PG8_SP2>(F.lds + RING_OFF, g, S, E); }
#undef IN
#undef SEAM
}

extern "C" void kernel_launch(void* const* d_in, const int* in_sizes, int n_in, void* d_out, int out_size, void* d_ws, size_t ws_size, hipStream_t stream) {
    static int grid = 0;
    if (grid == 0) {
        if (n_in != 13 || in_sizes[0] != M * DM || out_size != M * DM || ws_size < WS_END) { fprintf(stderr, "kernel_launch: shape/workspace mismatch (n_in %d, in0 %d, out %d, ws %zu, need %zu)\n", n_in, n_in > 0 ? in_sizes[0] : -1, out_size, ws_size, (size_t)WS_END); grid = -1; return; }
        int dev = 0, cus = 0, per_cu = 0;
        if (hipGetDevice(&dev) != hipSuccess || hipDeviceGetAttribute(&cus, hipDeviceAttributeMultiprocessorCount, dev) != hipSuccess) { grid = -1; return; }
        if (hipFuncSetAttribute((const void*)mk_fwd, hipFuncAttributeMaxDynamicSharedMemorySize, LDS_BYTES) != hipSuccess) { fprintf(stderr, "kernel_launch: hipFuncSetAttribute failed\n"); grid = -1; return; }
        if (hipOccupancyMaxActiveBlocksPerMultiprocessor(&per_cu, (const void*)mk_fwd, NTHR, LDS_BYTES) != hipSuccess || per_cu < 1) fprintf(stderr, "kernel_launch: occupancy query reports %d blocks per CU\n", per_cu);
        (void)hipGetLastError();
        grid = cus;
    }
    if (grid < 0) return;
    if (hipMemsetAsync((char*)d_ws + WS_CTL, 0, CTL_ZERO_BYTES, stream) != hipSuccess) { fprintf(stderr, "kernel_launch: memset failed\n"); return; }
    Args a{};
    for (int i = 0; i < 13; ++i) a.in[i] = (const float*)d_in[i];
    a.out = (float*)d_out; a.ws = (unsigned char*)d_ws;
#if MK_MULTI
    unsigned char* ws = (unsigned char*)d_ws;
    for (int p = 0; p < N_PHASES; ++p) {
        if (p == 4 && ORA_IDX) continue;
        if (p == 3 && ORA_IDX) {
#if ORA_IDX
            hipLaunchKernelGGL(ora_indexer, dim3(M), dim3(256), 0, stream, (const bf16*)(ws + WS_QI), (const bf16*)(ws + WS_KI), (const float*)(ws + WS_WI), (u64*)(ws + WS_MASK));
#endif
            continue; }
        if (p == 5 && ORA_ATT) {
#if ORA_ATT
            hipLaunchKernelGGL(ora_attn, dim3(M * 4), dim3(128), 0, stream, (const bf16*)(ws + WS_Q), (const bf16*)(ws + WS_K), (const bf16*)(ws + WS_V), (const u64*)(ws + WS_MASK), (bf16*)(ws + WS_O));
#endif
            continue; }
        if (p == 11 && ORA_ML) continue;
        if (p == 10 && ORA_ML) {
#if ORA_ML
            hipLaunchKernelGGL(ora_mlstm, dim3(BATCH * MH), dim3(256), 0, stream, (const bf16*)(ws + WS_PROJ), (const float*)(ws + WS_GATE), (const float*)(ws + WS_GATE + 512 * 1024), (const float*)d_in[9], (bf16*)(ws + WS_O));
#endif
            continue; }
        a.ph_lo = p; a.ph_hi = p + 1; a.li = p;
        hipLaunchKernelGGL(mk_fwd, dim3(grid), dim3(NTHR), LDS_BYTES, stream, a);
    }
#else
    a.ph_lo = 0; a.ph_hi = N_PHASES; a.li = 0;
    hipLaunchKernelGGL(mk_fwd, dim3(grid), dim3(NTHR), LDS_BYTES, stream, a);
#endif
    const hipError_t le = hipPeekAtLastError();
    if (le != hipSuccess) fprintf(stderr, "kernel_launch: launch failed: %s\n", hipGetErrorName(le));
}
```

```cpp
#ifndef MK_MULTI
#define MK_MULTI 0
#endif
#ifndef ORA_IDX
#define ORA_IDX 0
#endif
#ifndef ORA_ATT
#define ORA_ATT 0
#endif
#ifndef ORA_ML
#define ORA_ML 0
#endif
#ifndef PROBE_DBL
#define PROBE_DBL (-1)
#endif
#include <hip/hip_runtime.h>
#include <cstdio>
#include <cstdint>
#include <cmath>
__device__ __forceinline__ int opaque_tid() { int t = threadIdx.x; asm volatile("" : "+v"(t)); return t; }
namespace pg8 {
#define PG8_LAS __attribute__((address_space(3)))
typedef unsigned short bf16_t;
typedef short bf16x8 __attribute__((ext_vector_type(8)));
typedef float f32x4 __attribute__((ext_vector_type(4)));
typedef unsigned u32x4 __attribute__((ext_vector_type(4)));
constexpr int BM = 256, BK = 64, HALF = 128, HTB = HALF * BK * 2  , STAGE_BYTES = 8 * HTB, NXCD = 8, WGM = 2;

__host__ __device__ __forceinline__ int lds_byte(int r, int c) { const int st = (r >> 4) * 2 + (c >> 5), rr = r & 15, cc = c & 31, ob = rr * 64 + cc * 2; return st * 1024 + (ob ^ (((ob >> 9) & 1) << 5)); }
__host__ __device__ __forceinline__ void stage_rc(int b, int& R, int& C) { const int st = b / 1024, sb = b % 1024, swz = sb ^ (((sb >> 9) & 1) << 5); R = (st >> 1) * 16 + swz / 64; C = (st & 1) * 32 + (swz % 64) / 2; }
__host__ __device__ __forceinline__ int perm32(int rho) { const int n = rho >> 4, i = rho & 15; return 8 * (i >> 2) + 4 * n + (i & 3); }

struct Unit { int pm, pn; };
struct Gemm { const bf16_t* A; const bf16_t* Bt; int M, N, K; };

struct StaticOrder {
    int nM, nN, nwg, G, c;
    __host__ __device__ void init(int M, int N, int G_, int c_) { nM = M / BM; nN = N / BM; nwg = nM * nN; G = G_; c = c_; }
    __host__ __device__ bool next(int i, Unit& u) const {
        const long L = (long)i * G + c; if (L >= nwg) return false;
        int wgid = (int)L; { const int q = nwg / NXCD, r = nwg % NXCD, xcd = wgid % NXCD, off = wgid / NXCD; wgid = (xcd < r ? xcd * (q + 1) : r * (q + 1) + (xcd - r) * q) + off; }
        const int nig = WGM * nN, gid = wgid / nig, fm = gid * WGM, gsz = (nM - fm) < WGM ? (nM - fm) : WGM;
        u.pm = fm + ((wgid % nig) % gsz); u.pn = (wgid % nig) / gsz; return true;
    }
    __device__ __forceinline__ void a_ready(const Unit&) const {}
    __device__ __forceinline__ void done(const Unit&) const {}
};

__device__ __forceinline__ unsigned cvt_pk_bf16(float lo, float hi) { unsigned r; asm volatile("v_cvt_pk_bf16_f32 %0, %1, %2" : "=v"(r) : "v"(lo), "v"(hi)); return r; }
typedef float f32x2 __attribute__((ext_vector_type(2)));
typedef unsigned u32x2 __attribute__((ext_vector_type(2)));
template <int MODE> struct EpiScale {
    static constexpr bool PERM = true, AFTER_DRAIN = false;
    bf16_t* O; int ldc; const float* ss; float inv_n, eps;
    __device__ __forceinline__ void operator()(const f32x4 (&acc)[2][2][4][2], const Unit& u, int wr, int wc, int fr, int fq) const {
        const int row0 = u.pm * BM + wr * 64 + fr, col0 = u.pn * BM + wc * 64 + 8 * fq;
#pragma unroll
        for (int ai = 0; ai < 2; ++ai)
#pragma unroll
            for (int m = 0; m < 4; ++m) { const int row = row0 + ai * HALF + m * 16; const float rs = __builtin_amdgcn_rsqf(ss[row] * inv_n + eps); const float rs2 = rs * rs;
                bf16_t* rowp = O + (size_t)row * ldc + col0;
#pragma unroll
                for (int bj = 0; bj < 2; ++bj) { f32x4 v0 = acc[ai][bj][m][0], v1 = acc[ai][bj][m][1];
                    if (MODE == 0) { v0 = v0 * rs; v1 = v1 * rs; }
                    else { v0 = __builtin_elementwise_max(v0, (f32x4){0.f, 0.f, 0.f, 0.f}); v1 = __builtin_elementwise_max(v1, (f32x4){0.f, 0.f, 0.f, 0.f}); v0 = v0 * v0 * rs2; v1 = v1 * v1 * rs2; }
                    u32x4 w; w.x = cvt_pk_bf16(v0[0], v0[1]); w.y = cvt_pk_bf16(v0[2], v0[3]); w.z = cvt_pk_bf16(v1[0], v1[1]); w.w = cvt_pk_bf16(v1[2], v1[3]);
                    *(u32x4*)(rowp + bj * 32) = w; } }
    }
};
struct EpiRes {
    static constexpr bool PERM = true, AFTER_DRAIN = false;
    const bf16_t* base; bf16_t* hb; float* outf; float* ss; int ldc;
    __device__ __forceinline__ void operator()(const f32x4 (&acc)[2][2][4][2], const Unit& u, int wr, int wc, int fr, int fq) const {
        const int col0 = u.pn * BM + wc * 64 + 8 * fq;
#pragma unroll
        for (int ai = 0; ai < 2; ++ai)
#pragma unroll
            for (int m = 0; m < 4; ++m) { const int row = u.pm * BM + ai * HALF + wr * 64 + m * 16 + fr; const size_t off = (size_t)row * ldc + col0; float s = 0.f;
#pragma unroll
                for (int bj = 0; bj < 2; ++bj) { const u32x4 bw = *(const u32x4*)(base + off + bj * 32);
                    const f32x4 b0 = {__builtin_bit_cast(float, bw.x << 16), __builtin_bit_cast(float, bw.x & 0xffff0000u), __builtin_bit_cast(float, bw.y << 16), __builtin_bit_cast(float, bw.y & 0xffff0000u)};
                    const f32x4 b1 = {__builtin_bit_cast(float, bw.z << 16), __builtin_bit_cast(float, bw.z & 0xffff0000u), __builtin_bit_cast(float, bw.w << 16), __builtin_bit_cast(float, bw.w & 0xffff0000u)};
                    const f32x4 o0 = b0 + acc[ai][bj][m][0], o1 = b1 + acc[ai][bj][m][1];
                    if (outf) { *(f32x4*)(outf + off + bj * 32) = o0; *(f32x4*)(outf + off + bj * 32 + 4) = o1; }
                    else { u32x4 w; w.x = cvt_pk_bf16(o0[0], o0[1]); w.y = cvt_pk_bf16(o0[2], o0[3]); w.z = cvt_pk_bf16(o1[0], o1[1]); w.w = cvt_pk_bf16(o1[2], o1[3]); *(u32x4*)(hb + off + bj * 32) = w;
                        s += ((o0[0] * o0[0] + o0[1] * o0[1]) + (o0[2] * o0[2] + o0[3] * o0[3])) + ((o1[0] * o1[0] + o1[1] * o1[1]) + (o1[2] * o1[2] + o1[3] * o1[3])); } }
                if (!outf) { s += __shfl_xor(s, 16); s += __shfl_xor(s, 32); if (fq == 0) atomicAdd(ss + row, s); }
                asm volatile("" ::: "memory"); }
    }
};
struct EpiNull {
    static constexpr bool PERM = false, AFTER_DRAIN = false;
    __device__ __forceinline__ void operator()(const f32x4 (&acc)[2][2][4][2], const Unit&, int, int, int, int) const {
#pragma unroll
        for (int ai = 0; ai < 2; ++ai)
#pragma unroll
            for (int bj = 0; bj < 2; ++bj)
#pragma unroll
                for (int m = 0; m < 4; ++m)
#pragma unroll
                    for (int n = 0; n < 2; ++n) asm volatile("" :: "v"(acc[ai][bj][m][n]));
    }
};
template <class Epi, class Sched, bool ALIGN_EPI = false, bool SP2 = false>
__device__ __forceinline__ void gemm_phase(PG8_LAS unsigned char* lds, const Gemm g, const Sched& S, const Epi& E) {
    const int tid = opaque_tid(), wid = __builtin_amdgcn_readfirstlane(tid >> 6), lane = tid & 63, wr = wid >> 2, wc = wid & 3, fr = lane & 15, fq = lane >> 4;
    const int K = g.K, nt = K / BK;
    unsigned voffA[2], voffB[2];
#pragma unroll
    for (int i = 0; i < 2; ++i) { int R, C; stage_rc(tid * 16 + i * 8192, R, C); const int Rb = Epi::PERM ? (64 * (R >> 5) + perm32(R & 31)) : R;
        voffA[i] = (unsigned)(R * K + C) * 2u; voffB[i] = (unsigned)(Rb * K + C) * 2u; }
    const size_t kstep = (size_t)(BK * 2);
    const size_t hstep = (size_t)HALF * K * 2;
    const size_t hstepB = Epi::PERM ? (size_t)32 * K * 2 : hstep;
    const size_t tstep = 2 * hstep;
    const unsigned ldsw = (unsigned)wid * 1024u;
    const int aoff = lds_byte(wr * 64 + fr, fq * 8), boff = lds_byte(wc * 32 + fr, fq * 8);
#define PG8_SA(b, h) (((b) * 2 + (h)) * HTB)
#define PG8_SB(b, h) ((4 + (b) * 2 + (h)) * HTB)
#define PG8_STAGE(bufoff, gbase, voff) do { _Pragma("unroll") for (int _i = 0; _i < 2; ++_i) \
        __builtin_amdgcn_global_load_lds((const unsigned*)((const char*)(gbase) + (voff)[_i]), (PG8_LAS unsigned*)(lds + (bufoff) + ldsw + _i * 8192), 16, 0, 0); } while (0)
#define PG8_LDA(dst, b, h) do { _Pragma("unroll") for (int m = 0; m < 4; ++m) _Pragma("unroll") for (int k = 0; k < 2; ++k) dst[m][k] = *(const PG8_LAS bf16x8*)(lds + PG8_SA(b, h) + aoff + m * 2048 + k * 1024); } while (0)
#define PG8_LDB(dst, b, h) do { _Pragma("unroll") for (int n = 0; n < 2; ++n) _Pragma("unroll") for (int k = 0; k < 2; ++k) dst[n][k] = *(const PG8_LAS bf16x8*)(lds + PG8_SB(b, h) + boff + n * 2048 + k * 1024); } while (0)
#define PG8_MMA(ai, bj, At, Bt) do { __builtin_amdgcn_s_setprio(1); _Pragma("unroll") for (int m = 0; m < 4; ++m) _Pragma("unroll") for (int n = 0; n < 2; ++n) _Pragma("unroll") for (int k = 0; k < 2; ++k) \
        acc[ai][bj][m][n] = __builtin_amdgcn_mfma_f32_16x16x32_bf16(Bt[n][k], At[m][k], acc[ai][bj][m][n], 0, 0, 0); __builtin_amdgcn_s_setprio(0); } while (0)
#define PG8_WAIT_V(n) asm volatile("s_waitcnt vmcnt(" #n ")" ::: "memory")
#define PG8_WAIT_L(n) asm volatile("s_waitcnt lgkmcnt(" #n ")" ::: "memory")
#define PG8_BAR __builtin_amdgcn_s_barrier()
#define PG8_SCHED __builtin_amdgcn_sched_barrier(0)
    Unit cur, nxt; int ui = 0;
    if (!S.next(0, cur)) return;
    f32x4 acc[2][2][4][2];
#pragma unroll
    for (int a = 0; a < 2; ++a)
#pragma unroll
        for (int b = 0; b < 2; ++b)
#pragma unroll
            for (int m = 0; m < 4; ++m)
#pragma unroll
                for (int n = 0; n < 2; ++n) acc[a][b][m][n] = (f32x4){0.f, 0.f, 0.f, 0.f};
    bf16x8 At[4][2], B0[2][2], B1[2][2];
    const char* cA = (const char*)g.A + (size_t)cur.pm * tstep; const char* cB = (const char*)g.Bt + (size_t)cur.pn * tstep;
    S.a_ready(cur);
    if constexpr (SP2) {
        PG8_STAGE(PG8_SB(0, 0), cB, voffB); PG8_STAGE(PG8_SB(0, 1), cB + hstepB, voffB); PG8_STAGE(PG8_SA(0, 0), cA, voffA); PG8_STAGE(PG8_SA(0, 1), cA + hstep, voffA);
        if (wr == 1) PG8_BAR;
        PG8_WAIT_V(2); PG8_BAR;
        PG8_STAGE(PG8_SB(1, 0), cB + kstep, voffB); PG8_STAGE(PG8_SA(1, 0), cA + kstep, voffA); PG8_STAGE(PG8_SB(1, 1), cB + hstepB + kstep, voffB);
        PG8_WAIT_V(6); PG8_BAR;
    } else {
        PG8_STAGE(PG8_SB(0, 0), cB, voffB); PG8_STAGE(PG8_SA(0, 0), cA, voffA); PG8_STAGE(PG8_SB(0, 1), cB + hstepB, voffB); PG8_STAGE(PG8_SA(0, 1), cA + hstep, voffA);
        if (wr == 1) PG8_BAR;
        PG8_WAIT_V(4); PG8_BAR;
        PG8_STAGE(PG8_SB(1, 0), cB + kstep, voffB); PG8_STAGE(PG8_SA(1, 0), cA + kstep, voffA); PG8_STAGE(PG8_SB(1, 1), cB + hstepB + kstep, voffB);
        PG8_WAIT_V(6); PG8_BAR;
    }
    for (;;) {
        const bool has_next = S.next(ui + 1, nxt);
        const char* nA = has_next ? (const char*)g.A + (size_t)nxt.pm * tstep : cA; const char* nB = has_next ? (const char*)g.Bt + (size_t)nxt.pn * tstep : cB;
        for (int t = 0; t < nt; t += 2) {
            const bool last = (t == nt - 2);
            const char* a1 = cA + (size_t)(t + 1) * kstep;
            const char* a2 = last ? nA : cA + (size_t)(t + 2) * kstep; const char* b2 = last ? nB : cB + (size_t)(t + 2) * kstep;
            const char* a3 = a2 + kstep; const char* b3 = b2 + kstep;
            if (last && has_next) S.a_ready(nxt);
            if constexpr (SP2) {
            PG8_LDB(B0, 0, 0); PG8_LDB(B1, 0, 1); PG8_SCHED; PG8_LDA(At, 0, 0); PG8_STAGE(PG8_SA(1, 1), a1 + hstep, voffA);
            PG8_WAIT_V(8); PG8_WAIT_L(0); PG8_BAR; PG8_MMA(0, 0, At, B0); PG8_MMA(0, 1, At, B1); PG8_BAR; PG8_SCHED;
            PG8_LDA(At, 0, 1); PG8_STAGE(PG8_SB(0, 0), b2, voffB); PG8_STAGE(PG8_SB(0, 1), b2 + hstepB, voffB); PG8_STAGE(PG8_SA(0, 0), a2, voffA);
            PG8_WAIT_V(8); PG8_WAIT_L(0); PG8_BAR; PG8_MMA(1, 0, At, B0); PG8_MMA(1, 1, At, B1); PG8_BAR; PG8_SCHED;
            PG8_LDB(B0, 1, 0); PG8_LDB(B1, 1, 1); PG8_SCHED; PG8_LDA(At, 1, 0); PG8_STAGE(PG8_SA(0, 1), a2 + hstep, voffA);
            PG8_WAIT_V(8); PG8_WAIT_L(0); PG8_BAR; PG8_MMA(0, 0, At, B0); PG8_MMA(0, 1, At, B1); PG8_BAR; PG8_SCHED;
            PG8_LDA(At, 1, 1); PG8_STAGE(PG8_SB(1, 0), b3, voffB); PG8_STAGE(PG8_SB(1, 1), b3 + hstepB, voffB); PG8_STAGE(PG8_SA(1, 0), a3, voffA);
            PG8_WAIT_V(8); PG8_WAIT_L(0); PG8_BAR; PG8_MMA(1, 0, At, B0); PG8_MMA(1, 1, At, B1); PG8_BAR; PG8_SCHED;
            } else {
            PG8_LDB(B0, 0, 0); PG8_SCHED; PG8_LDA(At, 0, 0); PG8_STAGE(PG8_SA(1, 1), a1 + hstep, voffA);
            PG8_WAIT_L(8); PG8_BAR; PG8_WAIT_L(0); PG8_MMA(0, 0, At, B0); PG8_BAR; PG8_SCHED;
            PG8_LDB(B1, 0, 1); PG8_STAGE(PG8_SB(0, 0), b2, voffB);
            PG8_BAR; PG8_WAIT_L(0); PG8_MMA(0, 1, At, B1); PG8_BAR;
            PG8_LDA(At, 0, 1); PG8_STAGE(PG8_SA(0, 0), a2, voffA);
            PG8_BAR; PG8_WAIT_L(0); PG8_MMA(1, 0, At, B0); PG8_BAR; PG8_SCHED;
            PG8_STAGE(PG8_SB(0, 1), b2 + hstepB, voffB);
            PG8_WAIT_V(6); PG8_BAR; PG8_MMA(1, 1, At, B1); PG8_BAR;
            PG8_LDB(B0, 1, 0); PG8_SCHED; PG8_LDA(At, 1, 0); PG8_STAGE(PG8_SA(0, 1), a2 + hstep, voffA);
            PG8_WAIT_L(8); PG8_BAR; PG8_WAIT_L(0); PG8_MMA(0, 0, At, B0); PG8_BAR; PG8_SCHED;
            PG8_LDB(B1, 1, 1); PG8_STAGE(PG8_SB(1, 0), b3, voffB);
            PG8_BAR; PG8_WAIT_L(0); PG8_MMA(0, 1, At, B1); PG8_BAR;
            PG8_LDA(At, 1, 1); PG8_STAGE(PG8_SA(1, 0), a3, voffA);
            PG8_BAR; PG8_WAIT_L(0); PG8_MMA(1, 0, At, B0); PG8_BAR; PG8_SCHED;
            PG8_STAGE(PG8_SB(1, 1), b3 + hstepB, voffB);
            PG8_WAIT_V(6); PG8_BAR; PG8_MMA(1, 1, At, B1); PG8_BAR;
            }
        }
        if constexpr (ALIGN_EPI) { if (wr == 0) PG8_BAR; }
        if constexpr (!Epi::AFTER_DRAIN) { E(acc, cur, wr, wc, fr, fq); S.done(cur); }
        if (!has_next) break;
#pragma unroll
        for (int a = 0; a < 2; ++a)
#pragma unroll
            for (int b = 0; b < 2; ++b)
#pragma unroll
                for (int m = 0; m < 4; ++m)
#pragma unroll
                    for (int n = 0; n < 2; ++n) acc[a][b][m][n] = (f32x4){0.f, 0.f, 0.f, 0.f};
        cur = nxt; cA = nA; cB = nB; ++ui;
        if constexpr (ALIGN_EPI) { if (wr == 1) PG8_BAR; }
    }
    PG8_WAIT_V(0);
    if constexpr (!ALIGN_EPI) { if (wr == 0) PG8_BAR; }
    PG8_BAR;
    if constexpr (Epi::AFTER_DRAIN) { E.fused(acc, cur, wr, wc, fr, fq, lds, wid, lane); S.done(cur); }
#undef PG8_SA
#undef PG8_SB
#undef PG8_STAGE
#undef PG8_LDA
#undef PG8_LDB
#undef PG8_MMA
#undef PG8_WAIT_V
#undef PG8_WAIT_L
#undef PG8_BAR
#undef PG8_SCHED
}
}
#ifndef PG8_SP2
#define PG8_SP2 true
#endif
#ifndef PG8_ALIGN
#define PG8_ALIGN true
#endif
constexpr int NWAVES = 8, NTHR = NWAVES * 64;
#ifndef MK_MULTI
#define MK_MULTI 0
#endif
#ifndef ORA_IDX
#define ORA_IDX 0
#endif
#ifndef ORA_ATT
#define ORA_ATT 0
#endif
#ifndef ORA_ML
#define ORA_ML 0
#endif
#ifndef CVT_STAGGER
#define CVT_STAGGER 1
#endif
constexpr int N_PHASES = 15;
#ifndef ML_CHAIN
#define ML_CHAIN 1
#endif
constexpr int BATCH = 4, T = 2048, DM = 2048, M = BATCH * T, FF = 8192;
constexpr int AH = 16, AG = 4, HD = 128, IH = 16, IDIM = 64, TOPK = 256;
constexpr int ATT_IN = 4176, ATT_N = 4096, SM_N = 80;
constexpr int C_Q = 0, C_K = 2048, C_V = 2560, C_QI = 3072;
constexpr int MH = 8, MDK = 128, MDV = 256, ML_IN = 6160, ML_N = 6144;
constexpr int C_MQ = 0, C_MK = 1024, C_MV = 2048, C_MO = 4096;
constexpr float EPS = 1e-6f, GATE_CAP = 15.0f;
constexpr size_t MiB = 1u << 20;
constexpr size_t WS_CTL = 0, CTL_ZERO_BYTES = 320 * 1024;
constexpr size_t WS_WIN = 1 * MiB, WS_WSM = 17 * MiB, WS_WO = 18 * MiB, WS_WML = 26 * MiB, WS_WG = 50 * MiB, WS_WMO = 51 * MiB;
constexpr size_t WS_WUP0 = 59 * MiB, WS_WUP1 = 91 * MiB, WS_WDN0 = 123 * MiB, WS_WDN1 = 155 * MiB;
constexpr size_t WS_XB = 188 * MiB, WS_PROJ = 220 * MiB, WS_Q = 316 * MiB, WS_K = 348 * MiB, WS_QI = 356 * MiB, WS_KI = 372 * MiB, WS_WI = 373 * MiB, WS_MASK = 374 * MiB;
constexpr size_t WS_GATE = 376 * MiB, WS_ROPE = 377 * MiB, WS_SC = 380 * MiB, WS_O = 444 * MiB, WS_V = 476 * MiB, WS_ML = 484 * MiB, WS_END = 486 * MiB;
constexpr size_t WS_H = 220 * MiB;
static_assert(WS_H + (size_t)M * FF * 2 <= WS_K && WS_PROJ + (size_t)M * ML_N * 2 <= WS_Q && WS_SC + (size_t)BATCH * T * T * 4 <= WS_O, "d_ws map");
constexpr int CW_TMO = 0, CW_CODE = 1, CW_BAR = 4096, CW_SS = 32768;
constexpr int RING_OFF = 0, RING_BYTES = 143360;
constexpr int LDSCTL_OFF = RING_BYTES, MISC_OFF = LDSCTL_OFF + 320;
constexpr int LDS_BYTES = 147456;
#define GAS __attribute__((address_space(1)))
#define LAS __attribute__((address_space(3)))
typedef unsigned short bf16;
typedef unsigned v4u __attribute__((ext_vector_type(4)));
typedef unsigned v2u __attribute__((ext_vector_type(2)));
typedef float f32x4 __attribute__((ext_vector_type(4)));
typedef float f32x16 __attribute__((ext_vector_type(16)));
typedef float f32x2 __attribute__((ext_vector_type(2)));
typedef short bf16x8 __attribute__((ext_vector_type(8)));
typedef short s16x4 __attribute__((ext_vector_type(4)));
typedef GAS unsigned gu32;
typedef GAS unsigned long long gu64;
typedef unsigned long long u64;
#define RLX_AGENT __ATOMIC_RELAXED, __HIP_MEMORY_SCOPE_AGENT
#define LDS_WAIT() asm volatile("s_waitcnt lgkmcnt(0)" ::: "memory")
#define VM_WAIT() asm volatile("s_waitcnt vmcnt(0)" ::: "memory")
__device__ __forceinline__ unsigned f2bf(float f) { unsigned u = __builtin_bit_cast(unsigned, f); return (u + 0x7fffu + ((u >> 16) & 1u)) >> 16; }
__device__ __forceinline__ unsigned pk2(float lo, float hi) { return f2bf(lo) | (f2bf(hi) << 16); }
__device__ __forceinline__ float bf2f(bf16 h) { return __builtin_bit_cast(float, (unsigned)h << 16); }
__device__ __forceinline__ float bflo(unsigned w) { return __builtin_bit_cast(float, w << 16); }
__device__ __forceinline__ float bfhi(unsigned w) { return __builtin_bit_cast(float, w & 0xffff0000u); }
__device__ __forceinline__ unsigned fkey(float f) { const unsigned u = __builtin_bit_cast(unsigned, f); return (u & 0x80000000u) ? ~u : (u | 0x80000000u); }
#define XB_TMO      128
#define XB_XCNT(j)  (256  + 64 * (j))
#define XB_XSUB(j)  (1280 + 64 * (j))
#define XB_XGEN(j)  (2304 + 64 * (j))
#define XB_TOP      3328
#define XB_TOPGEN   3392
#define XCD_BAR_WORDS 3456
#define XB_SPIN_CAP (1u << 18)

__device__ __forceinline__ unsigned xb_ld(unsigned* p)              { return __hip_atomic_load(p, __ATOMIC_RELAXED, __HIP_MEMORY_SCOPE_AGENT); }
__device__ __forceinline__ unsigned xb_add(unsigned* p, unsigned v) { return __hip_atomic_fetch_add(p, v, __ATOMIC_RELAXED, __HIP_MEMORY_SCOPE_AGENT); }
__device__ __forceinline__ unsigned xb_xcc_id() { return (unsigned)__builtin_amdgcn_s_getreg((3 << 11) | 20) & 0xFu; }
#define XB_SPIN(cond, bar) do { unsigned _sp = 0; while (cond) { __builtin_amdgcn_s_sleep(0); \
    if ((++_sp & 255u) == 0u) { if (xb_ld(&(bar)[XB_TMO])) break; if (_sp > XB_SPIN_CAP) { atomicAdd(&(bar)[XB_TMO], 1u); break; } } } } while (0)

struct XcdBarrier {
    unsigned* bar; unsigned x;
    volatile LAS unsigned* st;
};

__device__ __forceinline__ XcdBarrier xcd_barrier_post(unsigned* bar, volatile LAS unsigned* st) {
    XcdBarrier b; b.bar = bar; b.x = xb_xcc_id(); b.st = st;
    if (threadIdx.x == 0) (void)xb_add(&bar[XB_XCNT(b.x)], 1u);
    return b;
}
__device__ __forceinline__ void xcd_barrier_complete(unsigned* bar, unsigned x, unsigned& nloc, unsigned& nx) {
    const unsigned G = gridDim.x * gridDim.y * gridDim.z;
    unsigned sum, cnt, mine, sp = 0u;
    for (;;) {
        sum = 0u; cnt = 0u; mine = 0u;
#pragma unroll
        for (unsigned j = 0; j < 16; ++j) { const unsigned c = xb_ld(&bar[XB_XCNT(j)]); sum += c; cnt += (c > 0u) ? 1u : 0u; mine = (j == x) ? c : mine; }
        if (sum == G) break;
        __builtin_amdgcn_s_sleep(1);
        if ((++sp & 255u) == 0u) { if (xb_ld(&bar[XB_TMO])) break; if (sp > XB_SPIN_CAP) { atomicAdd(&bar[XB_TMO], 1u); break; } }
    }
    nloc = mine > 0u ? mine : 1u; nx = cnt > 0u ? cnt : 1u;
}

__device__ __forceinline__ void xcd_barrier(const XcdBarrier& b) {
    asm volatile("s_waitcnt vmcnt(0)" ::: "memory");
    __syncthreads();
    if (threadIdx.x == 0) {
        unsigned* bar = b.bar;
        __builtin_amdgcn_s_waitcnt(0);
        unsigned nloc = b.st[0], nx = b.st[1];
        if (nloc == 0u) { xcd_barrier_complete(bar, b.x, nloc, nx); b.st[0] = nloc; b.st[1] = nx; }
        const unsigned old = xb_add(&bar[XB_XSUB(b.x)], 1u);
        const unsigned gen = old / nloc;
        if (old + 1u == (gen + 1u) * nloc) {
            __builtin_amdgcn_fence(__ATOMIC_RELEASE, "agent");
            asm volatile("s_waitcnt vmcnt(0)" ::: "memory");
            const unsigned og = xb_add(&bar[XB_TOP], 1u);
            const unsigned tg = og / nx;
            if (og + 1u == (tg + 1u) * nx) xb_add(&bar[XB_TOPGEN], 1u);
            else XB_SPIN(xb_ld(&bar[XB_TOPGEN]) == tg, bar);
            __builtin_amdgcn_fence(__ATOMIC_ACQUIRE, "agent");
            xb_add(&bar[XB_XGEN(b.x)], 1u);
            asm volatile("s_waitcnt vmcnt(0)" ::: "memory");
        } else {
            XB_SPIN(xb_ld(&bar[XB_XGEN(b.x)]) == gen, bar);
            __builtin_amdgcn_fence(__ATOMIC_ACQUIRE, "agent");
            asm volatile("s_waitcnt vmcnt(0)" ::: "memory");
        }
    }
    __syncthreads();
}
struct Args { const float* in[13]; float* out; unsigned char* ws; int ph_lo, ph_hi, li, pad; };
struct Frame {
    LAS unsigned char* lds;
    volatile LAS unsigned* MISC;
    gu32* ctl;
    int tid, lane, wave, vcu, G;
    const float* x; float* out;
    const float *norm_mix, *norm_ffn, *att_w_in, *q_gain, *k_gain, *att_w_out, *ml_w_in, *b_gate, *h_gain, *ml_w_out, *w_up, *w_dn;
    bf16 *WinT, *WsmT, *WoT, *WmlT, *WgT, *WmoT, *WupT0, *WupT1, *WdnT0, *WdnT1;
    bf16 *XB, *PROJ, *Q, *K, *V, *QI, *KI, *O, *H;
    float *WI, *IG, *LF, *SC, *NST, *SCAL; bf16* ST; f32x2 *ROPE_A, *ROPE_I; u64* MASK;
    float *ss0, *ss1, *ss2, *ss3;
};
__device__ __forceinline__ float wave_sum(float v) {
#pragma unroll
    for (int o = 1; o < 64; o <<= 1) v += __shfl_xor(v, o);
    return v;
}
__device__ __forceinline__ unsigned cvtpk2(float lo, float hi) { unsigned r; asm volatile("v_cvt_pk_bf16_f32 %0, %1, %2" : "=v"(r) : "v"(lo), "v"(hi)); return r; }
template <bool NTS = false> __device__ __forceinline__ void tr_item(const float* W, int ldw, int col0, int nvalid, int nblk, int K, const float* gain, float scale, bf16* WT, LAS float* scr, int item, int lane) {
    const int kb = item / nblk, nb = item - kb * nblk, k0 = 64 * kb, n0 = 32 * nb, nn = n0 + (lane & 31), nc = nn < nvalid ? nn : nvalid - 1, c = lane & 7;
    const GAS float* wp = (const GAS float*)W + (size_t)(k0 + (lane >> 5)) * ldw + col0 + nc;
    float v[32];
#pragma unroll
    for (int i = 0; i < 32; ++i) v[i] = __builtin_nontemporal_load(wp + (size_t)(2 * i) * ldw);
    f32x4 g0 = (f32x4){scale, scale, scale, scale}, g1 = g0;
    if (gain) { g0 = *(const GAS f32x4*)(gain + k0 + 8 * c) * scale; g1 = *(const GAS f32x4*)(gain + k0 + 8 * c + 4) * scale; }
    const bool ok = nn < nvalid;
#pragma unroll
    for (int i = 0; i < 32; ++i) scr[(2 * i + (lane >> 5)) * 33 + (lane & 31)] = ok ? v[i] : 0.f;
    LDS_WAIT(); asm volatile("" ::: "memory");
#pragma unroll
    for (int j = 0; j < 4; ++j) { const int n = (lane >> 3) + 8 * j; const LAS float* s = scr + (8 * c) * 33 + n;
        v4u o; o.x = cvtpk2(s[0 * 33] * g0.x, s[1 * 33] * g0.y); o.y = cvtpk2(s[2 * 33] * g0.z, s[3 * 33] * g0.w); o.z = cvtpk2(s[4 * 33] * g1.x, s[5 * 33] * g1.y); o.w = cvtpk2(s[6 * 33] * g1.z, s[7 * 33] * g1.w);
        if (NTS) __builtin_nontemporal_store(o, (GAS v4u*)(WT + (size_t)(n0 + n) * K + k0 + 8 * c)); else *(GAS v4u*)(WT + (size_t)(n0 + n) * K + k0 + 8 * c) = o; }
    LDS_WAIT(); asm volatile("" ::: "memory");
}
namespace cvt {
constexpr int I0 = 32 * 128, I1 = 32 * 3, I2 = 32 * 64, I3 = 32 * 256, I4 = 128 * 64, I5 = 32 * 32, I6 = 32 * 32, I7 = 32 * 128, I8 = 32 * 1, I9 = 32 * 64, I10 = I3, I11 = I4;
constexpr int E1 = I0 + I1, E2 = E1 + I2, E3 = E2 + I3, E4 = E3 + I4, E8 = E4 + I5 + I6 + I7 + I8, E9 = E8 + I9, E10 = E9 + I10, E11 = E10 + I11;
}
struct TrJob { const float* W; const float* gain; bf16* WT; float scale; int ldw, col0, nvalid, nblk, K, item; bool nts; };
__device__ __forceinline__ TrJob tr_job(const Frame& F, int it) {
    using namespace cvt;
    constexpr float KSC = 0.08838834764831845f;
    int r = it;
    if (r < I0) return TrJob{F.att_w_in, F.norm_mix, F.WinT, 1.f, ATT_IN, 0, ATT_N, 128, DM, r, false}; r -= I0;
    if (r < I1) return TrJob{F.att_w_in, F.norm_mix, F.WsmT, 1.f, ATT_IN, ATT_N, SM_N, 3, DM, r, false}; r -= I1;
    if (r < I2) return TrJob{F.att_w_out, nullptr, F.WoT, 1.f, DM, 0, DM, 64, DM, r, true}; r -= I2;
    if (r < I3) return TrJob{F.w_up, F.norm_ffn, F.WupT0, 1.f, FF, 0, FF, 256, DM, r, true}; r -= I3;
    if (r < I4) return TrJob{F.w_dn, nullptr, F.WdnT0, 1.f, DM, 0, DM, 64, FF, r, true}; r -= I4;
    if (r < I5) return TrJob{F.ml_w_in, F.norm_mix + DM, F.WmlT, 1.f, ML_IN, C_MQ, 1024, 32, DM, r, true}; r -= I5;
    if (r < I6) return TrJob{F.ml_w_in, F.norm_mix + DM, F.WmlT + (size_t)C_MK * DM, KSC, ML_IN, C_MK, 1024, 32, DM, r, true}; r -= I6;
    if (r < I7) return TrJob{F.ml_w_in, F.norm_mix + DM, F.WmlT + (size_t)C_MV * DM, 1.f, ML_IN, C_MV, 4096, 128, DM, r, true}; r -= I7;
    if (r < I8) return TrJob{F.ml_w_in, F.norm_mix + DM, F.WgT, 1.f, ML_IN, ML_N, 16, 1, DM, r, true}; r -= I8;
    if (r < I9) return TrJob{F.ml_w_out, nullptr, F.WmoT, 1.f, DM, 0, DM, 64, DM, r, true}; r -= I9;
    if (r < I10) return TrJob{F.w_up + (size_t)DM * FF, F.norm_ffn + DM, F.WupT1, 1.f, FF, 0, FF, 256, DM, r, true}; r -= I10;
    return TrJob{F.w_dn + (size_t)FF * DM, nullptr, F.WdnT1, 1.f, DM, 0, DM, 64, FF, r, true};
}
#define TR_LOAD(J, V) do { const int kb_ = (J).item / (J).nblk, nb_ = (J).item - kb_ * (J).nblk, nn_ = 32 * nb_ + (lane & 31), nc_ = nn_ < (J).nvalid ? nn_ : (J).nvalid - 1;                   \
    const GAS float* wp_ = (const GAS float*)(J).W + (size_t)(64 * kb_ + (lane >> 5)) * (J).ldw + (J).col0 + nc_;                                                                                  \
    _Pragma("unroll") for (int i = 0; i < 32; ++i) V[i] = __builtin_nontemporal_load(wp_ + (size_t)(2 * i) * (J).ldw); } while (0)
#define TR_FINISH(J, V) do { const int kb_ = (J).item / (J).nblk, nb_ = (J).item - kb_ * (J).nblk, k0_ = 64 * kb_, n0_ = 32 * nb_, c_ = lane & 7; const bool ok_ = n0_ + (lane & 31) < (J).nvalid;    \
    f32x4 g0_ = (f32x4){(J).scale, (J).scale, (J).scale, (J).scale}, g1_ = g0_;                                                                                                                   \
    if ((J).gain) { g0_ = *(const GAS f32x4*)((J).gain + k0_ + 8 * c_) * (J).scale; g1_ = *(const GAS f32x4*)((J).gain + k0_ + 8 * c_ + 4) * (J).scale; }                                        \
    _Pragma("unroll") for (int i = 0; i < 32; ++i) scr[(2 * i + (lane >> 5)) * 33 + (lane & 31)] = ok_ ? V[i] : 0.f;                                                                               \
    LDS_WAIT(); asm volatile("" ::: "memory");                                                                                                                                                     \
    _Pragma("unroll") for (int j = 0; j < 4; ++j) { const int n_ = (lane >> 3) + 8 * j; const LAS float* s_ = scr + (8 * c_) * 33 + n_;                                                           \
        v4u o_; o_.x = cvtpk2(s_[0 * 33] * g0_.x, s_[1 * 33] * g0_.y); o_.y = cvtpk2(s_[2 * 33] * g0_.z, s_[3 * 33] * g0_.w); o_.z = cvtpk2(s_[4 * 33] * g1_.x, s_[5 * 33] * g1_.y); o_.w = cvtpk2(s_[6 * 33] * g1_.z, s_[7 * 33] * g1_.w); \
        GAS v4u* d_ = (GAS v4u*)((J).WT + (size_t)(n0_ + n_) * (J).K + k0_ + 8 * c_);                                                                                                             \
        if ((J).nts) __builtin_nontemporal_store(o_, d_); else *d_ = o_; }                                                                                                                         \
    LDS_WAIT(); asm volatile("" ::: "memory"); } while (0)
__device__ __forceinline__ void cvt_items(Frame& F, int lo, int hi) {
    const int tid = opaque_tid(), lane = tid & 63, wave = tid >> 6;
    LAS float* scr = (LAS float*)(F.lds + RING_OFF + wave * 16384);
    const int gw = F.vcu * NWAVES + wave, NGW = F.G * NWAVES;
    int it = lo + gw; if (it >= hi) return;
    float va[32], vb[32]; TrJob ja = tr_job(F, it), jb = ja;
    TR_LOAD(ja, va);
    for (;;) {
        it += NGW; const bool more1 = it < hi; if (more1) { jb = tr_job(F, it); TR_LOAD(jb, vb); }
        TR_FINISH(ja, va); if (!more1) break;
        it += NGW; const bool more2 = it < hi; if (more2) { ja = tr_job(F, it); TR_LOAD(ja, va); }
        TR_FINISH(jb, vb); if (!more2) break;
    }
}
#undef TR_LOAD
#undef TR_FINISH
__device__ __forceinline__ void cvt_slot(Frame& F, int lo, int hi, bool before) {
#if CVT_STAGGER
    if (CVT_STAGGER == 2 ? before : ((F.vcu & 1) == 0) == before) { __syncthreads(); cvt_items(F, lo, hi); __syncthreads(); }
#endif
}
__device__ __forceinline__ void p0_prologue(Frame& F) {
    const int gw = F.vcu * NWAVES + F.wave, NGW = F.G * NWAVES;
    cvt_items(F, 0, CVT_STAGGER ? cvt::E1 : cvt::E11);
    for (int m = gw; m < M; m += NGW) {
        const GAS f32x4* xr = (const GAS f32x4*)(F.x + (size_t)m * DM) + F.lane; GAS u64* o8 = (GAS u64*)(F.XB + (size_t)m * DM) + F.lane;
        f32x4 v[8]; float s = 0.f;
#pragma unroll
        for (int j = 0; j < 8; ++j) { v[j] = __builtin_nontemporal_load(xr + 64 * j); s += (v[j].x * v[j].x + v[j].y * v[j].y) + (v[j].z * v[j].z + v[j].w * v[j].w); }
        s = wave_sum(s); if (F.lane == 0) F.ss0[m] = s;
#pragma unroll
        for (int j = 0; j < 8; ++j) o8[64 * j] = (u64)cvtpk2(v[j].x, v[j].y) | ((u64)cvtpk2(v[j].z, v[j].w) << 32);
    }
    for (int idx = gw * 64 + F.lane; idx < T * 24; idx += NGW * 64) { const int t = idx / 24, i = idx - t * 24;
        if (i < 16) { const float inv = powf(500000.0f, -2.0f * (float)i / 32.0f), a = (float)t * inv; F.ROPE_A[t * 16 + i] = (f32x2){cosf(a), sinf(a)}; }
        else { const int ii = i - 16; const float inv = powf(500000.0f, -2.0f * (float)ii / 16.0f), a = (float)t * inv; F.ROPE_I[t * 8 + ii] = (f32x2){cosf(a), sinf(a)}; } }
}
template <int NT> __device__ __forceinline__ void skinny_mma(Frame& F, const bf16* A, const bf16* Wt, int r0, LAS float* red) {
    const int rt = F.wave & 1, kq = F.wave >> 1, fr = F.lane & 15, fq = F.lane >> 4;
    f32x4 acc[NT];
#pragma unroll
    for (int n = 0; n < NT; ++n) acc[n] = (f32x4){0.f, 0.f, 0.f, 0.f};
    const bf16* ap = A + (size_t)(r0 + rt * 16 + fr) * DM + kq * 512 + fq * 8; const bf16* bp = Wt + (size_t)fr * DM + kq * 512 + fq * 8;
#pragma unroll 4
    for (int ks = 0; ks < 16; ++ks) { const bf16x8 a = *(const bf16x8*)(ap + ks * 32);
#pragma unroll
        for (int n = 0; n < NT; ++n) { const bf16x8 b = *(const bf16x8*)(bp + (size_t)n * 16 * DM + ks * 32); acc[n] = __builtin_amdgcn_mfma_f32_16x16x32_bf16(a, b, acc[n], 0, 0, 0); } }
#pragma unroll
    for (int n = 0; n < NT; ++n)
#pragma unroll
        for (int g = 0; g < 4; ++g) red[((kq * 32 + rt * 16 + 4 * fq + g) * (NT * 16)) + n * 16 + fr] = acc[n][g];
}
__device__ __forceinline__ void skinny_att(Frame& F) {
    LAS float* red = (LAS float*)(F.lds + RING_OFF);
    for (int u = F.vcu; u < M / 32; u += F.G) { const int r0 = u * 32;
        skinny_mma<5>(F, F.XB, F.WsmT, r0, red);
        LDS_WAIT(); __syncthreads();
        const int r = F.tid >> 4, q = F.tid & 15, m = r0 + r, t = m % T; const float rs = __builtin_amdgcn_rsqf(F.ss0[m] * (1.f / DM) + EPS);
#define SMV(c) ((red[(0 * 32 + r) * 80 + (c)] + red[(1 * 32 + r) * 80 + (c)] + red[(2 * 32 + r) * 80 + (c)] + red[(3 * 32 + r) * 80 + (c)]) * rs)
        if (q < 8) { const float a = SMV(q), b = SMV(q + 8); const f32x2 cs = F.ROPE_I[t * 8 + q];
            F.KI[(size_t)m * 64 + q] = (bf16)f2bf(a * cs.x - b * cs.y); F.KI[(size_t)m * 64 + q + 8] = (bf16)f2bf(a * cs.y + b * cs.x); }
#pragma unroll
        for (int e = 0; e < 3; ++e) { const int c = 16 + q * 3 + e; F.KI[(size_t)m * 64 + c] = (bf16)f2bf(SMV(c)); }
        F.WI[(size_t)m * 16 + q] = SMV(64 + q) * 0.03125f;
#undef SMV
        LDS_WAIT(); __syncthreads();
    }
}
__device__ __forceinline__ void skinny_gates(Frame& F) {
    LAS float* red = (LAS float*)(F.lds + RING_OFF);
    for (int u = F.vcu; u < M / 32; u += F.G) { const int r0 = u * 32;
        skinny_mma<1>(F, F.XB, F.WgT, r0, red);
        LDS_WAIT(); __syncthreads();
        const int r = F.tid >> 4, c = F.tid & 15, m = r0 + r, b = m / T, t = m - b * T; const float rs = __builtin_amdgcn_rsqf(F.ss2[m] * (1.f / DM) + EPS);
        float g = (red[(0 * 32 + r) * 16 + c] + red[(1 * 32 + r) * 16 + c] + red[(2 * 32 + r) * 16 + c] + red[(3 * 32 + r) * 16 + c]) * rs + F.b_gate[c];
        g = GATE_CAP * tanhf(g * (1.f / GATE_CAP));
        if (c < 8) F.IG[(size_t)(b * MH + c) * T + t] = g;
        else { const float ls = g >= 0.f ? -log1pf(expf(-g)) : g - log1pf(expf(g)); F.LF[(size_t)(b * MH + c - 8) * T + t] = ls; }
        LDS_WAIT(); __syncthreads();
    }
}
__device__ __forceinline__ void unpack8(const v4u w, float* f) { f[0] = bflo(w.x); f[1] = bfhi(w.x); f[2] = bflo(w.y); f[3] = bfhi(w.y); f[4] = bflo(w.z); f[5] = bfhi(w.z); f[6] = bflo(w.w); f[7] = bfhi(w.w); }
__device__ __forceinline__ v4u pack8f(const float* f) { v4u w; w.x = pk2(f[0], f[1]); w.y = pk2(f[2], f[3]); w.z = pk2(f[4], f[5]); w.w = pk2(f[6], f[7]); return w; }
__device__ __forceinline__ void norm_rope32(Frame& F, const bf16* src, bf16* dst, const float* gain, int t, bool active) {
    float y[32]; float s = 0.f;
    if (active) {
#pragma unroll
        for (int j = 0; j < 4; ++j) unpack8(*(const GAS v4u*)(src + 8 * j), y + 8 * j);
    } else {
#pragma unroll
        for (int e = 0; e < 32; ++e) y[e] = 0.f;
    }
#pragma unroll
    for (int e = 0; e < 32; ++e) s += y[e] * y[e];
    s += __shfl_xor(s, 1); s += __shfl_xor(s, 2);
    const float rs = __builtin_amdgcn_rsqf(s * (1.f / 128.f) + EPS); const int d0 = (F.lane & 3) * 32;
    if (active) {
#pragma unroll
        for (int e = 0; e < 32; ++e) y[e] = y[e] * rs * gain[d0 + e];
        if ((F.lane & 3) == 0) {
#pragma unroll
            for (int i = 0; i < 16; ++i) { const f32x2 cs = F.ROPE_A[t * 16 + i]; const float a = y[i], b = y[i + 16]; y[i] = a * cs.x - b * cs.y; y[i + 16] = a * cs.y + b * cs.x; }
        }
#pragma unroll
        for (int j = 0; j < 4; ++j) *(GAS v4u*)(dst + 8 * j) = pack8f(y + 8 * j);
    }
}
__device__ __forceinline__ void p2_prep(Frame& F) {
    const int gw = F.vcu * NWAVES + F.wave, NGW = F.G * NWAVES;
    for (int m = gw; m < M; m += NGW) { const int t = m % T; const bf16* pr = F.PROJ + (size_t)m * ATT_N;
        norm_rope32(F, pr + C_Q + 32 * F.lane, F.Q + (size_t)m * DM + 32 * F.lane, F.q_gain, t, true);
        norm_rope32(F, pr + C_K + 32 * (F.lane & 15), F.K + (size_t)m * 512 + 32 * (F.lane & 15), F.k_gain, t, F.lane < 16);
        *(GAS v4u*)(F.V + (size_t)m * 512 + 8 * F.lane) = *(const GAS v4u*)(pr + C_V + 8 * F.lane);
        float y[16]; unpack8(*(const GAS v4u*)(pr + C_QI + 16 * F.lane), y); unpack8(*(const GAS v4u*)(pr + C_QI + 16 * F.lane + 8), y + 8);
        if ((F.lane & 3) == 0) {
#pragma unroll
            for (int i = 0; i < 8; ++i) { const f32x2 cs = F.ROPE_I[t * 8 + i]; const float a = y[i], b = y[i + 8]; y[i] = a * cs.x - b * cs.y; y[i + 8] = a * cs.y + b * cs.x; }
        }
        *(GAS v4u*)(F.QI + (size_t)m * 1024 + 16 * F.lane) = pack8f(y); *(GAS v4u*)(F.QI + (size_t)m * 1024 + 16 * F.lane + 8) = pack8f(y + 8);
    }
}
template <bool TWO, int ABL = 0> __device__ __forceinline__ void p3a_tiles(Frame& F, int b, size_t m0, int kt, const LAS unsigned char* qrow, int swz, const LAS float* wl, int r32, int hi) {
    bf16x8 ka[4], kb[4];
    { const bf16* kp = F.KI + ((size_t)b * T + 32 * kt + r32) * 64 + hi * 8;
#pragma unroll
      for (int ks = 0; ks < 4; ++ks) { ka[ks] = *(const GAS bf16x8*)(kp + 16 * ks); if (TWO) kb[ks] = *(const GAS bf16x8*)(kp + (size_t)32 * NWAVES * 64 + 16 * ks); } }
    f32x16 sa, sb;
#pragma unroll
    for (int r = 0; r < 16; ++r) { sa[r] = 0.f; sb[r] = 0.f; }
#pragma unroll 2
    for (int h = 0; h < 16; ++h) { f32x16 da, db; const float wh = wl[r32 * 16 + h];
#pragma unroll
        for (int r = 0; r < 16; ++r) { da[r] = 0.f; db[r] = 0.f; }
#pragma unroll
        for (int ks = 0; ks < 4; ++ks) { const bf16x8 q = *(const LAS bf16x8*)(qrow + (((h * 64 + 16 * ks + 8 * hi) * 2) ^ swz));
            da = __builtin_amdgcn_mfma_f32_32x32x16_bf16(ka[ks], q, da, 0, 0, 0); if (TWO) db = __builtin_amdgcn_mfma_f32_32x32x16_bf16(kb[ks], q, db, 0, 0, 0); }
#pragma unroll
        for (int r = 0; r < 16; ++r) { const float xa = da[r]; const int ia = __float_as_int(xa); sa[r] = fmaf(wh, __int_as_float(ia > 0 ? ia : 0), sa[r]);
            if (TWO) { const float xb = db[r]; const int ib = __float_as_int(xb); sb[r] = fmaf(wh, __int_as_float(ib > 0 ? ib : 0), sb[r]); } } }
    LAS float* tsc = (LAS float*)(F.lds + RING_OFF + 69632 + F.wave * 4608);
    const int trow = F.lane >> 1, th = F.lane & 1;
#pragma unroll
    for (int q4 = 0; q4 < 4; ++q4) *(LAS f32x4*)(tsc + r32 * 36 + 8 * q4 + 4 * hi) = (f32x4){sa[4 * q4], sa[4 * q4 + 1], sa[4 * q4 + 2], sa[4 * q4 + 3]};
    if (ABL != 2) { float* dst = F.SC + (m0 + trow) * T + 32 * kt + 16 * th;
#pragma unroll
      for (int q4 = 0; q4 < 4; ++q4) *(GAS f32x4*)(dst + 4 * q4) = *(const LAS f32x4*)(tsc + trow * 36 + 16 * th + 4 * q4); }
    if (TWO) {
#pragma unroll
        for (int q4 = 0; q4 < 4; ++q4) *(LAS f32x4*)(tsc + r32 * 36 + 8 * q4 + 4 * hi) = (f32x4){sb[4 * q4], sb[4 * q4 + 1], sb[4 * q4 + 2], sb[4 * q4 + 3]};
        float* dst = F.SC + (m0 + trow) * T + 32 * (kt + NWAVES) + 16 * th;
        if (ABL != 2) {
#pragma unroll
        for (int q4 = 0; q4 < 4; ++q4) *(GAS f32x4*)(dst + 4 * q4) = *(const LAS f32x4*)(tsc + trow * 36 + 16 * th + 4 * q4); } }
}
template <int ABL = 0> __device__ __forceinline__ void p3a_segment(Frame& F, int b, int i, int kt0, int kt1) {
    LAS unsigned char* qs = F.lds + RING_OFF;
    LAS float* wl = (LAS float*)(F.lds + RING_OFF + 65536);
    const int r32 = F.lane & 31, hi = F.lane >> 5, t0 = 32 * i; const size_t m0 = (size_t)b * T + t0;
#pragma unroll
    for (int k = 0; k < 8; ++k) { const int p = F.tid + 512 * k, row = p >> 7, ch = p & 127;
        v4u v = *(const GAS v4u*)(F.PROJ + (m0 + row) * ATT_N + C_QI + ch * 8);
        v4u o; o.x = (unsigned)__builtin_amdgcn_update_dpp(0, (int)v.x, 0xB1, 0xf, 0xf, false); o.y = (unsigned)__builtin_amdgcn_update_dpp(0, (int)v.y, 0xB1, 0xf, 0xf, false);
        o.z = (unsigned)__builtin_amdgcn_update_dpp(0, (int)v.z, 0xB1, 0xf, 0xf, false); o.w = (unsigned)__builtin_amdgcn_update_dpp(0, (int)v.w, 0xB1, 0xf, 0xf, false);
        if ((ch & 7) < 2) { float a[8], bq[8]; unpack8((ch & 1) ? o : v, a); unpack8((ch & 1) ? v : o, bq); const f32x2* rp = F.ROPE_I + (size_t)(t0 + row) * 8; float y[8];
#pragma unroll
            for (int e = 0; e < 8; ++e) { const f32x2 cs = rp[e]; y[e] = (ch & 1) ? a[e] * cs.y + bq[e] * cs.x : a[e] * cs.x - bq[e] * cs.y; }
            v = pack8f(y); }
        *(LAS v4u*)(qs + row * 2048 + ((ch * 16) ^ ((row & 15) << 4))) = v; }
    wl[F.tid] = F.WI[(m0 + (F.tid >> 4)) * 16 + (F.tid & 15)];
    LDS_WAIT(); __syncthreads();
    const LAS unsigned char* qrow = qs + r32 * 2048; const int swz = (r32 & 15) << 4;
    if (ABL != 1) for (int kt = kt0 + F.wave; kt < kt1; kt += 2 * NWAVES) { const bool two = kt + NWAVES < kt1;
        if (two) p3a_tiles<true, ABL>(F, b, m0, kt, qrow, swz, wl, r32, hi); else p3a_tiles<false, ABL>(F, b, m0, kt, qrow, swz, wl, r32, hi); }
    LDS_WAIT(); __syncthreads();
}
template <int ABL = 0> __device__ __forceinline__ void p3a_scores(Frame& F) {
    { const int gw = F.vcu * NWAVES + F.wave, NGW = F.G * NWAVES;
      for (int m = gw; m < M; m += NGW) { const int t = m % T; const bf16* pr = F.PROJ + (size_t)m * ATT_N;
          norm_rope32(F, pr + C_K + 32 * (F.lane & 15), F.K + (size_t)m * 512 + 32 * (F.lane & 15), F.k_gain, t, F.lane < 16);
          *(GAS v4u*)(F.V + (size_t)m * 512 + 8 * F.lane) = *(const GAS v4u*)(pr + C_V + 8 * F.lane); } }
    for (int c = F.vcu; c < 256; c += F.G) { const int p = c >> 1, b = p >> 5, i = p & 31;
        if ((c & 1) == 0) p3a_segment<ABL>(F, b, 63 - i, 0, 32);
        else { p3a_segment<ABL>(F, b, 63 - i, 32, 64 - i); p3a_segment<ABL>(F, b, i, 0, i + 1); } }
}
__device__ __forceinline__ void p3b_select(Frame& F) {
    LAS unsigned* hist = (LAS unsigned*)(F.lds + RING_OFF + F.wave * 8192);
    const int gw = F.vcu * NWAVES + F.wave, NGW = F.G * NWAVES, rep = F.lane & 7;
    float sn[32];
#define ROW_OF(e_, t_, m_) const int bb_ = (e_) / T, tt_ = (e_) - bb_ * T, t_ = (bb_ & 1) ? T - 1 - tt_ : tt_, m_ = bb_ * T + t_
#define ROW_LOAD(e_) do { ROW_OF(e_, tl_, ml_); const float* sr_ = F.SC + (size_t)ml_ * T;                                             \
        _Pragma("unroll") for (int j = 0; j < 32; ++j) { const int s = F.lane + 64 * j; sn[j] = __builtin_nontemporal_load(sr_ + (s < tl_ ? s : tl_)); } } while (0)
    if (gw < M) ROW_LOAD(gw);
    for (int e = gw; e < M; e += NGW) { ROW_OF(e, t, m); const int nj = (t >> 6) + 1;
            unsigned k[32];
#pragma unroll
            for (int j = 0; j < 32; ++j) { const int s = F.lane + 64 * j; k[j] = fkey(s <= t ? sn[j] : -__builtin_inff()); }
            if (e + NGW < M) ROW_LOAD(e + NGW);
            unsigned P = 0;
            if (t + 1 > TOPK) { unsigned need = TOPK;
#pragma unroll 1
                for (int p = 0; p < 4; ++p) { const int sh = 24 - 8 * p; const unsigned hmask = p ? (0xffffffffu << (sh + 8)) : 0u;
#pragma unroll
                    for (int z = 0; z < 8; ++z) *(LAS v4u*)(hist + 4 * (F.lane + 64 * z)) = (v4u){0u, 0u, 0u, 0u};
#pragma unroll
                    for (int j = 0; j < 32; ++j) if (j < nj) { if (((k[j] ^ P) & hmask) == 0u) __hip_atomic_fetch_add(hist + (((k[j] >> sh) & 255u) * 8u + rep), 1u, __ATOMIC_RELAXED, __HIP_MEMORY_SCOPE_WORKGROUP); }
                    v4u hb;
                    { const LAS v4u* hp = (const LAS v4u*)(hist + 32 * F.lane);
                      const v4u r0 = hp[0], r1 = hp[1], r2 = hp[2], r3 = hp[3], r4 = hp[4], r5 = hp[5], r6 = hp[6], r7 = hp[7];
                      hb.x = (r0.x + r0.y + r0.z + r0.w) + (r1.x + r1.y + r1.z + r1.w); hb.y = (r2.x + r2.y + r2.z + r2.w) + (r3.x + r3.y + r3.z + r3.w);
                      hb.z = (r4.x + r4.y + r4.z + r4.w) + (r5.x + r5.y + r5.z + r5.w); hb.w = (r6.x + r6.y + r6.z + r6.w) + (r7.x + r7.y + r7.z + r7.w); }
                    const unsigned s4 = hb.x + hb.y + hb.z + hb.w;
                    unsigned ps = s4;
                    ps += (unsigned)__builtin_amdgcn_update_dpp(0, (int)ps, 0x111, 0xf, 0xf, false); ps += (unsigned)__builtin_amdgcn_update_dpp(0, (int)ps, 0x112, 0xf, 0xf, false);
                    ps += (unsigned)__builtin_amdgcn_update_dpp(0, (int)ps, 0x114, 0xf, 0xf, false); ps += (unsigned)__builtin_amdgcn_update_dpp(0, (int)ps, 0x118, 0xf, 0xf, false);
                    ps += (unsigned)__builtin_amdgcn_update_dpp(0, (int)ps, 0x142, 0xa, 0xf, false); ps += (unsigned)__builtin_amdgcn_update_dpp(0, (int)ps, 0x143, 0xc, 0xf, false);
                    const unsigned total = (unsigned)__builtin_amdgcn_readlane((int)ps, 63), above = total - ps;
                    const u64 bm = __ballot(above < need && need <= above + s4); const int src = __builtin_ctzll(bm);
                    const unsigned a3 = above + hb.w, a2 = a3 + hb.z, a1 = a2 + hb.y;
                    unsigned dig, gt, cb;
                    if (need <= a3) { dig = 3; gt = above; cb = hb.w; } else if (need <= a2) { dig = 2; gt = a3; cb = hb.z; } else if (need <= a1) { dig = 1; gt = a2; cb = hb.y; } else { dig = 0; gt = a1; cb = hb.x; }
                    dig += 4u * F.lane;
                    dig = (unsigned)__builtin_amdgcn_readlane((int)dig, src); gt = (unsigned)__builtin_amdgcn_readlane((int)gt, src); cb = (unsigned)__builtin_amdgcn_readlane((int)cb, src);
                    P |= dig << sh; need -= gt;
                    if (need == cb) break; } }
            u64 myw = 0;
#pragma unroll
            for (int j = 0; j < 32; ++j) { const int s = F.lane + 64 * j; const u64 w = __ballot(k[j] >= P && s <= t); if (F.lane == j) myw = w; }
            if (F.lane < 32) F.MASK[(size_t)m * 32 + F.lane] = myw;
    }
#undef ROW_OF
#undef ROW_LOAD
}
#ifndef IDX_FUSED
#define IDX_FUSED 0
#endif
__device__ __forceinline__ unsigned radix_select(const unsigned (&k)[32], int nj, int lane, LAS unsigned* hist) {
    unsigned P = 0, need = TOPK;
#pragma unroll 1
    for (int p = 0; p < 4; ++p) { const int sh = 24 - 8 * p; const unsigned hmask = p ? (0xffffffffu << (sh + 8)) : 0u;
        *(LAS v4u*)(hist + 4 * lane) = (v4u){0u, 0u, 0u, 0u};
#pragma unroll
        for (int j = 0; j < 32; ++j) if (j < nj) { if (((k[j] ^ P) & hmask) == 0u) __hip_atomic_fetch_add(hist + ((k[j] >> sh) & 255u), 1u, __ATOMIC_RELAXED, __HIP_MEMORY_SCOPE_WORKGROUP); }
        const v4u hb = *(const LAS v4u*)(hist + 4 * lane);
        const unsigned s4 = hb.x + hb.y + hb.z + hb.w;
        unsigned ps = s4;
        ps += (unsigned)__builtin_amdgcn_update_dpp(0, (int)ps, 0x111, 0xf, 0xf, false); ps += (unsigned)__builtin_amdgcn_update_dpp(0, (int)ps, 0x112, 0xf, 0xf, false);
        ps += (unsigned)__builtin_amdgcn_update_dpp(0, (int)ps, 0x114, 0xf, 0xf, false); ps += (unsigned)__builtin_amdgcn_update_dpp(0, (int)ps, 0x118, 0xf, 0xf, false);
        ps += (unsigned)__builtin_amdgcn_update_dpp(0, (int)ps, 0x142, 0xa, 0xf, false); ps += (unsigned)__builtin_amdgcn_update_dpp(0, (int)ps, 0x143, 0xc, 0xf, false);
        const unsigned total = (unsigned)__builtin_amdgcn_readlane((int)ps, 63), above = total - ps;
        const u64 bm = __ballot(above < need && need <= above + s4); const int src = __builtin_ctzll(bm);
        const unsigned a3 = above + hb.w, a2 = a3 + hb.z, a1 = a2 + hb.y;
        unsigned dig, gt;
        if (need <= a3) { dig = 3; gt = above; } else if (need <= a2) { dig = 2; gt = a3; } else if (need <= a1) { dig = 1; gt = a2; } else { dig = 0; gt = a1; }
        dig += 4u * lane;
        dig = (unsigned)__builtin_amdgcn_readlane((int)dig, src); gt = (unsigned)__builtin_amdgcn_readlane((int)gt, src);
        P |= dig << sh; need -= gt; }
    return P;
}
__device__ __forceinline__ void p3f_tile(Frame& F, int b, int ti) {
    constexpr int SROW = 2052;
    LAS float* SCL = (LAS float*)(F.lds + RING_OFF);
    LAS unsigned* hist = (LAS unsigned*)(F.lds + RING_OFF + 16 * SROW * 4 + F.wave * 1024);
    static_assert(16 * SROW * 4 + 8 * 1024 <= RING_BYTES, "fused indexer LDS");
    const int lane = F.lane, c16 = lane & 15, kq = lane >> 4, t0 = 16 * ti; const size_t m0 = (size_t)b * T + t0;
#pragma unroll 1
    for (int hh = 0; hh < 2; ++hh) {
        bf16x8 qf[8][2]; float wv[8];
        { const bf16* qp = F.PROJ + (m0 + c16) * ATT_N + C_QI + hh * 512 + 8 * kq; const f32x2* rp = F.ROPE_I + (size_t)(t0 + c16) * 8;
          f32x2 cs[8];
#pragma unroll
          for (int e = 0; e < 8; ++e) cs[e] = rp[e];
#pragma unroll
          for (int h = 0; h < 8; ++h) { v4u v0 = *(const GAS v4u*)(qp + h * 64), v1 = *(const GAS v4u*)(qp + h * 64 + 32);
              v4u o; o.x = (unsigned)__shfl_xor((int)v0.x, 16); o.y = (unsigned)__shfl_xor((int)v0.y, 16); o.z = (unsigned)__shfl_xor((int)v0.z, 16); o.w = (unsigned)__shfl_xor((int)v0.w, 16);
              if (kq < 2) { float a[8], bq[8], y[8]; unpack8(kq ? o : v0, a); unpack8(kq ? v0 : o, bq);
#pragma unroll
                  for (int e = 0; e < 8; ++e) y[e] = kq ? a[e] * cs[e].y + bq[e] * cs[e].x : a[e] * cs[e].x - bq[e] * cs[e].y;
                  v0 = pack8f(y); }
              qf[h][0] = *reinterpret_cast<bf16x8*>(&v0); qf[h][1] = *reinterpret_cast<bf16x8*>(&v1); }
          const float* wp = F.WI + (m0 + c16) * 16 + hh * 8;
#pragma unroll
          for (int h4 = 0; h4 < 2; ++h4) { const f32x4 w4 = *(const GAS f32x4*)(wp + 4 * h4); wv[4 * h4] = w4.x; wv[4 * h4 + 1] = w4.y; wv[4 * h4 + 2] = w4.z; wv[4 * h4 + 3] = w4.w; } }
        bf16x8 a0, a1, n0, n1;
        { const int kt = F.wave; if (kt <= ti) { const bf16* kp = F.KI + ((size_t)b * T + 16 * kt + c16) * 64 + 8 * kq; n0 = *(const GAS bf16x8*)kp; n1 = *(const GAS bf16x8*)(kp + 32); } }
        for (int kt = F.wave; kt <= ti; kt += NWAVES) { const int s0 = 16 * kt;
            a0 = n0; a1 = n1;
            if (kt + NWAVES <= ti) { const bf16* kp = F.KI + ((size_t)b * T + 16 * (kt + NWAVES) + c16) * 64 + 8 * kq; n0 = *(const GAS bf16x8*)kp; n1 = *(const GAS bf16x8*)(kp + 32); }
            LAS f32x4* dst = (LAS f32x4*)(SCL + c16 * SROW + s0 + 4 * kq);
            f32x4 sc = (f32x4){0.f, 0.f, 0.f, 0.f}; if (hh) sc = *dst;
#pragma unroll
            for (int h = 0; h < 8; ++h) { f32x4 d = __builtin_amdgcn_mfma_f32_16x16x32_bf16(a0, qf[h][0], (f32x4){0.f, 0.f, 0.f, 0.f}, 0, 0, 0); d = __builtin_amdgcn_mfma_f32_16x16x32_bf16(a1, qf[h][1], d, 0, 0, 0);
                sc += __builtin_elementwise_max(d, (f32x4){0.f, 0.f, 0.f, 0.f}) * wv[h]; }
            *dst = sc;
        }
    }
    LDS_WAIT(); __syncthreads();
#pragma unroll 1
    for (int rr = 0; rr < 2; ++rr) { const int row = 2 * F.wave + rr, t = t0 + row, nj = (t >> 6) + 1; const LAS float* srow = SCL + row * SROW;
        unsigned k[32];
#pragma unroll
        for (int j = 0; j < 32; ++j) { const int s = lane + 64 * j; k[j] = fkey(s <= t ? srow[s] : -__builtin_inff()); }
        unsigned P = 0;
        if (t + 1 > TOPK) P = radix_select(k, nj, lane, hist);
        u64 myw = 0;
#pragma unroll
        for (int j = 0; j < 32; ++j) { const int s = lane + 64 * j; const u64 w = __ballot(k[j] >= P && s <= t); if (lane == j) myw = w; }
        if (lane < 32) F.MASK[(m0 + row) * 32 + lane] = myw;
    }
    LDS_WAIT(); __syncthreads();
}
__device__ __forceinline__ void p3_fused(Frame& F) {
    { const int gw = F.vcu * NWAVES + F.wave, NGW = F.G * NWAVES;
      for (int m = gw; m < M; m += NGW) { const int t = m % T; const bf16* pr = F.PROJ + (size_t)m * ATT_N;
          norm_rope32(F, pr + C_K + 32 * (F.lane & 15), F.K + (size_t)m * 512 + 32 * (F.lane & 15), F.k_gain, t, F.lane < 16);
          *(GAS v4u*)(F.V + (size_t)m * 512 + 8 * F.lane) = *(const GAS v4u*)(pr + C_V + 8 * F.lane); } }
    for (int u = F.vcu; u < 256; u += F.G) { const int b = u >> 6, i = u & 63; p3f_tile(F, b, 127 - i); p3f_tile(F, b, i); }
}
namespace att {
constexpr int D = 128, NW = 8, QBLK = 32, KVBLK = 64;
constexpr float SCALE = 0.088388347648318440f;
constexpr int LDQ = ATT_N, LDK = 512, LDO = DM;
constexpr int SHM_V = KVBLK * D * 2, SHM_K = KVBLK * D * 2, SHM_MASK = 2 * SHM_V + 2 * SHM_K + NW * 64 * 4, MROW = 33 * 8, SHM_ATTN = SHM_MASK + 256 * MROW;
#define KSWZ(row, colB) ((row) * 256 + ((colB) ^ (((row) & 7) << 4)))
#define SBAR() __builtin_amdgcn_sched_barrier(0)
__device__ __forceinline__ int crow(int r, int hi) { return (r & 3) + 8 * (r >> 2) + 4 * hi; }
__device__ __forceinline__ unsigned cvtpk(float lo, float hi) { unsigned r; asm volatile("v_cvt_pk_bf16_f32 %0, %1, %2" : "=v"(r) : "v"(lo), "v"(hi)); return r; }
__device__ __forceinline__ void partialSM(f32x16& p0, f32x16& p1) {
  for (int r = 0; r < 16; ++r) p0[r] = __builtin_amdgcn_exp2f(p0[r]);
}
__device__ __forceinline__ void finishSM(f32x16& p0, f32x16& p1, float& l_reg, bf16x8& pa0, bf16x8& pa1, bf16x8& pa2, bf16x8& pa3) {
  for (int r = 0; r < 16; ++r) p1[r] = __builtin_amdgcn_exp2f(p1[r]);
  float ps = 0; for (int r = 0; r < 16; ++r) ps += p0[r]; for (int r = 0; r < 16; ++r) ps += p1[r];
  { auto rr = __builtin_amdgcn_permlane32_swap(__float_as_uint(ps), __float_as_uint(ps), false, false);
    ps = __uint_as_float(rr[0]) + __uint_as_float(rr[1]); }
  l_reg += ps;
#define PK4(P, BASE, OUT) do { unsigned a0 = cvtpk(P[BASE + 0], P[BASE + 1]), a1 = cvtpk(P[BASE + 2], P[BASE + 3]);   \
    unsigned b0 = cvtpk(P[BASE + 4], P[BASE + 5]), b1 = cvtpk(P[BASE + 6], P[BASE + 7]);                              \
    auto r0 = __builtin_amdgcn_permlane32_swap(a0, b0, false, false); auto r1 = __builtin_amdgcn_permlane32_swap(a1, b1, false, false); \
    v4u w = {r0[0], r1[0], r0[1], r1[1]}; OUT = *reinterpret_cast<bf16x8*>(&w); } while (0)
  PK4(p0, 0, pa0); PK4(p0, 8, pa1); PK4(p1, 0, pa2); PK4(p1, 8, pa3);
#undef PK4
}
__device__ __forceinline__ void qkt(f32x16& p0, f32x16& p1, const bf16* Ks, const bf16x8* qr, int r32, int hi, unsigned mlo, unsigned mhi, float negm) {
  const unsigned nlo = ~mlo >> (4 * hi), nhi = ~mhi >> (4 * hi), nb = __float_as_uint(negm);
#pragma unroll
  for (int g = 0; g < 4; ++g) { const unsigned a0 = nlo << (27 - 8 * g), b0 = nlo << (26 - 8 * g), a1 = nhi << (27 - 8 * g), b1 = nhi << (26 - 8 * g);
    p0[4 * g + 0] = __uint_as_float((a0 & 0x08000000u) | nb); p0[4 * g + 1] = __uint_as_float((a0 & 0x10000000u) | nb); p0[4 * g + 2] = __uint_as_float((a0 & 0x20000000u) | nb); p0[4 * g + 3] = __uint_as_float((b0 & 0x20000000u) | nb);
    p1[4 * g + 0] = __uint_as_float((a1 & 0x08000000u) | nb); p1[4 * g + 1] = __uint_as_float((a1 & 0x10000000u) | nb); p1[4 * g + 2] = __uint_as_float((a1 & 0x20000000u) | nb); p1[4 * g + 3] = __uint_as_float((b1 & 0x20000000u) | nb); }
#pragma unroll
  for (int d0 = 0; d0 < 8; ++d0) { int cb = (d0 * 16 + hi * 8) * 2;
    bf16x8 b0 = *reinterpret_cast<const bf16x8*>((const char*)Ks + KSWZ(r32, cb));
    bf16x8 b1 = *reinterpret_cast<const bf16x8*>((const char*)Ks + KSWZ(32 + r32, cb));
    p0 = __builtin_amdgcn_mfma_f32_32x32x16_bf16(b0, qr[d0], p0, 0, 0, 0);
    p1 = __builtin_amdgcn_mfma_f32_32x32x16_bf16(b1, qr[d0], p1, 0, 0, 0); }
}
__device__ __forceinline__ int v_st(int k, int c) { const int kk = (k & ~0xC) | ((k & 4) << 1) | ((k & 8) >> 1); return ((kk >> 3) * 4 + (c >> 5)) * 512 + ((kk & 7) * 32 + (c & 31)) * 2; }
__device__ __forceinline__ int v_rd_base(int lane) { return ((lane & 3) << 3) | (((lane >> 2) & 3) << 6) | (((lane >> 4) & 1) << 5) | (((lane >> 5) & 1) << 8); }
constexpr int v_rd_off(int d0, int ks, int half) { return d0 * 512 + ks * 4096 + half * 2048; }
template <int OFF> __device__ __forceinline__ s16x4 tr_read(int vb) {
  s16x4 r; asm volatile("ds_read_b64_tr_b16 %0, %1 offset:%2" : "=&v"(r) : "v"(vb), "i"(OFF) : "memory"); return r;
}
template <int D0> __device__ __forceinline__ void pv_one(f32x16& od, int vb, bf16x8 pa0, bf16x8 pa1, bf16x8 pa2, bf16x8 pa3) {
  const s16x4 l0 = tr_read<v_rd_off(D0, 0, 0)>(vb), h0 = tr_read<v_rd_off(D0, 0, 1)>(vb), l1 = tr_read<v_rd_off(D0, 1, 0)>(vb), h1 = tr_read<v_rd_off(D0, 1, 1)>(vb);
  const s16x4 l2 = tr_read<v_rd_off(D0, 2, 0)>(vb), h2 = tr_read<v_rd_off(D0, 2, 1)>(vb), l3 = tr_read<v_rd_off(D0, 3, 0)>(vb), h3 = tr_read<v_rd_off(D0, 3, 1)>(vb);
  asm volatile("s_waitcnt lgkmcnt(0)" ::: "memory"); SBAR();
#define PK(L, H) (bf16x8){L[0], L[1], L[2], L[3], H[0], H[1], H[2], H[3]}
  od = __builtin_amdgcn_mfma_f32_32x32x16_bf16(pa0, PK(l0, h0), od, 0, 0, 0);
  od = __builtin_amdgcn_mfma_f32_32x32x16_bf16(pa1, PK(l1, h1), od, 0, 0, 0);
  od = __builtin_amdgcn_mfma_f32_32x32x16_bf16(pa2, PK(l2, h2), od, 0, 0, 0);
  od = __builtin_amdgcn_mfma_f32_32x32x16_bf16(pa3, PK(l3, h3), od, 0, 0, 0);
#undef PK
}
__device__ __forceinline__ void pv_d0(f32x16* o, int vb, bf16x8 pa0, bf16x8 pa1, bf16x8 pa2, bf16x8 pa3) {
  pv_one<0>(o[0], vb, pa0, pa1, pa2, pa3); pv_one<1>(o[1], vb, pa0, pa1, pa2, pa3); pv_one<2>(o[2], vb, pa0, pa1, pa2, pa3); pv_one<3>(o[3], vb, pa0, pa1, pa2, pa3);
}
__device__ __forceinline__ void attn_body(const bf16* __restrict__ Qb, const bf16* __restrict__ Kh, const bf16* __restrict__ Vh, bf16* __restrict__ Ob, const u64* __restrict__ mrow, int seq, char* lds,
                                          const float* __restrict__ qgain, const float* __restrict__ kgain, const f32x2* __restrict__ ropeA, int tpos0) {
  const int tid = opaque_tid(), wid = tid >> 6, lane = tid & 63, r32 = lane & 31, hi = lane >> 5;
  bf16* V_lds = (bf16*)lds; bf16* K_lds = (bf16*)(lds + 2 * SHM_V);
  float* ws = (float*)(lds + 2 * SHM_V + 2 * SHM_K) + wid * 64; float* li_l = ws;
  float l_reg = 0, negmC; f32x16 o[4] = {}; bf16x8 qr[8];
  const bf16* Qw = Qb + (long)(wid * QBLK + r32) * LDQ + hi * 8;
  { float x[64]; float s = 0.f;
#pragma unroll
    for (int d0 = 0; d0 < 8; ++d0) unpack8(*reinterpret_cast<const v4u*>(Qw + d0 * 16), x + 8 * d0);
#pragma unroll
    for (int e = 0; e < 64; ++e) s += x[e] * x[e];
    { auto rr = __builtin_amdgcn_permlane32_swap(__float_as_uint(s), __float_as_uint(s), false, false); s = __uint_as_float(rr[0]) + __uint_as_float(rr[1]); }
    const float rs = __builtin_amdgcn_rsqf(s * (1.f / 128.f) + EPS) * (SCALE * 1.4426950408889634f);
#pragma unroll
    for (int d0 = 0; d0 < 8; ++d0) { const f32x4 g0 = *(const f32x4*)(qgain + 16 * d0 + 8 * hi), g1 = *(const f32x4*)(qgain + 16 * d0 + 8 * hi + 4);
        x[8 * d0 + 0] *= rs * g0.x; x[8 * d0 + 1] *= rs * g0.y; x[8 * d0 + 2] *= rs * g0.z; x[8 * d0 + 3] *= rs * g0.w; x[8 * d0 + 4] *= rs * g1.x; x[8 * d0 + 5] *= rs * g1.y; x[8 * d0 + 6] *= rs * g1.z; x[8 * d0 + 7] *= rs * g1.w; }
    const f32x2* rp = ropeA + (size_t)(tpos0 + wid * QBLK + r32) * 16 + 8 * hi;
#pragma unroll
    for (int e = 0; e < 8; ++e) { const f32x2 cs = rp[e]; const float a = x[e], bq = x[8 + e]; x[e] = a * cs.x - bq * cs.y; x[8 + e] = a * cs.y + bq * cs.x; }
    { float q2 = 0.f, g2;
#pragma unroll
      for (int e = 0; e < 64; ++e) q2 += x[e] * x[e];
      { auto rr = __builtin_amdgcn_permlane32_swap(__float_as_uint(q2), __float_as_uint(q2), false, false); q2 = __uint_as_float(rr[0]) + __uint_as_float(rr[1]); }
      { const f32x2 kg = *(const f32x2*)(kgain + 2 * lane); g2 = fmaxf(kg.x * kg.x, kg.y * kg.y); }
#pragma unroll
      for (int sh = 1; sh < 64; sh <<= 1) g2 = fmaxf(g2, __shfl_xor(g2, sh));
      negmC = -fminf(fmaxf(1.02f * __builtin_sqrtf(q2 * g2 * 128.f), 2.f), 65000.f); }
#pragma unroll
    for (int d0 = 0; d0 < 8; ++d0) { v4u w = pack8f(x + 8 * d0); qr[d0] = *reinterpret_cast<bf16x8*>(&w); } }
  const char* mw = lds + SHM_MASK + (wid * QBLK + r32) * MROW;
  const int sr = tid >> 4, sc = (tid & 15) * 8, vst0 = v_st(sr, sc), vst1 = v_st(32 + sr, sc);
  const int vb0 = (int)(uintptr_t)V_lds + v_rd_base(lane);
  constexpr int SDEPTH = 2;
  struct { bf16x8 vs0, vs1, ks0, ks1; } sr_[SDEPTH];
#define SLOAD(i, k0) do { sr_[i].vs0 = *reinterpret_cast<const bf16x8*>(&Vh[(long)((k0) + sr) * LDK + sc]); sr_[i].vs1 = *reinterpret_cast<const bf16x8*>(&Vh[(long)((k0) + 32 + sr) * LDK + sc]); \
    sr_[i].ks0 = *reinterpret_cast<const bf16x8*>(&Kh[(long)((k0) + sr) * LDK + sc]); sr_[i].ks1 = *reinterpret_cast<const bf16x8*>(&Kh[(long)((k0) + 32 + sr) * LDK + sc]); } while (0)
#define SWRITE(b, i) do { *(bf16x8*)((char*)V_lds + (b) * SHM_V + vst0) = sr_[i].vs0;          \
    *(bf16x8*)((char*)V_lds + (b) * SHM_V + vst1) = sr_[i].vs1; int kc = sc * 2;               \
    *(bf16x8*)((char*)K_lds + (b) * SHM_K + KSWZ(sr, kc)) = sr_[i].ks0;                       \
    *(bf16x8*)((char*)K_lds + (b) * SHM_K + KSWZ(32 + sr, kc)) = sr_[i].ks1; } while (0)
#define SWAIT() do { if constexpr (SDEPTH == 2) asm volatile("s_waitcnt vmcnt(4)" ::: "memory"); else asm volatile("s_waitcnt vmcnt(0)" ::: "memory"); } while (0)
  f32x16 pA0, pA1, pB0, pB1; bf16x8 pa0, pa1, pa2, pa3; const int NT = seq / KVBLK;
  constexpr int SE = 0, SO = SDEPTH - 1;
  { const int NTw = seq / KVBLK; for (int e = tid; e < 256 * NTw; e += 512) { const int row = e / NTw, j = e - row * NTw; *(u64*)(lds + SHM_MASK + row * MROW + j * 8) = mrow[(size_t)row * 32 + j]; } }
#define MK(j) (*(const v2u*)(mw + (j) * 8))
  v2u mk;
  SLOAD(SE, 0); asm volatile("s_waitcnt vmcnt(0)" ::: "memory"); SWRITE(0, SE); __syncthreads();
  mk = MK(0); qkt(pA0, pA1, K_lds, qr, r32, hi, mk.x, mk.y, negmC); partialSM(pA0, pA1);
  SLOAD(SO, KVBLK); if constexpr (SDEPTH == 2) { if (2 < NT) SLOAD(SE, 2 * KVBLK); }
  SWAIT(); SWRITE(1, SO); __syncthreads();
  for (int j = 1; j + 1 < NT; j += 2) {
    SBAR(); mk = MK(j); qkt(pB0, pB1, (bf16*)((char*)K_lds + SHM_K), qr, r32, hi, mk.x, mk.y, negmC);
    finishSM(pA0, pA1, l_reg, pa0, pa1, pa2, pa3); SBAR();
    SLOAD(SO, (j + SDEPTH) * KVBLK); SBAR();
    pv_d0(o, vb0, pa0, pa1, pa2, pa3); partialSM(pB0, pB1);
    __syncthreads(); SWAIT(); SWRITE(0, SE);
    __syncthreads();
    SBAR(); mk = MK(j + 1); qkt(pA0, pA1, K_lds, qr, r32, hi, mk.x, mk.y, negmC);
    finishSM(pB0, pB1, l_reg, pa0, pa1, pa2, pa3); SBAR();
    if (SDEPTH == 1 || j + 3 < NT) SLOAD(SE, (j + 1 + SDEPTH) * KVBLK); SBAR();
    pv_d0(o, vb0 + (int)SHM_V, pa0, pa1, pa2, pa3); partialSM(pA0, pA1);
    __syncthreads(); SWAIT(); SWRITE(1, SO);
    __syncthreads();
  }
  SBAR(); mk = MK(NT - 1); qkt(pB0, pB1, (bf16*)((char*)K_lds + SHM_K), qr, r32, hi, mk.x, mk.y, negmC);
  finishSM(pA0, pA1, l_reg, pa0, pa1, pa2, pa3); SBAR();
  pv_d0(o, vb0, pa0, pa1, pa2, pa3); partialSM(pB0, pB1);
  __syncthreads();
  finishSM(pB0, pB1, l_reg, pa0, pa1, pa2, pa3); SBAR();
  pv_d0(o, vb0 + (int)SHM_V, pa0, pa1, pa2, pa3);
  if (hi == 0) li_l[r32] = l_reg; asm volatile("s_waitcnt lgkmcnt(0)" ::: "memory");
  float rli[16];
#pragma unroll
  for (int r = 0; r < 16; ++r) rli[r] = __builtin_amdgcn_rcpf(li_l[crow(r, hi)]);
  bf16* Ow = Ob + (long)(wid * QBLK) * LDO;
#pragma unroll
  for (int r = 0; r < 16; ++r) { const int orow = crow(r, hi);
#pragma unroll
    for (int d0 = 0; d0 < 4; ++d0) { const float v = o[d0][r] * rli[r]; const float vn = __shfl_xor(v, 1);
      if ((r32 & 1) == 0) *(unsigned*)(Ow + (long)orow * LDO + d0 * 32 + r32) = cvtpk(v, vn); } }
#undef MK
#undef SLOAD
#undef SWRITE
#undef SWAIT
}
#undef KSWZ
#undef SBAR
}
__device__ __forceinline__ void p4_attention(Frame& F, char* lds) {
    static_assert(att::SHM_ATTN <= RING_BYTES, "attention LDS");
    for (int it = F.vcu; it < 256; it += F.G) { const int grp = it >> 4, b = grp >> 2, g = grp & 3, h = g * 4 + ((it >> 2) & 3), x = it & 3;
        for (int pass = 0; pass < 2; ++pass) { const int qb = pass ? x : 7 - x; const size_t row0 = (size_t)b * T + (size_t)qb * 256;
            att::attn_body(F.PROJ + row0 * ATT_N + C_Q + h * HD, F.K + (size_t)b * T * 512 + g * HD, F.V + (size_t)b * T * 512 + g * HD, F.O + row0 * DM + h * HD, F.MASK + row0 * 32, 256 * (qb + 1), lds, F.q_gain, F.k_gain, F.ROPE_A, qb * 256);
            __syncthreads(); } }
}
namespace ml {
constexpr int QS = 0, KS = 16384, VS = 32768, PF = 65536, HS = 73728, HROW = 528, MISC = HS + 64 * HROW, PW = MISC + 2048, PWB = 1536, LDS_END_B = PW + 8 * PWB;
constexpr int A_KP = 0, A_VS = 16384, A_BUF = 49152, A_WK = 2 * A_BUF, A_B = A_WK + 8192, A_U = A_B + 8192, A_M = A_U + 8192, A_CH = A_M + 8192, LDS_END_A = A_CH + 1024;
#define SW16(row, colB) ((row) * 256 + ((colB) ^ (((row) & 15) << 4)))
#define SBAR() __builtin_amdgcn_sched_barrier(0)
#define MBAR() do { asm volatile("s_waitcnt lgkmcnt(0)" ::: "memory"); __builtin_amdgcn_s_barrier(); asm volatile("" ::: "memory"); } while (0)
using att::crow; using att::cvtpk; using att::v_st; using att::v_rd_base; using att::tr_read;
__device__ __forceinline__ bf16x8 pk88(const s16x4 l, const s16x4 h) { return (bf16x8){l[0], l[1], l[2], l[3], h[0], h[1], h[2], h[3]}; }
__device__ __forceinline__ bf16x8 pack_acc8(const f32x16& x, int s8) { v4u w = {cvtpk(x[s8 + 0], x[s8 + 1]), cvtpk(x[s8 + 2], x[s8 + 3]), cvtpk(x[s8 + 4], x[s8 + 5]), cvtpk(x[s8 + 6], x[s8 + 7])}; return *reinterpret_cast<bf16x8*>(&w); }
__device__ __forceinline__ v4u wmul8(const v4u k, float w) { v4u o; o.x = cvtpk(bflo(k.x) * w, bfhi(k.x) * w); o.y = cvtpk(bflo(k.y) * w, bfhi(k.y) * w); o.z = cvtpk(bflo(k.z) * w, bfhi(k.z) * w); o.w = cvtpk(bflo(k.w) * w, bfhi(k.w) * w); return o; }
template <int CTRL, int ROWMASK> __device__ __forceinline__ float dppf(float old, float src) {
    return __builtin_bit_cast(float, __builtin_amdgcn_update_dpp(__builtin_bit_cast(int, old), __builtin_bit_cast(int, src), CTRL, ROWMASK, 0xf, false)); }
__device__ __forceinline__ float wave_sum_dpp(float v) {
    v += dppf<0xB1, 0xf>(0.f, v); v += dppf<0x4E, 0xf>(0.f, v); v += dppf<0x141, 0xf>(0.f, v); v += dppf<0x140, 0xf>(0.f, v);
    const int iv = __builtin_bit_cast(int, v);
    return (__builtin_bit_cast(float, __builtin_amdgcn_readlane(iv, 0)) + __builtin_bit_cast(float, __builtin_amdgcn_readlane(iv, 16))) +
           (__builtin_bit_cast(float, __builtin_amdgcn_readlane(iv, 32)) + __builtin_bit_cast(float, __builtin_amdgcn_readlane(iv, 48)));
}
__device__ __forceinline__ float scan_sum64(float x) {
    x += dppf<0x111, 0xf>(0.f, x); x += dppf<0x112, 0xf>(0.f, x); x += dppf<0x114, 0xf>(0.f, x); x += dppf<0x118, 0xf>(0.f, x);
    x += dppf<0x142, 0xa>(0.f, x); x += dppf<0x143, 0xc>(0.f, x); return x;
}
__device__ __forceinline__ float scan_max64(float x) {
    const float NI = -__builtin_inff();
    x = fmaxf(x, dppf<0x111, 0xf>(NI, x)); x = fmaxf(x, dppf<0x112, 0xf>(NI, x)); x = fmaxf(x, dppf<0x114, 0xf>(NI, x)); x = fmaxf(x, dppf<0x118, 0xf>(NI, x));
    x = fmaxf(x, dppf<0x142, 0xa>(NI, x)); x = fmaxf(x, dppf<0x143, 0xc>(NI, x)); return x;
}
template <int I> __device__ __forceinline__ void cupd(f32x16& Xi, int vbK, const bf16x8 (&vB)[4]) {
    const s16x4 l0 = tr_read<I * 512 + 0 * 4096>(vbK), h0 = tr_read<I * 512 + 0 * 4096 + 2048>(vbK), l1 = tr_read<I * 512 + 1 * 4096>(vbK), h1 = tr_read<I * 512 + 1 * 4096 + 2048>(vbK);
    const s16x4 l2 = tr_read<I * 512 + 2 * 4096>(vbK), h2 = tr_read<I * 512 + 2 * 4096 + 2048>(vbK), l3 = tr_read<I * 512 + 3 * 4096>(vbK), h3 = tr_read<I * 512 + 3 * 4096 + 2048>(vbK);
    asm volatile("s_waitcnt lgkmcnt(0)" ::: "memory"); SBAR();
    Xi = __builtin_amdgcn_mfma_f32_32x32x16_bf16(pk88(l0, h0), vB[0], Xi, 0, 0, 0);
    Xi = __builtin_amdgcn_mfma_f32_32x32x16_bf16(pk88(l1, h1), vB[1], Xi, 0, 0, 0);
    Xi = __builtin_amdgcn_mfma_f32_32x32x16_bf16(pk88(l2, h2), vB[2], Xi, 0, 0, 0);
    Xi = __builtin_amdgcn_mfma_f32_32x32x16_bf16(pk88(l3, h3), vB[3], Xi, 0, 0, 0);
}
template <int I> __device__ __forceinline__ void yinter(f32x16& acc, const LAS unsigned char* qrow, int swz, int hi, bf16x8 xb0, bf16x8 xb1) {
    const v2u a00 = *(const LAS v2u*)(qrow + (((I * 32 + 0) * 2) ^ swz) + 8 * hi), a01 = *(const LAS v2u*)(qrow + (((I * 32 + 8) * 2) ^ swz) + 8 * hi);
    const v2u a10 = *(const LAS v2u*)(qrow + (((I * 32 + 16) * 2) ^ swz) + 8 * hi), a11 = *(const LAS v2u*)(qrow + (((I * 32 + 24) * 2) ^ swz) + 8 * hi);
    v4u A0 = {a00.x, a00.y, a01.x, a01.y}, A1 = {a10.x, a10.y, a11.x, a11.y};
    acc = __builtin_amdgcn_mfma_f32_32x32x16_bf16(*reinterpret_cast<bf16x8*>(&A0), xb0, acc, 0, 0, 0);
    acc = __builtin_amdgcn_mfma_f32_32x32x16_bf16(*reinterpret_cast<bf16x8*>(&A1), xb1, acc, 0, 0, 0);
}
}
__device__ __forceinline__ void late_weights(Frame& F, int gw, int NGW) {
    LAS float* scr = (LAS float*)(F.lds + RING_OFF + F.wave * 16384);
    constexpr int I9 = 32 * 64, I10 = 32 * 256, I11 = 128 * 64;
    for (int it = gw; it < I9 + I10 + I11; it += NGW) { int r = it;
        if (r < I9) { tr_item(F.ml_w_out, DM, 0, DM, 64, DM, nullptr, 1.f, F.WmoT, scr, r, F.lane); continue; } r -= I9;
        if (r < I10) { tr_item(F.w_up + (size_t)DM * FF, FF, 0, FF, 256, DM, F.norm_ffn + DM, 1.f, F.WupT1, scr, r, F.lane); continue; } r -= I10;
        tr_item(F.w_dn + (size_t)FF * DM, DM, 0, DM, 64, FF, nullptr, 1.f, F.WdnT1, scr, r, F.lane); }
}
template <int mode> __device__ __forceinline__ void p9a_state(Frame& F) {
    using namespace ml;
    constexpr int NBH = BATCH * MH, NC = T / 64;
    if (F.vcu >= NBH) { if (F.G > NBH && mode != 1) late_weights(F, (F.vcu - NBH) * NWAVES + F.wave, (F.G - NBH) * NWAVES); return; }
    if (mode == 2) return;
    LAS unsigned char* L = F.lds + RING_OFF;
    static_assert(ml::LDS_END_A <= RING_BYTES, "mLSTM pass A LDS");
    const int bh = F.vcu, b = bh / MH, h = bh % MH, w = F.wave, tid = F.tid;
    const size_t mb = (size_t)b * T;
    LAS float* WKL = (LAS float*)(L + A_WK); LAS float* BL = (LAS float*)(L + A_B); LAS float* UL = (LAS float*)(L + A_U); LAS float* MLs = (LAS float*)(L + A_M);
    LAS float* CH = (LAS float*)(L + A_CH);
    const float* igp = F.IG + (size_t)bh * T; const float* lfp = F.LF + (size_t)bh * T;
#pragma unroll
    for (int cc = 0; cc < 4; ++cc) { const int c = 4 * w + cc, t = c * 64 + F.lane; const float ig = igp[t], lf = lfp[t];
        const float bb = scan_sum64(lf), u = ig - bb, Mx = scan_max64(u);
        BL[t] = bb; UL[t] = u; MLs[t] = Mx; if (F.lane == 63) { CH[c] = bb; CH[32 + c] = Mx; } }
    LDS_WAIT(); __syncthreads();
    if (tid == 0) { float m = 0.f; for (int c = 0; c < NC; ++c) { const float mm63 = fmaxf(m, CH[32 + c]); CH[64 + c] = m; CH[96 + c] = __expf(m - mm63); CH[128 + c] = mm63; m = CH[c] + mm63; } }
    LDS_WAIT(); __syncthreads();
    { float* scal = F.SCAL + (size_t)bh * 4 * T;
      for (int t = tid; t < T; t += NTHR) { const int c = t >> 6; const float mst = CH[64 + c], mm = fmaxf(mst, MLs[t]), u = UL[t];
          scal[t] = u; scal[T + t] = mm; scal[2 * T + t] = __expf(mst - mm); scal[3 * T + t] = __expf(-(BL[t] + mm)); WKL[t] = __expf(u - CH[128 + c]); } }
    LDS_WAIT(); __syncthreads();
    f32x16 X[4];
#pragma unroll
    for (int i = 0; i < 4; ++i)
#pragma unroll
        for (int r = 0; r < 16; ++r) X[i][r] = 0.f;
    float nreg = 0.f;
    struct KV { v4u k0, k1, v00, v01, v10, v11; }; KV S0, S1, S2;
    const int lbase = (int)(uintptr_t)L;
#define A_LOAD(cc, S) do { const bf16* rp0 = F.PROJ + (mb + (size_t)(cc) * 64 + sr) * ML_N + sc; const bf16* rp1 = rp0 + 32 * ML_N;                              \
        S.k0 = *(const GAS v4u*)(rp0 + C_MK + h * MDK); S.k1 = *(const GAS v4u*)(rp1 + C_MK + h * MDK);                                                       \
        S.v00 = *(const GAS v4u*)(rp0 + C_MV + h * MDV); S.v01 = *(const GAS v4u*)(rp0 + C_MV + h * MDV + 128); S.v10 = *(const GAS v4u*)(rp1 + C_MV + h * MDV); S.v11 = *(const GAS v4u*)(rp1 + C_MV + h * MDV + 128); } while (0)
#define A_WRITE(cc, S) do { LAS unsigned char* B_ = L + ((cc) & 1) * A_BUF; const float w0 = WKL[(cc) * 64 + sr], w1 = WKL[(cc) * 64 + 32 + sr];            \
        *(LAS v4u*)(B_ + A_KP + v_st(sr, sc)) = wmul8(S.k0, w0); *(LAS v4u*)(B_ + A_KP + v_st(32 + sr, sc)) = wmul8(S.k1, w1);                                \
        *(LAS v4u*)(B_ + A_VS + v_st(sr, sc)) = S.v00; *(LAS v4u*)(B_ + A_VS + 16384 + v_st(sr, sc)) = S.v01;                                                 \
        *(LAS v4u*)(B_ + A_VS + v_st(32 + sr, sc)) = S.v10; *(LAS v4u*)(B_ + A_VS + 16384 + v_st(32 + sr, sc)) = S.v11; } while (0)
    { const int sr = tid >> 4, sc = (tid & 15) * 8; A_LOAD(0, S0); A_WRITE(0, S0); A_LOAD(1, S1); A_LOAD(2, S2); A_LOAD(3, S0); }
    LDS_WAIT(); __syncthreads();
#define A_ITER(cc, SN) do { if ((cc) < NC) {                                                                                                                  \
        int lane_o = F.lane, tid_o = F.tid; asm volatile("" : "+v"(lane_o), "+v"(tid_o));           \
        const int lane = lane_o, sr = tid_o >> 4, sc = (tid_o & 15) * 8;                                                                                         \
        { bf16* st = F.ST + ((((size_t)bh * NC + (cc)) * 8 + w) * 8) * 512 + lane * 8;                                                                           \
          _Pragma("unroll") for (int i = 0; i < 4; ++i) { *(GAS bf16x8*)(st + (i * 2 + 0) * 512) = pack_acc8(X[i], 0); *(GAS bf16x8*)(st + (i * 2 + 1) * 512) = pack_acc8(X[i], 8); } \
          if (w == 4 || w == 5) F.NST[((size_t)bh * NC + (cc)) * 128 + (w - 4) * 64 + lane] = nreg; }                                                            \
        if ((cc) < NC - 1) {                                                                                                                                     \
        const int boff = ((cc) & 1) * A_BUF; const float s_old = CH[96 + (cc)];                                                                                  \
        const int vbK = lbase + boff + A_KP + v_rd_base(lane), vbV = lbase + boff + A_VS + (w >> 2) * 16384 + (w & 3) * 512 + v_rd_base(lane);                   \
        bf16x8 vB[4];                                                                                                                                            \
        { const s16x4 l0 = tr_read<0 * 4096>(vbV), h0 = tr_read<0 * 4096 + 2048>(vbV), l1 = tr_read<1 * 4096>(vbV), h1 = tr_read<1 * 4096 + 2048>(vbV);          \
          const s16x4 l2 = tr_read<2 * 4096>(vbV), h2 = tr_read<2 * 4096 + 2048>(vbV), l3 = tr_read<3 * 4096>(vbV), h3 = tr_read<3 * 4096 + 2048>(vbV);          \
          asm volatile("s_waitcnt lgkmcnt(0)" ::: "memory"); SBAR();                                                                                             \
          vB[0] = pk88(l0, h0); vB[1] = pk88(l1, h1); vB[2] = pk88(l2, h2); vB[3] = pk88(l3, h3); }                                                              \
        _Pragma("unroll") for (int i = 0; i < 4; ++i) _Pragma("unroll") for (int r = 0; r < 16; ++r) X[i][r] *= s_old;                                           \
        cupd<0>(X[0], vbK, vB); cupd<1>(X[1], vbK, vB); cupd<2>(X[2], vbK, vB); cupd<3>(X[3], vbK, vB);                                                          \
        if (w == 4 || w == 5) { const int d = (w - 4) * 64 + lane; float acc = 0.f; const LAS unsigned char* kcol = L + boff + A_KP + ((d >> 5) * 512 + (d & 31) * 2); \
            _Pragma("unroll 1") for (int s8 = 0; s8 < 8; ++s8) {                                                                                                  \
                _Pragma("unroll") for (int e = 0; e < 8; ++e) acc += bf2f(*(const LAS bf16*)(kcol + s8 * 2048 + e * 64)); }                                       \
            nreg = s_old * nreg + acc; }                                                                                                                         \
        if ((cc) + 1 < NC - 1) { A_WRITE((cc) + 1, SN); if ((cc) + 4 < NC - 1) A_LOAD((cc) + 4, SN); }                                                           \
        MBAR(); } } } while (0)
    for (int c = 0; c < NC; c += 3) { A_ITER(c, S1); A_ITER(c + 1, S2); A_ITER(c + 2, S0); }
#undef A_ITER
#undef A_LOAD
#undef A_WRITE
}
__device__ __forceinline__ void p9b_output(Frame& F) {
    using namespace ml;
    constexpr int NC = T / 64, NITEMS = BATCH * MH * NC;
    LAS unsigned char* L = F.lds + RING_OFF;
    static_assert(ml::LDS_END_B <= RING_BYTES, "mLSTM pass B LDS");
    const int w = F.wave, tid = F.tid;
    LAS float* misc = (LAS float*)(L + MISC); LAS float* RSA = misc, * RSB = misc + 64, * QN = misc + 128;
    LAS float* pw = (LAS float*)(L + PW + w * PWB);
    const int lbase = (int)(uintptr_t)L;
    if (tid < 64) RSB[tid] = 0.f;
    f32x4 hg; { const float* gp = F.h_gain + 4 * F.lane; hg = (f32x4){gp[0], gp[1], gp[2], gp[3]}; }
    v4u sq0, sq1, sk0, sk1, sv00, sv01, sv10, sv11; float s_u, s_mm, s_sint, s_nrm; f32x2 s_n;
    LAS float* NBl = misc + 192;
#define B_LOAD(it_) do { const int bh_ = (it_) & 31, c_ = (it_) >> 5, b_ = bh_ / MH, h_ = bh_ % MH;                                                         \
        const bf16* rp0 = F.PROJ + ((size_t)b_ * T + (size_t)c_ * 64 + sr) * ML_N + sc; const bf16* rp1 = rp0 + 32 * ML_N;                                      \
        sq0 = *(const GAS v4u*)(rp0 + C_MQ + h_ * MDK); sq1 = *(const GAS v4u*)(rp1 + C_MQ + h_ * MDK); sk0 = *(const GAS v4u*)(rp0 + C_MK + h_ * MDK); sk1 = *(const GAS v4u*)(rp1 + C_MK + h_ * MDK);   \
        sv00 = *(const GAS v4u*)(rp0 + C_MV + h_ * MDV); sv01 = *(const GAS v4u*)(rp0 + C_MV + h_ * MDV + 128); sv10 = *(const GAS v4u*)(rp1 + C_MV + h_ * MDV); sv11 = *(const GAS v4u*)(rp1 + C_MV + h_ * MDV + 128); \
        const float* sp_ = F.SCAL + (size_t)bh_ * 4 * T + c_ * 64 + lane; s_u = sp_[0]; s_mm = sp_[T]; s_sint = sp_[2 * T]; s_nrm = sp_[3 * T];                                                \
        s_n = *(const GAS f32x2*)(F.NST + ((size_t)bh_ * NC + c_) * 128 + 2 * lane); } while (0)
#define B_WRITE() do { pw[lane] = s_u; pw[64 + lane] = s_mm; if (w == 3) *(LAS f32x2*)(NBl + 2 * lane) = s_n;                                                                                            \
        *(LAS v4u*)(L + QS + SW16(sr, sc * 2)) = sq0; *(LAS v4u*)(L + QS + SW16(32 + sr, sc * 2)) = sq1;                                                \
        *(LAS v4u*)(L + KS + SW16(sr, sc * 2)) = sk0; *(LAS v4u*)(L + KS + SW16(32 + sr, sc * 2)) = sk1;                                                \
        *(LAS v4u*)(L + VS + v_st(sr, sc)) = sv00; *(LAS v4u*)(L + VS + 16384 + v_st(sr, sc)) = sv01;                                                   \
        *(LAS v4u*)(L + VS + v_st(32 + sr, sc)) = sv10; *(LAS v4u*)(L + VS + 16384 + v_st(32 + sr, sc)) = sv11; } while (0)
    int it = F.vcu; if (it >= NITEMS) return;
    float c_sint, c_nrm;
    { const int lane = F.lane, sr = tid >> 4, sc = (tid & 15) * 8; B_LOAD(it); B_WRITE(); c_sint = s_sint; c_nrm = s_nrm; if (it + F.G < NITEMS) B_LOAD(it + F.G); }
    LDS_WAIT(); __syncthreads();
    for (; it < NITEMS; it += F.G) {
        const int bh = it & 31, c = it >> 5, b = bh / MH, h = bh % MH, t0 = c * 64; const size_t mb = (size_t)b * T;
        int lane_o = F.lane, tid_o = F.tid; asm volatile("" : "+v"(lane_o), "+v"(tid_o));
        const int lane = lane_o, r32 = lane & 31, hi = lane >> 5, sr = tid_o >> 4, sc = (tid_o & 15) * 8;
        const int vbV = lbase + VS + (w >> 2) * 16384 + (w & 3) * 512 + v_rd_base(lane);
        bf16x8 xb[4][2];
        { const bf16* st = F.ST + ((((size_t)bh * NC + c) * 8 + w) * 8) * 512 + lane * 8;
#pragma unroll
          for (int i = 0; i < 4; ++i) { xb[i][0] = __builtin_nontemporal_load((const GAS bf16x8*)(st + (i * 2 + 0) * 512)); xb[i][1] = __builtin_nontemporal_load((const GAS bf16x8*)(st + (i * 2 + 1) * 512)); } }
        if (w < 3) { const int lt = w ? 1 : 0, st = w == 2 ? 1 : 0; const int srow = r32 + 32 * st, lrow = r32 + 32 * lt;
            f32x16 p;
#pragma unroll
            for (int r = 0; r < 16; ++r) p[r] = 0.f;
#pragma unroll
            for (int kk = 0; kk < 8; ++kk) { const bf16x8 ka = *(const LAS bf16x8*)(L + KS + SW16(srow, (16 * kk + 8 * hi) * 2)), qb = *(const LAS bf16x8*)(L + QS + SW16(lrow, (16 * kk + 8 * hi) * 2));
                p = __builtin_amdgcn_mfma_f32_32x32x16_bf16(ka, qb, p, 0, 0, 0); }
            const float mml = pw[64 + lrow]; float ps = 0.f;
#pragma unroll
            for (int r = 0; r < 16; ++r) { const int s = crow(r, hi) + 32 * st; const float us = pw[s]; const float wgt = (s <= lrow) ? __expf(us - mml) : 0.f; p[r] *= wgt; ps += p[r]; }
            { auto rr = __builtin_amdgcn_permlane32_swap(__float_as_uint(ps), __float_as_uint(ps), false, false); ps = __uint_as_float(rr[0]) + __uint_as_float(rr[1]); }
            if (hi == 0) { if (st == 0) RSA[lrow] = ps; else RSB[lrow] = ps; }
            bf16x8 pa0, pa1;
#define PK4(P, BASE, OUT) do { unsigned a0 = cvtpk(P[BASE + 0], P[BASE + 1]), a1 = cvtpk(P[BASE + 2], P[BASE + 3]);   \
    unsigned b0 = cvtpk(P[BASE + 4], P[BASE + 5]), b1 = cvtpk(P[BASE + 6], P[BASE + 7]);                              \
    auto r0 = __builtin_amdgcn_permlane32_swap(a0, b0, false, false); auto r1 = __builtin_amdgcn_permlane32_swap(a1, b1, false, false); \
    v4u w_ = {r0[0], r1[0], r0[1], r1[1]}; OUT = *reinterpret_cast<bf16x8*>(&w_); } while (0)
            PK4(p, 0, pa0); PK4(p, 8, pa1);
#undef PK4
            *(LAS bf16x8*)(L + PF + (lt * 4 + 2 * st + 0) * 1024 + lane * 16) = pa0; *(LAS bf16x8*)(L + PF + (lt * 4 + 2 * st + 1) * 1024 + lane * 16) = pa1;
        } else if (w == 3) { const LAS float* nb = NBl; float acc = 0.f;
#pragma unroll 2
            for (int ch = 0; ch < 16; ++ch) { const v4u qv = *(const LAS v4u*)(L + QS + SW16(lane, ch * 16)); const f32x4 n0 = *(const LAS f32x4*)(nb + 8 * ch), n1 = *(const LAS f32x4*)(nb + 8 * ch + 4);
                acc += bflo(qv.x) * n0.x + bfhi(qv.x) * n0.y + bflo(qv.y) * n0.z + bfhi(qv.y) * n0.w + bflo(qv.z) * n1.x + bfhi(qv.z) * n1.y + bflo(qv.w) * n1.z + bfhi(qv.w) * n1.w; }
            QN[lane] = acc;
        }
        MBAR();
        { const float den = RSA[lane] + RSB[lane] + c_sint * QN[lane]; const float rinv = 1.f / fmaxf(fabsf(den), c_nrm); pw[192 + lane] = rinv; pw[256 + lane] = c_sint * rinv; }
        bf16x8 vB[4];
        { const s16x4 l0 = tr_read<0 * 4096>(vbV), h0 = tr_read<0 * 4096 + 2048>(vbV), l1 = tr_read<1 * 4096>(vbV), h1 = tr_read<1 * 4096 + 2048>(vbV);
          const s16x4 l2 = tr_read<2 * 4096>(vbV), h2 = tr_read<2 * 4096 + 2048>(vbV), l3 = tr_read<3 * 4096>(vbV), h3 = tr_read<3 * 4096 + 2048>(vbV);
          asm volatile("s_waitcnt lgkmcnt(0)" ::: "memory"); SBAR();
          vB[0] = pk88(l0, h0); vB[1] = pk88(l1, h1); vB[2] = pk88(l2, h2); vB[3] = pk88(l3, h3); }
        f32x16 aI0, aI1;
#pragma unroll
        for (int r = 0; r < 16; ++r) { aI0[r] = 0.f; aI1[r] = 0.f; }
        { const LAS unsigned char* qrow0 = L + QS + r32 * 256; const LAS unsigned char* qrow1 = qrow0 + 32 * 256; const int swz = (r32 & 15) << 4;
#define YI(I) do { yinter<I>(aI0, qrow0, swz, hi, xb[I][0], xb[I][1]); yinter<I>(aI1, qrow1, swz, hi, xb[I][0], xb[I][1]); } while (0)
          YI(0); YI(1); YI(2); YI(3);
#undef YI
        }
        v2u og[8];
#pragma unroll
        for (int e = 0; e < 8; ++e) og[e] = *(const GAS v2u*)(F.PROJ + (mb + t0 + 8 * w + e) * ML_N + C_MO + h * MDV + 4 * lane);
#pragma unroll
        for (int lt = 0; lt < 2; ++lt) { f32x16 aY;
#pragma unroll
            for (int r = 0; r < 16; ++r) aY[r] = 0.f;
            { const bf16x8 p0 = *(const LAS bf16x8*)(L + PF + (lt * 4 + 0) * 1024 + lane * 16), p1 = *(const LAS bf16x8*)(L + PF + (lt * 4 + 1) * 1024 + lane * 16);
              aY = __builtin_amdgcn_mfma_f32_32x32x16_bf16(p0, vB[0], aY, 0, 0, 0); aY = __builtin_amdgcn_mfma_f32_32x32x16_bf16(p1, vB[1], aY, 0, 0, 0); }
            if (lt == 1) { const bf16x8 p2 = *(const LAS bf16x8*)(L + PF + (4 + 2) * 1024 + lane * 16), p3 = *(const LAS bf16x8*)(L + PF + (4 + 3) * 1024 + lane * 16);
              aY = __builtin_amdgcn_mfma_f32_32x32x16_bf16(p2, vB[2], aY, 0, 0, 0); aY = __builtin_amdgcn_mfma_f32_32x32x16_bf16(p3, vB[3], aY, 0, 0, 0); }
#pragma unroll
            for (int r = 0; r < 16; ++r) { const int l = crow(r, hi) + 32 * lt; const float y = aY[r] * pw[192 + l] + (lt ? aI1[r] : aI0[r]) * pw[256 + l];
                *(LAS bf16*)(L + HS + l * HROW + (32 * w + r32) * 2) = (bf16)f2bf(y); }
        }
        MBAR();
#pragma unroll
        for (int e = 0; e < 8; ++e) { const int l = 8 * w + e; const v2u hv = *(const LAS v2u*)(L + HS + l * HROW + lane * 8);
            const float h0 = bflo(hv.x), h1 = bfhi(hv.x), h2 = bflo(hv.y), h3 = bfhi(hv.y);
            const float ss = wave_sum_dpp((h0 * h0 + h1 * h1) + (h2 * h2 + h3 * h3)); const float rn = __builtin_amdgcn_rsqf(ss * (1.f / MDV) + EPS);
            const float o0 = bflo(og[e].x), o1 = bfhi(og[e].x), o2 = bflo(og[e].y), o3 = bfhi(og[e].y);
            const float y0 = h0 * rn * hg.x / (1.f + __expf(-o0)), y1 = h1 * rn * hg.y / (1.f + __expf(-o1)), y2 = h2 * rn * hg.z / (1.f + __expf(-o2)), y3 = h3 * rn * hg.w / (1.f + __expf(-o3));
            v2u ov; ov.x = cvtpk(y0, y1); ov.y = cvtpk(y2, y3);
            *(GAS v2u*)(F.O + (mb + t0 + l) * DM + h * MDV + 4 * lane) = ov; }
        if (it + F.G < NITEMS) { B_WRITE(); c_sint = s_sint; c_nrm = s_nrm; if (it + 2 * F.G < NITEMS) B_LOAD(it + 2 * F.G); }
        MBAR();
    }
#undef B_LOAD
#undef B_WRITE
}
#undef SW16
#undef SBAR
#undef MBAR
namespace mlh {
constexpr int WREG = 12288, KIMG = 0, VIMG = 8192, XB0 = 8 * WREG, XBSZ = 16384 + 1024, WKO = XB0 + 2 * XBSZ, CHO = WKO + 8192, FLAGO = CHO + 1024, LDS_END = FLAGO + 64;
constexpr int TB = 0, TU = 8192, TM = 16384;
__device__ __forceinline__ int kh_st(int k, int c) { const int kk = (k & ~0xC) | ((k & 4) << 1) | ((k & 8) >> 1); return ((kk >> 3) * 2 + (c >> 5)) * 512 + ((kk & 7) * 32 + (c & 31)) * 2; }
__device__ __forceinline__ int vs_st(int k, int c) { const int kk = (k & ~0xC) | ((k & 4) << 1) | ((k & 8) >> 1); return (kk >> 3) * 512 + ((kk & 7) * 32 + c) * 2; }
using att::tr_read; using att::v_rd_base; using att::cvtpk; using ml::pk88; using ml::pack_acc8; using ml::wmul8; using ml::scan_sum64; using ml::scan_max64;
template <bool WITHN> __device__ __forceinline__ void dhalf(f32x16& D0, f32x16& D1, float& n0, float& n1, int vbK, const bf16x8 (&vB)[4]) {
    const bf16x8 ones = (bf16x8){0x3f80, 0x3f80, 0x3f80, 0x3f80, 0x3f80, 0x3f80, 0x3f80, 0x3f80};
    f32x16 N0, N1;
    if (WITHN) {
#pragma unroll
        for (int r = 0; r < 16; ++r) { N0[r] = 0.f; N1[r] = 0.f; } }
#define DH_STEP(KS) do { const s16x4 l0 = tr_read<0 * 512 + KS * 2048>(vbK), h0 = tr_read<0 * 512 + KS * 2048 + 1024>(vbK), l1 = tr_read<1 * 512 + KS * 2048>(vbK), h1 = tr_read<1 * 512 + KS * 2048 + 1024>(vbK); \
        asm volatile("s_waitcnt lgkmcnt(0)" ::: "memory"); __builtin_amdgcn_sched_barrier(0);                                                                           \
        const bf16x8 a0 = pk88(l0, h0), a1 = pk88(l1, h1);                                                                                                               \
        D0 = __builtin_amdgcn_mfma_f32_32x32x16_bf16(a0, vB[KS], D0, 0, 0, 0); D1 = __builtin_amdgcn_mfma_f32_32x32x16_bf16(a1, vB[KS], D1, 0, 0, 0);                      \
        if (WITHN) { N0 = __builtin_amdgcn_mfma_f32_32x32x16_bf16(ones, a0, N0, 0, 0, 0); N1 = __builtin_amdgcn_mfma_f32_32x32x16_bf16(ones, a1, N1, 0, 0, 0); } } while (0)
    DH_STEP(0); DH_STEP(1); DH_STEP(2); DH_STEP(3);
#undef DH_STEP
    if (WITHN) { n0 = N0[0]; n1 = N1[0]; }
}
}
template <bool WITHN> __device__ __forceinline__ void p10_chain(Frame& F, int bh, int js) {
    using namespace mlh;
    constexpr int NC = T / 64;
    LAS unsigned char* L = F.lds + RING_OFF;
    const int b = bh / MH, h = bh % MH, w = F.wave, lane = F.lane;
    const size_t mb = (size_t)b * T;
    LAS unsigned char* R = L + w * WREG;
    const LAS float* WKL = (const LAS float*)(L + WKO); const LAS float* CH = (const LAS float*)(L + CHO);
    volatile LAS unsigned* flag = (volatile LAS unsigned*)(L + FLAGO);
    const int lbase = (int)(uintptr_t)R;
    const int vbK = lbase + KIMG + v_rd_base(lane), vbV = lbase + VIMG + v_rd_base(lane);
    v4u ka[8], va[4];
    const int krow = lane >> 3, kc16 = lane & 7, vrow = lane >> 2, vc16 = lane & 3;
#define H_LOADK(cc, hh) do { const bf16* kp = F.PROJ + (mb + (size_t)(cc) * 64 + krow) * ML_N + C_MK + h * MDK + (hh) * 64 + 8 * kc16;                      \
        _Pragma("unroll") for (int e = 0; e < 8; ++e) ka[e] = *(const GAS v4u*)(kp + (size_t)(8 * e) * ML_N); } while (0)
#define H_LOADV(cc) do { const bf16* vp = F.PROJ + (mb + (size_t)(cc) * 64 + vrow) * ML_N + C_MV + h * MDV + js * 32 + 8 * vc16;                           \
        _Pragma("unroll") for (int e = 0; e < 4; ++e) va[e] = *(const GAS v4u*)(vp + (size_t)(16 * e) * ML_N); } while (0)
#define H_WRITEK(cc) do { _Pragma("unroll") for (int e = 0; e < 8; ++e) { const int s = 8 * e + krow; *(LAS v4u*)(R + KIMG + kh_st(s, 8 * kc16)) = wmul8(ka[e], WKL[(cc) * 64 + s]); } } while (0)
#define H_WRITEV() do { _Pragma("unroll") for (int e = 0; e < 4; ++e) { const int s = 16 * e + vrow; *(LAS v4u*)(R + VIMG + vs_st(s, 8 * vc16)) = va[e]; } } while (0)
    f32x16 D[4]; float dn[4] = {0.f, 0.f, 0.f, 0.f};
    if (w < NC - 1) { H_LOADK(w, 0); H_LOADV(w); }
#pragma unroll 1
    for (int r = 0; r < NC / 8; ++r) { const int c = w + 8 * r;
        if (c < NC - 1) {
#pragma unroll
            for (int i = 0; i < 4; ++i)
#pragma unroll
                for (int q = 0; q < 16; ++q) D[i][q] = 0.f;
            H_WRITEK(c); H_WRITEV(); H_LOADK(c, 1);
            bf16x8 vB[4];
            { const s16x4 l0 = tr_read<0 * 1024>(vbV), h0 = tr_read<0 * 1024 + 512>(vbV), l1 = tr_read<1 * 1024>(vbV), h1 = tr_read<1 * 1024 + 512>(vbV);
              const s16x4 l2 = tr_read<2 * 1024>(vbV), h2 = tr_read<2 * 1024 + 512>(vbV), l3 = tr_read<3 * 1024>(vbV), h3 = tr_read<3 * 1024 + 512>(vbV);
              asm volatile("s_waitcnt lgkmcnt(0)" ::: "memory"); __builtin_amdgcn_sched_barrier(0);
              vB[0] = pk88(l0, h0); vB[1] = pk88(l1, h1); vB[2] = pk88(l2, h2); vB[3] = pk88(l3, h3); }
            dhalf<WITHN>(D[0], D[1], dn[0], dn[1], vbK, vB);
            H_WRITEK(c);
            if (c + 8 < NC - 1) { H_LOADK(c + 8, 0); }
            dhalf<WITHN>(D[2], D[3], dn[2], dn[3], vbK, vB);
            if (c + 8 < NC - 1) { H_LOADV(c + 8); }
        }
        f32x16 X[4]; float nn[4] = {0.f, 0.f, 0.f, 0.f};
        if (c > 0) { while (*flag < (unsigned)c) __builtin_amdgcn_s_sleep(1);
            asm volatile("" ::: "memory");
            const LAS unsigned char* xb = L + XB0 + (c & 1) * XBSZ;
#pragma unroll
            for (int i = 0; i < 4; ++i)
#pragma unroll
                for (int q = 0; q < 4; ++q) { const f32x4 v = *(const LAS f32x4*)(xb + ((i * 4 + q) * 64 + lane) * 16); X[i][4 * q] = v.x; X[i][4 * q + 1] = v.y; X[i][4 * q + 2] = v.z; X[i][4 * q + 3] = v.w; }
            if (WITHN) {
#pragma unroll
                for (int i = 0; i < 4; ++i) nn[i] = *(const LAS float*)(xb + 16384 + (i * 32 + (lane & 31)) * 4); }
        } else {
#pragma unroll
            for (int i = 0; i < 4; ++i)
#pragma unroll
                for (int q = 0; q < 16; ++q) X[i][q] = 0.f;
        }
        { bf16* st = F.ST + ((((size_t)bh * NC + c) * 8 + js) * 8) * 512 + lane * 8;
#pragma unroll
          for (int i = 0; i < 4; ++i) { *(GAS bf16x8*)(st + (i * 2 + 0) * 512) = pack_acc8(X[i], 0); *(GAS bf16x8*)(st + (i * 2 + 1) * 512) = pack_acc8(X[i], 8); }
          if (WITHN && lane < 32) {
#pragma unroll
              for (int i = 0; i < 4; ++i) F.NST[((size_t)bh * NC + c) * 128 + i * 32 + lane] = nn[i]; } }
        if (c < NC - 1) { const float s_old = CH[96 + c]; LAS unsigned char* xo = L + XB0 + ((c + 1) & 1) * XBSZ;
#pragma unroll
            for (int i = 0; i < 4; ++i)
#pragma unroll
                for (int q = 0; q < 4; ++q) { f32x4 v; v.x = s_old * X[i][4 * q] + D[i][4 * q]; v.y = s_old * X[i][4 * q + 1] + D[i][4 * q + 1]; v.z = s_old * X[i][4 * q + 2] + D[i][4 * q + 2]; v.w = s_old * X[i][4 * q + 3] + D[i][4 * q + 3];
                    *(LAS f32x4*)(xo + ((i * 4 + q) * 64 + lane) * 16) = v; }
            if (WITHN && lane < 32) {
#pragma unroll
                for (int i = 0; i < 4; ++i) *(LAS float*)(xo + 16384 + (i * 32 + lane) * 4) = s_old * nn[i] + dn[i]; }
            asm volatile("s_waitcnt lgkmcnt(0)" ::: "memory");
            if (lane == 0) *flag = (unsigned)(c + 1);
        }
    }
#undef H_LOADK
#undef H_LOADV
#undef H_WRITEK
#undef H_WRITEV
}
__device__ __forceinline__ void p10_state_chain(Frame& F) {
    using namespace mlh;
    constexpr int NC = T / 64;
    static_assert(mlh::LDS_END <= RING_BYTES, "mLSTM chain LDS");
    LAS unsigned char* L = F.lds + RING_OFF;
    for (int it = F.vcu; it < BATCH * MH * 8; it += F.G) { const int bh = it >> 3, js = it & 7, w = F.wave, tid = F.tid;
        LAS float* WKL = (LAS float*)(L + WKO); LAS float* BL = (LAS float*)(L + TB); LAS float* UL = (LAS float*)(L + TU); LAS float* MLs = (LAS float*)(L + TM); LAS float* CH = (LAS float*)(L + CHO);
        const float* igp = F.IG + (size_t)bh * T; const float* lfp = F.LF + (size_t)bh * T;
        if (tid == 0) *(LAS unsigned*)(L + FLAGO) = 0u;
#pragma unroll
        for (int cc = 0; cc < 4; ++cc) { const int c = 4 * w + cc, t = c * 64 + F.lane; const float ig = igp[t], lf = lfp[t];
            const float bb = scan_sum64(lf), u = ig - bb, Mx = scan_max64(u);
            BL[t] = bb; UL[t] = u; MLs[t] = Mx; if (F.lane == 63) { CH[c] = bb; CH[32 + c] = Mx; } }
        LDS_WAIT(); __syncthreads();
        if (tid == 0) { float m = 0.f; for (int c = 0; c < NC; ++c) { const float mm63 = fmaxf(m, CH[32 + c]); CH[64 + c] = m; CH[96 + c] = __expf(m - mm63); CH[128 + c] = mm63; m = CH[c] + mm63; } }
        LDS_WAIT(); __syncthreads();
        { float* scal = F.SCAL + (size_t)bh * 4 * T;
          for (int t = tid; t < T; t += NTHR) { const int c = t >> 6; const float mst = CH[64 + c], mm = fmaxf(mst, MLs[t]), u = UL[t];
              if (js == 0) { scal[t] = u; scal[T + t] = mm; scal[2 * T + t] = __expf(mst - mm); scal[3 * T + t] = __expf(-(BL[t] + mm)); }
              WKL[t] = __expf(u - CH[128 + c]); } }
        LDS_WAIT(); __syncthreads();
        if (js == 0) p10_chain<true>(F, bh, js); else p10_chain<false>(F, bh, js);
        LDS_WAIT(); __syncthreads();
    }
}
#if ORA_IDX
__global__ __launch_bounds__(256) void ora_indexer(const bf16* QI, const bf16* KI, const float* WI, u64* MASK) {
    __shared__ float qi[1024]; __shared__ float sc[2048]; __shared__ float wi[16]; __shared__ unsigned cnt;
    const int m = blockIdx.x, b = m / T, t = m % T, tid = threadIdx.x;
    for (int i = tid; i < 1024; i += 256) qi[i] = bf2f(QI[(size_t)m * 1024 + i]);
    if (tid < 16) wi[tid] = WI[(size_t)m * 16 + tid];
    __syncthreads();
    for (int s = tid; s < T; s += 256) { float v = -__builtin_inff();
        if (s <= t) { float kk[64]; const v4u* kp = (const v4u*)(KI + (size_t)(b * T + s) * 64);
#pragma unroll
            for (int j = 0; j < 8; ++j) unpack8(kp[j], kk + 8 * j);
            v = 0.f;
            for (int h = 0; h < 16; ++h) { float d = 0.f;
#pragma unroll
                for (int e = 0; e < 64; ++e) d += qi[h * 64 + e] * kk[e];
                v += wi[h] * fmaxf(d, 0.f); } }
        sc[s] = v; }
    __syncthreads();
    unsigned k[8];
#pragma unroll
    for (int j = 0; j < 8; ++j) k[j] = fkey(sc[tid + 256 * j]);
    unsigned P = 0;
    for (int bit = 31; bit >= 0; --bit) { const unsigned cand = P | (1u << bit); unsigned c = 0;
#pragma unroll
        for (int j = 0; j < 8; ++j) c += (k[j] >= cand) ? 1u : 0u;
        if (tid == 0) cnt = 0; __syncthreads(); atomicAdd(&cnt, c); __syncthreads(); if (cnt >= (unsigned)TOPK) P = cand; __syncthreads(); }
    if (tid < 32) { u64 w = 0; for (int e = 0; e < 64; ++e) { const int s = 64 * tid + e; if (s <= t && fkey(sc[s]) >= P) w |= (1ull << e); } MASK[(size_t)m * 32 + tid] = w; }
}
#endif
#if ORA_ATT
__global__ __launch_bounds__(128) void ora_attn(const bf16* Q, const bf16* K, const bf16* V, const u64* MASK, bf16* O) {
    __shared__ float q[4][128]; __shared__ int idx[320]; __shared__ float p[4][320]; __shared__ int cnts[128]; __shared__ int total; __shared__ float linv[4];
    const int m = blockIdx.x >> 2, g = blockIdx.x & 3, b = m / T, tid = threadIdx.x;
    for (int r = 0; r < 4; ++r) q[r][tid] = bf2f(Q[(size_t)m * DM + (g * 4 + r) * HD + tid]);
    const unsigned bits = (unsigned)(MASK[(size_t)m * 32 + (tid >> 2)] >> (16 * (tid & 3))) & 0xffffu;
    cnts[tid] = __builtin_popcount(bits); __syncthreads();
    if (tid == 0) { int a = 0; for (int i = 0; i < 128; ++i) { const int c = cnts[i]; cnts[i] = a; a += c; } total = a; }
    __syncthreads();
    { int o = cnts[tid]; for (int e = 0; e < 16; ++e) if ((bits >> e) & 1u) { if (o < 320) idx[o] = 16 * tid + e; ++o; } }
    __syncthreads();
    const int n = total < 320 ? total : 320;
    for (int j = tid; j < n; j += 128) { const bf16* kr = K + (size_t)(b * T + idx[j]) * 512 + g * HD; float d0 = 0, d1 = 0, d2 = 0, d3 = 0;
        for (int e = 0; e < 128; ++e) { const float kv = bf2f(kr[e]); d0 += q[0][e] * kv; d1 += q[1][e] * kv; d2 += q[2][e] * kv; d3 += q[3][e] * kv; }
        const float sc = 0.08838834764831845f; p[0][j] = d0 * sc; p[1][j] = d1 * sc; p[2][j] = d2 * sc; p[3][j] = d3 * sc; }
    __syncthreads();
    if (tid < 4) { float mx = -__builtin_inff(); for (int j = 0; j < n; ++j) mx = fmaxf(mx, p[tid][j]); float s = 0.f; for (int j = 0; j < n; ++j) { const float e = expf(p[tid][j] - mx); p[tid][j] = e; s += e; } linv[tid] = 1.f / s; }
    __syncthreads();
    float o0 = 0, o1 = 0, o2 = 0, o3 = 0;
    for (int j = 0; j < n; ++j) { const float v = bf2f(V[(size_t)(b * T + idx[j]) * 512 + g * HD + tid]); o0 += p[0][j] * v; o1 += p[1][j] * v; o2 += p[2][j] * v; o3 += p[3][j] * v; }
    bf16* op = O + (size_t)m * DM + g * 4 * HD + tid;
    op[0] = (bf16)f2bf(o0 * linv[0]); op[HD] = (bf16)f2bf(o1 * linv[1]); op[2 * HD] = (bf16)f2bf(o2 * linv[2]); op[3 * HD] = (bf16)f2bf(o3 * linv[3]);
}
#endif
#if ORA_ML
__global__ __launch_bounds__(256) void ora_mlstm(const bf16* PROJ, const float* IG, const float* LF, const float* hgain, bf16* A2) {
    __shared__ float qs[128], ks[128], pr[128], red[4];
    const int b = blockIdx.x / MH, h = blockIdx.x % MH, e = threadIdx.x;
    float C[128]; float nd = 0.f, mst = 0.f;
#pragma unroll
    for (int d = 0; d < 128; ++d) C[d] = 0.f;
    const float hg = hgain[e];
    for (int t = 0; t < T; ++t) { const size_t m = (size_t)b * T + t; const bf16* row = PROJ + m * ML_N;
        const float ig = IG[(size_t)(b * MH + h) * T + t], lf = LF[(size_t)(b * MH + h) * T + t];
        const float mn = fmaxf(lf + mst, ig), fo = expf(lf + mst - mn), io = expf(ig - mn);
        if (e < 128) { const float qv = bf2f(row[C_MQ + h * MDK + e]), kv = bf2f(row[C_MK + h * MDK + e]); nd = fo * nd + io * kv; qs[e] = qv; ks[e] = kv; pr[e] = qv * nd; }
        __syncthreads();
        const float v = bf2f(row[C_MV + h * MDV + e]); float num = 0.f, den = 0.f;
#pragma unroll
        for (int d = 0; d < 128; ++d) { C[d] = fo * C[d] + io * ks[d] * v; num += qs[d] * C[d]; den += pr[d]; }
        const float hv = num / fmaxf(fabsf(den), expf(-mn));
        float s2 = wave_sum(hv * hv); if ((e & 63) == 0) red[e >> 6] = s2;
        __syncthreads();
        const float ssq = (red[0] + red[1]) + (red[2] + red[3]); const float rn = __builtin_amdgcn_rsqf(ssq * (1.f / MDV) + EPS);
        const float og = bf2f(row[C_MO + h * MDV + e]); const float sg = 1.f / (1.f + expf(-og));
        A2[m * DM + h * MDV + e] = (bf16)f2bf(sg * hv * rn * hg);
        mst = mn;
        __syncthreads();
    }
}
#endif
__global__ void __launch_bounds__(NTHR, 2) mk_fwd(Args args) {
    extern __shared__ __attribute__((aligned(16))) unsigned char lds[];
    Frame F;
    F.lds = (LAS unsigned char*)lds;
    F.MISC = (volatile LAS unsigned*)(F.lds + MISC_OFF);
    F.tid = threadIdx.x; F.lane = F.tid & 63; F.wave = __builtin_amdgcn_readfirstlane(F.tid >> 6);
    F.G = gridDim.x; { const int bx = blockIdx.x; F.vcu = (F.G % 8 == 0) ? (bx % 8) * (F.G / 8) + bx / 8 : bx; }
    unsigned char* ws = args.ws;
    F.ctl = (gu32*)(ws + WS_CTL);
    F.x = args.in[0]; F.norm_mix = args.in[1]; F.norm_ffn = args.in[2]; F.att_w_in = args.in[3]; F.q_gain = args.in[4]; F.k_gain = args.in[5]; F.att_w_out = args.in[6];
    F.ml_w_in = args.in[7]; F.b_gate = args.in[8]; F.h_gain = args.in[9]; F.ml_w_out = args.in[10]; F.w_up = args.in[11]; F.w_dn = args.in[12]; F.out = args.out;
    F.WinT = (bf16*)(ws + WS_WIN); F.WsmT = (bf16*)(ws + WS_WSM); F.WoT = (bf16*)(ws + WS_WO); F.WmlT = (bf16*)(ws + WS_WML); F.WgT = (bf16*)(ws + WS_WG); F.WmoT = (bf16*)(ws + WS_WMO);
    F.WupT0 = (bf16*)(ws + WS_WUP0); F.WupT1 = (bf16*)(ws + WS_WUP1); F.WdnT0 = (bf16*)(ws + WS_WDN0); F.WdnT1 = (bf16*)(ws + WS_WDN1);
    F.XB = (bf16*)(ws + WS_XB); F.PROJ = (bf16*)(ws + WS_PROJ); F.Q = (bf16*)(ws + WS_Q); F.K = (bf16*)(ws + WS_K); F.V = (bf16*)(ws + WS_V); F.QI = (bf16*)(ws + WS_QI); F.KI = (bf16*)(ws + WS_KI);
    F.O = (bf16*)(ws + WS_O); F.H = (bf16*)(ws + WS_H); F.WI = (float*)(ws + WS_WI); F.IG = (float*)(ws + WS_GATE); F.LF = (float*)(ws + WS_GATE + 512 * 1024); F.SC = (float*)(ws + WS_SC); F.ST = (bf16*)(ws + WS_SC); F.NST = (float*)(ws + WS_ML); F.SCAL = (float*)(ws + WS_ML + MiB);
    F.ROPE_A = (f32x2*)(ws + WS_ROPE); F.ROPE_I = (f32x2*)(ws + WS_ROPE + 512 * 1024); F.MASK = (u64*)(ws + WS_MASK);
    F.ss0 = (float*)(ws + WS_CTL) + CW_SS; F.ss1 = F.ss0 + M; F.ss2 = F.ss1 + M; F.ss3 = F.ss2 + M;
    for (int u = F.tid; u < (LDS_BYTES - LDSCTL_OFF) / 4; u += NTHR) ((LAS unsigned*)(F.lds + LDSCTL_OFF))[u] = 0u;
    __syncthreads();
    XcdBarrier bar; bar.bar = (unsigned*)(F.ctl + CW_BAR); bar.x = 0; bar.st = nullptr;
    if (!MK_MULTI) bar = xcd_barrier_post((unsigned*)(F.ctl + CW_BAR), F.MISC + 8);
    const int lo = args.ph_lo, hi = args.ph_hi;
#ifdef ONLY_PHASE
#define IN(k) ((k) == ONLY_PHASE && lo <= (k) && (k) < hi)
#else
#define IN(k) (lo <= (k) && (k) < hi)
#endif
#define SEAM(k) do { if (IN(k) && IN((k) + 1)) xcd_barrier(bar); } while (0)
#ifndef PROBE_DBL
#define PROBE_DBL (-1)
#endif
#define REPS(k) for (int rep_ = (F.tid = opaque_tid(), F.lane = F.tid & 63, 0); rep_ < ((k) == PROBE_DBL ? 2 : 1); ++rep_, ((k) == PROBE_DBL && rep_ == 1 ? xcd_barrier(bar) : (void)0))
#define DUMMY(k) ((k) == PROBE_DBL && rep_ == 0)
    float* const dummy_out = (float*)(ws + WS_SC);
    if (IN(0)) REPS(0) { p0_prologue(F); } SEAM(0);
    if (IN(1)) REPS(1) { cvt_slot(F, cvt::E1, cvt::E3, true); pg8::Gemm g{F.XB, F.WinT, M, ATT_N, DM}; pg8::StaticOrder S; S.init(M, ATT_N, F.G, (int)blockIdx.x);
        pg8::EpiScale<0> E{F.PROJ, ATT_N, F.ss0, 1.f / DM, EPS};
        pg8::gemm_phase<pg8::EpiScale<0>, pg8::StaticOrder, PG8_ALIGN, PG8_SP2>(F.lds + RING_OFF, g, S, E);
        skinny_att(F);
#ifdef PROBE_SK
        xcd_barrier(bar); skinny_att(F);
#endif
        cvt_slot(F, cvt::E1, cvt::E3, false); } SEAM(1);
#if IDX_FUSED
    if (IN(3)) REPS(3) {
#if !ORA_IDX
        p3_fused(F);
#endif
    } SEAM(3);
#else
    if (IN(3)) REPS(3) {
#if !ORA_IDX
        p3a_scores(F);
#ifdef PROBE_P3ABL
        xcd_barrier(bar); p3a_scores<PROBE_P3ABL>(F);
#endif
#endif
    } SEAM(3);
    if (IN(4)) REPS(4) {
#if !ORA_IDX
        p3b_select(F);
#endif
    } SEAM(4);
#endif
#ifdef PROBE_BAR
    if (IN(5)) { for (int q = 0; q < 10; ++q) xcd_barrier(bar); }
#endif
    if (IN(5)) REPS(5) {
#if !ORA_ATT
        cvt_slot(F, cvt::E3, cvt::E4, true);
        p4_attention(F, (char*)lds + RING_OFF);
        cvt_slot(F, cvt::E3, cvt::E4, false);
#endif
    } SEAM(5);
    if (IN(6)) REPS(6) { cvt_slot(F, cvt::E4, cvt::E8, true); pg8::Gemm g{F.O, F.WoT, M, DM, DM}; pg8::StaticOrder S; S.init(M, DM, F.G, (int)blockIdx.x);
        pg8::EpiRes E{F.XB, DUMMY(6) ? (bf16*)dummy_out : F.XB, nullptr, DUMMY(6) ? F.ss0 + 4 * M : F.ss1, DM};
        pg8::gemm_phase<pg8::EpiRes, pg8::StaticOrder, PG8_ALIGN, PG8_SP2>(F.lds + RING_OFF, g, S, E); cvt_slot(F, cvt::E4, cvt::E8, false); } SEAM(6);
#ifdef PROBE_NULLEPI
    if (IN(PROBE_NULLEPI)) { xcd_barrier(bar);
#ifndef PROBE_NULLK
#define PROBE_NULLK DM
#endif
        if (PROBE_NULLEPI == 7) { pg8::Gemm g{F.XB, F.WupT0, M, FF, PROBE_NULLK}; pg8::StaticOrder S; S.init(M, FF, F.G, (int)blockIdx.x); pg8::EpiNull E{}; pg8::gemm_phase<pg8::EpiNull, pg8::StaticOrder, PG8_ALIGN, PG8_SP2>(F.lds + RING_OFF, g, S, E); }
        if (PROBE_NULLEPI == 8) { pg8::Gemm g{F.H, F.WdnT0, M, DM, FF}; pg8::StaticOrder S; S.init(M, DM, F.G, (int)blockIdx.x); pg8::EpiNull E{}; pg8::gemm_phase<pg8::EpiNull, pg8::StaticOrder, PG8_ALIGN, PG8_SP2>(F.lds + RING_OFF, g, S, E); }
        xcd_barrier(bar); }
#endif
    if (IN(7)) REPS(7) { cvt_slot(F, cvt::E8, cvt::E10, true); pg8::Gemm g{F.XB, F.WupT0, M, FF, DM}; pg8::StaticOrder S; S.init(M, FF, F.G, (int)blockIdx.x);
        pg8::EpiScale<1> E{F.H, FF, F.ss1, 1.f / DM, EPS};
        pg8::gemm_phase<pg8::EpiScale<1>, pg8::StaticOrder, PG8_ALIGN, PG8_SP2>(F.lds + RING_OFF, g, S, E); cvt_slot(F, cvt::E8, cvt::E10, false); } SEAM(7);
    if (IN(8)) REPS(8) { cvt_slot(F, cvt::E10, cvt::E11, true); pg8::Gemm g{F.H, F.WdnT0, M, DM, FF}; pg8::StaticOrder S; S.init(M, DM, F.G, (int)blockIdx.x);
        pg8::EpiRes E{F.XB, DUMMY(8) ? (bf16*)dummy_out : F.XB, nullptr, DUMMY(8) ? F.ss0 + 4 * M : F.ss2, DM};
        pg8::gemm_phase<pg8::EpiRes, pg8::StaticOrder, PG8_ALIGN, PG8_SP2>(F.lds + RING_OFF, g, S, E); cvt_slot(F, cvt::E10, cvt::E11, false); } SEAM(8);
    if (IN(9)) REPS(9) { pg8::Gemm g{F.XB, F.WmlT, M, ML_N, DM}; pg8::StaticOrder S; S.init(M, ML_N, F.G, (int)blockIdx.x);
        pg8::EpiScale<0> E{F.PROJ, ML_N, F.ss2, 1.f / DM, EPS};
        pg8::gemm_phase<pg8::EpiScale<0>, pg8::StaticOrder, PG8_ALIGN, PG8_SP2>(F.lds + RING_OFF, g, S, E);
        skinny_gates(F); } SEAM(9);
    if (IN(10)) REPS(10) {
#if !ORA_ML
#if ML_CHAIN
        p10_state_chain(F);
#else
        p9a_state<0>(F);
#endif
#ifdef PROBE_SUB
        xcd_barrier(bar); p9a_state<PROBE_SUB>(F);
#endif
#endif
    } SEAM(10);
    if (IN(11)) REPS(11) {
#if !ORA_ML
        p9b_output(F);
#endif
    } SEAM(11);
    if (IN(12)) REPS(12) { pg8::Gemm g{F.O, F.WmoT, M, DM, DM}; pg8::StaticOrder S; S.init(M, DM, F.G, (int)blockIdx.x);
        pg8::EpiRes E{F.XB, DUMMY(12) ? (bf16*)dummy_out : F.XB, nullptr, DUMMY(12) ? F.ss0 + 4 * M : F.ss3, DM};
        pg8::gemm_phase<pg8::EpiRes, pg8::StaticOrder, PG8_ALIGN, PG8_SP2>(F.lds + RING_OFF, g, S, E); } SEAM(12);
    if (IN(13)) REPS(13) { pg8::Gemm g{F.XB, F.WupT1, M, FF, DM}; pg8::StaticOrder S; S.init(M, FF, F.G, (int)blockIdx.x);
        pg8::EpiScale<1> E{F.H, FF, F.ss3, 1.f / DM, EPS};
        pg8::gemm_phase<pg8::EpiScale<1>, pg8::StaticOrder, PG8_ALIGN, PG8_SP2>(F.lds + RING_OFF, g, S, E); } SEAM(13);
    if (IN(14)) REPS(14) { pg8::Gemm g{F.H, F.WdnT1, M, DM, FF}; pg8::StaticOrder S; S.init(M, DM, F.G, (int)blockIdx.x);
        pg8::EpiRes E{F.XB, nullptr, DUMMY(14) ? dummy_out : F.out, nullptr, DM};
        pg8::gemm_phase<pg8::EpiRes, pg8::StaticOrder, PG8_ALIGN, PG8_SP2>(F.lds + RING_OFF, g, S, E); }
#undef IN
#undef SEAM
}

extern "C" void kernel_launch(void* const* d_in, const int* in_sizes, int n_in, void* d_out, int out_size, void* d_ws, size_t ws_size, hipStream_t stream) {
    static int grid = 0;
    if (grid == 0) {
        if (n_in != 13 || in_sizes[0] != M * DM || out_size != M * DM || ws_size < WS_END) { fprintf(stderr, "kernel_launch: shape/workspace mismatch (n_in %d, in0 %d, out %d, ws %zu, need %zu)\n", n_in, n_in > 0 ? in_sizes[0] : -1, out_size, ws_size, (size_t)WS_END); grid = -1; return; }
        int dev = 0, cus = 0, per_cu = 0;
        if (hipGetDevice(&dev) != hipSuccess || hipDeviceGetAttribute(&cus, hipDeviceAttributeMultiprocessorCount, dev) != hipSuccess) { grid = -1; return; }
        if (hipFuncSetAttribute((const void*)mk_fwd, hipFuncAttributeMaxDynamicSharedMemorySize, LDS_BYTES) != hipSuccess) { fprintf(stderr, "kernel_launch: hipFuncSetAttribute failed\n"); grid = -1; return; }
        if (hipOccupancyMaxActiveBlocksPerMultiprocessor(&per_cu, (const void*)mk_fwd, NTHR, LDS_BYTES) != hipSuccess || per_cu < 1) fprintf(stderr, "kernel_launch: occupancy query reports %d blocks per CU\n", per_cu);
        (void)hipGetLastError();
        grid = cus;
    }
    if (grid < 0) return;
    if (hipMemsetAsync((char*)d_ws + WS_CTL, 0, CTL_ZERO_BYTES, stream) != hipSuccess) { fprintf(stderr, "kernel_launch: memset failed\n"); return; }
    Args a{};
    for (int i = 0; i < 13; ++i) a.in[i] = (const float*)d_in[i];
    a.out = (float*)d_out; a.ws = (unsigned char*)d_ws;
#if MK_MULTI
    unsigned char* ws = (unsigned char*)d_ws;
    for (int p = 0; p < N_PHASES; ++p) {
        if (p == 4 && ORA_IDX) continue;
        if (p == 3 && ORA_IDX) {
#if ORA_IDX
            hipLaunchKernelGGL(ora_indexer, dim3(M), dim3(256), 0, stream, (const bf16*)(ws + WS_QI), (const bf16*)(ws + WS_KI), (const float*)(ws + WS_WI), (u64*)(ws + WS_MASK));
#endif
            continue; }
        if (p == 5 && ORA_ATT) {
#if ORA_ATT
            hipLaunchKernelGGL(ora_attn, dim3(M * 4), dim3(128), 0, stream, (const bf16*)(ws + WS_Q), (const bf16*)(ws + WS_K), (const bf16*)(ws + WS_V), (const u64*)(ws + WS_MASK), (bf16*)(ws + WS_O));
#endif
            continue; }
        if (p == 11 && ORA_ML) continue;
        if (p == 10 && ORA_ML) {
#if ORA_ML
            hipLaunchKernelGGL(ora_mlstm, dim3(BATCH * MH), dim3(256), 0, stream, (const bf16*)(ws + WS_PROJ), (const float*)(ws + WS_GATE), (const float*)(ws + WS_GATE + 512 * 1024), (const float*)d_in[9], (bf16*)(ws + WS_O));
#endif
            continue; }
        a.ph_lo = p; a.ph_hi = p + 1; a.li = p;
        hipLaunchKernelGGL(mk_fwd, dim3(grid), dim3(NTHR), LDS_BYTES, stream, a);
    }
#else
    a.ph_lo = 0; a.ph_hi = N_PHASES; a.li = 0;
    hipLaunchKernelGGL(mk_fwd, dim3(grid), dim3(NTHR), LDS_BYTES, stream, a);
#endif
    const hipError_t le = hipPeekAtLastError();
    if (le != hipSuccess) fprintf(stderr, "kernel_launch: launch failed: %s\n", hipGetErrorName(le));
}
```
